# Optimizing an MI355X kernel written in HIP

```python
import numpy as np
import jax
import jax.numpy as jnp
from jax import lax

D_MODEL = 1024
BATCH = 32
SEQ = 2048
DEPTH = 4

HEAD_DIM = 64
QBLOCK = 128
ROPE_THETA = 10000.0
PLE_DIM = 256
LN_EPS = 1e-5
RMS_EPS = 1e-6
NEG = -1e30
BIG = 1e30

A_HEADS = 8
IDX_HEADS = 8
IDX_DIM = 64
DSA_TOPK_MAX = 256

B_HEADS = 8
CMP_LEN = 32
CMP_STRIDE = 16
SEL_LEN = 32
SEL_BLOCKS_MAX = 8
WINDOW = 512

C_HEADS = 16
FORGET_BIAS_INIT = 3.0

N_EXPERTS = 64
TOP_K = 8
N_GROUPS = 8
TOPK_GROUPS = 4
D_EXPERT = 256
ROUTED_SCALE = 2.5
EXPERT_BLOCK = 256

N_EVEN = (DEPTH + 1) // 2
N_ODD = DEPTH // 2
ALPHA = (2.0 * DEPTH) ** 0.25
BETA = (8.0 * DEPTH) ** -0.25

MIX_A = A_HEADS * HEAD_DIM
MIX_B = B_HEADS * HEAD_DIM
MIX_EVEN = MIX_A + MIX_B
MIX_ODD = C_HEADS * HEAD_DIM
EVEN_SPLITS = (MIX_A, HEAD_DIM, HEAD_DIM, IDX_HEADS * IDX_DIM, IDX_DIM, IDX_HEADS, MIX_B, 6 * HEAD_DIM, 3 * B_HEADS)
EVEN_COLS = sum(EVEN_SPLITS)
ODD_SPLITS = (MIX_ODD, MIX_ODD, MIX_ODD, C_HEADS)
ODD_COLS = sum(ODD_SPLITS)

kernel_name = 'hybrid_dsa_nsa_fox_moe_trunk'


def split_cols(h, sizes):
    cuts = [int(c) for c in np.cumsum(sizes)[:-1]]
    return jnp.split(h, cuts, axis=-1)


def rope_tables(pos):
    inv = 1.0 / (ROPE_THETA ** (np.arange(0, HEAD_DIM, 2, dtype=np.float32) / HEAD_DIM))
    ang = pos.astype(jnp.float32)[:, None] * jnp.asarray(inv, dtype=jnp.float32)[None, :]
    return jnp.cos(ang), jnp.sin(ang)


def apply_rope(x, cos, sin):
    if x.ndim == 4:
        cos = cos[:, None, :]
        sin = sin[:, None, :]
    half = x.shape[-1] // 2
    xf = x.astype(jnp.float32)
    x1, x2 = xf[..., :half], xf[..., half:]
    return jnp.concatenate([x1 * cos - x2 * sin, x2 * cos + x1 * sin], axis=-1).astype(x.dtype)


def layer_norm(x, g, b):
    xf = x.astype(jnp.float32)
    mu = jnp.mean(xf, axis=-1, keepdims=True)
    var = jnp.mean(jnp.square(xf - mu), axis=-1, keepdims=True)
    return ((xf - mu) * lax.rsqrt(var + LN_EPS)).astype(x.dtype) * g + b


def rms_norm(x, g):
    xf = x.astype(jnp.float32)
    return (xf * lax.rsqrt(jnp.mean(jnp.square(xf), axis=-1, keepdims=True) + RMS_EPS)).astype(x.dtype) * g


def masked_softmax(s, valid):
    p = jax.nn.softmax(jnp.where(valid, s, NEG), axis=-1)
    return jnp.where(valid, p, 0.0)


def to_blocks(a):
    b, s = a.shape[:2]
    return jnp.swapaxes(a.reshape((b, s // QBLOCK, QBLOCK) + a.shape[2:]), 0, 1)


def from_blocks(a):
    nb, b = a.shape[:2]
    return jnp.swapaxes(a, 0, 1).reshape((b, nb * QBLOCK) + a.shape[3:])


def dsa_attention(q, k, v, q_idx, k_idx, w_idx, pos):
    bsz, s_len = q.shape[:2]
    k_sel = min(DSA_TOPK_MAX, s_len // 4)
    b_idx = jnp.arange(bsz)[:, None, None]
    idx_scale = (IDX_HEADS * IDX_DIM) ** -0.5
    scale = HEAD_DIM ** -0.5

    def block(args):
        qb, qib, wb, t = args
        logits = jnp.einsum('bqhd,bkd->bqhk', qib, k_idx, preferred_element_type=jnp.float32)
        score = jnp.einsum('bqhk,bqh->bqk', jax.nn.relu(logits), wb.astype(jnp.float32)) * idx_scale
        causal = pos[None, :] <= t[:, None]
        score = jnp.where(causal[None], score, NEG)
        _, sel = lax.top_k(score, k_sel)
        ks = k[b_idx, sel]
        vs = v[b_idx, sel]
        valid = (sel <= t[None, :, None])[:, :, None, :]
        s = jnp.einsum('bqhd,bqkd->bqhk', qb, ks, preferred_element_type=jnp.float32) * scale
        pr = masked_softmax(s, valid)
        return jnp.einsum('bqhk,bqkd->bqhd', pr.astype(vs.dtype), vs)

    out = lax.map(block, (to_blocks(q), to_blocks(q_idx), to_blocks(w_idx), pos.reshape(-1, QBLOCK)))
    return from_blocks(out)


def nsa_attention(q, k_cmp, v_cmp, k_slc, v_slc, k_win, v_win, gate_logits,
                  pos_k, w1_k, w2_k, pos_v, w1_v, w2_v, pos, cos, sin):
    bsz, s_len = q.shape[:2]
    n_cmp = (s_len - CMP_LEN) // CMP_STRIDE + 1
    c_start = np.arange(n_cmp) * CMP_STRIDE
    cidx = c_start[:, None] + np.arange(CMP_LEN)[None, :]
    c_last = c_start + CMP_LEN - 1

    def compress(kv, pe, w1, w2):
        blk = (kv[:, cidx] + pe).reshape(bsz, n_cmp, CMP_LEN * HEAD_DIM)
        return jax.nn.silu(blk @ w1) @ w2

    kc = apply_rope(compress(k_cmp, pos_k, w1_k, w2_k), cos[c_last], sin[c_last])
    vc = compress(v_cmp, pos_v, w1_v, w2_v)
    n_sb = s_len // SEL_LEN
    n_sel = min(SEL_BLOCKS_MAX, n_sb)
    s_start = np.arange(n_sb) * SEL_LEN
    ov = np.clip(np.minimum(c_start[:, None] + CMP_LEN, s_start[None, :] + SEL_LEN)
                 - np.maximum(c_start[:, None], s_start[None, :]), 0, None)
    overlap = jnp.asarray(ov / CMP_LEN, dtype=jnp.float32)
    kw_pad = jnp.pad(k_win, ((0, 0), (WINDOW, 0), (0, 0)))
    vw_pad = jnp.pad(v_win, ((0, 0), (WINDOW, 0), (0, 0)))
    b_idx = jnp.arange(bsz)[:, None, None]
    c_last_j = jnp.asarray(c_last)
    s_start_j = jnp.asarray(s_start)
    blk_ids = jnp.arange(n_sb)
    scale = HEAD_DIM ** -0.5

    def block(args):
        qb, gb, t = args
        s_c = jnp.einsum('bqhd,bcd->bqhc', qb, kc, preferred_element_type=jnp.float32) * scale
        valid_c = (c_last_j[None, :] <= t[:, None])[None, :, None, :]
        p_c = masked_softmax(s_c, valid_c)
        o_c = jnp.einsum('bqhc,bcd->bqhd', p_c.astype(vc.dtype), vc, preferred_element_type=jnp.float32)
        imp = jnp.einsum('bqhc,cj->bqj', p_c, overlap)
        cur = t // SEL_LEN
        forced = (blk_ids[None, :] == 0) | (blk_ids[None, :] == cur[:, None]) | (blk_ids[None, :] == cur[:, None] - 1)
        future = s_start_j[None, :] > t[:, None]
        imp = jnp.where(forced[None], BIG, jnp.where(future[None], NEG, imp))
        _, sb = lax.top_k(imp, n_sel)
        tok = (sb[..., None] * SEL_LEN + jnp.arange(SEL_LEN)).reshape(bsz, QBLOCK, n_sel * SEL_LEN)
        ks = k_slc[b_idx, tok]
        vs = v_slc[b_idx, tok]
        valid_s = (tok <= t[None, :, None])[:, :, None, :]
        s_s = jnp.einsum('bqhd,bqkd->bqhk', qb, ks, preferred_element_type=jnp.float32) * scale
        o_s = jnp.einsum('bqhk,bqkd->bqhd', masked_softmax(s_s, valid_s).astype(vs.dtype), vs,
                         preferred_element_type=jnp.float32)
        q0 = t[0]
        kw = lax.dynamic_slice_in_dim(kw_pad, q0, WINDOW + QBLOCK, axis=1)
        vw = lax.dynamic_slice_in_dim(vw_pad, q0, WINDOW + QBLOCK, axis=1)
        kpos = q0 - WINDOW + jnp.arange(WINDOW + QBLOCK)
        valid_w = ((kpos[None, :] <= t[:, None]) & (kpos[None, :] > t[:, None] - WINDOW)
                   & (kpos[None, :] >= 0))[None, :, None, :]
        s_w = jnp.einsum('bqhd,bkd->bqhk', qb, kw, preferred_element_type=jnp.float32) * scale
        o_w = jnp.einsum('bqhk,bkd->bqhd', masked_softmax(s_w, valid_w).astype(vw.dtype), vw,
                         preferred_element_type=jnp.float32)
        g = jax.nn.sigmoid(gb.astype(jnp.float32))
        o = g[..., 0:1] * o_c + g[..., 1:2] * o_s + g[..., 2:3] * o_w
        return o.astype(qb.dtype)

    out = lax.map(block, (to_blocks(q), to_blocks(gate_logits), pos.reshape(-1, QBLOCK)))
    return from_blocks(out)


def fox_attention(q, k, v, log_f, pos):
    dcum = jnp.cumsum(log_f, axis=1)
    d_keys = jnp.transpose(dcum, (0, 2, 1))
    scale = HEAD_DIM ** -0.5

    def block(args):
        qb, db, t = args
        s = jnp.einsum('bqhd,bkhd->bhqk', qb, k, preferred_element_type=jnp.float32) * scale
        s = s + jnp.transpose(db, (0, 2, 1))[..., None] - d_keys[:, :, None, :]
        valid = (pos[None, :] <= t[:, None])[None, None]
        p = masked_softmax(s, valid)
        return jnp.einsum('bhqk,bkhd->bqhd', p.astype(v.dtype), v)

    out = lax.map(block, (to_blocks(q), to_blocks(dcum), pos.reshape(-1, QBLOCK)))
    return from_blocks(out)


def even_mixer(x, w_in, b_gate, pos_k, w1_k, w2_k, pos_v, w1_v, w2_v, w_o, pos, cos, sin):
    bsz, s_len, _ = x.shape
    h = x @ w_in
    q_a, k_a, v_a, q_i, k_i, w_i, q_b, kv_b, g_b = split_cols(h, EVEN_SPLITS)
    q_a = apply_rope(q_a.reshape(bsz, s_len, A_HEADS, HEAD_DIM), cos, sin)
    k_a = apply_rope(k_a, cos, sin)
    q_i = apply_rope(q_i.reshape(bsz, s_len, IDX_HEADS, IDX_DIM), cos, sin)
    k_i = apply_rope(k_i, cos, sin)
    o_a = dsa_attention(q_a, k_a, v_a, q_i, k_i, w_i, pos)
    k_c, v_c, k_s, v_s, k_w, v_w = jnp.split(kv_b, 6, axis=-1)
    q_b = apply_rope(q_b.reshape(bsz, s_len, B_HEADS, HEAD_DIM), cos, sin)
    o_b = nsa_attention(q_b, k_c, v_c, apply_rope(k_s, cos, sin), v_s, apply_rope(k_w, cos, sin), v_w,
                        (g_b + b_gate).reshape(bsz, s_len, B_HEADS, 3),
                        pos_k, w1_k, w2_k, pos_v, w1_v, w2_v, pos, cos, sin)
    o = jnp.concatenate([o_a.reshape(bsz, s_len, MIX_A), o_b.reshape(bsz, s_len, MIX_B)], axis=-1)
    return o @ w_o


def odd_mixer(x, w_in, b_f, w_o, pos):
    bsz, s_len, _ = x.shape
    q, k, v, f = split_cols(x @ w_in, ODD_SPLITS)
    shp = (bsz, s_len, C_HEADS, HEAD_DIM)
    log_f = jax.nn.log_sigmoid((f + b_f).astype(jnp.float32))
    o = fox_attention(q.reshape(shp), k.reshape(shp), v.reshape(shp), log_f, pos)
    return o.reshape(bsz, s_len, MIX_ODD) @ w_o


def grouped_experts(xf, eidx, gates, w1, w3, w2):
    n_tok, d = xf.shape
    tk = n_tok * TOP_K
    n_blocks = (tk + N_EXPERTS * (EXPERT_BLOCK - 1)) // EXPERT_BLOCK + 1
    flat_e = eidx.reshape(tk)
    flat_tok = jnp.arange(tk, dtype=jnp.int32) // TOP_K
    flat_g = gates.reshape(tk)
    order = jnp.argsort(flat_e)
    se = flat_e[order]
    counts = jnp.bincount(flat_e, length=N_EXPERTS)
    padded = (counts + EXPERT_BLOCK - 1) // EXPERT_BLOCK * EXPERT_BLOCK
    start_sorted = jnp.cumsum(counts) - counts
    pad_end = jnp.cumsum(padded)
    start_pad = pad_end - padded
    dest = start_pad[se] + (jnp.arange(tk, dtype=jnp.int32) - start_sorted[se])
    n_slots = n_blocks * EXPERT_BLOCK
    slot_tok = jnp.full((n_slots,), n_tok, jnp.int32).at[dest].set(flat_tok[order])
    slot_gate = jnp.zeros((n_slots,), jnp.float32).at[dest].set(flat_g[order])
    blk_e = jnp.minimum(jnp.searchsorted(pad_end, jnp.arange(n_blocks, dtype=jnp.int32) * EXPERT_BLOCK,
                                         side='right'), N_EXPERTS - 1)
    xpad = jnp.concatenate([xf, jnp.zeros((1, d), xf.dtype)], axis=0)

    def step(out, args):
        tok, g, e = args
        xe = xpad[tok]
        h = jax.nn.silu(xe @ w1[e]) * (xe @ w3[e])
        y = (h @ w2[e]) * g[:, None].astype(xe.dtype)
        return out.at[tok].add(y), None

    out, _ = lax.scan(step, jnp.zeros((n_tok + 1, d), xf.dtype),
                      (slot_tok.reshape(n_blocks, EXPERT_BLOCK), slot_gate.reshape(n_blocks, EXPERT_BLOCK), blk_e))
    return out[:n_tok]


def moe_ffn(x, router_w, router_bias, w1, w3, w2, sw1, sw3, sw2):
    bsz, s_len, d = x.shape
    n_tok = bsz * s_len
    xf = x.reshape(n_tok, d)
    shared = (jax.nn.silu(xf @ sw1) * (xf @ sw3)) @ sw2
    s = jax.nn.sigmoid(jnp.matmul(xf, router_w, preferred_element_type=jnp.float32))
    sb = s + router_bias.astype(jnp.float32)
    gscore = lax.top_k(sb.reshape(n_tok, N_GROUPS, N_EXPERTS // N_GROUPS), 2)[0].sum(-1)
    _, gsel = lax.top_k(gscore, TOPK_GROUPS)
    gmask = jnp.any(gsel[..., None] == jnp.arange(N_GROUPS), axis=-2)
    emask = jnp.repeat(gmask, N_EXPERTS // N_GROUPS, axis=-1)
    _, eidx = lax.top_k(jnp.where(emask, sb, NEG), TOP_K)
    sel = jnp.take_along_axis(s, eidx, axis=-1)
    gates = sel / jnp.sum(sel, axis=-1, keepdims=True) * ROUTED_SCALE
    routed = grouped_experts(xf, eidx, gates, w1, w3, w2)
    return (shared + routed).reshape(bsz, s_len, d)


def setup_inputs(seed: int = 0) -> dict:
    key = jax.random.key(seed)
    ks = jax.random.split(key, 32)

    def nrm(k, shape, scale):
        return jax.random.normal(k, shape, jnp.float32) * scale

    d, f, e = D_MODEL, D_EXPERT, N_EXPERTS
    cl = CMP_LEN * HEAD_DIM
    return {
        'x': nrm(ks[0], (BATCH, SEQ, d), 1.0),
        'p': nrm(ks[1], (DEPTH, BATCH, SEQ, PLE_DIM), 1.0),
        'ev_w_in': nrm(ks[2], (N_EVEN, d, EVEN_COLS), d ** -0.5),
        'ev_b_gate': nrm(ks[3], (N_EVEN, 3 * B_HEADS), 0.1),
        'ev_cmp_pos_k': nrm(ks[4], (N_EVEN, CMP_LEN, HEAD_DIM), 0.1),
        'ev_cmp_w1_k': nrm(ks[5], (N_EVEN, cl, HEAD_DIM), cl ** -0.5),
        'ev_cmp_w2_k': nrm(ks[6], (N_EVEN, HEAD_DIM, HEAD_DIM), HEAD_DIM ** -0.5),
        'ev_cmp_pos_v': nrm(ks[7], (N_EVEN, CMP_LEN, HEAD_DIM), 0.1),
        'ev_cmp_w1_v': nrm(ks[8], (N_EVEN, cl, HEAD_DIM), cl ** -0.5),
        'ev_cmp_w2_v': nrm(ks[9], (N_EVEN, HEAD_DIM, HEAD_DIM), HEAD_DIM ** -0.5),
        'ev_w_o': nrm(ks[10], (N_EVEN, MIX_EVEN, d), BETA * MIX_EVEN ** -0.5),
        'od_w_in': nrm(ks[11], (N_ODD, d, ODD_COLS), d ** -0.5),
        'od_b_f': FORGET_BIAS_INIT + nrm(ks[12], (N_ODD, C_HEADS), 0.1),
        'od_w_o': nrm(ks[13], (N_ODD, MIX_ODD, d), BETA * MIX_ODD ** -0.5),
        'ln1_g': 1.0 + nrm(ks[14], (DEPTH, d), 0.05),
        'ln1_b': nrm(ks[15], (DEPTH, d), 0.02),
        'ln2_g': 1.0 + nrm(ks[16], (DEPTH, d), 0.05),
        'ln2_b': nrm(ks[17], (DEPTH, d), 0.02),
        'router_w': nrm(ks[18], (DEPTH, d, e), d ** -0.5),
        'router_bias': nrm(ks[19], (DEPTH, e), 0.01),
        'exp_w1': nrm(ks[20], (DEPTH, e, d, f), d ** -0.5),
        'exp_w3': nrm(ks[21], (DEPTH, e, d, f), d ** -0.5),
        'exp_w2': nrm(ks[22], (DEPTH, e, f, d), BETA * f ** -0.5),
        'sh_w1': nrm(ks[23], (DEPTH, d, f), d ** -0.5),
        'sh_w3': nrm(ks[24], (DEPTH, d, f), d ** -0.5),
        'sh_w2': nrm(ks[25], (DEPTH, f, d), BETA * f ** -0.5),
        'ple_w_gate': nrm(ks[26], (DEPTH, d, d), d ** -0.5),
        'ple_w_proj': nrm(ks[27], (DEPTH, PLE_DIM, d), PLE_DIM ** -0.5),
        'ple_norm_g': 1.0 + nrm(ks[28], (DEPTH, d), 0.05),
    }


def reference(x, p, ev_w_in, ev_b_gate, ev_cmp_pos_k, ev_cmp_w1_k, ev_cmp_w2_k,
              ev_cmp_pos_v, ev_cmp_w1_v, ev_cmp_w2_v, ev_w_o, od_w_in, od_b_f, od_w_o,
              ln1_g, ln1_b, ln2_g, ln2_b, router_w, router_bias, exp_w1, exp_w3, exp_w2,
              sh_w1, sh_w3, sh_w2, ple_w_gate, ple_w_proj, ple_norm_g):
    s_len = x.shape[1]
    pos = jnp.arange(s_len, dtype=jnp.int32)
    cos, sin = rope_tables(pos)
    for i in range(DEPTH):
        j = i // 2
        if i % 2 == 0:
            h = even_mixer(x, ev_w_in[j], ev_b_gate[j], ev_cmp_pos_k[j], ev_cmp_w1_k[j], ev_cmp_w2_k[j],
                           ev_cmp_pos_v[j], ev_cmp_w1_v[j], ev_cmp_w2_v[j], ev_w_o[j], pos, cos, sin)
        else:
            h = odd_mixer(x, od_w_in[j], od_b_f[j], od_w_o[j], pos)
        x = layer_norm(ALPHA * x + h, ln1_g[i], ln1_b[i])
        m = moe_ffn(x, router_w[i], router_bias[i], exp_w1[i], exp_w3[i], exp_w2[i],
                    sh_w1[i], sh_w3[i], sh_w2[i])
        x = layer_norm(ALPHA * x + m, ln2_g[i], ln2_b[i])
        e_i = rms_norm(p[i] @ ple_w_proj[i], ple_norm_g[i])
        x = x + jax.nn.sigmoid(x @ ple_w_gate[i]) * e_i
    return x
```

```cpp
#include <hip/hip_runtime.h>
#include <cstdio>
#include <cstdint>

#define LAS __attribute__((address_space(3)))
#define GAS __attribute__((address_space(1)))
typedef unsigned short bf16_t;
typedef short bf16x8 __attribute__((ext_vector_type(8)));
typedef short s16x4 __attribute__((ext_vector_type(4)));
typedef float f32x2 __attribute__((ext_vector_type(2)));
typedef float f32x4 __attribute__((ext_vector_type(4)));
typedef float f32x16 __attribute__((ext_vector_type(16)));
typedef unsigned u32x2 __attribute__((ext_vector_type(2)));
typedef unsigned u32x4 __attribute__((ext_vector_type(4)));
typedef GAS unsigned gu32;

#ifndef MK_ONE_LAUNCH
#define MK_ONE_LAUNCH 0
#endif

constexpr int DM = 1024, NB = 32, SEQ = 2048, DEPTH = 4, T = NB * SEQ;
constexpr int EVEN_COLS = 2144, ODD_COLS = 3088, NE_PAD = 2304, NO_PAD = 3328;
constexpr int NEXP = 64, NV = 130  , HALF_T = T / 2, DFF = 256;
constexpr float LN_EPS = 1e-5f, RMS_EPS = 1e-6f;
constexpr float ALPHA = 1.6817928305074290f;
constexpr float LOG2E = 1.4426950408889634f;
constexpr float QK_C = 0.125f * LOG2E;
constexpr float NEGBIG = -1e30f;

constexpr int EC_QA = 0, EC_QB = 512, EC_QI = 1024, EC_KA = 1536, EC_KI = 1600, EC_KS = 1664, EC_KW = 1728;
constexpr int EC_VA = 1792, EC_KC = 1856, EC_VC = 1920, EC_VS = 1984, EC_VW = 2048, EC_WI = 2112, EC_GB = 2120;

constexpr size_t MiB = 1u << 20;
constexpr size_t WS_CTL = 0, CTL_BYTES = 1 * MiB;
constexpr size_t WS_ROPE_COS = 1 * MiB, WS_ROPE_SIN = WS_ROPE_COS + 256 * 1024;
constexpr size_t WS_SLOT_TK = 2 * MiB;
constexpr size_t WS_SLOT_G = WS_SLOT_TK + (size_t)NV * HALF_T * 4;
constexpr size_t WS_DCUM = 38 * MiB;
constexpr size_t WS_LOGF = 42 * MiB;
constexpr size_t WS_KC = 46 * MiB, WS_VC = WS_KC + 512 * 1024;
constexpr size_t WS_SSQ = 47 * MiB;
constexpr size_t WS_PB = 51 * MiB;
constexpr size_t WS_MISC = 83 * MiB;
constexpr size_t WS_XB = 84 * MiB;
constexpr size_t WS_W = 212 * MiB;
constexpr size_t W_IN = 0, W_O = 7 * MiB, W_G = 9 * MiB, W_P = 11 * MiB, W_C1K = 12 * MiB, W_C1V = W_C1K + 256 * 1024, W_C2K = W_C1V + 256 * 1024, W_C2V = W_C2K + 8192;
constexpr size_t W_UP = 16 * MiB  , W_DN = 82 * MiB  ;
constexpr size_t WS_R = 340 * MiB;
constexpr size_t R_H = 0, R_HMID = 0, R_E = 0, R_YTOK = 320 * MiB, R_XB2 = 440 * MiB;
constexpr size_t WS_END = WS_R + 896 * MiB;
static_assert(R_YTOK + (size_t)HALF_T * 9 * 1024 * 2 <= 896 * MiB, "ytok");
static_assert(W_DN + 65ull * 1024 * 256 * 2 <= 128 * MiB, "w");
constexpr int CW_BAR = 4096;
constexpr int CW_CNT = 16384;
constexpr int XBW = 3456;

constexpr int RING_BYTES = 131072;
constexpr int LDS_TAB = RING_BYTES;
constexpr int LDS_MISC = RING_BYTES + 20480;
constexpr int LDS_BYTES = RING_BYTES + 20480 + 256;

#define LDS_WAIT() asm volatile("s_waitcnt lgkmcnt(0)" ::: "memory")
#define VM_WAIT() asm volatile("s_waitcnt vmcnt(0)" ::: "memory")
#define RLX_AGENT __ATOMIC_RELAXED, __HIP_MEMORY_SCOPE_AGENT
__device__ __forceinline__ unsigned f2bf(float f) { unsigned u = __builtin_bit_cast(unsigned, f); return (u + 0x7fffu + ((u >> 16) & 1u)) >> 16; }
__device__ __forceinline__ unsigned pk2(float lo, float hi) { return f2bf(lo) | (f2bf(hi) << 16); }
__device__ __forceinline__ float bf2f(unsigned short h) { return __builtin_bit_cast(float, (unsigned)h << 16); }
__device__ __forceinline__ float bflo(unsigned w) { return __builtin_bit_cast(float, w << 16); }
__device__ __forceinline__ float bfhi(unsigned w) { return __builtin_bit_cast(float, w & 0xffff0000u); }
__device__ __forceinline__ float wave_sum(float v) {
#pragma unroll
    for (int o = 1; o < 64; o <<= 1) v += __shfl_xor(v, o);
    return v;
}
__device__ __forceinline__ float fast_exp2(float x) { return __builtin_amdgcn_exp2f(x); }
__device__ __forceinline__ float sigmoidf_(float x) { return 1.0f / (1.0f + __expf(-x)); }

#define XB_TMO      128
#define XB_XCNT(j)  (256  + 64 * (j))
#define XB_XSUB(j)  (1280 + 64 * (j))
#define XB_XGEN(j)  (2304 + 64 * (j))
#define XB_TOP      3328
#define XB_TOPGEN   3392
#define XCD_BAR_WORDS 3456
#define XB_SPIN_CAP (1u << 22)
__device__ __forceinline__ unsigned xb_ld(unsigned* p)              { return __hip_atomic_load(p, __ATOMIC_RELAXED, __HIP_MEMORY_SCOPE_AGENT); }
__device__ __forceinline__ unsigned xb_add(unsigned* p, unsigned v) { return __hip_atomic_fetch_add(p, v, __ATOMIC_RELAXED, __HIP_MEMORY_SCOPE_AGENT); }
__device__ __forceinline__ unsigned xb_xcc_id() { return (unsigned)__builtin_amdgcn_s_getreg((3 << 11) | 20) & 0xFu; }
#define XB_SPIN(cond, bar) do { unsigned _sp = 0; while (cond) { __builtin_amdgcn_s_sleep(1); \
    if ((++_sp & 255u) == 0u) { if (xb_ld(&(bar)[XB_TMO])) break; if (_sp > XB_SPIN_CAP) { atomicAdd(&(bar)[XB_TMO], 1u); break; } } } } while (0)
struct XcdBarrier { unsigned* bar; unsigned x; volatile LAS unsigned* st; };
__device__ __forceinline__ XcdBarrier xcd_barrier_post(unsigned* bar, volatile LAS unsigned* st) {
    XcdBarrier b; b.bar = bar; b.x = xb_xcc_id(); b.st = st;
    if (threadIdx.x == 0) (void)xb_add(&bar[XB_XCNT(b.x)], 1u);
    return b;
}
__device__ __forceinline__ void xcd_barrier_complete(unsigned* bar, unsigned x, unsigned& nloc, unsigned& nx) {
    const unsigned G = gridDim.x * gridDim.y * gridDim.z;
    unsigned sum, cnt, mine, sp = 0u;
    for (;;) {
        sum = 0u; cnt = 0u; mine = 0u;
#pragma unroll
        for (unsigned j = 0; j < 16; ++j) { const unsigned c = xb_ld(&bar[XB_XCNT(j)]); sum += c; cnt += (c > 0u) ? 1u : 0u; mine = (j == x) ? c : mine; }
        if (sum == G) break;
        __builtin_amdgcn_s_sleep(1);
        if ((++sp & 255u) == 0u) { if (xb_ld(&bar[XB_TMO])) break; if (sp > XB_SPIN_CAP) { atomicAdd(&bar[XB_TMO], 1u); break; } }
    }
    nloc = mine > 0u ? mine : 1u; nx = cnt > 0u ? cnt : 1u;
}
__device__ __forceinline__ void xcd_barrier(const XcdBarrier& b) {
    asm volatile("s_waitcnt vmcnt(0)" ::: "memory");
    __syncthreads();
    if (threadIdx.x == 0) {
        unsigned* bar = b.bar;
        __builtin_amdgcn_s_waitcnt(0);
        unsigned nloc = b.st[0], nx = b.st[1];
        if (nloc == 0u) { xcd_barrier_complete(bar, b.x, nloc, nx); b.st[0] = nloc; b.st[1] = nx; }
        const unsigned old = xb_add(&bar[XB_XSUB(b.x)], 1u);
        const unsigned gen = old / nloc;
        if (old + 1u == (gen + 1u) * nloc) {
            __builtin_amdgcn_fence(__ATOMIC_RELEASE, "agent");
            asm volatile("s_waitcnt vmcnt(0)" ::: "memory");
            const unsigned og = xb_add(&bar[XB_TOP], 1u);
            const unsigned tg = og / nx;
            if (og + 1u == (tg + 1u) * nx) xb_add(&bar[XB_TOPGEN], 1u);
            else XB_SPIN(xb_ld(&bar[XB_TOPGEN]) == tg, bar);
            __builtin_amdgcn_fence(__ATOMIC_ACQUIRE, "agent");
            xb_add(&bar[XB_XGEN(b.x)], 1u);
            asm volatile("s_waitcnt vmcnt(0)" ::: "memory");
        } else {
            XB_SPIN(xb_ld(&bar[XB_XGEN(b.x)]) == gen, bar);
            __builtin_amdgcn_fence(__ATOMIC_ACQUIRE, "agent");
            asm volatile("s_waitcnt vmcnt(0)" ::: "memory");
        }
    }
    __syncthreads();
}

namespace pg8 {
constexpr int BM = 256, BK = 64, HALF = 128, HTB = HALF * BK * 2, STAGE_BYTES = 8 * HTB, NXCD = 8, WGM = 8;
__host__ __device__ __forceinline__ int lds_byte(int r, int c) { const int st = (r >> 4) * 2 + (c >> 5), rr = r & 15, cc = c & 31, ob = rr * 64 + cc * 2; return st * 1024 + (ob ^ (((ob >> 9) & 1) << 5)); }
__host__ __device__ __forceinline__ void stage_rc(int b, int& R, int& C) { const int st = b / 1024, sb = b % 1024, swz = sb ^ (((sb >> 9) & 1) << 5); R = (st >> 1) * 16 + swz / 64; C = (st & 1) * 32 + (swz % 64) / 2; }
__host__ __device__ __forceinline__ int perm32(int rho) { const int n = rho >> 4, i = rho & 15; return 8 * (i >> 2) + 4 * n + (i & 3); }

struct Unit { int pm, pn, v, rb; };

__device__ __forceinline__ bool static_next(int nM, int nN, int G, int c, int i, Unit& u) {
    const int nwg = nM * nN; const long L = (long)i * G + c; if (L >= nwg) return false;
    int wgid = (int)L; { const int q = nwg / NXCD, r = nwg % NXCD, xcd = wgid % NXCD, off = wgid / NXCD; wgid = (xcd < r ? xcd * (q + 1) : r * (q + 1) + (xcd - r) * q) + off; }
    const int nig = WGM * nN, gid = wgid / nig, fm = gid * WGM, gsz = (nM - fm) < WGM ? (nM - fm) : WGM;
    u.pm = fm + ((wgid % nig) % gsz); u.pn = (wgid % nig) / gsz; u.v = 0; u.rb = 0; return true;
}
struct DenseSched {
    const char* A; const char* Bt; int lda, K, nM, nN, G, c;
    __device__ __forceinline__ bool next(int i, Unit& u) const { return static_next(nM, nN, G, c, i, u); }
    __device__ __forceinline__ const char* a_base(const Unit& u) const { return A + (size_t)u.pm * 256 * lda * 2; }
    __device__ __forceinline__ const char* b_base(const Unit& u) const { return Bt + (size_t)u.pn * 256 * K * 2; }
    __device__ __forceinline__ void a_off(const Unit&, const int (&R)[2], const int (&C)[2], unsigned (&o)[2][2]) const {
#pragma unroll
        for (int h = 0; h < 2; ++h)
#pragma unroll
            for (int i = 0; i < 2; ++i) o[h][i] = (unsigned)((h * 128 + R[i]) * lda + C[i]) * 2u;
    }
};

__device__ __forceinline__ unsigned cvt_pk_bf16(float lo, float hi) { unsigned r; asm volatile("v_cvt_pk_bf16_f32 %0, %1, %2" : "=v"(r) : "v"(lo), "v"(hi)); return r; }

template <class Epi, class Sched>
__device__ __forceinline__ void gemm_phase(LAS unsigned char* lds, const Sched& S, const Epi& E, int tid) {
    const int wid = __builtin_amdgcn_readfirstlane(tid >> 6), lane = tid & 63, wr = wid >> 2, wc = wid & 3, fr = lane & 15, fq = lane >> 4;
    const int K = S.K, nt = K / BK;
    int RR[2], CC[2]; unsigned voffB[2];
#pragma unroll
    for (int i = 0; i < 2; ++i) { int R, C; stage_rc(tid * 16 + i * 8192, R, C); const int Rb = Epi::PERM ? ((R & ~31) + perm32(R & 31)) : R;
        RR[i] = R; CC[i] = C; voffB[i] = (unsigned)(Rb * K + C) * 2u; }
    const size_t kstep = (size_t)(BK * 2);
    const size_t hstep = (size_t)HALF * K * 2;
    const unsigned ldsw = (unsigned)wid * 1024u;
    const int aoff = lds_byte(wr * 64 + fr, fq * 8), boff = lds_byte(wc * 32 + fr, fq * 8);
#define PG8_SA(b, h) (((b) * 2 + (h)) * HTB)
#define PG8_SB(b, h) ((4 + (b) * 2 + (h)) * HTB)
#define PG8_STAGE(bufoff, gbase, voff) do { _Pragma("unroll") for (int _i = 0; _i < 2; ++_i) \
        __builtin_amdgcn_global_load_lds((const unsigned*)((const char*)(gbase) + (voff)[_i]), (LAS unsigned*)(lds + (bufoff) + ldsw + _i * 8192), 16, 0, 0); } while (0)
#define PG8_LDA(dst, b, h) do { _Pragma("unroll") for (int m = 0; m < 4; ++m) _Pragma("unroll") for (int k = 0; k < 2; ++k) dst[m][k] = *(const LAS bf16x8*)(lds + PG8_SA(b, h) + aoff + m * 2048 + k * 1024); } while (0)
#define PG8_LDB(dst, b, h) do { _Pragma("unroll") for (int n = 0; n < 2; ++n) _Pragma("unroll") for (int k = 0; k < 2; ++k) dst[n][k] = *(const LAS bf16x8*)(lds + PG8_SB(b, h) + boff + n * 2048 + k * 1024); } while (0)
#define PG8_MMA(ai, bj, At, Bt) do { __builtin_amdgcn_s_setprio(1); _Pragma("unroll") for (int m = 0; m < 4; ++m) _Pragma("unroll") for (int n = 0; n < 2; ++n) _Pragma("unroll") for (int k = 0; k < 2; ++k) \
        acc[ai][bj][m][n] = __builtin_amdgcn_mfma_f32_16x16x32_bf16(Bt[n][k], At[m][k], acc[ai][bj][m][n], 0, 0, 0); __builtin_amdgcn_s_setprio(0); } while (0)
#define PG8_WAIT_V(n) asm volatile("s_waitcnt vmcnt(" #n ")" ::: "memory")
#define PG8_WAIT_L(n) asm volatile("s_waitcnt lgkmcnt(" #n ")" ::: "memory")
#define PG8_BAR __builtin_amdgcn_s_barrier()
#define PG8_SCHED __builtin_amdgcn_sched_barrier(0)
    Unit cur, nxt; int ui = 0;
    if (!S.next(0, cur)) return;
    f32x4 acc[2][2][4][2];
#pragma unroll
    for (int a = 0; a < 2; ++a)
#pragma unroll
        for (int b = 0; b < 2; ++b)
#pragma unroll
            for (int m = 0; m < 4; ++m)
#pragma unroll
                for (int n = 0; n < 2; ++n) acc[a][b][m][n] = (f32x4){0.f, 0.f, 0.f, 0.f};
    bf16x8 At[4][2], B0[2][2], B1[2][2];
    unsigned oa[2][2], on[2][2];
    S.a_off(cur, RR, CC, oa);
    const char* cA = S.a_base(cur); const char* cB = S.b_base(cur);
    PG8_STAGE(PG8_SB(0, 0), cB, voffB); PG8_STAGE(PG8_SB(0, 1), cB + hstep, voffB); PG8_STAGE(PG8_SA(0, 0), cA, oa[0]); PG8_STAGE(PG8_SA(0, 1), cA, oa[1]);
    if (wr == 1) PG8_BAR;
    PG8_WAIT_V(2); PG8_BAR;
    PG8_STAGE(PG8_SB(1, 0), cB + kstep, voffB); PG8_STAGE(PG8_SA(1, 0), cA + kstep, oa[0]); PG8_STAGE(PG8_SB(1, 1), cB + hstep + kstep, voffB);
    PG8_WAIT_V(6); PG8_BAR;
    for (;;) {
        const bool has_next = S.next(ui + 1, nxt);
        const char* nA = has_next ? S.a_base(nxt) : cA; const char* nB = has_next ? S.b_base(nxt) : cB;
        if (has_next) S.a_off(nxt, RR, CC, on);
        else {
#pragma unroll
            for (int h = 0; h < 2; ++h)
#pragma unroll
                for (int i = 0; i < 2; ++i) on[h][i] = oa[h][i];
        }
        for (int t = 0; t < nt; t += 2) {
            const bool last = (t == nt - 2);
            const char* a1 = cA + (size_t)(t + 1) * kstep;
            const char* a2 = last ? nA : cA + (size_t)(t + 2) * kstep; const char* b2 = last ? nB : cB + (size_t)(t + 2) * kstep;
            const char* a3 = a2 + kstep; const char* b3 = b2 + kstep;
            unsigned x0[2], x1[2];
#pragma unroll
            for (int i = 0; i < 2; ++i) { x0[i] = last ? on[0][i] : oa[0][i]; x1[i] = last ? on[1][i] : oa[1][i]; }
            PG8_LDB(B0, 0, 0); PG8_LDB(B1, 0, 1); PG8_SCHED; PG8_LDA(At, 0, 0); PG8_STAGE(PG8_SA(1, 1), a1, oa[1]);
            PG8_WAIT_V(8); PG8_WAIT_L(0); PG8_BAR; PG8_MMA(0, 0, At, B0); PG8_MMA(0, 1, At, B1); PG8_BAR; PG8_SCHED;
            PG8_LDA(At, 0, 1); PG8_STAGE(PG8_SB(0, 0), b2, voffB); PG8_STAGE(PG8_SB(0, 1), b2 + hstep, voffB); PG8_STAGE(PG8_SA(0, 0), a2, x0);
            PG8_WAIT_V(8); PG8_WAIT_L(0); PG8_BAR; PG8_MMA(1, 0, At, B0); PG8_MMA(1, 1, At, B1); PG8_BAR; PG8_SCHED;
            PG8_LDB(B0, 1, 0); PG8_LDB(B1, 1, 1); PG8_SCHED; PG8_LDA(At, 1, 0); PG8_STAGE(PG8_SA(0, 1), a2, x1);
            PG8_WAIT_V(8); PG8_WAIT_L(0); PG8_BAR; PG8_MMA(0, 0, At, B0); PG8_MMA(0, 1, At, B1); PG8_BAR; PG8_SCHED;
            PG8_LDA(At, 1, 1); PG8_STAGE(PG8_SB(1, 0), b3, voffB); PG8_STAGE(PG8_SB(1, 1), b3 + hstep, voffB); PG8_STAGE(PG8_SA(1, 0), a3, x0);
            PG8_WAIT_V(8); PG8_WAIT_L(0); PG8_BAR; PG8_MMA(1, 0, At, B0); PG8_MMA(1, 1, At, B1); PG8_BAR; PG8_SCHED;
        }
        if (wr == 0) PG8_BAR;
        E(acc, cur, wr, wc, fr, fq);
        if (!has_next) break;
#pragma unroll
        for (int a = 0; a < 2; ++a)
#pragma unroll
            for (int b = 0; b < 2; ++b)
#pragma unroll
                for (int m = 0; m < 4; ++m)
#pragma unroll
                    for (int n = 0; n < 2; ++n) acc[a][b][m][n] = (f32x4){0.f, 0.f, 0.f, 0.f};
        cur = nxt; cA = nA; cB = nB; ++ui;
#pragma unroll
        for (int h = 0; h < 2; ++h)
#pragma unroll
            for (int i = 0; i < 2; ++i) oa[h][i] = on[h][i];
        if (wr == 1) PG8_BAR;
    }
    PG8_WAIT_V(0);
    PG8_BAR;
#undef PG8_SA
#undef PG8_SB
#undef PG8_STAGE
#undef PG8_LDA
#undef PG8_LDB
#undef PG8_MMA
#undef PG8_WAIT_V
#undef PG8_WAIT_L
#undef PG8_BAR
#undef PG8_SCHED
}
}

using pg8::Unit;
__device__ __forceinline__ u32x4 pack8(f32x4 a, f32x4 b) { u32x4 w; w.x = pg8::cvt_pk_bf16(a[0], a[1]); w.y = pg8::cvt_pk_bf16(a[2], a[3]); w.z = pg8::cvt_pk_bf16(b[0], b[1]); w.w = pg8::cvt_pk_bf16(b[2], b[3]); return w; }

struct EpiInEven {
    static constexpr bool PERM = true;
    bf16_t* H; const float* cosT; const float* sinT;
    __device__ __forceinline__ void operator()(const f32x4 (&acc)[2][2][4][2], const Unit& u, int wr, int wc, int fr, int fq) const {
        const int row0 = u.pm * 256 + wr * 64 + fr, col0 = u.pn * 256 + wc * 32 + 8 * fq;
        const bool rope = u.pn < 7; const int j0 = (wc & 1) * 16 + 4 * fq;
#pragma unroll
        for (int ai = 0; ai < 2; ++ai)
#pragma unroll
            for (int m = 0; m < 4; ++m) {
                const int row = row0 + ai * 128 + m * 16, pos = row & (SEQ - 1);
                f32x4 cs = {1.f, 1.f, 1.f, 1.f}, sn = {0.f, 0.f, 0.f, 0.f};
                if (rope) { cs = *(const f32x4*)(cosT + pos * 32 + j0); sn = *(const f32x4*)(sinT + pos * 32 + j0); }
                bf16_t* rowp = H + (size_t)row * NE_PAD + col0;
#pragma unroll
                for (int bj = 0; bj < 2; ++bj) {
                    const f32x4 v0 = acc[ai][bj][m][0], v1 = acc[ai][bj][m][1];
                    f32x4 o0, o1;
                    o0[0] = v0[0] * cs[0] - v0[1] * sn[0]; o0[1] = v0[1] * cs[0] + v0[0] * sn[0];
                    o0[2] = v0[2] * cs[1] - v0[3] * sn[1]; o0[3] = v0[3] * cs[1] + v0[2] * sn[1];
                    o1[0] = v1[0] * cs[2] - v1[1] * sn[2]; o1[1] = v1[1] * cs[2] + v1[0] * sn[2];
                    o1[2] = v1[2] * cs[3] - v1[3] * sn[3]; o1[3] = v1[3] * cs[3] + v1[2] * sn[3];
                    *(u32x4*)(rowp + bj * 128) = pack8(o0, o1);
                }
                asm volatile("" ::: "memory");
            }
    }
};
struct EpiInOdd {
    static constexpr bool PERM = true;
    bf16_t* H; float* logf; const float* bf;
    __device__ __forceinline__ void operator()(const f32x4 (&acc)[2][2][4][2], const Unit& u, int wr, int wc, int fr, int fq) const {
        const int row0 = u.pm * 256 + wr * 64 + fr, col0 = u.pn * 256 + wc * 32 + 8 * fq;
#pragma unroll
        for (int ai = 0; ai < 2; ++ai)
#pragma unroll
            for (int m = 0; m < 4; ++m) {
                const int row = row0 + ai * 128 + m * 16;
                bf16_t* rowp = H + (size_t)row * NO_PAD + col0;
#pragma unroll
                for (int bj = 0; bj < 2; ++bj) *(u32x4*)(rowp + bj * 128) = pack8(acc[ai][bj][m][0], acc[ai][bj][m][1]);
                if (u.pn == 12 && wc == 0 && fq < 2) {
                    f32x4 r0, r1;
#pragma unroll
                    for (int j = 0; j < 4; ++j) {
                        const float x0 = acc[ai][0][m][0][j] + bf[8 * fq + j], x1 = acc[ai][0][m][1][j] + bf[8 * fq + 4 + j];
                        r0[j] = fminf(x0, 0.f) - log1pf(__expf(-fabsf(x0))); r1[j] = fminf(x1, 0.f) - log1pf(__expf(-fabsf(x1)));
                    }
                    *(f32x4*)(logf + (size_t)row * 16 + 8 * fq) = r0; *(f32x4*)(logf + (size_t)row * 16 + 8 * fq + 4) = r1;
                }
                asm volatile("" ::: "memory");
            }
    }
};
struct EpiOut {
    static constexpr bool PERM = false;
    const float* X; float* Y;
    __device__ __forceinline__ void operator()(const f32x4 (&acc)[2][2][4][2], const Unit& u, int wr, int wc, int fr, int fq) const {
        const int row0 = u.pm * 256 + wr * 64 + fr, col0 = u.pn * 256 + wc * 32 + 4 * fq;
#pragma unroll
        for (int ai = 0; ai < 2; ++ai)
#pragma unroll
            for (int m = 0; m < 4; ++m) {
                const size_t off = (size_t)(row0 + ai * 128 + m * 16) * DM + col0;
#pragma unroll
                for (int bj = 0; bj < 2; ++bj)
#pragma unroll
                    for (int n = 0; n < 2; ++n) { const f32x4 x = *(const f32x4*)(X + off + bj * 128 + n * 16); *(f32x4*)(Y + off + bj * 128 + n * 16) = x * ALPHA + acc[ai][bj][m][n]; }
                asm volatile("" ::: "memory");
            }
    }
};
struct EpiUp {
    static constexpr bool PERM = false;
    bf16_t* Hm;
    __device__ __forceinline__ void operator()(const f32x4 (&acc)[2][2][4][2], const Unit& u, int wr, int wc, int fr, int fq) const {
        const int row0 = u.pm * 256 + wr * 64 + fr, col0 = u.pn * 128 + wc * 16 + 4 * fq;
#pragma unroll
        for (int ai = 0; ai < 2; ++ai)
#pragma unroll
            for (int m = 0; m < 4; ++m) {
                bf16_t* rowp = Hm + (size_t)(row0 + ai * 128 + m * 16) * DFF + col0;
#pragma unroll
                for (int bj = 0; bj < 2; ++bj) {
                    const f32x4 a = acc[ai][bj][m][0], b = acc[ai][bj][m][1]; f32x4 h;
#pragma unroll
                    for (int j = 0; j < 4; ++j) h[j] = a[j] * b[j] * __builtin_amdgcn_rcpf(1.0f + fast_exp2(-a[j] * LOG2E));
                    u32x2 w; w.x = pg8::cvt_pk_bf16(h[0], h[1]); w.y = pg8::cvt_pk_bf16(h[2], h[3]);
                    *(u32x2*)(rowp + bj * 64) = w;
                }
            }
    }
};
struct EpiDown {
    static constexpr bool PERM = true;
    bf16_t* Y; const int* slot_tk; const float* slot_g; const LAS int* cnt;
    __device__ __forceinline__ void operator()(const f32x4 (&acc)[2][2][4][2], const Unit& u, int wr, int wc, int fr, int fq) const {
        const int e = u.v % 65, half = u.v / 65, n = cnt[u.v];
        const int col0 = u.pn * 256 + wc * 32 + 8 * fq;
#pragma unroll
        for (int ai = 0; ai < 2; ++ai)
#pragma unroll
            for (int m = 0; m < 4; ++m) {
                const int pos = u.rb * 256 + ai * 128 + wr * 64 + m * 16 + fr;
                if (pos < n) {
                    int drow; float g;
                    if (e == 64) { drow = pos * 9 + 8; g = 1.f; }
                    else { const int tk = slot_tk[(size_t)u.v * HALF_T + pos]; g = slot_g[(size_t)u.v * HALF_T + pos]; drow = ((tk >> 3) - half * HALF_T) * 9 + (tk & 7); }
                    bf16_t* rowp = Y + (size_t)drow * DM + col0;
#pragma unroll
                    for (int bj = 0; bj < 2; ++bj) *(u32x4*)(rowp + bj * 128) = pack8(acc[ai][bj][m][0] * g, acc[ai][bj][m][1] * g);
                }
                asm volatile("" ::: "memory");
            }
    }
};
struct EpiPleE {
    static constexpr bool PERM = true;
    bf16_t* E; float* ssq;
    __device__ __forceinline__ void operator()(const f32x4 (&acc)[2][2][4][2], const Unit& u, int wr, int wc, int fr, int fq) const {
        const int row0 = u.pm * 256 + wr * 64 + fr, col0 = u.pn * 256 + wc * 32 + 8 * fq;
#pragma unroll
        for (int ai = 0; ai < 2; ++ai)
#pragma unroll
            for (int m = 0; m < 4; ++m) {
                const int row = row0 + ai * 128 + m * 16;
                bf16_t* rowp = E + (size_t)row * DM + col0; float s = 0.f;
#pragma unroll
                for (int bj = 0; bj < 2; ++bj) {
                    const f32x4 a = acc[ai][bj][m][0], b = acc[ai][bj][m][1];
                    s += (a[0] * a[0] + a[1] * a[1]) + (a[2] * a[2] + a[3] * a[3]) + (b[0] * b[0] + b[1] * b[1]) + (b[2] * b[2] + b[3] * b[3]);
                    *(u32x4*)(rowp + bj * 128) = pack8(a, b);
                }
                s += __shfl_xor(s, 16); s += __shfl_xor(s, 32);
                if (fq == 0) ssq[(size_t)row * 16 + u.pn * 4 + wc] = s;
                asm volatile("" ::: "memory");
            }
    }
};
struct EpiPleG {
    static constexpr bool PERM = false;
    float* X; const bf16_t* E; const float* ssq; const float* g; bf16_t* XB;
    __device__ __forceinline__ void operator()(const f32x4 (&acc)[2][2][4][2], const Unit& u, int wr, int wc, int fr, int fq) const {
        const int row0 = u.pm * 256 + wr * 64 + fr, col0 = u.pn * 256 + wc * 32 + 4 * fq;
#pragma unroll
        for (int ai = 0; ai < 2; ++ai)
#pragma unroll
            for (int m = 0; m < 4; ++m) {
                const int row = row0 + ai * 128 + m * 16;
                const f32x4 s0 = *(const f32x4*)(ssq + (size_t)row * 16), s1 = *(const f32x4*)(ssq + (size_t)row * 16 + 4), s2 = *(const f32x4*)(ssq + (size_t)row * 16 + 8), s3 = *(const f32x4*)(ssq + (size_t)row * 16 + 12);
                const float ss = ((s0[0] + s0[1]) + (s0[2] + s0[3])) + ((s1[0] + s1[1]) + (s1[2] + s1[3])) + ((s2[0] + s2[1]) + (s2[2] + s2[3])) + ((s3[0] + s3[1]) + (s3[2] + s3[3]));
                const float rs = 1.0f / sqrtf(ss * (1.0f / DM) + RMS_EPS);
                const size_t off = (size_t)row * DM + col0;
#pragma unroll
                for (int bj = 0; bj < 2; ++bj)
#pragma unroll
                    for (int n = 0; n < 2; ++n) {
                        const int co = bj * 128 + n * 16;
                        const f32x4 x = *(const f32x4*)(X + off + co); const u32x2 ew = *(const u32x2*)(E + off + co); const f32x4 gg = *(const f32x4*)(g + col0 + co);
                        const f32x4 a = acc[ai][bj][m][n]; f32x4 o;
                        o[0] = x[0] + sigmoidf_(a[0]) * (bflo(ew.x) * rs) * gg[0]; o[1] = x[1] + sigmoidf_(a[1]) * (bfhi(ew.x) * rs) * gg[1];
                        o[2] = x[2] + sigmoidf_(a[2]) * (bflo(ew.y) * rs) * gg[2]; o[3] = x[3] + sigmoidf_(a[3]) * (bfhi(ew.y) * rs) * gg[3];
                        *(f32x4*)(X + off + co) = o;
                        u32x2 w; w.x = pg8::cvt_pk_bf16(o[0], o[1]); w.y = pg8::cvt_pk_bf16(o[2], o[3]); *(u32x2*)(XB + off + co) = w;
                    }
                asm volatile("" ::: "memory");
            }
    }
};

struct MoeSched {
    const char* A; const char* W; int lda, K, npn; size_t wstride;
    const LAS int* rbs; const LAS int* cnt; int vlo, vhi, rb0, nunits, G, c; const int* slot_tk; bool gather;
    __device__ __forceinline__ bool next(int i, Unit& u) const {
        const long L = (long)i * G + c; if (L >= nunits) return false;
        const int rbg = rb0 + (int)(L / npn); u.pn = (int)(L % npn);
        int lo = vlo, hi = vhi;
        while (lo < hi) { const int mid = (lo + hi + 1) >> 1; if (rbs[mid] <= rbg) lo = mid; else hi = mid - 1; }
        u.v = lo; u.rb = rbg - rbs[lo]; u.pm = rbg; return true;
    }
    __device__ __forceinline__ const char* a_base(const Unit& u) const { return gather ? A : A + (size_t)u.pm * 256 * lda * 2; }
    __device__ __forceinline__ const char* b_base(const Unit& u) const { return W + (size_t)(u.v % 65) * wstride + (size_t)u.pn * 256 * K * 2; }
    __device__ __forceinline__ void a_off(const Unit& u, const int (&R)[2], const int (&C)[2], unsigned (&o)[2][2]) const {
        if (gather) {
            const int e = u.v % 65, half = u.v / 65, n = cnt[u.v];
#pragma unroll
            for (int h = 0; h < 2; ++h)
#pragma unroll
                for (int i = 0; i < 2; ++i) {
                    const int pos = u.rb * 256 + h * 128 + R[i]; int tok;
                    if (e == 64) tok = half * HALF_T + pos;
                    else tok = pos < n ? (slot_tk[(size_t)u.v * HALF_T + pos] >> 3) : 0;
                    o[h][i] = (unsigned)(tok * lda + C[i]) * 2u;
                    asm volatile("" : "+v"(o[h][i]));
                }
        } else {
#pragma unroll
            for (int h = 0; h < 2; ++h)
#pragma unroll
                for (int i = 0; i < 2; ++i) o[h][i] = (unsigned)((h * 128 + R[i]) * lda + C[i]) * 2u;
        }
    }
};

struct Args {
    const float* in[29]; float* out; unsigned char* ws; int ph_lo, ph_hi;
};
enum InIdx { I_X = 0, I_P, I_EV_WIN, I_EV_BGATE, I_CPK, I_CW1K, I_CW2K, I_CPV, I_CW1V, I_CW2V, I_EV_WO, I_OD_WIN, I_OD_BF, I_OD_WO,
             I_LN1G, I_LN1B, I_LN2G, I_LN2B, I_RW, I_RB, I_EW1, I_EW3, I_EW2, I_SW1, I_SW3, I_SW2, I_PWG, I_PWP, I_PNG };
struct Frame {
    LAS unsigned char* lds; int tid, lane, wave, G, bid;
    unsigned char* ws; gu32* ctl;
};

__device__ __forceinline__ int rope_perm(int d) { return 2 * (d & 31) + (d >> 5); }
__device__ __forceinline__ int map_even(int c) {
    if (c < 512) return EC_QA + (c & ~63) + rope_perm(c & 63);
    if (c < 576) return EC_KA + rope_perm(c - 512);
    if (c < 640) return EC_VA + (c - 576);
    if (c < 1152) { const int r = c - 640; return EC_QI + (r & ~63) + rope_perm(r & 63); }
    if (c < 1216) return EC_KI + rope_perm(c - 1152);
    if (c < 1224) return EC_WI + (c - 1216);
    if (c < 1736) { const int r = c - 1224; return EC_QB + (r & ~63) + rope_perm(r & 63); }
    if (c < 2120) { const int r = c - 1736, j = r >> 6, d = r & 63;
        switch (j) { case 0: return EC_KC + d; case 1: return EC_VC + d; case 2: return EC_KS + rope_perm(d); case 3: return EC_VS + d; case 4: return EC_KW + rope_perm(d); default: return EC_VW + d; } }
    return EC_GB + (c - 2120);
}
enum MapId { MAP_ID = 0, MAP_EVEN, MAP_W1, MAP_W3, MAP_ROPE };
__device__ __forceinline__ int map_col(int id, int c) {
    switch (id) { case MAP_EVEN: return map_even(c); case MAP_W1: return 32 * (c >> 4) + (c & 15); case MAP_W3: return 32 * (c >> 4) + 16 + (c & 15); case MAP_ROPE: return rope_perm(c); default: return c; }
}
__device__ __forceinline__ void tr_item(const float* src, int ldn, int ncols, bf16_t* dst, int dpitch, int k0, int n0, int mapid, LAS float* scr, int lane) {
#pragma unroll 8
    for (int i = 0; i < 32; ++i) { const int kk = 2 * i + (lane >> 5), n = n0 + (lane & 31); scr[kk * 33 + (lane & 31)] = (n < ncols) ? src[(size_t)(k0 + kk) * ldn + n] : 0.f; }
    LDS_WAIT(); asm volatile("" ::: "memory");
    const int c = lane & 7;
#pragma unroll
    for (int j = 0; j < 4; ++j) { const int nl = (lane >> 3) + 8 * j, n = n0 + nl; const LAS float* s = scr + (8 * c) * 33 + nl;
        u32x4 o; o.x = pk2(s[0 * 33], s[1 * 33]); o.y = pk2(s[2 * 33], s[3 * 33]); o.z = pk2(s[4 * 33], s[5 * 33]); o.w = pk2(s[6 * 33], s[7 * 33]);
        if (n < ncols) *(u32x4*)(dst + (size_t)map_col(mapid, n) * dpitch + k0 + 8 * c) = o; }
    LDS_WAIT(); asm volatile("" ::: "memory");
}
__device__ __forceinline__ int tr_matrix(const Frame& F, const float* src, int K, int N, int ldn, bf16_t* dst, int dpitch, int mapid, int it0) {
    LAS float* scr = (LAS float*)(F.lds + F.wave * 16384);
    const int nblk = (N + 31) / 32, nit = (K / 64) * nblk, gw = F.bid * 8 + F.wave, NGW = F.G * 8;
    int first = (gw - (it0 % NGW) + NGW) % NGW;
    for (int it = first; it < nit; it += NGW) tr_item(src, ldn, N, dst, dpitch, 64 * (it / nblk), 32 * (it % nblk), mapid, scr, F.lane);
    return nit;
}
__device__ __forceinline__ void sincos_d(double a, float& s, float& c) {
    const double TWO_PI = 6.283185307179586476925286766559, INV = 0.15915494309189533576888376337251;
    const double k = rint(a * INV); double r = a - k * TWO_PI;
    const double r2 = r * r; double ts = 1.0, tc = 1.0;
#pragma unroll
    for (int i = 14; i >= 1; --i) { ts = 1.0 - ts * r2 / (double)((2 * i) * (2 * i + 1)); tc = 1.0 - tc * r2 / (double)((2 * i - 1) * (2 * i)); }
    s = (float)(r * ts); c = (float)tc;
}

struct TrJob { const float* src; bf16_t* dst; int K, N, ldn, dpitch, mapid; };
__device__ __forceinline__ TrJob get_job(const Args& a, unsigned char* wsp, int layer, int jid) {
    const int j = layer >> 1; const bool even = (layer & 1) == 0;
    bf16_t* W = (bf16_t*)(wsp + WS_W);
    TrJob t; t.mapid = MAP_ID;
    if (jid == 0) { if (even) { t.src = a.in[I_EV_WIN] + (size_t)j * DM * EVEN_COLS; t.N = EVEN_COLS; t.mapid = MAP_EVEN; } else { t.src = a.in[I_OD_WIN] + (size_t)j * DM * ODD_COLS; t.N = ODD_COLS; }
        t.K = DM; t.ldn = t.N; t.dst = W + W_IN / 2; t.dpitch = DM; return t; }
    if (jid == 1) { t.src = (even ? a.in[I_EV_WO] : a.in[I_OD_WO]) + (size_t)j * DM * DM; t.K = DM; t.N = DM; t.ldn = DM; t.dst = W + W_O / 2; t.dpitch = DM; return t; }
    if (jid == 2) { t.src = a.in[I_PWG] + (size_t)layer * DM * DM; t.K = DM; t.N = DM; t.ldn = DM; t.dst = W + W_G / 2; t.dpitch = DM; return t; }
    if (jid == 3) { t.src = a.in[I_PWP] + (size_t)layer * 256 * DM; t.K = 256; t.N = DM; t.ldn = DM; t.dst = W + W_P / 2; t.dpitch = 256; return t; }
    if (jid < 8) {
        const int q = jid - 4;
        if (q == 0) { t.src = a.in[I_CW1K] + (size_t)j * 2048 * 64; t.K = 2048; t.dst = W + W_C1K / 2; t.dpitch = 2048; }
        else if (q == 1) { t.src = a.in[I_CW1V] + (size_t)j * 2048 * 64; t.K = 2048; t.dst = W + W_C1V / 2; t.dpitch = 2048; }
        else if (q == 2) { t.src = a.in[I_CW2K] + (size_t)j * 64 * 64; t.K = 64; t.dst = W + W_C2K / 2; t.dpitch = 64; t.mapid = MAP_ROPE; }
        else { t.src = a.in[I_CW2V] + (size_t)j * 64 * 64; t.K = 64; t.dst = W + W_C2V / 2; t.dpitch = 64; }
        t.N = 64; t.ldn = 64; return t; }
    const int r = jid - 8, e = r / 3, w = r % 3;
    if (w < 2) { const float* s = (e == 64) ? a.in[w == 0 ? I_SW1 : I_SW3] + (size_t)layer * DM * DFF : a.in[w == 0 ? I_EW1 : I_EW3] + ((size_t)layer * NEXP + e) * DM * DFF;
        t.src = s; t.K = DM; t.N = DFF; t.ldn = DFF; t.dst = W + W_UP / 2 + (size_t)e * 512 * DM; t.dpitch = DM; t.mapid = (w == 0) ? MAP_W1 : MAP_W3; return t; }
    t.src = (e == 64) ? a.in[I_SW2] + (size_t)layer * DFF * DM : a.in[I_EW2] + ((size_t)layer * NEXP + e) * DFF * DM;
    t.K = DFF; t.N = DM; t.ldn = DM; t.dst = W + W_DN / 2 + (size_t)e * DM * DFF; t.dpitch = DFF; return t;
}
constexpr int NJOBS = 8 + 65 * 3;

__device__ __forceinline__ void prep_phase(const Frame& F, const Args& a, int layer) {
    const int gw = F.bid * 8 + F.wave, NGW = F.G * 8, gt = F.bid * 512 + F.tid, NGT = F.G * 512;
    LAS float* scr = (LAS float*)(F.lds + F.wave * 16384);
    int base = 0;
    for (int jid = 0; jid < NJOBS; ++jid) {
        const TrJob jb = get_job(a, F.ws, layer, jid);
        const int nblk = (jb.N + 31) / 32, nit = (jb.K / 64) * nblk;
        int first = (gw - (base % NGW) + NGW) % NGW;
        for (int it = first; it < nit; it += NGW) tr_item(jb.src, jb.ldn, jb.N, jb.dst, jb.dpitch, 64 * (it / nblk), 32 * (it % nblk), jb.mapid, scr, F.lane);
        base += nit;
    }
    { const int r0 = (layer & 1) ? ODD_COLS : EVEN_COLS, r1 = (layer & 1) ? NO_PAD : NE_PAD; u32x4* z = (u32x4*)(F.ws + WS_W + W_IN + (size_t)r0 * DM * 2);
      const int n16 = (r1 - r0) * DM * 2 / 16; for (int i = gt; i < n16; i += NGT) z[i] = (u32x4){0u, 0u, 0u, 0u}; }
    { const f32x4* p = (const f32x4*)(a.in[I_P] + (size_t)layer * T * 256); u32x2* o = (u32x2*)(F.ws + WS_PB);
      for (int i = gt; i < T * 256 / 4; i += NGT) { const f32x4 v = p[i]; u32x2 w; w.x = pk2(v[0], v[1]); w.y = pk2(v[2], v[3]); o[i] = w; } }
    if (layer == 0) {
        const f32x4* x = (const f32x4*)a.in[I_X]; u32x2* o = (u32x2*)(F.ws + WS_XB);
        for (int i = gt; i < T * DM / 4; i += NGT) { const f32x4 v = x[i]; u32x2 w; w.x = pk2(v[0], v[1]); w.y = pk2(v[2], v[3]); o[i] = w; }
        float* ct = (float*)(F.ws + WS_ROPE_COS); float* st = (float*)(F.ws + WS_ROPE_SIN);
        for (int i = gt; i < SEQ * 32; i += NGT) { const int pos = i >> 5, j = i & 31; double inv = 1.0;
            for (int q = 0; q < j; ++q) inv *= 0.74989420933245582730;
            const float ang = (float)pos * (float)inv; float s, c; sincos_d((double)ang, s, c); ct[i] = c; st[i] = s; }
    }
    if ((layer & 1) == 0 && F.bid < 2) {
        const int j = layer >> 1; const float* pe = a.in[F.bid == 0 ? I_CPK : I_CPV] + (size_t)j * 2048; const float* w1 = a.in[F.bid == 0 ? I_CW1K : I_CW1V] + (size_t)j * 2048 * 64;
        LAS float* red = (LAS float*)(F.lds + 8 * 16384);
        __syncthreads();
        const int n = F.tid & 63, part = F.tid >> 6; float s = 0.f;
        for (int k = part * 256; k < part * 256 + 256; ++k) s += pe[k] * w1[(size_t)k * 64 + n];
        red[part * 64 + n] = s; __syncthreads();
        if (F.tid < 64) { float tot = 0.f; for (int q = 0; q < 8; ++q) tot += red[q * 64 + F.tid]; ((float*)(F.ws + WS_MISC))[F.bid * 64 + F.tid] = tot; }
        __syncthreads();
    }
}

__device__ __forceinline__ void scan_phase(const Frame& F, const Args& a) {
    const float* lf = (const float*)(F.ws + WS_LOGF); float* dc = (float*)(F.ws + WS_DCUM);
    LAS float* wsum = (LAS float*)F.lds;
    for (int s = F.bid; s < NB * 16; s += F.G) {
        const int b = s >> 4, h = s & 15; const size_t base = ((size_t)b * SEQ) * 16 + h;
        float v[4]; float run = 0.f;
#pragma unroll
        for (int i = 0; i < 4; ++i) { run += lf[base + (size_t)(F.tid * 4 + i) * 16]; v[i] = run; }
        float inc = run;
#pragma unroll
        for (int o = 1; o < 64; o <<= 1) { const float t = __shfl_up(inc, o); if (F.lane >= o) inc += t; }
        if (F.lane == 63) wsum[F.wave] = inc;
        __syncthreads();
        float off = inc - run;
        for (int w = 0; w < F.wave; ++w) off += wsum[w];
#pragma unroll
        for (int i = 0; i < 4; ++i) dc[base + (size_t)(F.tid * 4 + i) * 16] = (v[i] + off) * LOG2E;
        __syncthreads();
    }
}

__device__ __forceinline__ void ln_row16(float (&v)[16], const float* g, const float* b, int lane) {
    float s = 0.f;
#pragma unroll
    for (int i = 0; i < 16; ++i) s += v[i];
    const float mean = wave_sum(s) * (1.f / DM); float s2 = 0.f;
#pragma unroll
    for (int i = 0; i < 16; ++i) { v[i] -= mean; s2 += v[i] * v[i]; }
    const float rstd = 1.0f / sqrtf(wave_sum(s2) * (1.f / DM) + LN_EPS);
#pragma unroll
    for (int q = 0; q < 4; ++q) { const f32x4 gg = *(const f32x4*)(g + lane * 16 + 4 * q), bb = *(const f32x4*)(b + lane * 16 + 4 * q);
#pragma unroll
        for (int i = 0; i < 4; ++i) v[4 * q + i] = v[4 * q + i] * rstd * gg[i] + bb[i]; }
}
__device__ __forceinline__ void store_row16(const float (&v)[16], float* xf, bf16_t* xb, int lane) {
#pragma unroll
    for (int q = 0; q < 4; ++q) *(f32x4*)(xf + lane * 16 + 4 * q) = (f32x4){v[4 * q], v[4 * q + 1], v[4 * q + 2], v[4 * q + 3]};
    u32x4 w0, w1; w0.x = pk2(v[0], v[1]); w0.y = pk2(v[2], v[3]); w0.z = pk2(v[4], v[5]); w0.w = pk2(v[6], v[7]);
    w1.x = pk2(v[8], v[9]); w1.y = pk2(v[10], v[11]); w1.z = pk2(v[12], v[13]); w1.w = pk2(v[14], v[15]);
    *(u32x4*)(xb + lane * 16) = w0; *(u32x4*)(xb + lane * 16 + 8) = w1;
}

__device__ __forceinline__ void route_phase(const Frame& F, const Args& a, int layer) {
    float* X = a.out; bf16_t* XB = (bf16_t*)(F.ws + WS_XB);
    const float* g = a.in[I_LN1G] + layer * DM; const float* bta = a.in[I_LN1B] + layer * DM;
    const float* RW = a.in[I_RW] + (size_t)layer * DM * NEXP; const float* RBs = a.in[I_RB] + layer * NEXP;
    int* slot_tk = (int*)(F.ws + WS_SLOT_TK); float* slot_g = (float*)(F.ws + WS_SLOT_G);
    gu32* cntg = F.ctl + CW_CNT + layer * 256;
    LAS float* lg = (LAS float*)(F.lds + F.wave * 8192);
    LAS unsigned* rec_e = (LAS unsigned*)(F.lds + 65536);
    LAS float* rec_g = (LAS float*)(F.lds + 65536 + 8192);
    LAS unsigned* lcnt = (LAS unsigned*)(F.lds + 65536 + 16384);
    LAS unsigned* gbase = lcnt + 64;
    const int lane = F.lane;
    for (int ub = F.bid; ub < T / 256; ub += F.G) {
        if (F.tid < 64) lcnt[F.tid] = 0u;
        __syncthreads();
        const int r0 = ub * 256 + F.wave * 32;
        for (int r = 0; r < 32; ++r) {
            float v[16]; float* xr = X + (size_t)(r0 + r) * DM;
#pragma unroll
            for (int q = 0; q < 4; ++q) { const f32x4 t = *(const f32x4*)(xr + lane * 16 + 4 * q); v[4 * q] = t[0]; v[4 * q + 1] = t[1]; v[4 * q + 2] = t[2]; v[4 * q + 3] = t[3]; }
            ln_row16(v, g, bta, lane);
            store_row16(v, xr, XB + (size_t)(r0 + r) * DM, lane);
        }
        VM_WAIT();
        f32x16 c0 = {}, c1 = {};
        { const float* ar = X + (size_t)(r0 + (lane & 31)) * DM + (lane >> 5) * 512; const float* br = RW + (size_t)((lane >> 5) * 512) * NEXP + (lane & 31);
          for (int s = 0; s < 512; s += 4) {
              const f32x4 av = *(const f32x4*)(ar + s);
#pragma unroll
              for (int q = 0; q < 4; ++q) { const float b0 = br[(size_t)(s + q) * NEXP], b1 = br[(size_t)(s + q) * NEXP + 32];
                  c0 = __builtin_amdgcn_mfma_f32_32x32x2f32(av[q], b0, c0, 0, 0, 0); c1 = __builtin_amdgcn_mfma_f32_32x32x2f32(av[q], b1, c1, 0, 0, 0); }
          } }
#pragma unroll
        for (int rr = 0; rr < 16; ++rr) { const int row = (rr & 3) + 8 * (rr >> 2) + 4 * (lane >> 5); lg[row * 64 + (lane & 31)] = c0[rr]; lg[row * 64 + 32 + (lane & 31)] = c1[rr]; }
        LDS_WAIT(); asm volatile("" ::: "memory");
        const float rbias = RBs[lane];
        for (int r = 0; r < 32; ++r) {
            const float sg = sigmoidf_(lg[r * 64 + lane]); const float sb = sg + rbias;
            float m1 = sb;
            m1 = fmaxf(m1, __shfl_xor(m1, 1)); m1 = fmaxf(m1, __shfl_xor(m1, 2)); m1 = fmaxf(m1, __shfl_xor(m1, 4));
            const unsigned long long eqm = __ballot(sb == m1); const int gsh = lane & ~7;
            const unsigned gm = (unsigned)(eqm >> gsh) & 0xffu; const int first = __builtin_ctz(gm);
            float m2 = ((lane & 7) == first) ? NEGBIG : sb;
            m2 = fmaxf(m2, __shfl_xor(m2, 1)); m2 = fmaxf(m2, __shfl_xor(m2, 2)); m2 = fmaxf(m2, __shfl_xor(m2, 4));
            const float gs = m1 + m2;
            int grank = 0;
#pragma unroll
            for (int q = 0; q < 8; ++q) { const float o = __shfl(gs, q * 8); grank += (o > gs || (o == gs && q < (lane >> 3))) ? 1 : 0; }
            const float sm = (grank < 4) ? sb : NEGBIG;
            int rank = 0;
            for (int q = 0; q < 64; ++q) { const float o = __builtin_bit_cast(float, __builtin_amdgcn_readlane(__builtin_bit_cast(int, sm), q)); rank += (o > sm || (o == sm && q < lane)) ? 1 : 0; }
            const bool sel = rank < 8;
            const float ssum = wave_sum(sel ? sg : 0.f);
            if (sel) { const unsigned lp = __hip_atomic_fetch_add(&lcnt[lane], 1u, __ATOMIC_RELAXED, __HIP_MEMORY_SCOPE_WORKGROUP); const int row = F.wave * 32 + r; rec_e[row * 8 + rank] = (unsigned)lane | (lp << 8); rec_g[row * 8 + rank] = sg / ssum * 2.5f; }
        }
        __syncthreads();
        const int half = (ub * 256) / HALF_T;
        if (F.tid < 64) gbase[F.tid] = __hip_atomic_fetch_add(cntg + half * 65 + F.tid, lcnt[F.tid], RLX_AGENT);
        __syncthreads();
        for (int i = F.tid; i < 2048; i += 512) { const unsigned re = rec_e[i]; const int e = re & 255, lp = re >> 8, v = half * 65 + e; const int pos = gbase[e] + lp;
            const int t = ub * 256 + (i >> 3);
            slot_tk[(size_t)v * HALF_T + pos] = t * 8 + (i & 7); slot_g[(size_t)v * HALF_T + pos] = rec_g[i]; }
        __syncthreads();
    }
}

__device__ __forceinline__ void combine_phase(const Frame& F, const Args& a, int layer, int half) {
    float* X = a.out; bf16_t* XB = (bf16_t*)(F.ws + WS_XB); const bf16_t* Y = (const bf16_t*)(F.ws + WS_R + R_YTOK);
    const float* g = a.in[I_LN2G] + layer * DM; const float* bta = a.in[I_LN2B] + layer * DM;
    const int lane = F.lane;
    for (int tl = F.bid * 8 + F.wave; tl < HALF_T; tl += F.G * 8) {
        const int t = half * HALF_T + tl; float v[16]; float* xr = X + (size_t)t * DM;
#pragma unroll
        for (int q = 0; q < 4; ++q) { const f32x4 x = *(const f32x4*)(xr + lane * 16 + 4 * q); v[4 * q] = x[0] * ALPHA; v[4 * q + 1] = x[1] * ALPHA; v[4 * q + 2] = x[2] * ALPHA; v[4 * q + 3] = x[3] * ALPHA; }
        float m[16];
#pragma unroll
        for (int i = 0; i < 16; ++i) m[i] = 0.f;
#pragma unroll
        for (int k = 0; k < 9; ++k) { const bf16_t* yr = Y + ((size_t)tl * 9 + k) * DM + lane * 16; const u32x4 w0 = *(const u32x4*)yr, w1 = *(const u32x4*)(yr + 8);
            m[0] += bflo(w0.x); m[1] += bfhi(w0.x); m[2] += bflo(w0.y); m[3] += bfhi(w0.y); m[4] += bflo(w0.z); m[5] += bfhi(w0.z); m[6] += bflo(w0.w); m[7] += bfhi(w0.w);
            m[8] += bflo(w1.x); m[9] += bfhi(w1.x); m[10] += bflo(w1.y); m[11] += bfhi(w1.y); m[12] += bflo(w1.z); m[13] += bfhi(w1.z); m[14] += bflo(w1.w); m[15] += bfhi(w1.w); }
#pragma unroll
        for (int i = 0; i < 16; ++i) v[i] += m[i];
        ln_row16(v, g, bta, lane);
        store_row16(v, xr, XB + (size_t)t * DM, lane);
    }
}

constexpr int KP = 144, VP = 192;
constexpr int KT_BYTES = 64 * KP, VT_BYTES = 64 * VP, KV_BUF = KT_BYTES + VT_BYTES;
__device__ __forceinline__ int crow(int r, int hi) { return (r & 3) + 8 * (r >> 2) + 4 * hi; }
__device__ __forceinline__ s16x4 vtr(const LAS unsigned char* p) { return __builtin_bit_cast(s16x4, __builtin_amdgcn_ds_read_tr16_b64_v4i16((LAS s16x4*)p)); }

struct KVRegs { u32x4 k, v; };
__device__ __forceinline__ void kv_load(KVRegs& r, const bf16_t* Kp, const bf16_t* Vp, size_t pitch, int row0, int tid) {
    const size_t off = (size_t)(row0 + (tid >> 3)) * pitch + (tid & 7) * 8;
    r.k = *(const u32x4*)(Kp + off); r.v = *(const u32x4*)(Vp + off);
}
__device__ __forceinline__ void kv_store(const KVRegs& r, LAS unsigned char* buf, int tid) {
    *(LAS u32x4*)(buf + (tid >> 3) * KP + (tid & 7) * 16) = r.k;
    *(LAS u32x4*)(buf + KT_BYTES + (tid >> 3) * VP + (tid & 7) * 16) = r.v;
}
__device__ __forceinline__ void qk_tile(f32x16& p0, f32x16& p1, const LAS unsigned char* kt, const bf16x8 (&qf)[4], int lane) {
    const LAS unsigned char* kb = kt + (lane & 31) * KP + (lane >> 5) * 16;
    p0 = (f32x16){}; p1 = (f32x16){};
#pragma unroll
    for (int ks = 0; ks < 4; ++ks) {
        const bf16x8 k0 = *(const LAS bf16x8*)(kb + ks * 32), k1 = *(const LAS bf16x8*)(kb + 32 * KP + ks * 32);
        p0 = __builtin_amdgcn_mfma_f32_32x32x16_bf16(k0, qf[ks], p0, 0, 0, 0);
        p1 = __builtin_amdgcn_mfma_f32_32x32x16_bf16(k1, qf[ks], p1, 0, 0, 0);
    }
}
__device__ __forceinline__ bf16x8 pfrag(const f32x16& p, int s) {
    u32x4 w; w.x = pg8::cvt_pk_bf16(p[8 * s], p[8 * s + 1]); w.y = pg8::cvt_pk_bf16(p[8 * s + 2], p[8 * s + 3]); w.z = pg8::cvt_pk_bf16(p[8 * s + 4], p[8 * s + 5]); w.w = pg8::cvt_pk_bf16(p[8 * s + 6], p[8 * s + 7]);
    return __builtin_bit_cast(bf16x8, w);
}
__device__ __forceinline__ void pv_sub(f32x16& o0, f32x16& o1, const LAS unsigned char* vt, int sub, const f32x16& p, int lane) {
    const LAS unsigned char* vb = vt + (sub * 32 + (lane >> 5) * 4 + ((lane & 15) >> 2)) * VP + (16 * ((lane >> 4) & 1) + 4 * (lane & 3)) * 2;
#pragma unroll
    for (int s = 0; s < 2; ++s) {
        const bf16x8 pb = pfrag(p, s);
        const s16x4 a0 = vtr(vb + (16 * s) * VP), a1 = vtr(vb + (16 * s + 8) * VP), b0 = vtr(vb + (16 * s) * VP + 64), b1 = vtr(vb + (16 * s + 8) * VP + 64);
        const bf16x8 va = {a0[0], a0[1], a0[2], a0[3], a1[0], a1[1], a1[2], a1[3]}, vbb = {b0[0], b0[1], b0[2], b0[3], b1[0], b1[1], b1[2], b1[3]};
        o0 = __builtin_amdgcn_mfma_f32_32x32x16_bf16(va, pb, o0, 0, 0, 0);
        o1 = __builtin_amdgcn_mfma_f32_32x32x16_bf16(vbb, pb, o1, 0, 0, 0);
    }
}
__device__ __forceinline__ void softmax_pv(f32x16& p0, f32x16& p1, f32x16& o0, f32x16& o1, float& m, float& l, const LAS unsigned char* vt, int lane) {
    float mx = NEGBIG;
#pragma unroll
    for (int r = 0; r < 16; ++r) mx = fmaxf(mx, fmaxf(p0[r], p1[r]));
    mx = fmaxf(mx, __shfl_xor(mx, 32));
    const float mn = fmaxf(m, mx), alpha = fast_exp2(m - mn);
    float ls = 0.f;
#pragma unroll
    for (int r = 0; r < 16; ++r) { p0[r] = (p0[r] > -1e29f) ? fast_exp2(p0[r] - mn) : 0.f; p1[r] = (p1[r] > -1e29f) ? fast_exp2(p1[r] - mn) : 0.f; ls += p0[r] + p1[r]; }
    ls += __shfl_xor(ls, 32);
    l = l * alpha + ls; m = mn;
    o0 *= alpha; o1 *= alpha;
    pv_sub(o0, o1, vt, 0, p0, lane); pv_sub(o0, o1, vt, 1, p1, lane);
}
__device__ __forceinline__ void load_qf(bf16x8 (&qf)[4], const bf16_t* qrow, int lane) {
#pragma unroll
    for (int ks = 0; ks < 4; ++ks) qf[ks] = *(const bf16x8*)(qrow + 16 * ks + 8 * (lane >> 5));
}
__device__ __forceinline__ void store_ot(const f32x16& o0, const f32x16& o1, float sc, bf16_t* orow, int lane) {
    const int hi = lane >> 5;
#pragma unroll
    for (int g = 0; g < 4; ++g) {
        u32x2 w; w.x = pg8::cvt_pk_bf16(o0[4 * g] * sc, o0[4 * g + 1] * sc); w.y = pg8::cvt_pk_bf16(o0[4 * g + 2] * sc, o0[4 * g + 3] * sc); *(u32x2*)(orow + 8 * g + 4 * hi) = w;
        u32x2 x; x.x = pg8::cvt_pk_bf16(o1[4 * g] * sc, o1[4 * g + 1] * sc); x.y = pg8::cvt_pk_bf16(o1[4 * g + 2] * sc, o1[4 * g + 3] * sc); *(u32x2*)(orow + 32 + 8 * g + 4 * hi) = x;
    }
}

__device__ __forceinline__ void fox_phase(const Frame& F, const Args& a) {
    bf16_t* H = (bf16_t*)(F.ws + WS_R + R_H); const float* DC = (const float*)(F.ws + WS_DCUM);
    const int lane = F.lane, tid = F.tid, hi = lane >> 5;
    LAS unsigned char* kvb = F.lds; LAS float* dkb = (LAS float*)(F.lds + 2 * KV_BUF);
    const int NU = NB * 16 * 8;
    for (int ui = F.bid; ui < NU; ui += F.G) {
        const int qb = 7 - (ui / (NB * 16)), bh = ui % (NB * 16), b = bh >> 4, h = bh & 15;
        const size_t rb0 = (size_t)b * SEQ;
        const bf16_t* Kp = H + rb0 * NO_PAD + 1024 + h * 64; const bf16_t* Vp = H + rb0 * NO_PAD + 2048 + h * 64;
        const int q0 = qb * 256 + F.wave * 32, tq = q0 + (lane & 31);
        bf16x8 qf[4]; load_qf(qf, H + (rb0 + tq) * NO_PAD + h * 64, lane);
        const float dq = DC[(rb0 + tq) * 16 + h];
        f32x16 o0 = {}, o1 = {}; float m = NEGBIG, l = 0.f;
        const int ntile = qb * 4 + 4; const int wlast = (q0 + 31) >> 6;
        KVRegs kr; float dkr = 0.f;
        kv_load(kr, Kp, Vp, NO_PAD, 0, tid); if (tid < 64) dkr = DC[(rb0 + tid) * 16 + h];
        __syncthreads();
        for (int t = 0; t < ntile; ++t) {
            LAS unsigned char* buf = kvb + (t & 1) * KV_BUF;
            kv_store(kr, buf, tid); if (tid < 64) dkb[(t & 1) * 64 + tid] = dkr;
            __syncthreads();
            if (t + 1 < ntile) { kv_load(kr, Kp, Vp, NO_PAD, (t + 1) * 64, tid); if (tid < 64) dkr = DC[(rb0 + (t + 1) * 64 + tid) * 16 + h]; }
            if (t <= wlast) {
                f32x16 p0, p1; qk_tile(p0, p1, buf, qf, lane);
                const LAS float* dk = dkb + (t & 1) * 64;
#pragma unroll
                for (int r = 0; r < 16; ++r) { const int kk = crow(r, hi), key = t * 64 + kk;
                    const float s0 = p0[r] * QK_C + dq - dk[kk], s1 = p1[r] * QK_C + dq - dk[kk + 32];
                    p0[r] = (key <= tq) ? s0 : NEGBIG; p1[r] = (key + 32 <= tq) ? s1 : NEGBIG; }
                softmax_pv(p0, p1, o0, o1, m, l, buf + KT_BYTES, lane);
            }
        }
        store_ot(o0, o1, 1.0f / l, H + (rb0 + tq) * NO_PAD + h * 64, lane);
        __syncthreads();
    }
}

template <class MaskFn>
__device__ __forceinline__ void attn_tiles(const Frame& F, unsigned tm, const bf16_t* Kp, const bf16_t* Vp, size_t pitch, const bf16x8 (&qf)[4],
                                            f32x16& o0, f32x16& o1, float& m, float& l, LAS unsigned char* kvb, MaskFn&& mask) {
    const int tid = F.tid, lane = F.lane;
    KVRegs kr; int par = 0;
    if (tm) kv_load(kr, Kp, Vp, pitch, __builtin_ctz(tm) * 64, tid);
    while (tm) {
        const int t = __builtin_ctz(tm); tm &= tm - 1;
        LAS unsigned char* buf = kvb + par * KV_BUF;
        kv_store(kr, buf, tid);
        __syncthreads();
        if (tm) kv_load(kr, Kp, Vp, pitch, __builtin_ctz(tm) * 64, tid);
        f32x16 p0, p1; qk_tile(p0, p1, buf, qf, lane);
        mask(p0, p1, t);
        softmax_pv(p0, p1, o0, o1, m, l, buf + KT_BYTES, lane);
        par ^= 1;
    }
    __syncthreads();
}
__device__ __forceinline__ unsigned pkh(float a, float b) { const _Float16 x = (_Float16)a, y = (_Float16)b; return (unsigned)__builtin_bit_cast(unsigned short, x) | ((unsigned)__builtin_bit_cast(unsigned short, y) << 16); }
__device__ __forceinline__ float h2f(unsigned short h) { return (float)__builtin_bit_cast(_Float16, h); }
__device__ __forceinline__ float dpp_f(float x, int ctrl_sel) {
    const int v = __builtin_bit_cast(int, x); int r;
    if (ctrl_sel == 0) r = __builtin_amdgcn_update_dpp(0, v, 0xB1, 0xf, 0xf, true);
    else if (ctrl_sel == 1) r = __builtin_amdgcn_update_dpp(0, v, 0x4E, 0xf, 0xf, true);
    else r = __builtin_amdgcn_update_dpp(0, v, 0x141, 0xf, 0xf, true);
    return __builtin_bit_cast(float, r);
}

__device__ __forceinline__ void dsa_unit(const Frame& F, const Args& a, int b, int qg) {
    bf16_t* H = (bf16_t*)(F.ws + WS_R + R_H);
    const int lane = F.lane, hi = lane >> 5, t0 = qg * 32; const size_t rb0 = (size_t)b * SEQ;
    LAS float* sc = (LAS float*)F.lds;
    LAS unsigned* bm = (LAS unsigned*)(F.lds + LDS_TAB);
    for (int hf = 0; hf < 2; ++hf) {
        const int tq0 = t0 + 16 * hf, nkt = ((tq0 + 15) >> 5) + 1;
        {
            bf16x8 qi[4][4]; float wl[4];
#pragma unroll
            for (int ct = 0; ct < 4; ++ct) { const int q = tq0 + 4 * ct + ((lane & 31) >> 3), head = lane & 7; const bf16_t* rp = H + (rb0 + q) * NE_PAD;
#pragma unroll
                for (int ks = 0; ks < 4; ++ks) qi[ct][ks] = *(const bf16x8*)(rp + EC_QI + head * 64 + 16 * ks + 8 * hi);
                wl[ct] = bf2f(rp[EC_WI + head]); }
            for (int kt = F.wave; kt < nkt; kt += 8) {
                bf16x8 kf[4]; { const bf16_t* kp = H + (rb0 + kt * 32 + (lane & 31)) * NE_PAD + EC_KI + 8 * hi;
#pragma unroll
                    for (int ks = 0; ks < 4; ++ks) kf[ks] = *(const bf16x8*)(kp + 16 * ks); }
#pragma unroll
                for (int ct = 0; ct < 4; ++ct) {
                    f32x16 acc = {};
#pragma unroll
                    for (int ks = 0; ks < 4; ++ks) acc = __builtin_amdgcn_mfma_f32_32x32x16_bf16(kf[ks], qi[ct][ks], acc, 0, 0, 0);
#pragma unroll
                    for (int r = 0; r < 16; ++r) { float v = fmaxf(acc[r], 0.f) * wl[ct]; v += dpp_f(v, 0); v += dpp_f(v, 1); v += dpp_f(v, 2); acc[r] = v; }
                    if ((lane & 7) == 0) { LAS float* dst = sc + (4 * ct + ((lane & 31) >> 3)) * 2048 + kt * 32 + 4 * hi;
#pragma unroll
                        for (int g = 0; g < 4; ++g) *(LAS f32x4*)(dst + 8 * g) = (f32x4){acc[4 * g], acc[4 * g + 1], acc[4 * g + 2], acc[4 * g + 3]}; }
                }
            }
        }
        __syncthreads();
        for (int q2 = 0; q2 < 2; ++q2) {
            const int ql = 2 * F.wave + q2, tq = tq0 + ql, n = tq + 1;
            unsigned u[32];
#pragma unroll
            for (int j = 0; j < 32; ++j) { const int idx = 64 * j + lane; unsigned bits = 0u;
                if (idx < n) { bits = __builtin_bit_cast(unsigned, sc[ql * 2048 + idx]); if ((bits << 1) == 0u) bits = 0u; bits ^= (bits & 0x80000000u) ? 0xffffffffu : 0x80000000u; }
                u[j] = bits; }
            unsigned thr = 0u; int need = 0;
            if (n > 256) {
                for (int bit = 31; bit >= 0; --bit) { const unsigned cand = thr | (1u << bit); int c = 0;
#pragma unroll
                    for (int j = 0; j < 32; ++j) c += __popcll(__ballot(u[j] >= cand));
                    if (c >= 256) thr = cand; }
                int cgt = 0;
#pragma unroll
                for (int j = 0; j < 32; ++j) cgt += __popcll(__ballot(u[j] > thr));
                need = 256 - cgt;
            }
            const unsigned long long lt = (1ull << lane) - 1ull; int er = 0;
#pragma unroll
            for (int j = 0; j < 32; ++j) { const int idx = 64 * j + lane; bool sel;
                if (n > 256) { const unsigned long long eqm = __ballot(u[j] == thr && idx < n); sel = (u[j] > thr) || (u[j] == thr && idx < n && (er + __popcll(eqm & lt)) < need); er += __popcll(eqm); }
                else sel = idx < n;
                const unsigned long long sm = __ballot(sel);
                if (lane == 0) { bm[(16 * hf + ql) * 64 + 2 * j] = (unsigned)sm; bm[(16 * hf + ql) * 64 + 2 * j + 1] = (unsigned)(sm >> 32); } }
        }
        __syncthreads();
    }
    const int tq = t0 + (lane & 31);
    bf16x8 qf[4]; load_qf(qf, H + (rb0 + tq) * NE_PAD + EC_QA + F.wave * 64, lane);
    f32x16 o0 = {}, o1 = {}; float m = NEGBIG, l = 0.f;
    const int ntile = ((t0 + 31) >> 6) + 1; const unsigned tm = (ntile >= 32) ? 0xffffffffu : ((1u << ntile) - 1u);
    const LAS unsigned* bq = bm + (lane & 31) * 64;
    attn_tiles(F, tm, H + rb0 * NE_PAD + EC_KA, H + rb0 * NE_PAD + EC_VA, NE_PAD, qf, o0, o1, m, l, F.lds,
        [&](f32x16& p0, f32x16& p1, int t) { const unsigned w0 = bq[2 * t] >> (4 * hi), w1 = bq[2 * t + 1] >> (4 * hi);
#pragma unroll
            for (int r = 0; r < 16; ++r) { const int sh = (r & 3) + 8 * (r >> 2);
                p0[r] = ((w0 >> sh) & 1u) ? p0[r] * QK_C : NEGBIG; p1[r] = ((w1 >> sh) & 1u) ? p1[r] * QK_C : NEGBIG; } });
    store_ot(o0, o1, 1.0f / l, H + (rb0 + tq) * NE_PAD + EC_QA + F.wave * 64, lane);
}

__device__ __forceinline__ void compress_item(const Frame& F, const Args& a, int item) {
    const bf16_t* H = (const bf16_t*)(F.ws + WS_R + R_H); const bf16_t* W = (const bf16_t*)(F.ws + WS_W);
    const int kv = item & 1, ct = (item >> 1) & 3, b = item >> 3, lane = F.lane, hi = lane >> 5;
    const bf16_t* w1t = W + (kv ? W_C1V : W_C1K) / 2; const bf16_t* w2t = W + (kv ? W_C2V : W_C2K) / 2;
    const float* bias1 = (const float*)(F.ws + WS_MISC) + kv * 64;
    bf16_t* outp = (bf16_t*)(F.ws + (kv ? WS_VC : WS_KC)) + (size_t)b * 128 * 64;
    const int col = kv ? EC_VC : EC_KC;
    LAS float* part = (LAS float*)F.lds; LAS unsigned short* hs = (LAS unsigned short*)(F.lds + 65536);
    int c = ct * 32 + (lane & 31); if (c > 126) c = 126;
    f32x16 a0 = {}, a1 = {};
    for (int ks = F.wave * 16; ks < F.wave * 16 + 16; ++ks) {
        const bf16x8 af = *(const bf16x8*)(H + ((size_t)b * SEQ + 16 * c + (ks >> 2)) * NE_PAD + col + 16 * (ks & 3) + 8 * hi);
        const bf16x8 b0 = *(const bf16x8*)(w1t + (size_t)(lane & 31) * 2048 + 16 * ks + 8 * hi), b1 = *(const bf16x8*)(w1t + (size_t)(32 + (lane & 31)) * 2048 + 16 * ks + 8 * hi);
        a0 = __builtin_amdgcn_mfma_f32_32x32x16_bf16(af, b0, a0, 0, 0, 0); a1 = __builtin_amdgcn_mfma_f32_32x32x16_bf16(af, b1, a1, 0, 0, 0);
    }
#pragma unroll
    for (int r = 0; r < 16; ++r) { part[F.wave * 2048 + crow(r, hi) * 64 + (lane & 31)] = a0[r]; part[F.wave * 2048 + crow(r, hi) * 64 + 32 + (lane & 31)] = a1[r]; }
    __syncthreads();
#pragma unroll
    for (int i = 0; i < 4; ++i) { const int idx = F.tid + 512 * i; float s = bias1[idx & 63];
#pragma unroll
        for (int w = 0; w < 8; ++w) s += part[w * 2048 + idx];
        const float h = s / (1.0f + __expf(-s)); hs[(idx >> 6) * 72 + (idx & 63)] = (unsigned short)f2bf(h); }
    __syncthreads();
    if (F.wave < 2) {
        const int nt = F.wave; f32x16 acc = {};
#pragma unroll
        for (int ks = 0; ks < 4; ++ks) { const bf16x8 af = *(const LAS bf16x8*)((const LAS unsigned char*)hs + (lane & 31) * 144 + (16 * ks + 8 * hi) * 2);
            const bf16x8 bf = *(const bf16x8*)(w2t + (size_t)(nt * 32 + (lane & 31)) * 64 + 16 * ks + 8 * hi);
            acc = __builtin_amdgcn_mfma_f32_32x32x16_bf16(af, bf, acc, 0, 0, 0); }
        const int n = nt * 32 + (lane & 31);
        const float* cosT = (const float*)(F.ws + WS_ROPE_COS); const float* sinT = (const float*)(F.ws + WS_ROPE_SIN);
#pragma unroll
        for (int r = 0; r < 16; ++r) { const int cg = ct * 32 + crow(r, hi); float v = acc[r];
            if (kv == 0) { const float o = __shfl_xor(v, 1); int pos = 16 * cg + 31; if (pos > SEQ - 1) pos = SEQ - 1; const float cs = cosT[pos * 32 + (n >> 1)], sn = sinT[pos * 32 + (n >> 1)];
                v = (n & 1) ? (v * cs + o * sn) : (v * cs - o * sn); }
            outp[(size_t)cg * 64 + n] = (unsigned short)((cg <= 126) ? f2bf(v) : 0u); }
    }
    __syncthreads();
}

__device__ __forceinline__ void nsa_unit(const Frame& F, const Args& a, int layer, int b, int qg) {
    bf16_t* H = (bf16_t*)(F.ws + WS_R + R_H);
    const int lane = F.lane, hi = lane >> 5, tid = F.tid, t0 = qg * 32, cur = qg; const size_t rb0 = (size_t)b * SEQ;
    const int tq = t0 + (lane & 31);
    LAS unsigned char* kvb = F.lds;
    LAS unsigned short* slab = (LAS unsigned short*)(F.lds + 2 * KV_BUF);
    LAS float* pcs = (LAS float*)(F.lds + 2 * KV_BUF + 65536);
    LAS unsigned* selm = (LAS unsigned*)(pcs + 4096);
    const bf16_t* rowp = H + (rb0 + tq) * NE_PAD;
    bf16x8 qf[4]; load_qf(qf, rowp + EC_QB + F.wave * 64, lane);
    const float* bg = a.in[I_EV_BGATE] + (layer >> 1) * 24 + F.wave * 3;
    const float g0 = sigmoidf_(bf2f(rowp[EC_GB + F.wave * 3 + 0]) + bg[0]), g1 = sigmoidf_(bf2f(rowp[EC_GB + F.wave * 3 + 1]) + bg[1]), g2 = sigmoidf_(bf2f(rowp[EC_GB + F.wave * 3 + 2]) + bg[2]);
    { const bf16_t* kc = (const bf16_t*)(F.ws + WS_KC) + (size_t)b * 128 * 64; const bf16_t* vc = (const bf16_t*)(F.ws + WS_VC) + (size_t)b * 128 * 64;
      KVRegs r0, r1; kv_load(r0, kc, vc, 64, 0, tid); kv_load(r1, kc, vc, 64, 64, tid); kv_store(r0, kvb, tid); kv_store(r1, kvb + KV_BUF, tid); }
    __syncthreads();
    f32x16 pc[4]; f32x16 oa0 = {}, oa1 = {};
    {
        const int cmax = (tq >= 31) ? min(126, (tq - 31) >> 4) : -1;
        qk_tile(pc[0], pc[1], kvb, qf, lane); qk_tile(pc[2], pc[3], kvb + KV_BUF, qf, lane);
        float mx = NEGBIG;
#pragma unroll
        for (int s = 0; s < 4; ++s)
#pragma unroll
            for (int r = 0; r < 16; ++r) { const int c = 32 * s + crow(r, hi); pc[s][r] = (c <= cmax) ? pc[s][r] * QK_C : NEGBIG; mx = fmaxf(mx, pc[s][r]); }
        mx = fmaxf(mx, __shfl_xor(mx, 32));
        float ls = 0.f;
#pragma unroll
        for (int s = 0; s < 4; ++s)
#pragma unroll
            for (int r = 0; r < 16; ++r) { pc[s][r] = (pc[s][r] > -1e29f) ? fast_exp2(pc[s][r] - mx) : 0.f; ls += pc[s][r]; }
        ls += __shfl_xor(ls, 32);
        const float inv = (ls > 0.f) ? 1.0f / ls : 0.f;
#pragma unroll
        for (int s = 0; s < 4; ++s) pc[s] *= inv;
        f32x16 c0 = {}, c1 = {};
        pv_sub(c0, c1, kvb + KT_BYTES, 0, pc[0], lane); pv_sub(c0, c1, kvb + KT_BYTES, 1, pc[1], lane);
        pv_sub(c0, c1, kvb + KV_BUF + KT_BYTES, 0, pc[2], lane); pv_sub(c0, c1, kvb + KV_BUF + KT_BYTES, 1, pc[3], lane);
        oa0 = c0 * g0; oa1 = c1 * g0;
    }
    { LAS unsigned short* sl = slab + F.wave * 4096 + (lane & 31) * 128 + 4 * hi;
#pragma unroll
      for (int s = 0; s < 4; ++s)
#pragma unroll
          for (int g = 0; g < 4; ++g) { u32x2 w; w.x = pkh(pc[s][4 * g], pc[s][4 * g + 1]); w.y = pkh(pc[s][4 * g + 2], pc[s][4 * g + 3]); *(LAS u32x2*)(sl + 32 * s + 8 * g) = w; } }
    __syncthreads();
#pragma unroll
    for (int i = 0; i < 8; ++i) { const int idx = tid + 512 * i; float s8 = 0.f;
#pragma unroll
        for (int w = 0; w < 8; ++w) s8 += h2f(slab[w * 4096 + idx]);
        pcs[idx] = s8; }
    __syncthreads();
#pragma unroll
    for (int qq = 0; qq < 4; ++qq) { const int q = 4 * F.wave + qq; const LAS float* pr = pcs + q * 128;
        float v = pr[2 * lane] + 0.5f * ((lane > 0 ? pr[2 * lane - 1] : 0.f) + pr[2 * lane + 1]);
        if (lane == 0 || lane == cur || lane == cur - 1) v = 1e30f; else if (lane > cur) v = NEGBIG;
        int rank = 0;
        for (int j = 0; j < 64; ++j) { const float o = __builtin_bit_cast(float, __builtin_amdgcn_readlane(__builtin_bit_cast(int, v), j)); rank += (o > v || (o == v && j < lane)) ? 1 : 0; }
        const unsigned long long sm = __ballot(rank < 8);
        if (lane == 0) { selm[2 * q] = (unsigned)sm; selm[2 * q + 1] = (unsigned)(sm >> 32); } }
    __syncthreads();
    {
        unsigned long long un = 0ull;
        { const unsigned lo = selm[2 * (lane & 31)], hh = selm[2 * (lane & 31) + 1]; unsigned ul = lo, uh = hh;
#pragma unroll
          for (int o = 1; o < 32; o <<= 1) { ul |= __shfl_xor(ul, o); uh |= __shfl_xor(uh, o); }
          un = ((unsigned long long)__builtin_amdgcn_readfirstlane(uh) << 32) | (unsigned)__builtin_amdgcn_readfirstlane(ul); }
        if (cur < 63) un &= (1ull << (cur + 1)) - 1ull;
        unsigned tm = 0u;
        for (int t = 0; t <= (cur >> 1); ++t) if ((un >> (2 * t)) & 3ull) tm |= 1u << t;
        const unsigned long long mysel = ((unsigned long long)selm[2 * (lane & 31) + 1] << 32) | selm[2 * (lane & 31)];
        f32x16 s0 = {}, s1 = {}; float m = NEGBIG, l = 0.f;
        attn_tiles(F, tm, H + rb0 * NE_PAD + EC_KS, H + rb0 * NE_PAD + EC_VS, NE_PAD, qf, s0, s1, m, l, kvb,
            [&](f32x16& p0, f32x16& p1, int t) { const bool b0 = (mysel >> (2 * t)) & 1ull, b1 = (mysel >> (2 * t + 1)) & 1ull;
#pragma unroll
                for (int r = 0; r < 16; ++r) { const int key = 64 * t + crow(r, hi);
                    p0[r] = (b0 && key <= tq) ? p0[r] * QK_C : NEGBIG; p1[r] = (b1 && key + 32 <= tq) ? p1[r] * QK_C : NEGBIG; } });
        const float sc = g1 / l; oa0 += s0 * sc; oa1 += s1 * sc;
    }
    {
        const int tlo = (t0 >= 511) ? ((t0 - 511) >> 6) : 0, thi = (t0 + 31) >> 6;
        unsigned tm = 0u; for (int t = tlo; t <= thi; ++t) tm |= 1u << t;
        f32x16 s0 = {}, s1 = {}; float m = NEGBIG, l = 0.f;
        attn_tiles(F, tm, H + rb0 * NE_PAD + EC_KW, H + rb0 * NE_PAD + EC_VW, NE_PAD, qf, s0, s1, m, l, kvb,
            [&](f32x16& p0, f32x16& p1, int t) {
#pragma unroll
                for (int r = 0; r < 16; ++r) { const int key = 64 * t + crow(r, hi);
                    p0[r] = (key <= tq && key + 512 > tq) ? p0[r] * QK_C : NEGBIG; p1[r] = (key + 32 <= tq && key + 32 + 512 > tq) ? p1[r] * QK_C : NEGBIG; } });
        const float sc = g2 / l; oa0 += s0 * sc; oa1 += s1 * sc;
    }
    store_ot(oa0, oa1, 1.0f, H + (rb0 + tq) * NE_PAD + EC_QB + F.wave * 64, lane);
    __syncthreads();
}

__device__ __forceinline__ void moe_tables(const Frame& F, int layer) {
    LAS int* cntl = (LAS int*)(F.lds + LDS_TAB); LAS int* rbs = cntl + 160;
    __syncthreads();
    if (F.tid < NV) cntl[F.tid] = ((F.tid % 65) == 64) ? HALF_T : (int)__hip_atomic_load(F.ctl + CW_CNT + layer * 256 + F.tid, RLX_AGENT);
    __syncthreads();
    if (F.tid == 0) { int run = 0; for (int v = 0; v < NV; ++v) { rbs[v] = run; run += (cntl[v] + 255) >> 8; } rbs[NV] = run; }
    __syncthreads();
}

constexpr int PH_PER_LAYER = 16, N_PHASES = DEPTH * PH_PER_LAYER;
__global__ void __launch_bounds__(512, 2) fwd(Args args) {
    extern __shared__ __attribute__((aligned(16))) unsigned char lds_raw[];
    Frame F; F.lds = (LAS unsigned char*)lds_raw; F.tid = threadIdx.x; F.lane = F.tid & 63; F.wave = __builtin_amdgcn_readfirstlane(F.tid >> 6);
    F.G = gridDim.x; F.bid = blockIdx.x; F.ws = args.ws; F.ctl = (gu32*)(args.ws + WS_CTL);
    volatile LAS unsigned* MISC = (volatile LAS unsigned*)(F.lds + LDS_MISC);
    if (F.tid < 64) MISC[F.tid] = 0u;
    __syncthreads();
    const int lo = args.ph_lo, hi = args.ph_hi; const bool multi = (hi - lo) > 1;
    XcdBarrier bar; bar.bar = (unsigned*)(F.ctl + CW_BAR); bar.x = 0; bar.st = MISC;
    if (multi) bar = xcd_barrier_post((unsigned*)(F.ctl + CW_BAR), MISC);
#ifndef PHMASK
#define PHMASK 0xffff
#endif
#define IN(k) (((PHMASK >> ((k) & 15)) & 1) && lo <= (k) && (k) < hi)
#define SEAM() do { if (multi) xcd_barrier(bar); } while (0)
#define PF() Frame P = F; { int t_ = F.tid; asm volatile("" : "+v"(t_)); P.tid = t_; P.lane = t_ & 63; int w_ = F.wave; asm volatile("" : "+s"(w_)); P.wave = w_; unsigned char* p_ = args.ws; asm volatile("" : "+s"(p_)); P.ws = p_; P.ctl = (gu32*)(p_ + WS_CTL); } \
    unsigned char* ws = P.ws; bf16_t* XB = (bf16_t*)(ws + WS_XB); bf16_t* XB2 = (bf16_t*)(ws + WS_R + R_XB2); bf16_t* H = (bf16_t*)(ws + WS_R + R_H); bf16_t* W = (bf16_t*)(ws + WS_W); (void)XB; (void)XB2; (void)H; (void)W;
    LAS int* cntl = (LAS int*)(F.lds + LDS_TAB); LAS int* rbs = cntl + 160;
    for (int layer = 0; layer < DEPTH; ++layer) {
        const int pb = layer * PH_PER_LAYER; const bool even = (layer & 1) == 0; const int jl = layer >> 1;
        if (IN(pb + 0)) { PF(); prep_phase(P, args, layer); SEAM(); }
        if (IN(pb + 1)) { PF();
            const bf16_t* xin = (layer == 0) ? XB : XB2;
            if (even) { pg8::DenseSched S{(const char*)xin, (const char*)(W + W_IN / 2), DM, DM, T / 256, NE_PAD / 256, P.G, P.bid};
                EpiInEven E{H, (const float*)(ws + WS_ROPE_COS), (const float*)(ws + WS_ROPE_SIN)}; pg8::gemm_phase(P.lds, S, E, P.tid); }
            else { pg8::DenseSched S{(const char*)xin, (const char*)(W + W_IN / 2), DM, DM, T / 256, NO_PAD / 256, P.G, P.bid};
                EpiInOdd E{H, (float*)(ws + WS_LOGF), args.in[I_OD_BF] + jl * 16}; pg8::gemm_phase(P.lds, S, E, P.tid); }
            SEAM();
        }
        if (even) {
            if (IN(pb + 2)) { PF();
                for (int it = P.bid; it < 256; it += P.G) compress_item(P, args, it);
                for (int u = P.bid; u < NB * 64; u += P.G) { const int qg = 63 - (u / NB), b = u % NB; dsa_unit(P, args, b, qg); }
                SEAM();
            }
            if (IN(pb + 3)) { PF(); for (int u = P.bid; u < NB * 64; u += P.G) { const int qg = 63 - (u / NB), b = u % NB; nsa_unit(P, args, layer, b, qg); } SEAM(); }
        } else {
            if (IN(pb + 2)) { PF(); scan_phase(P, args); SEAM(); }
            if (IN(pb + 3)) { PF(); fox_phase(P, args); SEAM(); }
        }
        if (IN(pb + 4)) { PF();
            pg8::DenseSched S{(const char*)H, (const char*)(W + W_O / 2), even ? NE_PAD : NO_PAD, DM, T / 256, DM / 256, P.G, P.bid};
            EpiOut E{(layer == 0) ? args.in[I_X] : args.out, args.out}; pg8::gemm_phase(P.lds, S, E, P.tid); SEAM();
        }
        if (IN(pb + 5)) { PF(); route_phase(P, args, layer); SEAM(); }
        if (IN(pb + 6)) { PF();
            moe_tables(P, layer);
            MoeSched S{(const char*)XB, (const char*)(W + W_UP / 2), DM, DM, 2, (size_t)512 * DM * 2, rbs, cntl, 0, NV - 1, 0, rbs[NV] * 2, P.G, P.bid, (const int*)(ws + WS_SLOT_TK), true};
            EpiUp E{(bf16_t*)(ws + WS_R + R_HMID)}; pg8::gemm_phase(P.lds, S, E, P.tid); SEAM();
        }
        for (int half = 0; half < 2; ++half) {
            if (IN(pb + 7 + 2 * half)) { PF();
                moe_tables(P, layer);
                MoeSched S{(const char*)(ws + WS_R + R_HMID), (const char*)(W + W_DN / 2), DFF, DFF, 4, (size_t)DM * DFF * 2, rbs, cntl, half * 65, half * 65 + 64, rbs[half * 65],
                           (rbs[half * 65 + 65] - rbs[half * 65]) * 4, P.G, P.bid, (const int*)(ws + WS_SLOT_TK), false};
                EpiDown E{(bf16_t*)(ws + WS_R + R_YTOK), (const int*)(ws + WS_SLOT_TK), (const float*)(ws + WS_SLOT_G), cntl}; pg8::gemm_phase(P.lds, S, E, P.tid); SEAM();
            }
            if (IN(pb + 8 + 2 * half)) { PF(); combine_phase(P, args, layer, half); SEAM(); }
        }
        if (IN(pb + 11)) { PF();
            pg8::DenseSched S{(const char*)(ws + WS_PB), (const char*)(W + W_P / 2), 256, 256, T / 256, DM / 256, P.G, P.bid};
            EpiPleE E{(bf16_t*)(ws + WS_R + R_E), (float*)(ws + WS_SSQ)}; pg8::gemm_phase(P.lds, S, E, P.tid); SEAM();
        }
        if (IN(pb + 12)) { PF();
            pg8::DenseSched S{(const char*)XB, (const char*)(W + W_G / 2), DM, DM, T / 256, DM / 256, P.G, P.bid};
            EpiPleG E{args.out, (const bf16_t*)(ws + WS_R + R_E), (const float*)(ws + WS_SSQ), args.in[I_PNG] + layer * DM, XB2}; pg8::gemm_phase(P.lds, S, E, P.tid); SEAM();
        }
    }
#undef IN
#undef SEAM
}

extern "C" void kernel_launch(void* const* d_in, const int* in_sizes, int n_in, void* d_out, int out_size, void* d_ws, size_t ws_size, hipStream_t stream) {
    static int grid = 0;
    if (grid == 0) {
        if (n_in != 29 || in_sizes[0] != T * DM || out_size != T * DM || ws_size < WS_END) { fprintf(stderr, "kernel_launch: unexpected shapes / workspace (n_in %d, ws %zu, need %zu)\n", n_in, ws_size, (size_t)WS_END); grid = -1; return; }
        int dev = 0, cus = 0, per_cu = 0;
        if (hipGetDevice(&dev) != hipSuccess || hipDeviceGetAttribute(&cus, hipDeviceAttributeMultiprocessorCount, dev) != hipSuccess) { grid = -1; return; }
        if (hipFuncSetAttribute((const void*)fwd, hipFuncAttributeMaxDynamicSharedMemorySize, LDS_BYTES) != hipSuccess) { fprintf(stderr, "kernel_launch: hipFuncSetAttribute failed\n"); grid = -1; return; }
        if (hipOccupancyMaxActiveBlocksPerMultiprocessor(&per_cu, (const void*)fwd, 512, LDS_BYTES) != hipSuccess || per_cu < 1) { fprintf(stderr, "kernel_launch: occupancy query says %d\n", per_cu); }
        (void)hipGetLastError();
        grid = cus;
    }
    if (grid < 0) return;
    if (hipMemsetAsync((char*)d_ws + WS_CTL, 0, CTL_BYTES, stream) != hipSuccess) return;
    Args a{};
    for (int i = 0; i < 29; ++i) a.in[i] = (const float*)d_in[i];
    a.out = (float*)d_out; a.ws = (unsigned char*)d_ws;
#if MK_ONE_LAUNCH
    a.ph_lo = 0; a.ph_hi = N_PHASES;
    hipLaunchKernelGGL(fwd, dim3(grid), dim3(512), LDS_BYTES, stream, a);
#else
    for (int ph = 0; ph < N_PHASES; ++ph) {
        if ((ph % PH_PER_LAYER) > 12) continue;
        a.ph_lo = ph; a.ph_hi = ph + 1;
        hipLaunchKernelGGL(fwd, dim3(grid), dim3(512), LDS_BYTES, stream, a);
    }
#endif
}
```

```cpp
#include <hip/hip_runtime.h>
#include <cstdio>
#include <cstdint>

#define LAS __attribute__((address_space(3)))
#define GAS __attribute__((address_space(1)))
typedef unsigned short bf16_t;
typedef short bf16x8 __attribute__((ext_vector_type(8)));
typedef short s16x4 __attribute__((ext_vector_type(4)));
typedef float f32x2 __attribute__((ext_vector_type(2)));
typedef float f32x4 __attribute__((ext_vector_type(4)));
typedef float f32x16 __attribute__((ext_vector_type(16)));
typedef unsigned u32x2 __attribute__((ext_vector_type(2)));
typedef unsigned u32x4 __attribute__((ext_vector_type(4)));
typedef GAS unsigned gu32;

#ifndef MK_ONE_LAUNCH
#define MK_ONE_LAUNCH 1
#endif

constexpr int DM = 1024, NB = 32, SEQ = 2048, DEPTH = 4, T = NB * SEQ;
constexpr int EVEN_COLS = 2144, ODD_COLS = 3088, NE_PAD = 2304, NO_PAD = 3328;
constexpr int NEXP = 64, NV = 130  , HALF_T = T / 2, DFF = 256;
constexpr float LN_EPS = 1e-5f, RMS_EPS = 1e-6f;
constexpr float ALPHA = 1.6817928305074290f;
constexpr float LOG2E = 1.4426950408889634f;
constexpr float QK_C = 0.125f * LOG2E;
constexpr float NEGBIG = -1e30f;

constexpr int EC_QA = 0, EC_QB = 512, EC_QI = 1024, EC_KA = 1536, EC_KI = 1600, EC_KS = 1664, EC_KW = 1728;
constexpr int EC_VA = 1792, EC_KC = 1856, EC_VC = 1920, EC_VS = 1984, EC_VW = 2048, EC_WI = 2112, EC_GB = 2120;

constexpr size_t MiB = 1u << 20;
constexpr size_t WS_CTL = 0, CTL_BYTES = 1 * MiB;
constexpr size_t WS_ROPE_COS = 1 * MiB, WS_ROPE_SIN = WS_ROPE_COS + 256 * 1024;
constexpr size_t WS_SLOT_TK = 2 * MiB;
constexpr size_t WS_SLOT_G = WS_SLOT_TK + (size_t)NV * HALF_T * 4;
constexpr size_t WS_DCUM = 38 * MiB;
constexpr size_t WS_LOGF = 42 * MiB;
constexpr size_t WS_KC = 46 * MiB, WS_VC = WS_KC + 512 * 1024;
constexpr size_t WS_SSQ = 47 * MiB;
constexpr size_t WS_PB = 51 * MiB;
constexpr size_t WS_MISC = 83 * MiB;
constexpr size_t WS_XB = 84 * MiB;
constexpr size_t WS_W = 212 * MiB;
constexpr size_t W_IN = 0, W_O = 7 * MiB, W_G = 9 * MiB, W_P = 11 * MiB, W_C1K = 12 * MiB, W_C1V = W_C1K + 256 * 1024, W_C2K = W_C1V + 256 * 1024, W_C2V = W_C2K + 8192;
constexpr size_t W_UP = 16 * MiB  , W_DN = 82 * MiB  ;
constexpr size_t WS_R = 340 * MiB;
constexpr size_t R_H = 0, R_HMID = 0, R_E = 0, R_YTOK = 320 * MiB, R_XB2 = 440 * MiB;
constexpr size_t WS_END = WS_R + 896 * MiB;
static_assert(R_YTOK + (size_t)HALF_T * 9 * 1024 * 2 <= 896 * MiB, "ytok");
static_assert(W_DN + 65ull * 1024 * 256 * 2 <= 128 * MiB, "w");
constexpr int CW_BAR = 4096;
constexpr int CW_CNT = 16384;
constexpr int XBW = 3456;

constexpr int RING_BYTES = 131072;
constexpr int LDS_TAB = RING_BYTES;
constexpr int LDS_MISC = RING_BYTES + 20480;
constexpr int LDS_BYTES = RING_BYTES + 20480 + 256;

#define LDS_WAIT() asm volatile("s_waitcnt lgkmcnt(0)" ::: "memory")
#define VM_WAIT() asm volatile("s_waitcnt vmcnt(0)" ::: "memory")
#define RLX_AGENT __ATOMIC_RELAXED, __HIP_MEMORY_SCOPE_AGENT
__device__ __forceinline__ unsigned f2bf(float f) { unsigned u = __builtin_bit_cast(unsigned, f); return (u + 0x7fffu + ((u >> 16) & 1u)) >> 16; }
__device__ __forceinline__ unsigned pk2(float lo, float hi) { return f2bf(lo) | (f2bf(hi) << 16); }
__device__ __forceinline__ float bf2f(unsigned short h) { return __builtin_bit_cast(float, (unsigned)h << 16); }
__device__ __forceinline__ float bflo(unsigned w) { return __builtin_bit_cast(float, w << 16); }
__device__ __forceinline__ float bfhi(unsigned w) { return __builtin_bit_cast(float, w & 0xffff0000u); }
__device__ __forceinline__ float wave_sum(float v) {
#pragma unroll
    for (int o = 1; o < 64; o <<= 1) v += __shfl_xor(v, o);
    return v;
}
__device__ __forceinline__ float fast_exp2(float x) { return __builtin_amdgcn_exp2f(x); }
__device__ __forceinline__ float sigmoidf_(float x) { return 1.0f / (1.0f + __expf(-x)); }

#define XB_TMO      128
#define XB_XCNT(j)  (256  + 64 * (j))
#define XB_XSUB(j)  (1280 + 64 * (j))
#define XB_XGEN(j)  (2304 + 64 * (j))
#define XB_TOP      3328
#define XB_TOPGEN   3392
#define XCD_BAR_WORDS 3456
#define XB_SPIN_CAP (1u << 22)
__device__ __forceinline__ unsigned xb_ld(unsigned* p)              { return __hip_atomic_load(p, __ATOMIC_RELAXED, __HIP_MEMORY_SCOPE_AGENT); }
__device__ __forceinline__ unsigned xb_add(unsigned* p, unsigned v) { return __hip_atomic_fetch_add(p, v, __ATOMIC_RELAXED, __HIP_MEMORY_SCOPE_AGENT); }
__device__ __forceinline__ unsigned xb_xcc_id() { return (unsigned)__builtin_amdgcn_s_getreg((3 << 11) | 20) & 0xFu; }
#define XB_SPIN(cond, bar) do { unsigned _sp = 0; while (cond) { __builtin_amdgcn_s_sleep(1); \
    if ((++_sp & 255u) == 0u) { if (xb_ld(&(bar)[XB_TMO])) break; if (_sp > XB_SPIN_CAP) { atomicAdd(&(bar)[XB_TMO], 1u); break; } } } } while (0)
struct XcdBarrier { unsigned* bar; unsigned x; volatile LAS unsigned* st; };
__device__ __forceinline__ XcdBarrier xcd_barrier_post(unsigned* bar, volatile LAS unsigned* st) {
    XcdBarrier b; b.bar = bar; b.x = xb_xcc_id(); b.st = st;
    if (threadIdx.x == 0) (void)xb_add(&bar[XB_XCNT(b.x)], 1u);
    return b;
}
__device__ __forceinline__ void xcd_barrier_complete(unsigned* bar, unsigned x, unsigned& nloc, unsigned& nx) {
    const unsigned G = gridDim.x * gridDim.y * gridDim.z;
    unsigned sum, cnt, mine, sp = 0u;
    for (;;) {
        sum = 0u; cnt = 0u; mine = 0u;
#pragma unroll
        for (unsigned j = 0; j < 16; ++j) { const unsigned c = xb_ld(&bar[XB_XCNT(j)]); sum += c; cnt += (c > 0u) ? 1u : 0u; mine = (j == x) ? c : mine; }
        if (sum == G) break;
        __builtin_amdgcn_s_sleep(1);
        if ((++sp & 255u) == 0u) { if (xb_ld(&bar[XB_TMO])) break; if (sp > XB_SPIN_CAP) { atomicAdd(&bar[XB_TMO], 1u); break; } }
    }
    nloc = mine > 0u ? mine : 1u; nx = cnt > 0u ? cnt : 1u;
}
__device__ __forceinline__ void xcd_barrier(const XcdBarrier& b) {
    asm volatile("s_waitcnt vmcnt(0)" ::: "memory");
    __syncthreads();
    if (threadIdx.x == 0) {
        unsigned* bar = b.bar;
        __builtin_amdgcn_s_waitcnt(0);
        unsigned nloc = b.st[0], nx = b.st[1];
        if (nloc == 0u) { xcd_barrier_complete(bar, b.x, nloc, nx); b.st[0] = nloc; b.st[1] = nx; }
        const unsigned old = xb_add(&bar[XB_XSUB(b.x)], 1u);
        const unsigned gen = old / nloc;
        if (old + 1u == (gen + 1u) * nloc) {
            __builtin_amdgcn_fence(__ATOMIC_RELEASE, "agent");
            asm volatile("s_waitcnt vmcnt(0)" ::: "memory");
            const unsigned og = xb_add(&bar[XB_TOP], 1u);
            const unsigned tg = og / nx;
            if (og + 1u == (tg + 1u) * nx) xb_add(&bar[XB_TOPGEN], 1u);
            else XB_SPIN(xb_ld(&bar[XB_TOPGEN]) == tg, bar);
            __builtin_amdgcn_fence(__ATOMIC_ACQUIRE, "agent");
            xb_add(&bar[XB_XGEN(b.x)], 1u);
            asm volatile("s_waitcnt vmcnt(0)" ::: "memory");
        } else {
            XB_SPIN(xb_ld(&bar[XB_XGEN(b.x)]) == gen, bar);
            __builtin_amdgcn_fence(__ATOMIC_ACQUIRE, "agent");
            asm volatile("s_waitcnt vmcnt(0)" ::: "memory");
        }
    }
    __syncthreads();
}

namespace pg8 {
constexpr int BM = 256, BK = 64, HALF = 128, HTB = HALF * BK * 2, STAGE_BYTES = 8 * HTB, NXCD = 8, WGM = 8;
__host__ __device__ __forceinline__ int lds_byte(int r, int c) { const int st = (r >> 4) * 2 + (c >> 5), rr = r & 15, cc = c & 31, ob = rr * 64 + cc * 2; return st * 1024 + (ob ^ (((ob >> 9) & 1) << 5)); }
__host__ __device__ __forceinline__ void stage_rc(int b, int& R, int& C) { const int st = b / 1024, sb = b % 1024, swz = sb ^ (((sb >> 9) & 1) << 5); R = (st >> 1) * 16 + swz / 64; C = (st & 1) * 32 + (swz % 64) / 2; }
__host__ __device__ __forceinline__ int perm32(int rho) { const int n = rho >> 4, i = rho & 15; return 8 * (i >> 2) + 4 * n + (i & 3); }

struct Unit { int pm, pn, v, rb; };

__device__ __forceinline__ bool static_next(int nM, int nN, int G, int c, int i, Unit& u) {
    const int nwg = nM * nN; const long L = (long)i * G + c; if (L >= nwg) return false;
    int wgid = (int)L; { const int q = nwg / NXCD, r = nwg % NXCD, xcd = wgid % NXCD, off = wgid / NXCD; wgid = (xcd < r ? xcd * (q + 1) : r * (q + 1) + (xcd - r) * q) + off; }
    const int nig = WGM * nN, gid = wgid / nig, fm = gid * WGM, gsz = (nM - fm) < WGM ? (nM - fm) : WGM;
    u.pm = fm + ((wgid % nig) % gsz); u.pn = (wgid % nig) / gsz; u.v = 0; u.rb = 0; return true;
}
struct DenseSched {
    const char* A; const char* Bt; int lda, K, nM, nN, G, c;
    __device__ __forceinline__ bool next(int i, Unit& u) const { return static_next(nM, nN, G, c, i, u); }
    __device__ __forceinline__ const char* a_base(const Unit& u) const { return A + (size_t)u.pm * 256 * lda * 2; }
    __device__ __forceinline__ const char* b_base(const Unit& u) const { return Bt + (size_t)u.pn * 256 * K * 2; }
    __device__ __forceinline__ void a_off(const Unit&, const int (&R)[2], const int (&C)[2], unsigned (&o)[2][2]) const {
#pragma unroll
        for (int h = 0; h < 2; ++h)
#pragma unroll
            for (int i = 0; i < 2; ++i) o[h][i] = (unsigned)((h * 128 + R[i]) * lda + C[i]) * 2u;
    }
};

__device__ __forceinline__ unsigned cvt_pk_bf16(float lo, float hi) { unsigned r; asm volatile("v_cvt_pk_bf16_f32 %0, %1, %2" : "=v"(r) : "v"(lo), "v"(hi)); return r; }

template <class Epi, class Sched>
__device__ __forceinline__ void gemm_phase(LAS unsigned char* lds, const Sched& S, const Epi& E, int tid) {
    const int wid = __builtin_amdgcn_readfirstlane(tid >> 6), lane = tid & 63, wr = wid >> 2, wc = wid & 3, fr = lane & 15, fq = lane >> 4;
    const int K = S.K, nt = K / BK;
    int RR[2], CC[2]; unsigned voffB[2];
#pragma unroll
    for (int i = 0; i < 2; ++i) { int R, C; stage_rc(tid * 16 + i * 8192, R, C); const int Rb = Epi::PERM ? ((R & ~31) + perm32(R & 31)) : R;
        RR[i] = R; CC[i] = C; voffB[i] = (unsigned)(Rb * K + C) * 2u; }
    const size_t kstep = (size_t)(BK * 2);
    const size_t hstep = (size_t)HALF * K * 2;
    const unsigned ldsw = (unsigned)wid * 1024u;
    const int aoff = lds_byte(wr * 64 + fr, fq * 8), boff = lds_byte(wc * 32 + fr, fq * 8);
#define PG8_SA(b, h) (((b) * 2 + (h)) * HTB)
#define PG8_SB(b, h) ((4 + (b) * 2 + (h)) * HTB)
#define PG8_STAGE(bufoff, gbase, voff) do { _Pragma("unroll") for (int _i = 0; _i < 2; ++_i) \
        __builtin_amdgcn_global_load_lds((const unsigned*)((const char*)(gbase) + (voff)[_i]), (LAS unsigned*)(lds + (bufoff) + ldsw + _i * 8192), 16, 0, 0); } while (0)
#define PG8_LDA(dst, b, h) do { _Pragma("unroll") for (int m = 0; m < 4; ++m) _Pragma("unroll") for (int k = 0; k < 2; ++k) dst[m][k] = *(const LAS bf16x8*)(lds + PG8_SA(b, h) + aoff + m * 2048 + k * 1024); } while (0)
#define PG8_LDB(dst, b, h) do { _Pragma("unroll") for (int n = 0; n < 2; ++n) _Pragma("unroll") for (int k = 0; k < 2; ++k) dst[n][k] = *(const LAS bf16x8*)(lds + PG8_SB(b, h) + boff + n * 2048 + k * 1024); } while (0)
#define PG8_MMA(ai, bj, At, Bt) do { __builtin_amdgcn_s_setprio(1); _Pragma("unroll") for (int m = 0; m < 4; ++m) _Pragma("unroll") for (int n = 0; n < 2; ++n) _Pragma("unroll") for (int k = 0; k < 2; ++k) \
        acc[ai][bj][m][n] = __builtin_amdgcn_mfma_f32_16x16x32_bf16(Bt[n][k], At[m][k], acc[ai][bj][m][n], 0, 0, 0); __builtin_amdgcn_s_setprio(0); } while (0)
#define PG8_WAIT_V(n) asm volatile("s_waitcnt vmcnt(" #n ")" ::: "memory")
#define PG8_WAIT_L(n) asm volatile("s_waitcnt lgkmcnt(" #n ")" ::: "memory")
#define PG8_BAR __builtin_amdgcn_s_barrier()
#define PG8_SCHED __builtin_amdgcn_sched_barrier(0)
    Unit cur, nxt; int ui = 0;
    if (!S.next(0, cur)) return;
    f32x4 acc[2][2][4][2];
#pragma unroll
    for (int a = 0; a < 2; ++a)
#pragma unroll
        for (int b = 0; b < 2; ++b)
#pragma unroll
            for (int m = 0; m < 4; ++m)
#pragma unroll
                for (int n = 0; n < 2; ++n) acc[a][b][m][n] = (f32x4){0.f, 0.f, 0.f, 0.f};
    bf16x8 At[4][2], B0[2][2], B1[2][2];
    unsigned oa[2][2], on[2][2];
    S.a_off(cur, RR, CC, oa);
    const char* cA = S.a_base(cur); const char* cB = S.b_base(cur);
    PG8_STAGE(PG8_SB(0, 0), cB, voffB); PG8_STAGE(PG8_SB(0, 1), cB + hstep, voffB); PG8_STAGE(PG8_SA(0, 0), cA, oa[0]); PG8_STAGE(PG8_SA(0, 1), cA, oa[1]);
    if (wr == 1) PG8_BAR;
    PG8_WAIT_V(2); PG8_BAR;
    PG8_STAGE(PG8_SB(1, 0), cB + kstep, voffB); PG8_STAGE(PG8_SA(1, 0), cA + kstep, oa[0]); PG8_STAGE(PG8_SB(1, 1), cB + hstep + kstep, voffB);
    PG8_WAIT_V(6); PG8_BAR;
    for (;;) {
        const bool has_next = S.next(ui + 1, nxt);
        const char* nA = has_next ? S.a_base(nxt) : cA; const char* nB = has_next ? S.b_base(nxt) : cB;
        if (has_next) S.a_off(nxt, RR, CC, on);
        else {
#pragma unroll
            for (int h = 0; h < 2; ++h)
#pragma unroll
                for (int i = 0; i < 2; ++i) on[h][i] = oa[h][i];
        }
        for (int t = 0; t < nt; t += 2) {
            const bool last = (t == nt - 2);
            const char* a1 = cA + (size_t)(t + 1) * kstep;
            const char* a2 = last ? nA : cA + (size_t)(t + 2) * kstep; const char* b2 = last ? nB : cB + (size_t)(t + 2) * kstep;
            const char* a3 = a2 + kstep; const char* b3 = b2 + kstep;
            unsigned x0[2], x1[2];
#pragma unroll
            for (int i = 0; i < 2; ++i) { x0[i] = last ? on[0][i] : oa[0][i]; x1[i] = last ? on[1][i] : oa[1][i]; }
            PG8_LDB(B0, 0, 0); PG8_LDB(B1, 0, 1); PG8_SCHED; PG8_LDA(At, 0, 0); PG8_STAGE(PG8_SA(1, 1), a1, oa[1]);
            PG8_WAIT_V(8); PG8_WAIT_L(0); PG8_BAR; PG8_MMA(0, 0, At, B0); PG8_MMA(0, 1, At, B1); PG8_BAR; PG8_SCHED;
            PG8_LDA(At, 0, 1); PG8_STAGE(PG8_SB(0, 0), b2, voffB); PG8_STAGE(PG8_SB(0, 1), b2 + hstep, voffB); PG8_STAGE(PG8_SA(0, 0), a2, x0);
            PG8_WAIT_V(8); PG8_WAIT_L(0); PG8_BAR; PG8_MMA(1, 0, At, B0); PG8_MMA(1, 1, At, B1); PG8_BAR; PG8_SCHED;
            PG8_LDB(B0, 1, 0); PG8_LDB(B1, 1, 1); PG8_SCHED; PG8_LDA(At, 1, 0); PG8_STAGE(PG8_SA(0, 1), a2, x1);
            PG8_WAIT_V(8); PG8_WAIT_L(0); PG8_BAR; PG8_MMA(0, 0, At, B0); PG8_MMA(0, 1, At, B1); PG8_BAR; PG8_SCHED;
            PG8_LDA(At, 1, 1); PG8_STAGE(PG8_SB(1, 0), b3, voffB); PG8_STAGE(PG8_SB(1, 1), b3 + hstep, voffB); PG8_STAGE(PG8_SA(1, 0), a3, x0);
            PG8_WAIT_V(8); PG8_WAIT_L(0); PG8_BAR; PG8_MMA(1, 0, At, B0); PG8_MMA(1, 1, At, B1); PG8_BAR; PG8_SCHED;
        }
        if (wr == 0) PG8_BAR;
        E(acc, cur, wr, wc, fr, fq);
        if (!has_next) break;
#pragma unroll
        for (int a = 0; a < 2; ++a)
#pragma unroll
            for (int b = 0; b < 2; ++b)
#pragma unroll
                for (int m = 0; m < 4; ++m)
#pragma unroll
                    for (int n = 0; n < 2; ++n) acc[a][b][m][n] = (f32x4){0.f, 0.f, 0.f, 0.f};
        cur = nxt; cA = nA; cB = nB; ++ui;
#pragma unroll
        for (int h = 0; h < 2; ++h)
#pragma unroll
            for (int i = 0; i < 2; ++i) oa[h][i] = on[h][i];
        if (wr == 1) PG8_BAR;
    }
    PG8_WAIT_V(0);
    PG8_BAR;
#undef PG8_SA
#undef PG8_SB
#undef PG8_STAGE
#undef PG8_LDA
#undef PG8_LDB
#undef PG8_MMA
#undef PG8_WAIT_V
#undef PG8_WAIT_L
#undef PG8_BAR
#undef PG8_SCHED
}
}

using pg8::Unit;
__device__ __forceinline__ u32x4 pack8(f32x4 a, f32x4 b) { u32x4 w; w.x = pg8::cvt_pk_bf16(a[0], a[1]); w.y = pg8::cvt_pk_bf16(a[2], a[3]); w.z = pg8::cvt_pk_bf16(b[0], b[1]); w.w = pg8::cvt_pk_bf16(b[2], b[3]); return w; }

struct EpiInEven {
    static constexpr bool PERM = true;
    bf16_t* H; const float* cosT; const float* sinT;
    __device__ __forceinline__ void operator()(const f32x4 (&acc)[2][2][4][2], const Unit& u, int wr, int wc, int fr, int fq) const {
        const int row0 = u.pm * 256 + wr * 64 + fr, col0 = u.pn * 256 + wc * 32 + 8 * fq;
        const bool rope = u.pn < 7; const int j0 = (wc & 1) * 16 + 4 * fq;
#pragma unroll
        for (int ai = 0; ai < 2; ++ai)
#pragma unroll
            for (int m = 0; m < 4; ++m) {
                const int row = row0 + ai * 128 + m * 16, pos = row & (SEQ - 1);
                f32x4 cs = {1.f, 1.f, 1.f, 1.f}, sn = {0.f, 0.f, 0.f, 0.f};
                if (rope) { cs = *(const f32x4*)(cosT + pos * 32 + j0); sn = *(const f32x4*)(sinT + pos * 32 + j0); }
                bf16_t* rowp = H + (size_t)row * NE_PAD + col0;
#pragma unroll
                for (int bj = 0; bj < 2; ++bj) {
                    const f32x4 v0 = acc[ai][bj][m][0], v1 = acc[ai][bj][m][1];
                    f32x4 o0, o1;
                    o0[0] = v0[0] * cs[0] - v0[1] * sn[0]; o0[1] = v0[1] * cs[0] + v0[0] * sn[0];
                    o0[2] = v0[2] * cs[1] - v0[3] * sn[1]; o0[3] = v0[3] * cs[1] + v0[2] * sn[1];
                    o1[0] = v1[0] * cs[2] - v1[1] * sn[2]; o1[1] = v1[1] * cs[2] + v1[0] * sn[2];
                    o1[2] = v1[2] * cs[3] - v1[3] * sn[3]; o1[3] = v1[3] * cs[3] + v1[2] * sn[3];
                    *(u32x4*)(rowp + bj * 128) = pack8(o0, o1);
                }
                asm volatile("" ::: "memory");
            }
    }
};
struct EpiInOdd {
    static constexpr bool PERM = true;
    bf16_t* H; float* logf; const float* bf;
    __device__ __forceinline__ void operator()(const f32x4 (&acc)[2][2][4][2], const Unit& u, int wr, int wc, int fr, int fq) const {
        const int row0 = u.pm * 256 + wr * 64 + fr, col0 = u.pn * 256 + wc * 32 + 8 * fq;
#pragma unroll
        for (int ai = 0; ai < 2; ++ai)
#pragma unroll
            for (int m = 0; m < 4; ++m) {
                const int row = row0 + ai * 128 + m * 16;
                bf16_t* rowp = H + (size_t)row * NO_PAD + col0;
#pragma unroll
                for (int bj = 0; bj < 2; ++bj) *(u32x4*)(rowp + bj * 128) = pack8(acc[ai][bj][m][0], acc[ai][bj][m][1]);
                if (u.pn == 12 && wc == 0 && fq < 2) {
                    f32x4 r0, r1;
#pragma unroll
                    for (int j = 0; j < 4; ++j) {
                        const float x0 = acc[ai][0][m][0][j] + bf[8 * fq + j], x1 = acc[ai][0][m][1][j] + bf[8 * fq + 4 + j];
                        r0[j] = fminf(x0, 0.f) - log1pf(__expf(-fabsf(x0))); r1[j] = fminf(x1, 0.f) - log1pf(__expf(-fabsf(x1)));
                    }
                    *(f32x4*)(logf + (size_t)row * 16 + 8 * fq) = r0; *(f32x4*)(logf + (size_t)row * 16 + 8 * fq + 4) = r1;
                }
                asm volatile("" ::: "memory");
            }
    }
};
struct EpiOut {
    static constexpr bool PERM = false;
    const float* X; float* Y;
    __device__ __forceinline__ void operator()(const f32x4 (&acc)[2][2][4][2], const Unit& u, int wr, int wc, int fr, int fq) const {
        const int row0 = u.pm * 256 + wr * 64 + fr, col0 = u.pn * 256 + wc * 32 + 4 * fq;
#pragma unroll
        for (int ai = 0; ai < 2; ++ai)
#pragma unroll
            for (int m = 0; m < 4; ++m) {
                const size_t off = (size_t)(row0 + ai * 128 + m * 16) * DM + col0;
#pragma unroll
                for (int bj = 0; bj < 2; ++bj)
#pragma unroll
                    for (int n = 0; n < 2; ++n) { const f32x4 x = *(const f32x4*)(X + off + bj * 128 + n * 16); *(f32x4*)(Y + off + bj * 128 + n * 16) = x * ALPHA + acc[ai][bj][m][n]; }
                asm volatile("" ::: "memory");
            }
    }
};
struct EpiUp {
    static constexpr bool PERM = false;
    bf16_t* Hm;
    __device__ __forceinline__ void operator()(const f32x4 (&acc)[2][2][4][2], const Unit& u, int wr, int wc, int fr, int fq) const {
        const int row0 = u.pm * 256 + wr * 64 + fr, col0 = u.pn * 128 + wc * 16 + 4 * fq;
#pragma unroll
        for (int ai = 0; ai < 2; ++ai)
#pragma unroll
            for (int m = 0; m < 4; ++m) {
                bf16_t* rowp = Hm + (size_t)(row0 + ai * 128 + m * 16) * DFF + col0;
#pragma unroll
                for (int bj = 0; bj < 2; ++bj) {
                    const f32x4 a = acc[ai][bj][m][0], b = acc[ai][bj][m][1]; f32x4 h;
#pragma unroll
                    for (int j = 0; j < 4; ++j) h[j] = a[j] * b[j] * __builtin_amdgcn_rcpf(1.0f + fast_exp2(-a[j] * LOG2E));
                    u32x2 w; w.x = pg8::cvt_pk_bf16(h[0], h[1]); w.y = pg8::cvt_pk_bf16(h[2], h[3]);
                    *(u32x2*)(rowp + bj * 64) = w;
                }
            }
    }
};
struct EpiDown {
    static constexpr bool PERM = true;
    bf16_t* Y; const int* slot_tk; const float* slot_g; const LAS int* cnt;
    __device__ __forceinline__ void operator()(const f32x4 (&acc)[2][2][4][2], const Unit& u, int wr, int wc, int fr, int fq) const {
        const int e = u.v % 65, half = u.v / 65, n = cnt[u.v];
        const int col0 = u.pn * 256 + wc * 32 + 8 * fq;
#pragma unroll
        for (int ai = 0; ai < 2; ++ai)
#pragma unroll
            for (int m = 0; m < 4; ++m) {
                const int pos = u.rb * 256 + ai * 128 + wr * 64 + m * 16 + fr;
                if (pos < n) {
                    int drow; float g;
                    if (e == 64) { drow = pos * 9 + 8; g = 1.f; }
                    else { const int tk = slot_tk[(size_t)u.v * HALF_T + pos]; g = slot_g[(size_t)u.v * HALF_T + pos]; drow = ((tk >> 3) - half * HALF_T) * 9 + (tk & 7); }
                    bf16_t* rowp = Y + (size_t)drow * DM + col0;
#pragma unroll
                    for (int bj = 0; bj < 2; ++bj) *(u32x4*)(rowp + bj * 128) = pack8(acc[ai][bj][m][0] * g, acc[ai][bj][m][1] * g);
                }
                asm volatile("" ::: "memory");
            }
    }
};
struct EpiPleE {
    static constexpr bool PERM = true;
    bf16_t* E; float* ssq;
    __device__ __forceinline__ void operator()(const f32x4 (&acc)[2][2][4][2], const Unit& u, int wr, int wc, int fr, int fq) const {
        const int row0 = u.pm * 256 + wr * 64 + fr, col0 = u.pn * 256 + wc * 32 + 8 * fq;
#pragma unroll
        for (int ai = 0; ai < 2; ++ai)
#pragma unroll
            for (int m = 0; m < 4; ++m) {
                const int row = row0 + ai * 128 + m * 16;
                bf16_t* rowp = E + (size_t)row * DM + col0; float s = 0.f;
#pragma unroll
                for (int bj = 0; bj < 2; ++bj) {
                    const f32x4 a = acc[ai][bj][m][0], b = acc[ai][bj][m][1];
                    s += (a[0] * a[0] + a[1] * a[1]) + (a[2] * a[2] + a[3] * a[3]) + (b[0] * b[0] + b[1] * b[1]) + (b[2] * b[2] + b[3] * b[3]);
                    *(u32x4*)(rowp + bj * 128) = pack8(a, b);
                }
                s += __shfl_xor(s, 16); s += __shfl_xor(s, 32);
                if (fq == 0) ssq[(size_t)row * 16 + u.pn * 4 + wc] = s;
                asm volatile("" ::: "memory");
            }
    }
};
struct EpiPleG {
    static constexpr bool PERM = false;
    float* X; const bf16_t* E; const float* ssq; const float* g; bf16_t* XB;
    __device__ __forceinline__ void operator()(const f32x4 (&acc)[2][2][4][2], const Unit& u, int wr, int wc, int fr, int fq) const {
        const int row0 = u.pm * 256 + wr * 64 + fr, col0 = u.pn * 256 + wc * 32 + 4 * fq;
#pragma unroll
        for (int ai = 0; ai < 2; ++ai)
#pragma unroll
            for (int m = 0; m < 4; ++m) {
                const int row = row0 + ai * 128 + m * 16;
                const f32x4 s0 = *(const f32x4*)(ssq + (size_t)row * 16), s1 = *(const f32x4*)(ssq + (size_t)row * 16 + 4), s2 = *(const f32x4*)(ssq + (size_t)row * 16 + 8), s3 = *(const f32x4*)(ssq + (size_t)row * 16 + 12);
                const float ss = ((s0[0] + s0[1]) + (s0[2] + s0[3])) + ((s1[0] + s1[1]) + (s1[2] + s1[3])) + ((s2[0] + s2[1]) + (s2[2] + s2[3])) + ((s3[0] + s3[1]) + (s3[2] + s3[3]));
                const float rs = 1.0f / sqrtf(ss * (1.0f / DM) + RMS_EPS);
                const size_t off = (size_t)row * DM + col0;
#pragma unroll
                for (int bj = 0; bj < 2; ++bj)
#pragma unroll
                    for (int n = 0; n < 2; ++n) {
                        const int co = bj * 128 + n * 16;
                        const f32x4 x = *(const f32x4*)(X + off + co); const u32x2 ew = *(const u32x2*)(E + off + co); const f32x4 gg = *(const f32x4*)(g + col0 + co);
                        const f32x4 a = acc[ai][bj][m][n]; f32x4 o;
                        o[0] = x[0] + sigmoidf_(a[0]) * (bflo(ew.x) * rs) * gg[0]; o[1] = x[1] + sigmoidf_(a[1]) * (bfhi(ew.x) * rs) * gg[1];
                        o[2] = x[2] + sigmoidf_(a[2]) * (bflo(ew.y) * rs) * gg[2]; o[3] = x[3] + sigmoidf_(a[3]) * (bfhi(ew.y) * rs) * gg[3];
                        *(f32x4*)(X + off + co) = o;
                        u32x2 w; w.x = pg8::cvt_pk_bf16(o[0], o[1]); w.y = pg8::cvt_pk_bf16(o[2], o[3]); *(u32x2*)(XB + off + co) = w;
                    }
                asm volatile("" ::: "memory");
            }
    }
};

struct MoeSched {
    const char* A; const char* W; int lda, K, npn; size_t wstride;
    const LAS int* rbs; const LAS int* cnt; int vlo, vhi, rb0, nunits, G, c; const int* slot_tk; bool gather;
    __device__ __forceinline__ bool next(int i, Unit& u) const {
        const long L = (long)i * G + c; if (L >= nunits) return false;
        const int rbg = rb0 + (int)(L / npn); u.pn = (int)(L % npn);
        int lo = vlo, hi = vhi;
        while (lo < hi) { const int mid = (lo + hi + 1) >> 1; if (rbs[mid] <= rbg) lo = mid; else hi = mid - 1; }
        u.v = lo; u.rb = rbg - rbs[lo]; u.pm = rbg; return true;
    }
    __device__ __forceinline__ const char* a_base(const Unit& u) const { return gather ? A : A + (size_t)u.pm * 256 * lda * 2; }
    __device__ __forceinline__ const char* b_base(const Unit& u) const { return W + (size_t)(u.v % 65) * wstride + (size_t)u.pn * 256 * K * 2; }
    __device__ __forceinline__ void a_off(const Unit& u, const int (&R)[2], const int (&C)[2], unsigned (&o)[2][2]) const {
        if (gather) {
            const int e = u.v % 65, half = u.v / 65, n = cnt[u.v];
#pragma unroll
            for (int h = 0; h < 2; ++h)
#pragma unroll
                for (int i = 0; i < 2; ++i) {
                    const int pos = u.rb * 256 + h * 128 + R[i]; int tok;
                    if (e == 64) tok = half * HALF_T + pos;
                    else tok = pos < n ? (slot_tk[(size_t)u.v * HALF_T + pos] >> 3) : 0;
                    o[h][i] = (unsigned)(tok * lda + C[i]) * 2u;
                    asm volatile("" : "+v"(o[h][i]));
                }
        } else {
#pragma unroll
            for (int h = 0; h < 2; ++h)
#pragma unroll
                for (int i = 0; i < 2; ++i) o[h][i] = (unsigned)((h * 128 + R[i]) * lda + C[i]) * 2u;
        }
    }
};

struct Args {
    const float* in[29]; float* out; unsigned char* ws; int ph_lo, ph_hi;
};
enum InIdx { I_X = 0, I_P, I_EV_WIN, I_EV_BGATE, I_CPK, I_CW1K, I_CW2K, I_CPV, I_CW1V, I_CW2V, I_EV_WO, I_OD_WIN, I_OD_BF, I_OD_WO,
             I_LN1G, I_LN1B, I_LN2G, I_LN2B, I_RW, I_RB, I_EW1, I_EW3, I_EW2, I_SW1, I_SW3, I_SW2, I_PWG, I_PWP, I_PNG };
struct Frame {
    LAS unsigned char* lds; int tid, lane, wave, G, bid;
    unsigned char* ws; gu32* ctl;
};

__device__ __forceinline__ int rope_perm(int d) { return 2 * (d & 31) + (d >> 5); }
__device__ __forceinline__ int map_even(int c) {
    if (c < 512) return EC_QA + (c & ~63) + rope_perm(c & 63);
    if (c < 576) return EC_KA + rope_perm(c - 512);
    if (c < 640) return EC_VA + (c - 576);
    if (c < 1152) { const int r = c - 640; return EC_QI + (r & ~63) + rope_perm(r & 63); }
    if (c < 1216) return EC_KI + rope_perm(c - 1152);
    if (c < 1224) return EC_WI + (c - 1216);
    if (c < 1736) { const int r = c - 1224; return EC_QB + (r & ~63) + rope_perm(r & 63); }
    if (c < 2120) { const int r = c - 1736, j = r >> 6, d = r & 63;
        switch (j) { case 0: return EC_KC + d; case 1: return EC_VC + d; case 2: return EC_KS + rope_perm(d); case 3: return EC_VS + d; case 4: return EC_KW + rope_perm(d); default: return EC_VW + d; } }
    return EC_GB + (c - 2120);
}
enum MapId { MAP_ID = 0, MAP_EVEN, MAP_W1, MAP_W3, MAP_ROPE };
__device__ __forceinline__ int map_col(int id, int c) {
    switch (id) { case MAP_EVEN: return map_even(c); case MAP_W1: return 32 * (c >> 4) + (c & 15); case MAP_W3: return 32 * (c >> 4) + 16 + (c & 15); case MAP_ROPE: return rope_perm(c); default: return c; }
}
__device__ __forceinline__ void tr_item(const float* src, int ldn, int ncols, bf16_t* dst, int dpitch, int k0, int n0, int mapid, LAS float* scr, int lane) {
#pragma unroll 8
    for (int i = 0; i < 32; ++i) { const int kk = 2 * i + (lane >> 5), n = n0 + (lane & 31); scr[kk * 33 + (lane & 31)] = (n < ncols) ? src[(size_t)(k0 + kk) * ldn + n] : 0.f; }
    LDS_WAIT(); asm volatile("" ::: "memory");
    const int c = lane & 7;
#pragma unroll
    for (int j = 0; j < 4; ++j) { const int nl = (lane >> 3) + 8 * j, n = n0 + nl; const LAS float* s = scr + (8 * c) * 33 + nl;
        u32x4 o; o.x = pk2(s[0 * 33], s[1 * 33]); o.y = pk2(s[2 * 33], s[3 * 33]); o.z = pk2(s[4 * 33], s[5 * 33]); o.w = pk2(s[6 * 33], s[7 * 33]);
        if (n < ncols) *(u32x4*)(dst + (size_t)map_col(mapid, n) * dpitch + k0 + 8 * c) = o; }
    LDS_WAIT(); asm volatile("" ::: "memory");
}
__device__ __forceinline__ int tr_matrix(const Frame& F, const float* src, int K, int N, int ldn, bf16_t* dst, int dpitch, int mapid, int it0) {
    LAS float* scr = (LAS float*)(F.lds + F.wave * 16384);
    const int nblk = (N + 31) / 32, nit = (K / 64) * nblk, gw = F.bid * 8 + F.wave, NGW = F.G * 8;
    int first = (gw - (it0 % NGW) + NGW) % NGW;
    for (int it = first; it < nit; it += NGW) tr_item(src, ldn, N, dst, dpitch, 64 * (it / nblk), 32 * (it % nblk), mapid, scr, F.lane);
    return nit;
}
__device__ __forceinline__ void sincos_d(double a, float& s, float& c) {
    const double TWO_PI = 6.283185307179586476925286766559, INV = 0.15915494309189533576888376337251;
    const double k = rint(a * INV); double r = a - k * TWO_PI;
    const double r2 = r * r; double ts = 1.0, tc = 1.0;
#pragma unroll
    for (int i = 14; i >= 1; --i) { ts = 1.0 - ts * r2 / (double)((2 * i) * (2 * i + 1)); tc = 1.0 - tc * r2 / (double)((2 * i - 1) * (2 * i)); }
    s = (float)(r * ts); c = (float)tc;
}

struct TrJob { const float* src; bf16_t* dst; int K, N, ldn, dpitch, mapid; };
__device__ __forceinline__ TrJob get_job(const Args& a, unsigned char* wsp, int layer, int jid) {
    const int j = layer >> 1; const bool even = (layer & 1) == 0;
    bf16_t* W = (bf16_t*)(wsp + WS_W);
    TrJob t; t.mapid = MAP_ID;
    if (jid == 0) { if (even) { t.src = a.in[I_EV_WIN] + (size_t)j * DM * EVEN_COLS; t.N = EVEN_COLS; t.mapid = MAP_EVEN; } else { t.src = a.in[I_OD_WIN] + (size_t)j * DM * ODD_COLS; t.N = ODD_COLS; }
        t.K = DM; t.ldn = t.N; t.dst = W + W_IN / 2; t.dpitch = DM; return t; }
    if (jid == 1) { t.src = (even ? a.in[I_EV_WO] : a.in[I_OD_WO]) + (size_t)j * DM * DM; t.K = DM; t.N = DM; t.ldn = DM; t.dst = W + W_O / 2; t.dpitch = DM; return t; }
    if (jid == 2) { t.src = a.in[I_PWG] + (size_t)layer * DM * DM; t.K = DM; t.N = DM; t.ldn = DM; t.dst = W + W_G / 2; t.dpitch = DM; return t; }
    if (jid == 3) { t.src = a.in[I_PWP] + (size_t)layer * 256 * DM; t.K = 256; t.N = DM; t.ldn = DM; t.dst = W + W_P / 2; t.dpitch = 256; return t; }
    if (jid < 8) {
        const int q = jid - 4;
        if (q == 0) { t.src = a.in[I_CW1K] + (size_t)j * 2048 * 64; t.K = 2048; t.dst = W + W_C1K / 2; t.dpitch = 2048; }
        else if (q == 1) { t.src = a.in[I_CW1V] + (size_t)j * 2048 * 64; t.K = 2048; t.dst = W + W_C1V / 2; t.dpitch = 2048; }
        else if (q == 2) { t.src = a.in[I_CW2K] + (size_t)j * 64 * 64; t.K = 64; t.dst = W + W_C2K / 2; t.dpitch = 64; t.mapid = MAP_ROPE; }
        else { t.src = a.in[I_CW2V] + (size_t)j * 64 * 64; t.K = 64; t.dst = W + W_C2V / 2; t.dpitch = 64; }
        t.N = 64; t.ldn = 64; return t; }
    const int r = jid - 8, e = r / 3, w = r % 3;
    if (w < 2) { const float* s = (e == 64) ? a.in[w == 0 ? I_SW1 : I_SW3] + (size_t)layer * DM * DFF : a.in[w == 0 ? I_EW1 : I_EW3] + ((size_t)layer * NEXP + e) * DM * DFF;
        t.src = s; t.K = DM; t.N = DFF; t.ldn = DFF; t.dst = W + W_UP / 2 + (size_t)e * 512 * DM; t.dpitch = DM; t.mapid = (w == 0) ? MAP_W1 : MAP_W3; return t; }
    t.src = (e == 64) ? a.in[I_SW2] + (size_t)layer * DFF * DM : a.in[I_EW2] + ((size_t)layer * NEXP + e) * DFF * DM;
    t.K = DFF; t.N = DM; t.ldn = DM; t.dst = W + W_DN / 2 + (size_t)e * DM * DFF; t.dpitch = DFF; return t;
}
constexpr int NJOBS = 8 + 65 * 3;

__device__ __forceinline__ void prep_phase(const Frame& F, const Args& a, int layer) {
    const int gw = F.bid * 8 + F.wave, NGW = F.G * 8, gt = F.bid * 512 + F.tid, NGT = F.G * 512;
    LAS float* scr = (LAS float*)(F.lds + F.wave * 16384);
    int base = 0;
    for (int jid = 0; jid < NJOBS; ++jid) {
        const TrJob jb = get_job(a, F.ws, layer, jid);
        const int nblk = (jb.N + 31) / 32, nit = (jb.K / 64) * nblk;
        int first = (gw - (base % NGW) + NGW) % NGW;
        for (int it = first; it < nit; it += NGW) tr_item(jb.src, jb.ldn, jb.N, jb.dst, jb.dpitch, 64 * (it / nblk), 32 * (it % nblk), jb.mapid, scr, F.lane);
        base += nit;
    }
    { const int r0 = (layer & 1) ? ODD_COLS : EVEN_COLS, r1 = (layer & 1) ? NO_PAD : NE_PAD; u32x4* z = (u32x4*)(F.ws + WS_W + W_IN + (size_t)r0 * DM * 2);
      const int n16 = (r1 - r0) * DM * 2 / 16; for (int i = gt; i < n16; i += NGT) z[i] = (u32x4){0u, 0u, 0u, 0u}; }
    { const f32x4* p = (const f32x4*)(a.in[I_P] + (size_t)layer * T * 256); u32x2* o = (u32x2*)(F.ws + WS_PB);
      for (int i = gt; i < T * 256 / 4; i += NGT) { const f32x4 v = p[i]; u32x2 w; w.x = pk2(v[0], v[1]); w.y = pk2(v[2], v[3]); o[i] = w; } }
    if (layer == 0) {
        const f32x4* x = (const f32x4*)a.in[I_X]; u32x2* o = (u32x2*)(F.ws + WS_XB);
        for (int i = gt; i < T * DM / 4; i += NGT) { const f32x4 v = x[i]; u32x2 w; w.x = pk2(v[0], v[1]); w.y = pk2(v[2], v[3]); o[i] = w; }
        float* ct = (float*)(F.ws + WS_ROPE_COS); float* st = (float*)(F.ws + WS_ROPE_SIN);
        for (int i = gt; i < SEQ * 32; i += NGT) { const int pos = i >> 5, j = i & 31; double inv = 1.0;
            for (int q = 0; q < j; ++q) inv *= 0.74989420933245582730;
            const float ang = (float)pos * (float)inv; float s, c; sincos_d((double)ang, s, c); ct[i] = c; st[i] = s; }
    }
    if ((layer & 1) == 0 && F.bid < 2) {
        const int j = layer >> 1; const float* pe = a.in[F.bid == 0 ? I_CPK : I_CPV] + (size_t)j * 2048; const float* w1 = a.in[F.bid == 0 ? I_CW1K : I_CW1V] + (size_t)j * 2048 * 64;
        LAS float* red = (LAS float*)(F.lds + 8 * 16384);
        __syncthreads();
        const int n = F.tid & 63, part = F.tid >> 6; float s = 0.f;
        for (int k = part * 256; k < part * 256 + 256; ++k) s += pe[k] * w1[(size_t)k * 64 + n];
        red[part * 64 + n] = s; __syncthreads();
        if (F.tid < 64) { float tot = 0.f; for (int q = 0; q < 8; ++q) tot += red[q * 64 + F.tid]; ((float*)(F.ws + WS_MISC))[F.bid * 64 + F.tid] = tot; }
        __syncthreads();
    }
}

__device__ __forceinline__ void scan_phase(const Frame& F, const Args& a) {
    const float* lf = (const float*)(F.ws + WS_LOGF); float* dc = (float*)(F.ws + WS_DCUM);
    LAS float* wsum = (LAS float*)F.lds;
    for (int s = F.bid; s < NB * 16; s += F.G) {
        const int b = s >> 4, h = s & 15; const size_t base = ((size_t)b * SEQ) * 16 + h;
        float v[4]; float run = 0.f;
#pragma unroll
        for (int i = 0; i < 4; ++i) { run += lf[base + (size_t)(F.tid * 4 + i) * 16]; v[i] = run; }
        float inc = run;
#pragma unroll
        for (int o = 1; o < 64; o <<= 1) { const float t = __shfl_up(inc, o); if (F.lane >= o) inc += t; }
        if (F.lane == 63) wsum[F.wave] = inc;
        __syncthreads();
        float off = inc - run;
        for (int w = 0; w < F.wave; ++w) off += wsum[w];
#pragma unroll
        for (int i = 0; i < 4; ++i) dc[base + (size_t)(F.tid * 4 + i) * 16] = (v[i] + off) * LOG2E;
        __syncthreads();
    }
}

__device__ __forceinline__ void ln_row16(float (&v)[16], const float* g, const float* b, int lane) {
    float s = 0.f;
#pragma unroll
    for (int i = 0; i < 16; ++i) s += v[i];
    const float mean = wave_sum(s) * (1.f / DM); float s2 = 0.f;
#pragma unroll
    for (int i = 0; i < 16; ++i) { v[i] -= mean; s2 += v[i] * v[i]; }
    const float rstd = 1.0f / sqrtf(wave_sum(s2) * (1.f / DM) + LN_EPS);
#pragma unroll
    for (int q = 0; q < 4; ++q) { const f32x4 gg = *(const f32x4*)(g + lane * 16 + 4 * q), bb = *(const f32x4*)(b + lane * 16 + 4 * q);
#pragma unroll
        for (int i = 0; i < 4; ++i) v[4 * q + i] = v[4 * q + i] * rstd * gg[i] + bb[i]; }
}
__device__ __forceinline__ void store_row16(const float (&v)[16], float* xf, bf16_t* xb, int lane) {
#pragma unroll
    for (int q = 0; q < 4; ++q) *(f32x4*)(xf + lane * 16 + 4 * q) = (f32x4){v[4 * q], v[4 * q + 1], v[4 * q + 2], v[4 * q + 3]};
    u32x4 w0, w1; w0.x = pk2(v[0], v[1]); w0.y = pk2(v[2], v[3]); w0.z = pk2(v[4], v[5]); w0.w = pk2(v[6], v[7]);
    w1.x = pk2(v[8], v[9]); w1.y = pk2(v[10], v[11]); w1.z = pk2(v[12], v[13]); w1.w = pk2(v[14], v[15]);
    *(u32x4*)(xb + lane * 16) = w0; *(u32x4*)(xb + lane * 16 + 8) = w1;
}

__device__ __forceinline__ void route_phase(const Frame& F, const Args& a, int layer) {
    float* X = a.out; bf16_t* XB = (bf16_t*)(F.ws + WS_XB);
    const float* g = a.in[I_LN1G] + layer * DM; const float* bta = a.in[I_LN1B] + layer * DM;
    const float* RW = a.in[I_RW] + (size_t)layer * DM * NEXP; const float* RBs = a.in[I_RB] + layer * NEXP;
    int* slot_tk = (int*)(F.ws + WS_SLOT_TK); float* slot_g = (float*)(F.ws + WS_SLOT_G);
    gu32* cntg = F.ctl + CW_CNT + layer * 256;
    LAS float* lg = (LAS float*)(F.lds + F.wave * 8192);
    LAS unsigned* rec_e = (LAS unsigned*)(F.lds + 65536);
    LAS float* rec_g = (LAS float*)(F.lds + 65536 + 8192);
    LAS unsigned* lcnt = (LAS unsigned*)(F.lds + 65536 + 16384);
    LAS unsigned* gbase = lcnt + 64;
    const int lane = F.lane;
    for (int ub = F.bid; ub < T / 256; ub += F.G) {
        if (F.tid < 64) lcnt[F.tid] = 0u;
        __syncthreads();
        const int r0 = ub * 256 + F.wave * 32;
        for (int r = 0; r < 32; ++r) {
            float v[16]; float* xr = X + (size_t)(r0 + r) * DM;
#pragma unroll
            for (int q = 0; q < 4; ++q) { const f32x4 t = *(const f32x4*)(xr + lane * 16 + 4 * q); v[4 * q] = t[0]; v[4 * q + 1] = t[1]; v[4 * q + 2] = t[2]; v[4 * q + 3] = t[3]; }
            ln_row16(v, g, bta, lane);
            store_row16(v, xr, XB + (size_t)(r0 + r) * DM, lane);
        }
        VM_WAIT();
        f32x16 c0 = {}, c1 = {};
        { const float* ar = X + (size_t)(r0 + (lane & 31)) * DM + (lane >> 5) * 512; const float* br = RW + (size_t)((lane >> 5) * 512) * NEXP + (lane & 31);
          for (int s = 0; s < 512; s += 4) {
              const f32x4 av = *(const f32x4*)(ar + s);
#pragma unroll
              for (int q = 0; q < 4; ++q) { const float b0 = br[(size_t)(s + q) * NEXP], b1 = br[(size_t)(s + q) * NEXP + 32];
                  c0 = __builtin_amdgcn_mfma_f32_32x32x2f32(av[q], b0, c0, 0, 0, 0); c1 = __builtin_amdgcn_mfma_f32_32x32x2f32(av[q], b1, c1, 0, 0, 0); }
          } }
#pragma unroll
        for (int rr = 0; rr < 16; ++rr) { const int row = (rr & 3) + 8 * (rr >> 2) + 4 * (lane >> 5); lg[row * 64 + (lane & 31)] = c0[rr]; lg[row * 64 + 32 + (lane & 31)] = c1[rr]; }
        LDS_WAIT(); asm volatile("" ::: "memory");
        const float rbias = RBs[lane];
        for (int r = 0; r < 32; ++r) {
            const float sg = sigmoidf_(lg[r * 64 + lane]); const float sb = sg + rbias;
            float m1 = sb;
            m1 = fmaxf(m1, __shfl_xor(m1, 1)); m1 = fmaxf(m1, __shfl_xor(m1, 2)); m1 = fmaxf(m1, __shfl_xor(m1, 4));
            const unsigned long long eqm = __ballot(sb == m1); const int gsh = lane & ~7;
            const unsigned gm = (unsigned)(eqm >> gsh) & 0xffu; const int first = __builtin_ctz(gm);
            float m2 = ((lane & 7) == first) ? NEGBIG : sb;
            m2 = fmaxf(m2, __shfl_xor(m2, 1)); m2 = fmaxf(m2, __shfl_xor(m2, 2)); m2 = fmaxf(m2, __shfl_xor(m2, 4));
            const float gs = m1 + m2;
            int grank = 0;
#pragma unroll
            for (int q = 0; q < 8; ++q) { const float o = __shfl(gs, q * 8); grank += (o > gs || (o == gs && q < (lane >> 3))) ? 1 : 0; }
            const float sm = (grank < 4) ? sb : NEGBIG;
            int rank = 0;
            for (int q = 0; q < 64; ++q) { const float o = __builtin_bit_cast(float, __builtin_amdgcn_readlane(__builtin_bit_cast(int, sm), q)); rank += (o > sm || (o == sm && q < lane)) ? 1 : 0; }
            const bool sel = rank < 8;
            const float ssum = wave_sum(sel ? sg : 0.f);
            if (sel) { const unsigned lp = __hip_atomic_fetch_add(&lcnt[lane], 1u, __ATOMIC_RELAXED, __HIP_MEMORY_SCOPE_WORKGROUP); const int row = F.wave * 32 + r; rec_e[row * 8 + rank] = (unsigned)lane | (lp << 8); rec_g[row * 8 + rank] = sg / ssum * 2.5f; }
        }
        __syncthreads();
        const int half = (ub * 256) / HALF_T;
        if (F.tid < 64) gbase[F.tid] = __hip_atomic_fetch_add(cntg + half * 65 + F.tid, lcnt[F.tid], RLX_AGENT);
        __syncthreads();
        for (int i = F.tid; i < 2048; i += 512) { const unsigned re = rec_e[i]; const int e = re & 255, lp = re >> 8, v = half * 65 + e; const int pos = gbase[e] + lp;
            const int t = ub * 256 + (i >> 3);
            slot_tk[(size_t)v * HALF_T + pos] = t * 8 + (i & 7); slot_g[(size_t)v * HALF_T + pos] = rec_g[i]; }
        __syncthreads();
    }
}

__device__ __forceinline__ void combine_phase(const Frame& F, const Args& a, int layer, int half) {
    float* X = a.out; bf16_t* XB = (bf16_t*)(F.ws + WS_XB); const bf16_t* Y = (const bf16_t*)(F.ws + WS_R + R_YTOK);
    const float* g = a.in[I_LN2G] + layer * DM; const float* bta = a.in[I_LN2B] + layer * DM;
    const int lane = F.lane;
    for (int tl = F.bid * 8 + F.wave; tl < HALF_T; tl += F.G * 8) {
        const int t = half * HALF_T + tl; float v[16]; float* xr = X + (size_t)t * DM;
#pragma unroll
        for (int q = 0; q < 4; ++q) { const f32x4 x = *(const f32x4*)(xr + lane * 16 + 4 * q); v[4 * q] = x[0] * ALPHA; v[4 * q + 1] = x[1] * ALPHA; v[4 * q + 2] = x[2] * ALPHA; v[4 * q + 3] = x[3] * ALPHA; }
        float m[16];
#pragma unroll
        for (int i = 0; i < 16; ++i) m[i] = 0.f;
#pragma unroll
        for (int k = 0; k < 9; ++k) { const bf16_t* yr = Y + ((size_t)tl * 9 + k) * DM + lane * 16; const u32x4 w0 = *(const u32x4*)yr, w1 = *(const u32x4*)(yr + 8);
            m[0] += bflo(w0.x); m[1] += bfhi(w0.x); m[2] += bflo(w0.y); m[3] += bfhi(w0.y); m[4] += bflo(w0.z); m[5] += bfhi(w0.z); m[6] += bflo(w0.w); m[7] += bfhi(w0.w);
            m[8] += bflo(w1.x); m[9] += bfhi(w1.x); m[10] += bflo(w1.y); m[11] += bfhi(w1.y); m[12] += bflo(w1.z); m[13] += bfhi(w1.z); m[14] += bflo(w1.w); m[15] += bfhi(w1.w); }
#pragma unroll
        for (int i = 0; i < 16; ++i) v[i] += m[i];
        ln_row16(v, g, bta, lane);
        store_row16(v, xr, XB + (size_t)t * DM, lane);
    }
}

constexpr int KP = 144, VP = 192;
constexpr int KT_BYTES = 64 * KP, VT_BYTES = 64 * VP, KV_BUF = KT_BYTES + VT_BYTES;
__device__ __forceinline__ int crow(int r, int hi) { return (r & 3) + 8 * (r >> 2) + 4 * hi; }
__device__ __forceinline__ s16x4 vtr(const LAS unsigned char* p) { return __builtin_bit_cast(s16x4, __builtin_amdgcn_ds_read_tr16_b64_v4i16((LAS s16x4*)p)); }

struct KVRegs { u32x4 k, v; };
__device__ __forceinline__ void kv_load(KVRegs& r, const bf16_t* Kp, const bf16_t* Vp, size_t pitch, int row0, int tid) {
    const size_t off = (size_t)(row0 + (tid >> 3)) * pitch + (tid & 7) * 8;
    r.k = *(const u32x4*)(Kp + off); r.v = *(const u32x4*)(Vp + off);
}
__device__ __forceinline__ void kv_store(const KVRegs& r, LAS unsigned char* buf, int tid) {
    *(LAS u32x4*)(buf + (tid >> 3) * KP + (tid & 7) * 16) = r.k;
    *(LAS u32x4*)(buf + KT_BYTES + (tid >> 3) * VP + (tid & 7) * 16) = r.v;
}
__device__ __forceinline__ void qk_tile(f32x16& p0, f32x16& p1, const LAS unsigned char* kt, const bf16x8 (&qf)[4], int lane) {
    const LAS unsigned char* kb = kt + (lane & 31) * KP + (lane >> 5) * 16;
    p0 = (f32x16){}; p1 = (f32x16){};
#pragma unroll
    for (int ks = 0; ks < 4; ++ks) {
        const bf16x8 k0 = *(const LAS bf16x8*)(kb + ks * 32), k1 = *(const LAS bf16x8*)(kb + 32 * KP + ks * 32);
        p0 = __builtin_amdgcn_mfma_f32_32x32x16_bf16(k0, qf[ks], p0, 0, 0, 0);
        p1 = __builtin_amdgcn_mfma_f32_32x32x16_bf16(k1, qf[ks], p1, 0, 0, 0);
    }
}
__device__ __forceinline__ bf16x8 pfrag(const f32x16& p, int s) {
    u32x4 w; w.x = pg8::cvt_pk_bf16(p[8 * s], p[8 * s + 1]); w.y = pg8::cvt_pk_bf16(p[8 * s + 2], p[8 * s + 3]); w.z = pg8::cvt_pk_bf16(p[8 * s + 4], p[8 * s + 5]); w.w = pg8::cvt_pk_bf16(p[8 * s + 6], p[8 * s + 7]);
    return __builtin_bit_cast(bf16x8, w);
}
__device__ __forceinline__ void pv_sub(f32x16& o0, f32x16& o1, const LAS unsigned char* vt, int sub, const f32x16& p, int lane) {
    const LAS unsigned char* vb = vt + (sub * 32 + (lane >> 5) * 4 + ((lane & 15) >> 2)) * VP + (16 * ((lane >> 4) & 1) + 4 * (lane & 3)) * 2;
#pragma unroll
    for (int s = 0; s < 2; ++s) {
        const bf16x8 pb = pfrag(p, s);
        const s16x4 a0 = vtr(vb + (16 * s) * VP), a1 = vtr(vb + (16 * s + 8) * VP), b0 = vtr(vb + (16 * s) * VP + 64), b1 = vtr(vb + (16 * s + 8) * VP + 64);
        const bf16x8 va = {a0[0], a0[1], a0[2], a0[3], a1[0], a1[1], a1[2], a1[3]}, vbb = {b0[0], b0[1], b0[2], b0[3], b1[0], b1[1], b1[2], b1[3]};
        o0 = __builtin_amdgcn_mfma_f32_32x32x16_bf16(va, pb, o0, 0, 0, 0);
        o1 = __builtin_amdgcn_mfma_f32_32x32x16_bf16(vbb, pb, o1, 0, 0, 0);
    }
}
__device__ __forceinline__ void softmax_pv(f32x16& p0, f32x16& p1, f32x16& o0, f32x16& o1, float& m, float& l, const LAS unsigned char* vt, int lane) {
    float mx = NEGBIG;
#pragma unroll
    for (int r = 0; r < 16; ++r) mx = fmaxf(mx, fmaxf(p0[r], p1[r]));
    mx = fmaxf(mx, __shfl_xor(mx, 32));
    const float mn = fmaxf(m, mx), alpha = fast_exp2(m - mn);
    float ls = 0.f;
#pragma unroll
    for (int r = 0; r < 16; ++r) { p0[r] = (p0[r] > -1e29f) ? fast_exp2(p0[r] - mn) : 0.f; p1[r] = (p1[r] > -1e29f) ? fast_exp2(p1[r] - mn) : 0.f; ls += p0[r] + p1[r]; }
    ls += __shfl_xor(ls, 32);
    l = l * alpha + ls; m = mn;
    o0 *= alpha; o1 *= alpha;
    pv_sub(o0, o1, vt, 0, p0, lane); pv_sub(o0, o1, vt, 1, p1, lane);
}
__device__ __forceinline__ void load_qf(bf16x8 (&qf)[4], const bf16_t* qrow, int lane) {
#pragma unroll
    for (int ks = 0; ks < 4; ++ks) qf[ks] = *(const bf16x8*)(qrow + 16 * ks + 8 * (lane >> 5));
}
__device__ __forceinline__ void store_ot(const f32x16& o0, const f32x16& o1, float sc, bf16_t* orow, int lane) {
    const int hi = lane >> 5;
#pragma unroll
    for (int g = 0; g < 4; ++g) {
        u32x2 w; w.x = pg8::cvt_pk_bf16(o0[4 * g] * sc, o0[4 * g + 1] * sc); w.y = pg8::cvt_pk_bf16(o0[4 * g + 2] * sc, o0[4 * g + 3] * sc); *(u32x2*)(orow + 8 * g + 4 * hi) = w;
        u32x2 x; x.x = pg8::cvt_pk_bf16(o1[4 * g] * sc, o1[4 * g + 1] * sc); x.y = pg8::cvt_pk_bf16(o1[4 * g + 2] * sc, o1[4 * g + 3] * sc); *(u32x2*)(orow + 32 + 8 * g + 4 * hi) = x;
    }
}

__device__ __forceinline__ void fox_phase(const Frame& F, const Args& a) {
    bf16_t* H = (bf16_t*)(F.ws + WS_R + R_H); const float* DC = (const float*)(F.ws + WS_DCUM);
    const int lane = F.lane, tid = F.tid, hi = lane >> 5;
    LAS unsigned char* kvb = F.lds; LAS float* dkb = (LAS float*)(F.lds + 2 * KV_BUF);
    const int NU = NB * 16 * 8;
    for (int ui = F.bid; ui < NU; ui += F.G) {
        const int qb = 7 - (ui / (NB * 16)), bh = ui % (NB * 16), b = bh >> 4, h = bh & 15;
        const size_t rb0 = (size_t)b * SEQ;
        const bf16_t* Kp = H + rb0 * NO_PAD + 1024 + h * 64; const bf16_t* Vp = H + rb0 * NO_PAD + 2048 + h * 64;
        const int q0 = qb * 256 + F.wave * 32, tq = q0 + (lane & 31);
        bf16x8 qf[4]; load_qf(qf, H + (rb0 + tq) * NO_PAD + h * 64, lane);
        const float dq = DC[(rb0 + tq) * 16 + h];
        f32x16 o0 = {}, o1 = {}; float m = NEGBIG, l = 0.f;
        const int ntile = qb * 4 + 4; const int wlast = (q0 + 31) >> 6;
        KVRegs kr; float dkr = 0.f;
        kv_load(kr, Kp, Vp, NO_PAD, 0, tid); if (tid < 64) dkr = DC[(rb0 + tid) * 16 + h];
        __syncthreads();
        for (int t = 0; t < ntile; ++t) {
            LAS unsigned char* buf = kvb + (t & 1) * KV_BUF;
            kv_store(kr, buf, tid); if (tid < 64) dkb[(t & 1) * 64 + tid] = dkr;
            __syncthreads();
            if (t + 1 < ntile) { kv_load(kr, Kp, Vp, NO_PAD, (t + 1) * 64, tid); if (tid < 64) dkr = DC[(rb0 + (t + 1) * 64 + tid) * 16 + h]; }
            if (t <= wlast) {
                f32x16 p0, p1; qk_tile(p0, p1, buf, qf, lane);
                const LAS float* dk = dkb + (t & 1) * 64;
#pragma unroll
                for (int r = 0; r < 16; ++r) { const int kk = crow(r, hi), key = t * 64 + kk;
                    const float s0 = p0[r] * QK_C + dq - dk[kk], s1 = p1[r] * QK_C + dq - dk[kk + 32];
                    p0[r] = (key <= tq) ? s0 : NEGBIG; p1[r] = (key + 32 <= tq) ? s1 : NEGBIG; }
                softmax_pv(p0, p1, o0, o1, m, l, buf + KT_BYTES, lane);
            }
        }
        store_ot(o0, o1, 1.0f / l, H + (rb0 + tq) * NO_PAD + h * 64, lane);
        __syncthreads();
    }
}

template <class MaskFn>
__device__ __forceinline__ void attn_tiles(const Frame& F, unsigned tm, const bf16_t* Kp, const bf16_t* Vp, size_t pitch, const bf16x8 (&qf)[4],
                                            f32x16& o0, f32x16& o1, float& m, float& l, LAS unsigned char* kvb, MaskFn&& mask) {
    const int tid = F.tid, lane = F.lane;
    KVRegs kr; int par = 0;
    if (tm) kv_load(kr, Kp, Vp, pitch, __builtin_ctz(tm) * 64, tid);
    while (tm) {
        const int t = __builtin_ctz(tm); tm &= tm - 1;
        LAS unsigned char* buf = kvb + par * KV_BUF;
        kv_store(kr, buf, tid);
        __syncthreads();
        if (tm) kv_load(kr, Kp, Vp, pitch, __builtin_ctz(tm) * 64, tid);
        f32x16 p0, p1; qk_tile(p0, p1, buf, qf, lane);
        mask(p0, p1, t);
        softmax_pv(p0, p1, o0, o1, m, l, buf + KT_BYTES, lane);
        par ^= 1;
    }
    __syncthreads();
}
__device__ __forceinline__ unsigned pkh(float a, float b) { const _Float16 x = (_Float16)a, y = (_Float16)b; return (unsigned)__builtin_bit_cast(unsigned short, x) | ((unsigned)__builtin_bit_cast(unsigned short, y) << 16); }
__device__ __forceinline__ float h2f(unsigned short h) { return (float)__builtin_bit_cast(_Float16, h); }
__device__ __forceinline__ float dpp_f(float x, int ctrl_sel) {
    const int v = __builtin_bit_cast(int, x); int r;
    if (ctrl_sel == 0) r = __builtin_amdgcn_update_dpp(0, v, 0xB1, 0xf, 0xf, true);
    else if (ctrl_sel == 1) r = __builtin_amdgcn_update_dpp(0, v, 0x4E, 0xf, 0xf, true);
    else r = __builtin_amdgcn_update_dpp(0, v, 0x141, 0xf, 0xf, true);
    return __builtin_bit_cast(float, r);
}

__device__ __forceinline__ void dsa_unit(const Frame& F, const Args& a, int b, int qg) {
    bf16_t* H = (bf16_t*)(F.ws + WS_R + R_H);
    const int lane = F.lane, hi = lane >> 5, t0 = qg * 32; const size_t rb0 = (size_t)b * SEQ;
    LAS float* sc = (LAS float*)F.lds;
    LAS unsigned* bm = (LAS unsigned*)(F.lds + LDS_TAB);
    for (int hf = 0; hf < 2; ++hf) {
        const int tq0 = t0 + 16 * hf, nkt = ((tq0 + 15) >> 5) + 1;
        {
            bf16x8 qi[4][4]; float wl[4];
#pragma unroll
            for (int ct = 0; ct < 4; ++ct) { const int q = tq0 + 4 * ct + ((lane & 31) >> 3), head = lane & 7; const bf16_t* rp = H + (rb0 + q) * NE_PAD;
#pragma unroll
                for (int ks = 0; ks < 4; ++ks) qi[ct][ks] = *(const bf16x8*)(rp + EC_QI + head * 64 + 16 * ks + 8 * hi);
                wl[ct] = bf2f(rp[EC_WI + head]); }
            for (int kt = F.wave; kt < nkt; kt += 8) {
                bf16x8 kf[4]; { const bf16_t* kp = H + (rb0 + kt * 32 + (lane & 31)) * NE_PAD + EC_KI + 8 * hi;
#pragma unroll
                    for (int ks = 0; ks < 4; ++ks) kf[ks] = *(const bf16x8*)(kp + 16 * ks); }
#pragma unroll
                for (int ct = 0; ct < 4; ++ct) {
                    f32x16 acc = {};
#pragma unroll
                    for (int ks = 0; ks < 4; ++ks) acc = __builtin_amdgcn_mfma_f32_32x32x16_bf16(kf[ks], qi[ct][ks], acc, 0, 0, 0);
#pragma unroll
                    for (int r = 0; r < 16; ++r) { float v = fmaxf(acc[r], 0.f) * wl[ct]; v += dpp_f(v, 0); v += dpp_f(v, 1); v += dpp_f(v, 2); acc[r] = v; }
                    if ((lane & 7) == 0) { LAS float* dst = sc + (4 * ct + ((lane & 31) >> 3)) * 2048 + kt * 32 + 4 * hi;
#pragma unroll
                        for (int g = 0; g < 4; ++g) *(LAS f32x4*)(dst + 8 * g) = (f32x4){acc[4 * g], acc[4 * g + 1], acc[4 * g + 2], acc[4 * g + 3]}; }
                }
            }
        }
        __syncthreads();
        for (int q2 = 0; q2 < 2; ++q2) {
            const int ql = 2 * F.wave + q2, tq = tq0 + ql, n = tq + 1;
            unsigned u[32];
#pragma unroll
            for (int j = 0; j < 32; ++j) { const int idx = 64 * j + lane; unsigned bits = 0u;
                if (idx < n) { bits = __builtin_bit_cast(unsigned, sc[ql * 2048 + idx]); if ((bits << 1) == 0u) bits = 0u; bits ^= (bits & 0x80000000u) ? 0xffffffffu : 0x80000000u; }
                u[j] = bits; }
            unsigned thr = 0u; int need = 0;
            if (n > 256) {
                for (int bit = 31; bit >= 0; --bit) { const unsigned cand = thr | (1u << bit); int c = 0;
#pragma unroll
                    for (int j = 0; j < 32; ++j) c += __popcll(__ballot(u[j] >= cand));
                    if (c >= 256) thr = cand; }
                int cgt = 0;
#pragma unroll
                for (int j = 0; j < 32; ++j) cgt += __popcll(__ballot(u[j] > thr));
                need = 256 - cgt;
            }
            const unsigned long long lt = (1ull << lane) - 1ull; int er = 0;
#pragma unroll
            for (int j = 0; j < 32; ++j) { const int idx = 64 * j + lane; bool sel;
                if (n > 256) { const unsigned long long eqm = __ballot(u[j] == thr && idx < n); sel = (u[j] > thr) || (u[j] == thr && idx < n && (er + __popcll(eqm & lt)) < need); er += __popcll(eqm); }
                else sel = idx < n;
                const unsigned long long sm = __ballot(sel);
                if (lane == 0) { bm[(16 * hf + ql) * 64 + 2 * j] = (unsigned)sm; bm[(16 * hf + ql) * 64 + 2 * j + 1] = (unsigned)(sm >> 32); } }
        }
        __syncthreads();
    }
    const int tq = t0 + (lane & 31);
    bf16x8 qf[4]; load_qf(qf, H + (rb0 + tq) * NE_PAD + EC_QA + F.wave * 64, lane);
    f32x16 o0 = {}, o1 = {}; float m = NEGBIG, l = 0.f;
    const int ntile = ((t0 + 31) >> 6) + 1; const unsigned tm = (ntile >= 32) ? 0xffffffffu : ((1u << ntile) - 1u);
    const LAS unsigned* bq = bm + (lane & 31) * 64;
    attn_tiles(F, tm, H + rb0 * NE_PAD + EC_KA, H + rb0 * NE_PAD + EC_VA, NE_PAD, qf, o0, o1, m, l, F.lds,
        [&](f32x16& p0, f32x16& p1, int t) { const unsigned w0 = bq[2 * t] >> (4 * hi), w1 = bq[2 * t + 1] >> (4 * hi);
#pragma unroll
            for (int r = 0; r < 16; ++r) { const int sh = (r & 3) + 8 * (r >> 2);
                p0[r] = ((w0 >> sh) & 1u) ? p0[r] * QK_C : NEGBIG; p1[r] = ((w1 >> sh) & 1u) ? p1[r] * QK_C : NEGBIG; } });
    store_ot(o0, o1, 1.0f / l, H + (rb0 + tq) * NE_PAD + EC_QA + F.wave * 64, lane);
}

__device__ __forceinline__ void compress_item(const Frame& F, const Args& a, int item) {
    const bf16_t* H = (const bf16_t*)(F.ws + WS_R + R_H); const bf16_t* W = (const bf16_t*)(F.ws + WS_W);
    const int kv = item & 1, ct = (item >> 1) & 3, b = item >> 3, lane = F.lane, hi = lane >> 5;
    const bf16_t* w1t = W + (kv ? W_C1V : W_C1K) / 2; const bf16_t* w2t = W + (kv ? W_C2V : W_C2K) / 2;
    const float* bias1 = (const float*)(F.ws + WS_MISC) + kv * 64;
    bf16_t* outp = (bf16_t*)(F.ws + (kv ? WS_VC : WS_KC)) + (size_t)b * 128 * 64;
    const int col = kv ? EC_VC : EC_KC;
    LAS float* part = (LAS float*)F.lds; LAS unsigned short* hs = (LAS unsigned short*)(F.lds + 65536);
    int c = ct * 32 + (lane & 31); if (c > 126) c = 126;
    f32x16 a0 = {}, a1 = {};
    for (int ks = F.wave * 16; ks < F.wave * 16 + 16; ++ks) {
        const bf16x8 af = *(const bf16x8*)(H + ((size_t)b * SEQ + 16 * c + (ks >> 2)) * NE_PAD + col + 16 * (ks & 3) + 8 * hi);
        const bf16x8 b0 = *(const bf16x8*)(w1t + (size_t)(lane & 31) * 2048 + 16 * ks + 8 * hi), b1 = *(const bf16x8*)(w1t + (size_t)(32 + (lane & 31)) * 2048 + 16 * ks + 8 * hi);
        a0 = __builtin_amdgcn_mfma_f32_32x32x16_bf16(af, b0, a0, 0, 0, 0); a1 = __builtin_amdgcn_mfma_f32_32x32x16_bf16(af, b1, a1, 0, 0, 0);
    }
#pragma unroll
    for (int r = 0; r < 16; ++r) { part[F.wave * 2048 + crow(r, hi) * 64 + (lane & 31)] = a0[r]; part[F.wave * 2048 + crow(r, hi) * 64 + 32 + (lane & 31)] = a1[r]; }
    __syncthreads();
#pragma unroll
    for (int i = 0; i < 4; ++i) { const int idx = F.tid + 512 * i; float s = bias1[idx & 63];
#pragma unroll
        for (int w = 0; w < 8; ++w) s += part[w * 2048 + idx];
        const float h = s / (1.0f + __expf(-s)); hs[(idx >> 6) * 72 + (idx & 63)] = (unsigned short)f2bf(h); }
    __syncthreads();
    if (F.wave < 2) {
        const int nt = F.wave; f32x16 acc = {};
#pragma unroll
        for (int ks = 0; ks < 4; ++ks) { const bf16x8 af = *(const LAS bf16x8*)((const LAS unsigned char*)hs + (lane & 31) * 144 + (16 * ks + 8 * hi) * 2);
            const bf16x8 bf = *(const bf16x8*)(w2t + (size_t)(nt * 32 + (lane & 31)) * 64 + 16 * ks + 8 * hi);
            acc = __builtin_amdgcn_mfma_f32_32x32x16_bf16(af, bf, acc, 0, 0, 0); }
        const int n = nt * 32 + (lane & 31);
        const float* cosT = (const float*)(F.ws + WS_ROPE_COS); const float* sinT = (const float*)(F.ws + WS_ROPE_SIN);
#pragma unroll
        for (int r = 0; r < 16; ++r) { const int cg = ct * 32 + crow(r, hi); float v = acc[r];
            if (kv == 0) { const float o = __shfl_xor(v, 1); int pos = 16 * cg + 31; if (pos > SEQ - 1) pos = SEQ - 1; const float cs = cosT[pos * 32 + (n >> 1)], sn = sinT[pos * 32 + (n >> 1)];
                v = (n & 1) ? (v * cs + o * sn) : (v * cs - o * sn); }
            outp[(size_t)cg * 64 + n] = (unsigned short)((cg <= 126) ? f2bf(v) : 0u); }
    }
    __syncthreads();
}

__device__ __forceinline__ void nsa_unit(const Frame& F, const Args& a, int layer, int b, int qg) {
    bf16_t* H = (bf16_t*)(F.ws + WS_R + R_H);
    const int lane = F.lane, hi = lane >> 5, tid = F.tid, t0 = qg * 32, cur = qg; const size_t rb0 = (size_t)b * SEQ;
    const int tq = t0 + (lane & 31);
    LAS unsigned char* kvb = F.lds;
    LAS unsigned short* slab = (LAS unsigned short*)(F.lds + 2 * KV_BUF);
    LAS float* pcs = (LAS float*)(F.lds + 2 * KV_BUF + 65536);
    LAS unsigned* selm = (LAS unsigned*)(pcs + 4096);
    const bf16_t* rowp = H + (rb0 + tq) * NE_PAD;
    bf16x8 qf[4]; load_qf(qf, rowp + EC_QB + F.wave * 64, lane);
    const float* bg = a.in[I_EV_BGATE] + (layer >> 1) * 24 + F.wave * 3;
    const float g0 = sigmoidf_(bf2f(rowp[EC_GB + F.wave * 3 + 0]) + bg[0]), g1 = sigmoidf_(bf2f(rowp[EC_GB + F.wave * 3 + 1]) + bg[1]), g2 = sigmoidf_(bf2f(rowp[EC_GB + F.wave * 3 + 2]) + bg[2]);
    { const bf16_t* kc = (const bf16_t*)(F.ws + WS_KC) + (size_t)b * 128 * 64; const bf16_t* vc = (const bf16_t*)(F.ws + WS_VC) + (size_t)b * 128 * 64;
      KVRegs r0, r1; kv_load(r0, kc, vc, 64, 0, tid); kv_load(r1, kc, vc, 64, 64, tid); kv_store(r0, kvb, tid); kv_store(r1, kvb + KV_BUF, tid); }
    __syncthreads();
    f32x16 pc[4]; f32x16 oa0 = {}, oa1 = {};
    {
        const int cmax = (tq >= 31) ? min(126, (tq - 31) >> 4) : -1;
        qk_tile(pc[0], pc[1], kvb, qf, lane); qk_tile(pc[2], pc[3], kvb + KV_BUF, qf, lane);
        float mx = NEGBIG;
#pragma unroll
        for (int s = 0; s < 4; ++s)
#pragma unroll
            for (int r = 0; r < 16; ++r) { const int c = 32 * s + crow(r, hi); pc[s][r] = (c <= cmax) ? pc[s][r] * QK_C : NEGBIG; mx = fmaxf(mx, pc[s][r]); }
        mx = fmaxf(mx, __shfl_xor(mx, 32));
        float ls = 0.f;
#pragma unroll
        for (int s = 0; s < 4; ++s)
#pragma unroll
            for (int r = 0; r < 16; ++r) { pc[s][r] = (pc[s][r] > -1e29f) ? fast_exp2(pc[s][r] - mx) : 0.f; ls += pc[s][r]; }
        ls += __shfl_xor(ls, 32);
        const float inv = (ls > 0.f) ? 1.0f / ls : 0.f;
#pragma unroll
        for (int s = 0; s < 4; ++s) pc[s] *= inv;
        f32x16 c0 = {}, c1 = {};
        pv_sub(c0, c1, kvb + KT_BYTES, 0, pc[0], lane); pv_sub(c0, c1, kvb + KT_BYTES, 1, pc[1], lane);
        pv_sub(c0, c1, kvb + KV_BUF + KT_BYTES, 0, pc[2], lane); pv_sub(c0, c1, kvb + KV_BUF + KT_BYTES, 1, pc[3], lane);
        oa0 = c0 * g0; oa1 = c1 * g0;
    }
    { LAS unsigned short* sl = slab + F.wave * 4096 + (lane & 31) * 128 + 4 * hi;
#pragma unroll
      for (int s = 0; s < 4; ++s)
#pragma unroll
          for (int g = 0; g < 4; ++g) { u32x2 w; w.x = pkh(pc[s][4 * g], pc[s][4 * g + 1]); w.y = pkh(pc[s][4 * g + 2], pc[s][4 * g + 3]); *(LAS u32x2*)(sl + 32 * s + 8 * g) = w; } }
    __syncthreads();
#pragma unroll
    for (int i = 0; i < 8; ++i) { const int idx = tid + 512 * i; float s8 = 0.f;
#pragma unroll
        for (int w = 0; w < 8; ++w) s8 += h2f(slab[w * 4096 + idx]);
        pcs[idx] = s8; }
    __syncthreads();
#pragma unroll
    for (int qq = 0; qq < 4; ++qq) { const int q = 4 * F.wave + qq; const LAS float* pr = pcs + q * 128;
        float v = pr[2 * lane] + 0.5f * ((lane > 0 ? pr[2 * lane - 1] : 0.f) + pr[2 * lane + 1]);
        if (lane == 0 || lane == cur || lane == cur - 1) v = 1e30f; else if (lane > cur) v = NEGBIG;
        int rank = 0;
        for (int j = 0; j < 64; ++j) { const float o = __builtin_bit_cast(float, __builtin_amdgcn_readlane(__builtin_bit_cast(int, v), j)); rank += (o > v || (o == v && j < lane)) ? 1 : 0; }
        const unsigned long long sm = __ballot(rank < 8);
        if (lane == 0) { selm[2 * q] = (unsigned)sm; selm[2 * q + 1] = (unsigned)(sm >> 32); } }
    __syncthreads();
    {
        unsigned long long un = 0ull;
        { const unsigned lo = selm[2 * (lane & 31)], hh = selm[2 * (lane & 31) + 1]; unsigned ul = lo, uh = hh;
#pragma unroll
          for (int o = 1; o < 32; o <<= 1) { ul |= __shfl_xor(ul, o); uh |= __shfl_xor(uh, o); }
          un = ((unsigned long long)__builtin_amdgcn_readfirstlane(uh) << 32) | (unsigned)__builtin_amdgcn_readfirstlane(ul); }
        if (cur < 63) un &= (1ull << (cur + 1)) - 1ull;
        unsigned tm = 0u;
        for (int t = 0; t <= (cur >> 1); ++t) if ((un >> (2 * t)) & 3ull) tm |= 1u << t;
        const unsigned long long mysel = ((unsigned long long)selm[2 * (lane & 31) + 1] << 32) | selm[2 * (lane & 31)];
        f32x16 s0 = {}, s1 = {}; float m = NEGBIG, l = 0.f;
        attn_tiles(F, tm, H + rb0 * NE_PAD + EC_KS, H + rb0 * NE_PAD + EC_VS, NE_PAD, qf, s0, s1, m, l, kvb,
            [&](f32x16& p0, f32x16& p1, int t) { const bool b0 = (mysel >> (2 * t)) & 1ull, b1 = (mysel >> (2 * t + 1)) & 1ull;
#pragma unroll
                for (int r = 0; r < 16; ++r) { const int key = 64 * t + crow(r, hi);
                    p0[r] = (b0 && key <= tq) ? p0[r] * QK_C : NEGBIG; p1[r] = (b1 && key + 32 <= tq) ? p1[r] * QK_C : NEGBIG; } });
        const float sc = g1 / l; oa0 += s0 * sc; oa1 += s1 * sc;
    }
    {
        const int tlo = (t0 >= 511) ? ((t0 - 511) >> 6) : 0, thi = (t0 + 31) >> 6;
        unsigned tm = 0u; for (int t = tlo; t <= thi; ++t) tm |= 1u << t;
        f32x16 s0 = {}, s1 = {}; float m = NEGBIG, l = 0.f;
        attn_tiles(F, tm, H + rb0 * NE_PAD + EC_KW, H + rb0 * NE_PAD + EC_VW, NE_PAD, qf, s0, s1, m, l, kvb,
            [&](f32x16& p0, f32x16& p1, int t) {
#pragma unroll
                for (int r = 0; r < 16; ++r) { const int key = 64 * t + crow(r, hi);
                    p0[r] = (key <= tq && key + 512 > tq) ? p0[r] * QK_C : NEGBIG; p1[r] = (key + 32 <= tq && key + 32 + 512 > tq) ? p1[r] * QK_C : NEGBIG; } });
        const float sc = g2 / l; oa0 += s0 * sc; oa1 += s1 * sc;
    }
    store_ot(oa0, oa1, 1.0f, H + (rb0 + tq) * NE_PAD + EC_QB + F.wave * 64, lane);
    __syncthreads();
}

__device__ __forceinline__ void moe_tables(const Frame& F, int layer) {
    LAS int* cntl = (LAS int*)(F.lds + LDS_TAB); LAS int* rbs = cntl + 160;
    __syncthreads();
    if (F.tid < NV) cntl[F.tid] = ((F.tid % 65) == 64) ? HALF_T : (int)__hip_atomic_load(F.ctl + CW_CNT + layer * 256 + F.tid, RLX_AGENT);
    __syncthreads();
    if (F.tid == 0) { int run = 0; for (int v = 0; v < NV; ++v) { rbs[v] = run; run += (cntl[v] + 255) >> 8; } rbs[NV] = run; }
    __syncthreads();
}

constexpr int PH_PER_LAYER = 16, N_PHASES = DEPTH * PH_PER_LAYER;
__global__ void __launch_bounds__(512, 2) fwd(Args args) {
    extern __shared__ __attribute__((aligned(16))) unsigned char lds_raw[];
    Frame F; F.lds = (LAS unsigned char*)lds_raw; F.tid = threadIdx.x; F.lane = F.tid & 63; F.wave = __builtin_amdgcn_readfirstlane(F.tid >> 6);
    F.G = gridDim.x; F.bid = blockIdx.x; F.ws = args.ws; F.ctl = (gu32*)(args.ws + WS_CTL);
    volatile LAS unsigned* MISC = (volatile LAS unsigned*)(F.lds + LDS_MISC);
    if (F.tid < 64) MISC[F.tid] = 0u;
    __syncthreads();
    const int lo = args.ph_lo, hi = args.ph_hi; const bool multi = (hi - lo) > 1;
    XcdBarrier bar; bar.bar = (unsigned*)(F.ctl + CW_BAR); bar.x = 0; bar.st = MISC;
    if (multi) bar = xcd_barrier_post((unsigned*)(F.ctl + CW_BAR), MISC);
#ifndef PHMASK
#define PHMASK 0xffff
#endif
#define IN(k) (((PHMASK >> ((k) & 15)) & 1) && lo <= (k) && (k) < hi)
#define SEAM() do { if (multi) xcd_barrier(bar); } while (0)
#define PF() Frame P = F; { int t_ = F.tid; asm volatile("" : "+v"(t_)); P.tid = t_; P.lane = t_ & 63; int w_ = F.wave; asm volatile("" : "+s"(w_)); P.wave = w_; unsigned char* p_ = args.ws; asm volatile("" : "+s"(p_)); P.ws = p_; P.ctl = (gu32*)(p_ + WS_CTL); } \
    unsigned char* ws = P.ws; bf16_t* XB = (bf16_t*)(ws + WS_XB); bf16_t* XB2 = (bf16_t*)(ws + WS_R + R_XB2); bf16_t* H = (bf16_t*)(ws + WS_R + R_H); bf16_t* W = (bf16_t*)(ws + WS_W); (void)XB; (void)XB2; (void)H; (void)W;
    LAS int* cntl = (LAS int*)(F.lds + LDS_TAB); LAS int* rbs = cntl + 160;
    for (int layer = 0; layer < DEPTH; ++layer) {
        const int pb = layer * PH_PER_LAYER; const bool even = (layer & 1) == 0; const int jl = layer >> 1;
        if (IN(pb + 0)) { PF(); prep_phase(P, args, layer); SEAM(); }
        if (IN(pb + 1)) { PF();
            const bf16_t* xin = (layer == 0) ? XB : XB2;
            if (even) { pg8::DenseSched S{(const char*)xin, (const char*)(W + W_IN / 2), DM, DM, T / 256, NE_PAD / 256, P.G, P.bid};
                EpiInEven E{H, (const float*)(ws + WS_ROPE_COS), (const float*)(ws + WS_ROPE_SIN)}; pg8::gemm_phase(P.lds, S, E, P.tid); }
            else { pg8::DenseSched S{(const char*)xin, (const char*)(W + W_IN / 2), DM, DM, T / 256, NO_PAD / 256, P.G, P.bid};
                EpiInOdd E{H, (float*)(ws + WS_LOGF), args.in[I_OD_BF] + jl * 16}; pg8::gemm_phase(P.lds, S, E, P.tid); }
            SEAM();
        }
        if (even) {
            if (IN(pb + 2)) { PF();
                for (int it = P.bid; it < 256; it += P.G) compress_item(P, args, it);
                for (int u = P.bid; u < NB * 64; u += P.G) { const int qg = 63 - (u / NB), b = u % NB; dsa_unit(P, args, b, qg); }
                SEAM();
            }
            if (IN(pb + 3)) { PF(); for (int u = P.bid; u < NB * 64; u += P.G) { const int qg = 63 - (u / NB), b = u % NB; nsa_unit(P, args, layer, b, qg); } SEAM(); }
        } else {
            if (IN(pb + 2)) { PF(); scan_phase(P, args); SEAM(); }
            if (IN(pb + 3)) { PF(); fox_phase(P, args); SEAM(); }
        }
        if (IN(pb + 4)) { PF();
            pg8::DenseSched S{(const char*)H, (const char*)(W + W_O / 2), even ? NE_PAD : NO_PAD, DM, T / 256, DM / 256, P.G, P.bid};
            EpiOut E{(layer == 0) ? args.in[I_X] : args.out, args.out}; pg8::gemm_phase(P.lds, S, E, P.tid); SEAM();
        }
        if (IN(pb + 5)) { PF(); route_phase(P, args, layer); SEAM(); }
        if (IN(pb + 6)) { PF();
            moe_tables(P, layer);
            MoeSched S{(const char*)XB, (const char*)(W + W_UP / 2), DM, DM, 2, (size_t)512 * DM * 2, rbs, cntl, 0, NV - 1, 0, rbs[NV] * 2, P.G, P.bid, (const int*)(ws + WS_SLOT_TK), true};
            EpiUp E{(bf16_t*)(ws + WS_R + R_HMID)}; pg8::gemm_phase(P.lds, S, E, P.tid); SEAM();
        }
        for (int half = 0; half < 2; ++half) {
            if (IN(pb + 7 + 2 * half)) { PF();
                moe_tables(P, layer);
                MoeSched S{(const char*)(ws + WS_R + R_HMID), (const char*)(W + W_DN / 2), DFF, DFF, 4, (size_t)DM * DFF * 2, rbs, cntl, half * 65, half * 65 + 64, rbs[half * 65],
                           (rbs[half * 65 + 65] - rbs[half * 65]) * 4, P.G, P.bid, (const int*)(ws + WS_SLOT_TK), false};
                EpiDown E{(bf16_t*)(ws + WS_R + R_YTOK), (const int*)(ws + WS_SLOT_TK), (const float*)(ws + WS_SLOT_G), cntl}; pg8::gemm_phase(P.lds, S, E, P.tid); SEAM();
            }
            if (IN(pb + 8 + 2 * half)) { PF(); combine_phase(P, args, layer, half); SEAM(); }
        }
        if (IN(pb + 11)) { PF();
            pg8::DenseSched S{(const char*)(ws + WS_PB), (const char*)(W + W_P / 2), 256, 256, T / 256, DM / 256, P.G, P.bid};
            EpiPleE E{(bf16_t*)(ws + WS_R + R_E), (float*)(ws + WS_SSQ)}; pg8::gemm_phase(P.lds, S, E, P.tid); SEAM();
        }
        if (IN(pb + 12)) { PF();
            pg8::DenseSched S{(const char*)XB, (const char*)(W + W_G / 2), DM, DM, T / 256, DM / 256, P.G, P.bid};
            EpiPleG E{args.out, (const bf16_t*)(ws + WS_R + R_E), (const float*)(ws + WS_SSQ), args.in[I_PNG] + layer * DM, XB2}; pg8::gemm_phase(P.lds, S, E, P.tid); SEAM();
        }
    }
#undef IN
#undef SEAM
}

extern "C" void kernel_launch(void* const* d_in, const int* in_sizes, int n_in, void* d_out, int out_size, void* d_ws, size_t ws_size, hipStream_t stream) {
    static int grid = 0;
    if (grid == 0) {
        if (n_in != 29 || in_sizes[0] != T * DM || out_size != T * DM || ws_size < WS_END) { fprintf(stderr, "kernel_launch: unexpected shapes / workspace (n_in %d, ws %zu, need %zu)\n", n_in, ws_size, (size_t)WS_END); grid = -1; return; }
        int dev = 0, cus = 0, per_cu = 0;
        if (hipGetDevice(&dev) != hipSuccess || hipDeviceGetAttribute(&cus, hipDeviceAttributeMultiprocessorCount, dev) != hipSuccess) { grid = -1; return; }
        if (hipFuncSetAttribute((const void*)fwd, hipFuncAttributeMaxDynamicSharedMemorySize, LDS_BYTES) != hipSuccess) { fprintf(stderr, "kernel_launch: hipFuncSetAttribute failed\n"); grid = -1; return; }
        if (hipOccupancyMaxActiveBlocksPerMultiprocessor(&per_cu, (const void*)fwd, 512, LDS_BYTES) != hipSuccess || per_cu < 1) { fprintf(stderr, "kernel_launch: occupancy query says %d\n", per_cu); }
        (void)hipGetLastError();
        grid = cus;
    }
    if (grid < 0) return;
    if (hipMemsetAsync((char*)d_ws + WS_CTL, 0, CTL_BYTES, stream) != hipSuccess) return;
    Args a{};
    for (int i = 0; i < 29; ++i) a.in[i] = (const float*)d_in[i];
    a.out = (float*)d_out; a.ws = (unsigned char*)d_ws;
#if MK_ONE_LAUNCH
    a.ph_lo = 0; a.ph_hi = N_PHASES;
    hipLaunchKernelGGL(fwd, dim3(grid), dim3(512), LDS_BYTES, stream, a);
#else
    for (int ph = 0; ph < N_PHASES; ++ph) {
        if ((ph % PH_PER_LAYER) > 12) continue;
        a.ph_lo = ph; a.ph_hi = ph + 1;
        hipLaunchKernelGGL(fwd, dim3(grid), dim3(512), LDS_BYTES, stream, a);
    }
#endif
}
```

```cpp
#include <hip/hip_runtime.h>
#include <cstdio>
#include <cstdint>

#define LAS __attribute__((address_space(3)))
#define GAS __attribute__((address_space(1)))
typedef unsigned short bf16_t;
typedef short bf16x8 __attribute__((ext_vector_type(8)));
typedef short s16x4 __attribute__((ext_vector_type(4)));
typedef float f32x2 __attribute__((ext_vector_type(2)));
typedef float f32x4 __attribute__((ext_vector_type(4)));
typedef float f32x16 __attribute__((ext_vector_type(16)));
typedef unsigned u32x2 __attribute__((ext_vector_type(2)));
typedef unsigned u32x4 __attribute__((ext_vector_type(4)));
typedef GAS unsigned gu32;

#ifndef SIDE_PX
#define SIDE_PX 3
#endif
#ifndef Y_FP8
#define Y_FP8 1
#endif
#ifndef MK_ONE_LAUNCH
#define MK_ONE_LAUNCH 1
#endif

constexpr int DM = 1024, NB = 32, SEQ = 2048, DEPTH = 4, T = NB * SEQ;
constexpr int EVEN_COLS = 2144, ODD_COLS = 3088, NE_PAD = 2304, NO_PAD = 3328;
constexpr int NEXP = 64, NV = 130  , HALF_T = T / 2, DFF = 256;
constexpr float LN_EPS = 1e-5f, RMS_EPS = 1e-6f;
constexpr float ALPHA = 1.6817928305074290f;
constexpr float LOG2E = 1.4426950408889634f;
constexpr float QK_C = 0.125f * LOG2E;
constexpr float NEGBIG = -1e30f;

constexpr int EC_QA = 0, EC_QB = 512, EC_QI = 1024, EC_KA = 1536, EC_KI = 1600, EC_KS = 1664, EC_KW = 1728;
constexpr int EC_VA = 1792, EC_KC = 1856, EC_VC = 1920, EC_VS = 1984, EC_VW = 2048, EC_WI = 2112, EC_GB = 2120;

constexpr size_t MiB = 1u << 20;
constexpr size_t WS_CTL = 0, CTL_BYTES = 1 * MiB;
constexpr size_t WS_ROPE_COS = 1 * MiB, WS_ROPE_SIN = WS_ROPE_COS + 256 * 1024;
constexpr size_t WS_SLOT_TK = 2 * MiB;
constexpr size_t WS_SLOT_G = WS_SLOT_TK + (size_t)NV * HALF_T * 4;
constexpr size_t WS_DCUM = 38 * MiB;
constexpr size_t WS_LOGF = 42 * MiB;
constexpr size_t WS_KC = 46 * MiB, WS_VC = WS_KC + 512 * 1024;
constexpr size_t WS_SSQ = 47 * MiB;
constexpr size_t WS_PB = 51 * MiB;
constexpr size_t WS_MISC = 83 * MiB;
constexpr size_t WS_XB = 84 * MiB;
constexpr size_t WS_W = 212 * MiB, W_BUF = 128 * MiB;
constexpr size_t W_IN = 0, W_O = 7 * MiB, W_G = 9 * MiB, W_P = 11 * MiB, W_RH = 11 * MiB + 512 * 1024, W_RL = W_RH + 128 * 1024  , W_C1K = 12 * MiB, W_C1V = W_C1K + 256 * 1024, W_C2K = W_C1V + 256 * 1024, W_C2V = W_C2K + 8192;
constexpr size_t W_UP = 16 * MiB  , W_DN = 82 * MiB  ;
constexpr size_t WS_R = 468 * MiB;
constexpr size_t R_H = 0, R_HMID = 0, R_E = 0, R_YTOK = 320 * MiB, R_XB2 = 440 * MiB;
constexpr size_t WS_END = WS_R + 896 * MiB;
static_assert(Y_FP8 == 1 && R_YTOK + (size_t)T * 9 * 1024 <= 896 * MiB, "ytok");
static_assert(W_DN + 65ull * 1024 * 256 * 2 <= 128 * MiB, "w");
constexpr int CW_BAR = 4096;
constexpr int CW_CNT = 16384;
constexpr int XBW = 3456;

constexpr int RING_BYTES = 131072;
constexpr int LDS_TAB = RING_BYTES;
constexpr int LDS_MISC = RING_BYTES + 20480;
constexpr int LDS_BYTES = RING_BYTES + 20480 + 256;

#define LDS_WAIT() asm volatile("s_waitcnt lgkmcnt(0)" ::: "memory")
#define VM_WAIT() asm volatile("s_waitcnt vmcnt(0)" ::: "memory")
#define RLX_AGENT __ATOMIC_RELAXED, __HIP_MEMORY_SCOPE_AGENT
__device__ __forceinline__ unsigned f2bf(float f) { unsigned u = __builtin_bit_cast(unsigned, f); return (u + 0x7fffu + ((u >> 16) & 1u)) >> 16; }
__device__ __forceinline__ unsigned pk2(float lo, float hi) { return f2bf(lo) | (f2bf(hi) << 16); }
__device__ __forceinline__ float bf2f(unsigned short h) { return __builtin_bit_cast(float, (unsigned)h << 16); }
__device__ __forceinline__ float bflo(unsigned w) { return __builtin_bit_cast(float, w << 16); }
__device__ __forceinline__ float bfhi(unsigned w) { return __builtin_bit_cast(float, w & 0xffff0000u); }
template <int CTRL> __device__ __forceinline__ float dpp_mov(float x) { return __builtin_bit_cast(float, __builtin_amdgcn_update_dpp(0, __builtin_bit_cast(int, x), CTRL, 0xf, 0xf, true)); }
template <int CTRL> __device__ __forceinline__ unsigned dpp_movu(unsigned x) { return (unsigned)__builtin_amdgcn_update_dpp(0, (int)x, CTRL, 0xf, 0xf, true); }
#define DPP_X1 0xB1
#define DPP_X2 0x4E
#define DPP_HM 0x141
#define DPP_RM 0x140
__device__ __forceinline__ float bperm_xor(float x, int lane, int mask) { return __builtin_bit_cast(float, __builtin_amdgcn_ds_bpermute((lane ^ mask) << 2, __builtin_bit_cast(int, x))); }
__device__ __forceinline__ float sum_x32(float x, int lane) { return x + bperm_xor(x, lane, 32); }
__device__ __forceinline__ float max_x32(float x, int lane) { return fmaxf(x, bperm_xor(x, lane, 32)); }
__device__ __forceinline__ float sum_x16(float x, int lane) { return x + bperm_xor(x, lane, 16); }
__device__ __forceinline__ float wave_sum(float v) {
    v += dpp_mov<DPP_X1>(v); v += dpp_mov<DPP_X2>(v); v += dpp_mov<DPP_HM>(v); v += dpp_mov<DPP_RM>(v);
    const float r0 = __builtin_bit_cast(float, __builtin_amdgcn_readlane(__builtin_bit_cast(int, v), 0)), r1 = __builtin_bit_cast(float, __builtin_amdgcn_readlane(__builtin_bit_cast(int, v), 16)),
                r2 = __builtin_bit_cast(float, __builtin_amdgcn_readlane(__builtin_bit_cast(int, v), 32)), r3 = __builtin_bit_cast(float, __builtin_amdgcn_readlane(__builtin_bit_cast(int, v), 48));
    return (r0 + r1) + (r2 + r3);
}
__device__ __forceinline__ int wave_sum_i(int v) {
    v += __builtin_amdgcn_update_dpp(0, v, DPP_X1, 0xf, 0xf, true); v += __builtin_amdgcn_update_dpp(0, v, DPP_X2, 0xf, 0xf, true);
    v += __builtin_amdgcn_update_dpp(0, v, DPP_HM, 0xf, 0xf, true); v += __builtin_amdgcn_update_dpp(0, v, DPP_RM, 0xf, 0xf, true);
    return (__builtin_amdgcn_readlane(v, 0) + __builtin_amdgcn_readlane(v, 16)) + (__builtin_amdgcn_readlane(v, 32) + __builtin_amdgcn_readlane(v, 48));
}
__device__ __forceinline__ float fast_exp2(float x) { return __builtin_amdgcn_exp2f(x); }
__device__ __forceinline__ float sigmoidf_(float x) { return __builtin_amdgcn_rcpf(1.0f + __expf(-x)); }

#define XB_TMO      128
#define XB_XCNT(j)  (256  + 64 * (j))
#define XB_XSUB(j)  (1280 + 64 * (j))
#define XB_XGEN(j)  (2304 + 64 * (j))
#define XB_TOP      3328
#define XB_TOPGEN   3392
#define XCD_BAR_WORDS 3456
#define XB_SPIN_CAP (1u << 22)
__device__ __forceinline__ unsigned xb_ld(unsigned* p)              { return __hip_atomic_load(p, __ATOMIC_RELAXED, __HIP_MEMORY_SCOPE_AGENT); }
__device__ __forceinline__ unsigned xb_add(unsigned* p, unsigned v) { return __hip_atomic_fetch_add(p, v, __ATOMIC_RELAXED, __HIP_MEMORY_SCOPE_AGENT); }
__device__ __forceinline__ unsigned xb_xcc_id() { return (unsigned)__builtin_amdgcn_s_getreg((3 << 11) | 20) & 0xFu; }
#define XB_SPIN(cond, bar) do { unsigned _sp = 0; while (cond) { __builtin_amdgcn_s_sleep(1); \
    if ((++_sp & 255u) == 0u) { if (xb_ld(&(bar)[XB_TMO])) break; if (_sp > XB_SPIN_CAP) { atomicAdd(&(bar)[XB_TMO], 1u); break; } } } } while (0)
struct XcdBarrier { unsigned* bar; unsigned x; volatile LAS unsigned* st; };
__device__ __forceinline__ XcdBarrier xcd_barrier_post(unsigned* bar, volatile LAS unsigned* st) {
    XcdBarrier b; b.bar = bar; b.x = xb_xcc_id(); b.st = st;
    if (threadIdx.x == 0) (void)xb_add(&bar[XB_XCNT(b.x)], 1u);
    return b;
}
__device__ __forceinline__ void xcd_barrier_complete(unsigned* bar, unsigned x, unsigned& nloc, unsigned& nx) {
    const unsigned G = gridDim.x * gridDim.y * gridDim.z;
    unsigned sum, cnt, mine, sp = 0u;
    for (;;) {
        sum = 0u; cnt = 0u; mine = 0u;
#pragma unroll
        for (unsigned j = 0; j < 16; ++j) { const unsigned c = xb_ld(&bar[XB_XCNT(j)]); sum += c; cnt += (c > 0u) ? 1u : 0u; mine = (j == x) ? c : mine; }
        if (sum == G) break;
        __builtin_amdgcn_s_sleep(1);
        if ((++sp & 255u) == 0u) { if (xb_ld(&bar[XB_TMO])) break; if (sp > XB_SPIN_CAP) { atomicAdd(&bar[XB_TMO], 1u); break; } }
    }
    nloc = mine > 0u ? mine : 1u; nx = cnt > 0u ? cnt : 1u;
}
__device__ __forceinline__ void xcd_barrier(const XcdBarrier& b) {
    asm volatile("s_waitcnt vmcnt(0)" ::: "memory");
    __syncthreads();
    if (threadIdx.x == 0) {
        unsigned* bar = b.bar; unsigned bx = b.x; asm volatile("" : "+s"(bx)); asm volatile("" : "+s"(bar));
        __builtin_amdgcn_s_waitcnt(0);
        unsigned nloc = b.st[0], nx = b.st[1];
        if (nloc == 0u) { xcd_barrier_complete(bar, bx, nloc, nx); b.st[0] = nloc; b.st[1] = nx; }
        const unsigned old = xb_add(&bar[XB_XSUB(bx)], 1u);
        const unsigned gen = old / nloc;
        if (old + 1u == (gen + 1u) * nloc) {
            __builtin_amdgcn_fence(__ATOMIC_RELEASE, "agent");
            asm volatile("s_waitcnt vmcnt(0)" ::: "memory");
            const unsigned og = xb_add(&bar[XB_TOP], 1u);
            const unsigned tg = og / nx;
            if (og + 1u == (tg + 1u) * nx) xb_add(&bar[XB_TOPGEN], 1u);
            else XB_SPIN(xb_ld(&bar[XB_TOPGEN]) == tg, bar);
            __builtin_amdgcn_fence(__ATOMIC_ACQUIRE, "agent");
            xb_add(&bar[XB_XGEN(bx)], 1u);
            asm volatile("s_waitcnt vmcnt(0)" ::: "memory");
        } else {
            XB_SPIN(xb_ld(&bar[XB_XGEN(bx)]) == gen, bar);
            __builtin_amdgcn_fence(__ATOMIC_ACQUIRE, "agent");
            asm volatile("s_waitcnt vmcnt(0)" ::: "memory");
        }
    }
    __syncthreads();
}

namespace pg8 {
constexpr int BM = 256, BK = 64, HALF = 128, HTB = HALF * BK * 2, STAGE_BYTES = 8 * HTB, NXCD = 8, WGM = 8;
__host__ __device__ __forceinline__ int lds_byte(int r, int c) { const int st = (r >> 4) * 2 + (c >> 5), rr = r & 15, cc = c & 31, ob = rr * 64 + cc * 2; return st * 1024 + (ob ^ (((ob >> 9) & 1) << 5)); }
__host__ __device__ __forceinline__ void stage_rc(int b, int& R, int& C) { const int st = b / 1024, sb = b % 1024, swz = sb ^ (((sb >> 9) & 1) << 5); R = (st >> 1) * 16 + swz / 64; C = (st & 1) * 32 + (swz % 64) / 2; }
__host__ __device__ __forceinline__ int perm32(int rho) { const int n = rho >> 4, i = rho & 15; return 8 * (i >> 2) + 4 * n + (i & 3); }

struct Unit { int pm, pn, v, rb; };

__device__ __forceinline__ bool static_next(int nM, int nN, int G, int c, int i, Unit& u) {
    const int nwg = nM * nN; const long L = (long)i * G + c; if (L >= nwg) return false;
    int wgid = (int)L; { const int q = nwg / NXCD, r = nwg % NXCD, xcd = wgid % NXCD, off = wgid / NXCD; wgid = (xcd < r ? xcd * (q + 1) : r * (q + 1) + (xcd - r) * q) + off; }
    const int nig = WGM * nN, gid = wgid / nig, fm = gid * WGM, gsz = (nM - fm) < WGM ? (nM - fm) : WGM;
    u.pm = fm + ((wgid % nig) % gsz); u.pn = (wgid % nig) / gsz; u.v = 0; u.rb = 0; return true;
}
struct DenseSched {
    const char* A; const char* Bt; int lda, K, nM, nN, G, c;
    __device__ __forceinline__ bool next(int i, Unit& u) const { return static_next(nM, nN, G, c, i, u); }
    __device__ __forceinline__ const char* a_base(const Unit& u) const { return A + (size_t)u.pm * 256 * lda * 2; }
    __device__ __forceinline__ const char* b_base(const Unit& u) const { return Bt + (size_t)u.pn * 256 * K * 2; }
    __device__ __forceinline__ void a_off(const Unit&, const int (&R)[2], const int (&C)[2], unsigned (&o)[2][2]) const {
#pragma unroll
        for (int h = 0; h < 2; ++h)
#pragma unroll
            for (int i = 0; i < 2; ++i) o[h][i] = (unsigned)((h * 128 + R[i]) * lda + C[i]) * 2u;
    }
};

__device__ __forceinline__ unsigned cvt_pk_bf16(float lo, float hi) { unsigned r; asm volatile("v_cvt_pk_bf16_f32 %0, %1, %2" : "=v"(r) : "v"(lo), "v"(hi)); return r; }

template <class Epi, class Sched>
__device__ __forceinline__ void gemm_phase(LAS unsigned char* lds, const Sched& S, const Epi& E, int tid) {
    const int wid = __builtin_amdgcn_readfirstlane(tid >> 6), lane = tid & 63, wr = wid >> 2, wc = wid & 3, fr = lane & 15, fq = lane >> 4;
    const int K = S.K, nt = K / BK;
    int RR[2], CC[2]; unsigned voffB[2];
#pragma unroll
    for (int i = 0; i < 2; ++i) { int R, C; stage_rc(tid * 16 + i * 8192, R, C); const int Rb = Epi::PERM ? ((R & ~31) + perm32(R & 31)) : R;
        RR[i] = R; CC[i] = C; voffB[i] = (unsigned)(Rb * K + C) * 2u; }
    const size_t kstep = (size_t)(BK * 2);
    const size_t hstep = (size_t)HALF * K * 2;
    const unsigned ldsw = (unsigned)wid * 1024u;
    const int aoff = lds_byte(wr * 64 + fr, fq * 8), boff = lds_byte(wc * 32 + fr, fq * 8);
#define PG8_SA(b, h) (((b) * 2 + (h)) * HTB)
#define PG8_SB(b, h) ((4 + (b) * 2 + (h)) * HTB)
#define PG8_STAGE(bufoff, gbase, voff) do { _Pragma("unroll") for (int _i = 0; _i < 2; ++_i) \
        __builtin_amdgcn_global_load_lds((const unsigned*)((const char*)(gbase) + (voff)[_i]), (LAS unsigned*)(lds + (bufoff) + ldsw + _i * 8192), 16, 0, 0); } while (0)
#define PG8_LDA(dst, b, h) do { _Pragma("unroll") for (int m = 0; m < 4; ++m) _Pragma("unroll") for (int k = 0; k < 2; ++k) dst[m][k] = *(const LAS bf16x8*)(lds + PG8_SA(b, h) + aoff + m * 2048 + k * 1024); } while (0)
#define PG8_LDB(dst, b, h) do { _Pragma("unroll") for (int n = 0; n < 2; ++n) _Pragma("unroll") for (int k = 0; k < 2; ++k) dst[n][k] = *(const LAS bf16x8*)(lds + PG8_SB(b, h) + boff + n * 2048 + k * 1024); } while (0)
#define PG8_MMA(ai, bj, At, Bt) do { __builtin_amdgcn_s_setprio(1); _Pragma("unroll") for (int m = 0; m < 4; ++m) _Pragma("unroll") for (int n = 0; n < 2; ++n) _Pragma("unroll") for (int k = 0; k < 2; ++k) \
        acc[ai][bj][m][n] = __builtin_amdgcn_mfma_f32_16x16x32_bf16(Bt[n][k], At[m][k], acc[ai][bj][m][n], 0, 0, 0); __builtin_amdgcn_s_setprio(0); } while (0)
#define PG8_WAIT_V(n) asm volatile("s_waitcnt vmcnt(" #n ")" ::: "memory")
#define PG8_WAIT_L(n) asm volatile("s_waitcnt lgkmcnt(" #n ")" ::: "memory")
#define PG8_BAR __builtin_amdgcn_s_barrier()
#define PG8_SCHED __builtin_amdgcn_sched_barrier(0)
    Unit cur, nxt; int ui = 0;
    if (!S.next(0, cur)) return;
    f32x4 acc[2][2][4][2];
    float zz = 0.f; asm volatile("" : "+v"(zz));
#pragma unroll
    for (int a = 0; a < 2; ++a)
#pragma unroll
        for (int b = 0; b < 2; ++b)
#pragma unroll
            for (int m = 0; m < 4; ++m)
#pragma unroll
                for (int n = 0; n < 2; ++n) acc[a][b][m][n] = (f32x4){zz, zz, zz, zz};
    bf16x8 At[4][2], B0[2][2], B1[2][2];
    unsigned oa[2][2], on[2][2];
    S.a_off(cur, RR, CC, oa);
    const char* cA = S.a_base(cur); const char* cB = S.b_base(cur);
    PG8_STAGE(PG8_SB(0, 0), cB, voffB); PG8_STAGE(PG8_SB(0, 1), cB + hstep, voffB); PG8_STAGE(PG8_SA(0, 0), cA, oa[0]); PG8_STAGE(PG8_SA(0, 1), cA, oa[1]);
    if (wr == 1) PG8_BAR;
    PG8_WAIT_V(2); PG8_BAR;
    PG8_STAGE(PG8_SB(1, 0), cB + kstep, voffB); PG8_STAGE(PG8_SA(1, 0), cA + kstep, oa[0]); PG8_STAGE(PG8_SB(1, 1), cB + hstep + kstep, voffB);
    PG8_WAIT_V(6); PG8_BAR;
    for (;;) {
        const bool has_next = S.next(ui + 1, nxt);
        const char* nA = has_next ? S.a_base(nxt) : cA; const char* nB = has_next ? S.b_base(nxt) : cB;
        if (has_next) S.a_off(nxt, RR, CC, on);
        else {
#pragma unroll
            for (int h = 0; h < 2; ++h)
#pragma unroll
                for (int i = 0; i < 2; ++i) on[h][i] = oa[h][i];
        }
        for (int t = 0; t < nt; t += 2) {
            const bool last = (t == nt - 2);
            const char* a1 = cA + (size_t)(t + 1) * kstep;
            const char* a2 = last ? nA : cA + (size_t)(t + 2) * kstep; const char* b2 = last ? nB : cB + (size_t)(t + 2) * kstep;
            const char* a3 = a2 + kstep; const char* b3 = b2 + kstep;
            unsigned x0[2], x1[2];
#pragma unroll
            for (int i = 0; i < 2; ++i) { x0[i] = last ? on[0][i] : oa[0][i]; x1[i] = last ? on[1][i] : oa[1][i]; }
            PG8_LDB(B0, 0, 0); PG8_LDB(B1, 0, 1); PG8_SCHED; PG8_LDA(At, 0, 0); PG8_STAGE(PG8_SA(1, 1), a1, oa[1]);
            PG8_WAIT_V(8); PG8_WAIT_L(0); PG8_BAR; PG8_MMA(0, 0, At, B0); PG8_MMA(0, 1, At, B1); PG8_BAR; PG8_SCHED;
            PG8_LDA(At, 0, 1); PG8_STAGE(PG8_SB(0, 0), b2, voffB); PG8_STAGE(PG8_SB(0, 1), b2 + hstep, voffB); PG8_STAGE(PG8_SA(0, 0), a2, x0);
            PG8_WAIT_V(8); PG8_WAIT_L(0); PG8_BAR; PG8_MMA(1, 0, At, B0); PG8_MMA(1, 1, At, B1); PG8_BAR; PG8_SCHED;
            PG8_LDB(B0, 1, 0); PG8_LDB(B1, 1, 1); PG8_SCHED; PG8_LDA(At, 1, 0); PG8_STAGE(PG8_SA(0, 1), a2, x1);
            PG8_WAIT_V(8); PG8_WAIT_L(0); PG8_BAR; PG8_MMA(0, 0, At, B0); PG8_MMA(0, 1, At, B1); PG8_BAR; PG8_SCHED;
            PG8_LDA(At, 1, 1); PG8_STAGE(PG8_SB(1, 0), b3, voffB); PG8_STAGE(PG8_SB(1, 1), b3 + hstep, voffB); PG8_STAGE(PG8_SA(1, 0), a3, x0);
            PG8_WAIT_V(8); PG8_WAIT_L(0); PG8_BAR; PG8_MMA(1, 0, At, B0); PG8_MMA(1, 1, At, B1); PG8_BAR; PG8_SCHED;
        }
        if (wr == 0) PG8_BAR;
        E(acc, cur, wr, wc, fr, fq);
        if (!has_next) break;
#pragma unroll
        for (int a = 0; a < 2; ++a)
#pragma unroll
            for (int b = 0; b < 2; ++b)
#pragma unroll
                for (int m = 0; m < 4; ++m)
#pragma unroll
                    for (int n = 0; n < 2; ++n) acc[a][b][m][n] = (f32x4){zz, zz, zz, zz};
        cur = nxt; cA = nA; cB = nB; ++ui;
#pragma unroll
        for (int h = 0; h < 2; ++h)
#pragma unroll
            for (int i = 0; i < 2; ++i) oa[h][i] = on[h][i];
        if (wr == 1) PG8_BAR;
    }
    PG8_WAIT_V(0);
    PG8_BAR;
#undef PG8_SA
#undef PG8_SB
#undef PG8_STAGE
#undef PG8_LDA
#undef PG8_LDB
#undef PG8_MMA
#undef PG8_WAIT_V
#undef PG8_WAIT_L
#undef PG8_BAR
#undef PG8_SCHED
}
}

using pg8::Unit;
__device__ __forceinline__ u32x4 pack8(f32x4 a, f32x4 b) { u32x4 w; w.x = pg8::cvt_pk_bf16(a[0], a[1]); w.y = pg8::cvt_pk_bf16(a[2], a[3]); w.z = pg8::cvt_pk_bf16(b[0], b[1]); w.w = pg8::cvt_pk_bf16(b[2], b[3]); return w; }

struct EpiInEven {
    static constexpr bool PERM = true;
    bf16_t* H; const float* cosT; const float* sinT;
    __device__ __forceinline__ void operator()(const f32x4 (&acc)[2][2][4][2], const Unit& u, int wr, int wc, int fr, int fq) const {
        const int row0 = u.pm * 256 + wr * 64 + fr, col0 = u.pn * 256 + wc * 32 + 8 * fq;
        const bool rope = u.pn < 7; const int j0 = (wc & 1) * 16 + 4 * fq;
#pragma unroll
        for (int ai = 0; ai < 2; ++ai) {
            f32x4 cs[4], sn[4];
#pragma unroll
            for (int m = 0; m < 4; ++m) { const int pos = (row0 + ai * 128 + m * 16) & (SEQ - 1);
                cs[m] = (f32x4){1.f, 1.f, 1.f, 1.f}; sn[m] = (f32x4){0.f, 0.f, 0.f, 0.f};
                if (rope) { cs[m] = *(const f32x4*)(cosT + pos * 32 + j0); sn[m] = *(const f32x4*)(sinT + pos * 32 + j0); } }
#pragma unroll
            for (int m = 0; m < 4; ++m) {
                const int row = row0 + ai * 128 + m * 16; const f32x4 c = cs[m], z = sn[m];
                bf16_t* rowp = H + (size_t)row * NE_PAD + col0;
#pragma unroll
                for (int bj = 0; bj < 2; ++bj) {
                    const f32x4 v0 = acc[ai][bj][m][0], v1 = acc[ai][bj][m][1];
                    f32x4 o0, o1;
                    o0[0] = v0[0] * c[0] - v0[1] * z[0]; o0[1] = v0[1] * c[0] + v0[0] * z[0];
                    o0[2] = v0[2] * c[1] - v0[3] * z[1]; o0[3] = v0[3] * c[1] + v0[2] * z[1];
                    o1[0] = v1[0] * c[2] - v1[1] * z[2]; o1[1] = v1[1] * c[2] + v1[0] * z[2];
                    o1[2] = v1[2] * c[3] - v1[3] * z[3]; o1[3] = v1[3] * c[3] + v1[2] * z[3];
                    *(u32x4*)(rowp + bj * 128) = pack8(o0, o1);
                }
            }
        }
    }
};
struct EpiInOdd {
    static constexpr bool PERM = true;
    bf16_t* H; float* logf; const float* bf;
    __device__ __forceinline__ void operator()(const f32x4 (&acc)[2][2][4][2], const Unit& u, int wr, int wc, int fr, int fq) const {
        const int row0 = u.pm * 256 + wr * 64 + fr, col0 = u.pn * 256 + wc * 32 + 8 * fq;
        float zz = 0.f; asm volatile("" : "+v"(zz));
#pragma unroll
        for (int ai = 0; ai < 2; ++ai)
#pragma unroll
            for (int m = 0; m < 4; ++m) {
                const int row = row0 + ai * 128 + m * 16;
                bf16_t* rowp = H + (size_t)row * NO_PAD + col0;
#pragma unroll
                for (int bj = 0; bj < 2; ++bj) *(u32x4*)(rowp + bj * 128) = pack8(acc[ai][bj][m][0] + zz, acc[ai][bj][m][1] + zz);
                if (u.pn == 12 && wc == 0 && fq < 2) {
                    f32x4 r0, r1;
#pragma unroll
                    for (int j = 0; j < 4; ++j) {
                        const float x0 = acc[ai][0][m][0][j] + bf[8 * fq + j], x1 = acc[ai][0][m][1][j] + bf[8 * fq + 4 + j];
                        r0[j] = fminf(x0, 0.f) - log1pf(__expf(-fabsf(x0))); r1[j] = fminf(x1, 0.f) - log1pf(__expf(-fabsf(x1)));
                    }
                    *(f32x4*)(logf + (size_t)row * 16 + 8 * fq) = r0; *(f32x4*)(logf + (size_t)row * 16 + 8 * fq + 4) = r1;
                }
                asm volatile("" ::: "memory");
            }
    }
};
struct EpiOut {
    static constexpr bool PERM = true;
    const bf16_t* X; bf16_t* Y;
    __device__ __forceinline__ void operator()(const f32x4 (&acc)[2][2][4][2], const Unit& u, int wr, int wc, int fr, int fq) const {
        const int row0 = u.pm * 256 + wr * 64 + fr, col0 = u.pn * 256 + wc * 32 + 8 * fq;
#pragma unroll
        for (int ai = 0; ai < 2; ++ai) {
            u32x4 x[4][2];
#pragma unroll
            for (int m = 0; m < 4; ++m) { const size_t off = (size_t)(row0 + ai * 128 + m * 16) * DM + col0;
#pragma unroll
                for (int bj = 0; bj < 2; ++bj) x[m][bj] = *(const u32x4*)(X + off + bj * 128); }
#pragma unroll
            for (int m = 0; m < 4; ++m) { const size_t off = (size_t)(row0 + ai * 128 + m * 16) * DM + col0;
#pragma unroll
                for (int bj = 0; bj < 2; ++bj) { const u32x4 w = x[m][bj]; const f32x4 a0 = acc[ai][bj][m][0], a1 = acc[ai][bj][m][1];
                    const f32x4 o0 = {bflo(w.x) * ALPHA + a0[0], bfhi(w.x) * ALPHA + a0[1], bflo(w.y) * ALPHA + a0[2], bfhi(w.y) * ALPHA + a0[3]};
                    const f32x4 o1 = {bflo(w.z) * ALPHA + a1[0], bfhi(w.z) * ALPHA + a1[1], bflo(w.w) * ALPHA + a1[2], bfhi(w.w) * ALPHA + a1[3]};
                    *(u32x4*)(Y + off + bj * 128) = pack8(o0, o1); } }
        }
    }
};
struct EpiUp {
    static constexpr bool PERM = false;
    bf16_t* Hm;
    __device__ __forceinline__ void operator()(const f32x4 (&acc)[2][2][4][2], const Unit& u, int wr, int wc, int fr, int fq) const {
        const int row0 = u.pm * 256 + wr * 64 + fr, col0 = u.pn * 128 + wc * 16 + 4 * fq;
#pragma unroll
        for (int ai = 0; ai < 2; ++ai)
#pragma unroll
            for (int m = 0; m < 4; ++m) {
                bf16_t* rowp = Hm + (size_t)(row0 + ai * 128 + m * 16) * DFF + col0;
#pragma unroll
                for (int bj = 0; bj < 2; ++bj) {
                    const f32x4 a = acc[ai][bj][m][0], b = acc[ai][bj][m][1]; f32x4 h;
#pragma unroll
                    for (int j = 0; j < 4; ++j) h[j] = a[j] * b[j] * __builtin_amdgcn_rcpf(1.0f + fast_exp2(-a[j] * LOG2E));
                    u32x2 w; w.x = pg8::cvt_pk_bf16(h[0], h[1]); w.y = pg8::cvt_pk_bf16(h[2], h[3]);
                    *(u32x2*)(rowp + bj * 64) = w;
                }
            }
    }
};
struct EpiDown {
    static constexpr bool PERM = true;
    bf16_t* Y; const int* slot_tk; const float* slot_g; const LAS int* cnt; bool dense;
    __device__ __forceinline__ void operator()(const f32x4 (&acc)[2][2][4][2], const Unit& u, int wr, int wc, int fr, int fq) const {
        const int e = u.v % 65, half = u.v / 65, n = cnt[u.v];
        const int col0 = u.pn * 256 + wc * 32 + 8 * fq;
        int drow[8]; float gg[8];
#pragma unroll
        for (int i = 0; i < 8; ++i) {
            const int pos = u.rb * 256 + (i >> 2) * 128 + wr * 64 + (i & 3) * 16 + fr;
            drow[i] = -1; gg[i] = 1.f;
            if (dense) { drow[i] = (u.pm & 63) * 256 + (i >> 2) * 128 + wr * 64 + (i & 3) * 16 + fr; }
            else if (pos < n) {
                if (e == 64) drow[i] = (half * HALF_T + pos) * 9 + 8;
                else { const int tk = slot_tk[(size_t)u.v * HALF_T + pos]; gg[i] = slot_g[(size_t)u.v * HALF_T + pos]; drow[i] = (tk >> 3) * 9 + (tk & 7); }
            }
        }
#pragma unroll
        for (int ai = 0; ai < 2; ++ai)
#pragma unroll
            for (int m = 0; m < 4; ++m) {
                const int i = ai * 4 + m;
                if (drow[i] >= 0) {
#if Y_FP8
                    const float g = gg[i] * 32.0f; unsigned char* rowp = (unsigned char*)Y + (size_t)drow[i] * DM + col0;
#pragma unroll
                    for (int bj = 0; bj < 2; ++bj) { f32x4 v0 = acc[ai][bj][m][0] * g, v1 = acc[ai][bj][m][1] * g; u32x2 w;
#pragma unroll
                        for (int q = 0; q < 4; ++q) { v0[q] = __builtin_amdgcn_fmed3f(v0[q], -416.0f, 416.0f); v1[q] = __builtin_amdgcn_fmed3f(v1[q], -416.0f, 416.0f); }
                        w.x = __builtin_amdgcn_cvt_pk_fp8_f32(v0[0], v0[1], 0u, false); w.x = __builtin_amdgcn_cvt_pk_fp8_f32(v0[2], v0[3], w.x, true);
                        w.y = __builtin_amdgcn_cvt_pk_fp8_f32(v1[0], v1[1], 0u, false); w.y = __builtin_amdgcn_cvt_pk_fp8_f32(v1[2], v1[3], w.y, true);
                        *(u32x2*)(rowp + bj * 128) = w; }
#else
                    const float g = gg[i]; bf16_t* rowp = Y + (size_t)drow[i] * DM + col0;
#pragma unroll
                    for (int bj = 0; bj < 2; ++bj) *(u32x4*)(rowp + bj * 128) = pack8(acc[ai][bj][m][0] * g, acc[ai][bj][m][1] * g);
#endif
                }
            }
    }
};
struct EpiPleE {
    static constexpr bool PERM = true;
    bf16_t* E; float* ssq;
    __device__ __forceinline__ void operator()(const f32x4 (&acc)[2][2][4][2], const Unit& u, int wr, int wc, int fr, int fq) const {
        const int row0 = u.pm * 256 + wr * 64 + fr, col0 = u.pn * 256 + wc * 32 + 8 * fq;
        float zz = 0.f; asm volatile("" : "+v"(zz));
#pragma unroll
        for (int ai = 0; ai < 2; ++ai)
#pragma unroll
            for (int m = 0; m < 4; ++m) {
                const int row = row0 + ai * 128 + m * 16;
                bf16_t* rowp = E + (size_t)row * DM + col0; float s = 0.f;
#pragma unroll
                for (int bj = 0; bj < 2; ++bj) {
                    const f32x4 a = acc[ai][bj][m][0] + zz, b = acc[ai][bj][m][1] + zz;
                    s += (a[0] * a[0] + a[1] * a[1]) + (a[2] * a[2] + a[3] * a[3]) + (b[0] * b[0] + b[1] * b[1]) + (b[2] * b[2] + b[3] * b[3]);
                    *(u32x4*)(rowp + bj * 128) = pack8(a, b);
                }
                s = sum_x16(s, fr + 16 * fq); s = sum_x32(s, fr + 16 * fq);
                if (fq == 0) ssq[(size_t)row * 16 + u.pn * 4 + wc] = s;
                asm volatile("" ::: "memory");
            }
    }
};
struct EpiPleG {
    static constexpr bool PERM = true;
    const bf16_t* X; const bf16_t* E; const float* ssq; const float* g; bf16_t* XO; float* OUTF;
    __device__ __forceinline__ void operator()(const f32x4 (&acc)[2][2][4][2], const Unit& u, int wr, int wc, int fr, int fq) const {
        const int row0 = u.pm * 256 + wr * 64 + fr, col0 = u.pn * 256 + wc * 32 + 8 * fq, lane = fr + 16 * fq;
#pragma unroll
        for (int ai = 0; ai < 2; ++ai)
#pragma unroll
            for (int mp = 0; mp < 2; ++mp) {
                u32x4 x[2][2], ew[2][2]; f32x4 sq[2];
#pragma unroll
                for (int mm = 0; mm < 2; ++mm) { const int row = row0 + ai * 128 + (2 * mp + mm) * 16; const size_t off = (size_t)row * DM + col0;
                    sq[mm] = *(const f32x4*)(ssq + (size_t)row * 16 + 4 * fq);
#pragma unroll
                    for (int bj = 0; bj < 2; ++bj) { x[mm][bj] = *(const u32x4*)(X + off + bj * 128); ew[mm][bj] = *(const u32x4*)(E + off + bj * 128); } }
#pragma unroll
                for (int mm = 0; mm < 2; ++mm) { const int m = 2 * mp + mm; const size_t off = (size_t)(row0 + ai * 128 + m * 16) * DM + col0;
                    float t = (sq[mm][0] + sq[mm][1]) + (sq[mm][2] + sq[mm][3]); t = sum_x16(t, lane); t = sum_x32(t, lane); const float r = 1.0f / sqrtf(t * (1.0f / DM) + RMS_EPS);
#pragma unroll
                    for (int bj = 0; bj < 2; ++bj) { const u32x4 xw = x[mm][bj], e = ew[mm][bj]; const f32x4 a0 = acc[ai][bj][m][0], a1 = acc[ai][bj][m][1];
                        const f32x4 g0 = *(const f32x4*)(g + col0 + bj * 128), g1 = *(const f32x4*)(g + col0 + bj * 128 + 4);
                        f32x4 o0, o1;
                        o0[0] = bflo(xw.x) + sigmoidf_(a0[0]) * (bflo(e.x) * r) * g0[0]; o0[1] = bfhi(xw.x) + sigmoidf_(a0[1]) * (bfhi(e.x) * r) * g0[1];
                        o0[2] = bflo(xw.y) + sigmoidf_(a0[2]) * (bflo(e.y) * r) * g0[2]; o0[3] = bfhi(xw.y) + sigmoidf_(a0[3]) * (bfhi(e.y) * r) * g0[3];
                        o1[0] = bflo(xw.z) + sigmoidf_(a1[0]) * (bflo(e.z) * r) * g1[0]; o1[1] = bfhi(xw.z) + sigmoidf_(a1[1]) * (bfhi(e.z) * r) * g1[1];
                        o1[2] = bflo(xw.w) + sigmoidf_(a1[2]) * (bflo(e.w) * r) * g1[2]; o1[3] = bfhi(xw.w) + sigmoidf_(a1[3]) * (bfhi(e.w) * r) * g1[3];
                        if (XO) *(u32x4*)(XO + off + bj * 128) = pack8(o0, o1);
                        if (OUTF) { *(f32x4*)(OUTF + off + bj * 128) = o0; *(f32x4*)(OUTF + off + bj * 128 + 4) = o1; } } }
            }
    }
};

struct MoeSched {
    const char* A; const char* W; int lda, K, npn; size_t wstride;
    const LAS int* rbs; const LAS int* cnt; int vlo, vhi, rb0, nunits, G, c; const int* slot_tk; bool gather; int gxl;
    __device__ __forceinline__ bool next(int i, Unit& u) const {
        const int nrb = nunits / npn;
        if ((G & 7) != 0) { const int r2 = (i / npn) * G + c; if (r2 >= nrb) return false; u.pn = i % npn; return finish(rb0 + r2, u); }
        const int chunk = (nrb + 7) >> 3, gx = gxl, x = c & 7, j = c >> 3;
        if (j >= gx) return false;
        int clen = nrb - x * chunk; clen = clen < 0 ? 0 : (clen > chunk ? chunk : clen);
        const int fr = clen / gx, ifull = fr * npn;
        int li, pn;
        if (i < ifull) { li = j + (i / npn) * gx; pn = i % npn; }
        else { const int q = (i - ifull) * gx + j; if (q >= (clen - fr * gx) * npn) return false;
               li = fr * gx + q / npn; pn = q % npn; }
        u.pn = pn; return finish(rb0 + x * chunk + li, u);
    }
    __device__ __forceinline__ bool finish(int rbg, Unit& u) const {
        int lo = vlo, hi = vhi;
        while (lo < hi) { const int mid = (lo + hi + 1) >> 1; if (rbs[mid] <= rbg) lo = mid; else hi = mid - 1; }
        u.v = lo; u.rb = rbg - rbs[lo]; u.pm = rbg; return true;
    }
    __device__ __forceinline__ const char* a_base(const Unit& u) const { return gather ? A : A + (size_t)u.pm * 256 * lda * 2; }
    __device__ __forceinline__ const char* b_base(const Unit& u) const { return W + (size_t)(u.v % 65) * wstride + (size_t)u.pn * 256 * K * 2; }
    __device__ __forceinline__ void a_off(const Unit& u, const int (&R)[2], const int (&C)[2], unsigned (&o)[2][2]) const {
        if (gather) {
            const int e = u.v % 65, half = u.v / 65, n = cnt[u.v];
#pragma unroll
            for (int h = 0; h < 2; ++h)
#pragma unroll
                for (int i = 0; i < 2; ++i) {
                    const int pos = u.rb * 256 + h * 128 + R[i]; int tok;
                    if (e == 64) tok = half * HALF_T + pos;
                    else tok = pos < n ? (slot_tk[(size_t)u.v * HALF_T + pos] >> 3) : 0;
                    o[h][i] = (unsigned)(tok * lda + C[i]) * 2u;
                    asm volatile("" : "+v"(o[h][i]));
                }
        } else {
#pragma unroll
            for (int h = 0; h < 2; ++h)
#pragma unroll
                for (int i = 0; i < 2; ++i) o[h][i] = (unsigned)((h * 128 + R[i]) * lda + C[i]) * 2u;
        }
    }
};

struct Args {
    const float* in[29]; float* out; unsigned char* ws; int ph_lo, ph_hi;
};
enum InIdx { I_X = 0, I_P, I_EV_WIN, I_EV_BGATE, I_CPK, I_CW1K, I_CW2K, I_CPV, I_CW1V, I_CW2V, I_EV_WO, I_OD_WIN, I_OD_BF, I_OD_WO,
             I_LN1G, I_LN1B, I_LN2G, I_LN2B, I_RW, I_RB, I_EW1, I_EW3, I_EW2, I_SW1, I_SW3, I_SW2, I_PWG, I_PWP, I_PNG };
__device__ __forceinline__ size_t wbuf_off(int layer) { int p = __builtin_amdgcn_readfirstlane(layer & 1); asm volatile("" : "+s"(p)); return (size_t)p * W_BUF; }
struct Frame {
    LAS unsigned char* lds; int tid, lane, wave, G, bid;
    unsigned char* ws; gu32* ctl;
};

__device__ __forceinline__ int rope_perm(int d) { return 2 * (d & 31) + (d >> 5); }
__device__ __forceinline__ int map_even(int c) {
    if (c < 512) return EC_QA + (c & ~63) + rope_perm(c & 63);
    if (c < 576) return EC_KA + rope_perm(c - 512);
    if (c < 640) return EC_VA + (c - 576);
    if (c < 1152) { const int r = c - 640; return EC_QI + (r & ~63) + rope_perm(r & 63); }
    if (c < 1216) return EC_KI + rope_perm(c - 1152);
    if (c < 1224) return EC_WI + (c - 1216);
    if (c < 1736) { const int r = c - 1224; return EC_QB + (r & ~63) + rope_perm(r & 63); }
    if (c < 2120) { const int r = c - 1736, j = r >> 6, d = r & 63;
        switch (j) { case 0: return EC_KC + d; case 1: return EC_VC + d; case 2: return EC_KS + rope_perm(d); case 3: return EC_VS + d; case 4: return EC_KW + rope_perm(d); default: return EC_VW + d; } }
    return EC_GB + (c - 2120);
}
enum MapId { MAP_ID = 0, MAP_EVEN, MAP_W1, MAP_W3, MAP_ROPE };
__device__ __forceinline__ int map_col(int id, int c) {
    switch (id) { case MAP_EVEN: return map_even(c); case MAP_W1: return 32 * (c >> 4) + (c & 15); case MAP_W3: return 32 * (c >> 4) + 16 + (c & 15); case MAP_ROPE: return rope_perm(c); default: return c; }
}
__device__ __forceinline__ void tr_load(f32x4 (&v)[16], const float* src, int ldn, int ncols, int k0, int n0, int lane) {
    const int cq = 4 * (lane & 15), rq = lane >> 4;
    const bool full = (n0 + 64 <= ncols);
#pragma unroll
    for (int i = 0; i < 16; ++i) {
        const float* p = src + (size_t)(k0 + 4 * i + rq) * ldn + n0 + cq;
        if (full) v[i] = *(const f32x4*)p;
        else { v[i][0] = (n0 + cq + 0 < ncols) ? p[0] : 0.f; v[i][1] = (n0 + cq + 1 < ncols) ? p[1] : 0.f; v[i][2] = (n0 + cq + 2 < ncols) ? p[2] : 0.f; v[i][3] = (n0 + cq + 3 < ncols) ? p[3] : 0.f; }
    }
}
__device__ __forceinline__ void tr_finish(const f32x4 (&v)[16], int ncols, bf16_t* dst, int dpitch, int k0, int n0, int mapid, LAS unsigned short* scr, int lane, const float* rscale, bool lo) {
    const int cq = 4 * (lane & 15), rq = lane >> 4;
    if (rscale == nullptr && !lo) {
#pragma unroll
        for (int i = 0; i < 16; ++i) {
#pragma unroll
            for (int j = 0; j < 4; ++j) scr[(cq + j) * 72 + 4 * i + rq] = (unsigned short)f2bf(v[i][j]); }
    } else {
#pragma unroll
        for (int i = 0; i < 16; ++i) {
            const int k = 4 * i + rq; const float rs = rscale ? rscale[k0 + k] : 1.f;
#pragma unroll
            for (int j = 0; j < 4; ++j) { float x = v[i][j] * rs; if (lo) x -= bf2f((unsigned short)f2bf(x));
                scr[(cq + j) * 72 + k] = (unsigned short)f2bf(x); }
        }
    }
    LDS_WAIT(); asm volatile("" ::: "memory");
    const int c = lane & 7;
#pragma unroll
    for (int j = 0; j < 8; ++j) { const int nl = (lane >> 3) + 8 * j, n = n0 + nl;
        const u32x4 o = *(const LAS u32x4*)(scr + nl * 72 + 8 * c);
        if (n < ncols) *(u32x4*)(dst + (size_t)map_col(mapid, n) * dpitch + k0 + 8 * c) = o; }
    LDS_WAIT(); asm volatile("" ::: "memory");
}
__device__ __forceinline__ void tr_item(const float* src, int ldn, int ncols, bf16_t* dst, int dpitch, int k0, int n0, int mapid, LAS unsigned short* scr, int lane, const float* rscale = nullptr, bool lo = false) {
    f32x4 v[16]; tr_load(v, src, ldn, ncols, k0, n0, lane); tr_finish(v, ncols, dst, dpitch, k0, n0, mapid, scr, lane, rscale, lo);
}
__device__ __forceinline__ void sincos_d(double a, float& s, float& c) {
    const double TWO_PI = 6.283185307179586476925286766559, INV = 0.15915494309189533576888376337251;
    const double k = rint(a * INV); double r = a - k * TWO_PI;
    const double r2 = r * r; double ts = 1.0, tc = 1.0;
#pragma unroll
    for (int i = 14; i >= 1; --i) { ts = 1.0 - ts * r2 / (double)((2 * i) * (2 * i + 1)); tc = 1.0 - tc * r2 / (double)((2 * i - 1) * (2 * i)); }
    s = (float)(r * ts); c = (float)tc;
}

struct TrJob { const float* src; bf16_t* dst; int K, N, ldn, dpitch, mapid; const float* rscale; int lo; };
__device__ __forceinline__ TrJob get_job(const Args& a, unsigned char* wsp, int layer, int jid) {
    const int j = layer >> 1; const bool even = (layer & 1) == 0;
    bf16_t* W = (bf16_t*)(wsp + WS_W + wbuf_off(layer));
    TrJob t; t.mapid = MAP_ID; t.rscale = nullptr; t.lo = 0;
    if (jid == 0) { if (even) { t.src = a.in[I_EV_WIN] + (size_t)j * DM * EVEN_COLS; t.N = EVEN_COLS; t.mapid = MAP_EVEN; } else { t.src = a.in[I_OD_WIN] + (size_t)j * DM * ODD_COLS; t.N = ODD_COLS; }
        t.K = DM; t.ldn = t.N; t.dst = W + W_IN / 2; t.dpitch = DM; return t; }
    if (jid == 1) { t.src = (even ? a.in[I_EV_WO] : a.in[I_OD_WO]) + (size_t)j * DM * DM; t.K = DM; t.N = DM; t.ldn = DM; t.dst = W + W_O / 2; t.dpitch = DM; return t; }
    if (jid == 2) { t.src = a.in[I_PWG] + (size_t)layer * DM * DM; t.K = DM; t.N = DM; t.ldn = DM; t.dst = W + W_G / 2; t.dpitch = DM; return t; }
    if (jid == 3) { t.src = a.in[I_PWP] + (size_t)layer * 256 * DM; t.K = 256; t.N = DM; t.ldn = DM; t.dst = W + W_P / 2; t.dpitch = 256; return t; }
    if (jid < 8) {
        const int q = jid - 4;
        if (q == 0) { t.src = a.in[I_CW1K] + (size_t)j * 2048 * 64; t.K = 2048; t.dst = W + W_C1K / 2; t.dpitch = 2048; }
        else if (q == 1) { t.src = a.in[I_CW1V] + (size_t)j * 2048 * 64; t.K = 2048; t.dst = W + W_C1V / 2; t.dpitch = 2048; }
        else if (q == 2) { t.src = a.in[I_CW2K] + (size_t)j * 64 * 64; t.K = 64; t.dst = W + W_C2K / 2; t.dpitch = 64; t.mapid = MAP_ROPE; }
        else { t.src = a.in[I_CW2V] + (size_t)j * 64 * 64; t.K = 64; t.dst = W + W_C2V / 2; t.dpitch = 64; }
        t.N = 64; t.ldn = 64; return t; }
    if (jid < 10) {
        t.src = a.in[I_RW] + (size_t)layer * DM * NEXP; t.K = DM; t.N = NEXP; t.ldn = NEXP; t.dpitch = DM; t.rscale = a.in[I_LN1G] + layer * DM; t.lo = jid - 8; t.dst = W + (t.lo ? W_RL : W_RH) / 2; return t; }
    const int r = jid - 10, e = r / 3, w = r % 3;
    if (w < 2) { const float* s = (e == 64) ? a.in[w == 0 ? I_SW1 : I_SW3] + (size_t)layer * DM * DFF : a.in[w == 0 ? I_EW1 : I_EW3] + ((size_t)layer * NEXP + e) * DM * DFF;
        t.src = s; t.K = DM; t.N = DFF; t.ldn = DFF; t.dst = W + W_UP / 2 + (size_t)e * 512 * DM; t.dpitch = DM; t.mapid = (w == 0) ? MAP_W1 : MAP_W3; return t; }
    t.src = (e == 64) ? a.in[I_SW2] + (size_t)layer * DFF * DM : a.in[I_EW2] + ((size_t)layer * NEXP + e) * DFF * DM;
    t.K = DFF; t.N = DM; t.ldn = DM; t.dst = W + W_DN / 2 + (size_t)e * DM * DFF; t.dpitch = DFF; return t;
}
constexpr int NJOBS = 10 + 65 * 3;

__device__ __forceinline__ void prep_weights(const Frame& F, const Args& a, int layer, int wid, int nw) {
    const int gw = wid * 8 + F.wave, NGW = nw * 8, gt = wid * 512 + F.tid, NGT = nw * 512;
    LAS unsigned short* scr = (LAS unsigned short*)(F.lds + F.wave * 16384);
    int base = 0;
    for (int jid = 0; jid < 10; ++jid) {
        const TrJob jb = get_job(a, F.ws, layer, jid);
        const int nblk = (jb.N + 63) / 64, nit = (jb.K / 64) * nblk;
        int first = (gw - (base % NGW) + NGW) % NGW;
        for (int it = first; it < nit; it += 2 * NGW) {
            const int it2 = it + NGW; const bool two = it2 < nit;
            f32x4 va[16], vb[16];
            tr_load(va, jb.src, jb.ldn, jb.N, 64 * (it / nblk), 64 * (it % nblk), F.lane);
            if (two) tr_load(vb, jb.src, jb.ldn, jb.N, 64 * (it2 / nblk), 64 * (it2 % nblk), F.lane);
            tr_finish(va, jb.N, jb.dst, jb.dpitch, 64 * (it / nblk), 64 * (it % nblk), jb.mapid, scr, F.lane, jb.rscale, jb.lo != 0);
            if (two) tr_finish(vb, jb.N, jb.dst, jb.dpitch, 64 * (it2 / nblk), 64 * (it2 % nblk), jb.mapid, scr, F.lane, jb.rscale, jb.lo != 0);
        }
        base += nit;
    }
    {
        constexpr int NI = 65 * 3 * 64;
        int g = (gw - (base % NGW) + NGW) % NGW;
        f32x4 va[16], vb[16]; TrJob ja, jn;
#define EXP_LOAD(V, J, G) do { J = get_job(a, F.ws, layer, 10 + ((G) >> 6)); const int it_ = (G) & 63, sh_ = (J.N == 256) ? 2 : 4; tr_load(V, J.src, J.ldn, J.N, 64 * (it_ >> sh_), 64 * (it_ & ((1 << sh_) - 1)), F.lane); } while (0)
#define EXP_FIN(V, J, G) do { const int it_ = (G) & 63, sh_ = (J.N == 256) ? 2 : 4; tr_finish(V, J.N, J.dst, J.dpitch, 64 * (it_ >> sh_), 64 * (it_ & ((1 << sh_) - 1)), J.mapid, scr, F.lane, nullptr, false); } while (0)
        if (g < NI) EXP_LOAD(va, ja, g);
        while (g < NI) {
            const int g1 = g + NGW, g2 = g + 2 * NGW;
            if (g1 < NI) EXP_LOAD(vb, jn, g1);
            EXP_FIN(va, ja, g);
            if (g1 >= NI) break;
            if (g2 < NI) EXP_LOAD(va, ja, g2);
            EXP_FIN(vb, jn, g1);
            g = g2;
        }
#undef EXP_LOAD
#undef EXP_FIN
    }
    { const int r0 = (layer & 1) ? ODD_COLS : EVEN_COLS, r1 = (layer & 1) ? NO_PAD : NE_PAD; u32x4* z = (u32x4*)(F.ws + WS_W + wbuf_off(layer) + W_IN + (size_t)r0 * DM * 2);
      const int n16 = (r1 - r0) * DM * 2 / 16; unsigned zq = 0u; asm volatile("" : "+v"(zq)); for (int i = gt; i < n16; i += NGT) z[i] = (u32x4){zq, zq, zq, zq}; }
    if ((layer & 1) == 0 && wid < 2) {
        const int j = layer >> 1; const float* pe = a.in[wid == 0 ? I_CPK : I_CPV] + (size_t)j * 2048; const float* w1 = a.in[wid == 0 ? I_CW1K : I_CW1V] + (size_t)j * 2048 * 64;
        LAS float* red = (LAS float*)(F.lds + 8 * 16384);
        __syncthreads();
        const int n = F.tid & 63, part = F.tid >> 6; float s = 0.f;
        for (int k0 = part * 256; k0 < part * 256 + 256; k0 += 32) {
            float wv[32], pv[32];
#pragma unroll
            for (int q = 0; q < 32; ++q) { wv[q] = w1[(size_t)(k0 + q) * 64 + n]; pv[q] = pe[k0 + q]; }
#pragma unroll
            for (int q = 0; q < 32; ++q) s += pv[q] * wv[q]; }
        red[part * 64 + n] = s; __syncthreads();
        if (F.tid < 64) { float tot = 0.f; for (int q = 0; q < 8; ++q) tot += red[q * 64 + F.tid]; ((float*)(F.ws + WS_MISC))[wid * 64 + F.tid] = tot; }
        __syncthreads();
    }
}
__device__ __forceinline__ void prep_acts(const Frame& F, const Args& a, int layer, bool first) {
    const int gt = F.bid * 512 + F.tid, NGT = F.G * 512;
    { const f32x4* p = (const f32x4*)(a.in[I_P] + (size_t)layer * T * 256); u32x2* o = (u32x2*)(F.ws + WS_PB);
      for (int i = gt; i < T * 256 / 4; i += NGT) { const f32x4 v = p[i]; u32x2 w; w.x = pk2(v[0], v[1]); w.y = pk2(v[2], v[3]); o[i] = w; } }
    if (first) {
        const f32x4* x = (const f32x4*)a.in[I_X]; u32x2* o = (u32x2*)(F.ws + WS_XB);
        for (int i = gt; i < T * DM / 4; i += NGT) { const f32x4 v = x[i]; u32x2 w; w.x = pk2(v[0], v[1]); w.y = pk2(v[2], v[3]); o[i] = w; }
        float* ct = (float*)(F.ws + WS_ROPE_COS); float* st = (float*)(F.ws + WS_ROPE_SIN);
        for (int i = gt; i < SEQ * 32; i += NGT) { const int pos = i >> 5, j = i & 31; double inv = 1.0;
            for (int q = 0; q < j; ++q) inv *= 0.74989420933245582730;
            const float ang = (float)pos * (float)inv; float s, c; sincos_d((double)ang, s, c); ct[i] = c; st[i] = s; }
    }
    if (F.bid == F.G - 1) {
        const float* RW = a.in[I_RW] + (size_t)layer * DM * NEXP; const float* g1 = a.in[I_LN1G] + layer * DM; const float* b1 = a.in[I_LN1B] + layer * DM;
        LAS float* red = (LAS float*)(F.lds + 8 * 16384);
        __syncthreads();
        const int n = F.tid & 63, part = F.tid >> 6; float sc = 0.f, sb = 0.f;
        for (int k0 = part * 128; k0 < part * 128 + 128; k0 += 32) {
            float wv[32];
#pragma unroll
            for (int q = 0; q < 32; ++q) wv[q] = RW[(size_t)(k0 + q) * NEXP + n];
#pragma unroll
            for (int q = 0; q < 32; ++q) { sc += g1[k0 + q] * wv[q]; sb += b1[k0 + q] * wv[q]; } }
        red[part * 64 + n] = sc; red[512 + part * 64 + n] = sb; __syncthreads();
        if (F.tid < 128) { const int o = F.tid & 63, w = F.tid >> 6; float tot = 0.f; for (int q = 0; q < 8; ++q) tot += red[w * 512 + q * 64 + o]; ((float*)(F.ws + WS_MISC))[256 + F.tid] = tot; }
        __syncthreads();
    }
}

__device__ __forceinline__ void scan_phase(const Frame& F, const Args& a) {
    const float* lf = (const float*)(F.ws + WS_LOGF); float* dc = (float*)(F.ws + WS_DCUM);
    LAS float* wsum = (LAS float*)F.lds;
    for (int s = F.bid; s < NB * 16; s += F.G) {
        const int b = s >> 4, h = s & 15; const size_t base = ((size_t)b * SEQ) * 16 + h;
        float v[4]; float run = 0.f;
#pragma unroll
        for (int i = 0; i < 4; ++i) { run += lf[base + (size_t)(F.tid * 4 + i) * 16]; v[i] = run; }
        float inc = run;
        inc += dpp_mov<0x111>(inc); inc += dpp_mov<0x112>(inc); inc += dpp_mov<0x114>(inc); inc += dpp_mov<0x118>(inc);
        { const float r0 = __builtin_bit_cast(float, __builtin_amdgcn_readlane(__builtin_bit_cast(int, inc), 15)), r1 = __builtin_bit_cast(float, __builtin_amdgcn_readlane(__builtin_bit_cast(int, inc), 31)),
                      r2 = __builtin_bit_cast(float, __builtin_amdgcn_readlane(__builtin_bit_cast(int, inc), 47));
          const int rw = F.lane >> 4; inc += (rw == 1) ? r0 : (rw == 2) ? (r0 + r1) : (rw == 3) ? ((r0 + r1) + r2) : 0.f; }
        if (F.lane == 63) wsum[F.wave] = inc;
        __syncthreads();
        float off = inc - run;
        for (int w = 0; w < F.wave; ++w) off += wsum[w];
#pragma unroll
        for (int i = 0; i < 4; ++i) dc[base + (size_t)(F.tid * 4 + i) * 16] = (v[i] + off) * LOG2E;
        __syncthreads();
    }
}

__device__ __forceinline__ void ln_row16(float (&v)[16], const float* g, const float* b, int lane) {
    float s = 0.f;
#pragma unroll
    for (int i = 0; i < 16; ++i) s += v[i];
    const float mean = wave_sum(s) * (1.f / DM); float s2 = 0.f;
#pragma unroll
    for (int i = 0; i < 16; ++i) { v[i] -= mean; s2 += v[i] * v[i]; }
    const float rstd = 1.0f / sqrtf(wave_sum(s2) * (1.f / DM) + LN_EPS);
#pragma unroll
    for (int q = 0; q < 4; ++q) { const f32x4 gg = *(const f32x4*)(g + lane * 16 + 4 * q), bb = *(const f32x4*)(b + lane * 16 + 4 * q);
#pragma unroll
        for (int i = 0; i < 4; ++i) v[4 * q + i] = v[4 * q + i] * rstd * gg[i] + bb[i]; }
}
__device__ __forceinline__ void ln_stats16(const float (&v)[16], float& mean, float& rstd) {
    float s = 0.f;
#pragma unroll
    for (int i = 0; i < 16; ++i) s += v[i];
    mean = wave_sum(s) * (1.f / DM); float s2 = 0.f;
#pragma unroll
    for (int i = 0; i < 16; ++i) { const float d = v[i] - mean; s2 += d * d; }
    rstd = 1.0f / sqrtf(wave_sum(s2) * (1.f / DM) + LN_EPS);
}
__device__ __forceinline__ void ln_apply16(float (&v)[16], float mean, float rstd, const float* g, const float* b, int lane) {
#pragma unroll
    for (int q = 0; q < 4; ++q) { const f32x4 gg = *(const f32x4*)(g + lane * 16 + 4 * q), bb = *(const f32x4*)(b + lane * 16 + 4 * q);
#pragma unroll
        for (int i = 0; i < 4; ++i) v[4 * q + i] = (v[4 * q + i] - mean) * rstd * gg[i] + bb[i]; }
}
__device__ __forceinline__ void store_row16_bf(const float (&v)[16], bf16_t* xb, int lane) {
    u32x4 w0, w1; w0.x = pk2(v[0], v[1]); w0.y = pk2(v[2], v[3]); w0.z = pk2(v[4], v[5]); w0.w = pk2(v[6], v[7]);
    w1.x = pk2(v[8], v[9]); w1.y = pk2(v[10], v[11]); w1.z = pk2(v[12], v[13]); w1.w = pk2(v[14], v[15]);
    *(u32x4*)(xb + lane * 16) = w0; *(u32x4*)(xb + lane * 16 + 8) = w1;
}
__device__ __forceinline__ void store_row16(const float (&v)[16], float* xf, bf16_t* xb, int lane) {
#pragma unroll
    for (int q = 0; q < 4; ++q) *(f32x4*)(xf + lane * 16 + 4 * q) = (f32x4){v[4 * q], v[4 * q + 1], v[4 * q + 2], v[4 * q + 3]};
    u32x4 w0, w1; w0.x = pk2(v[0], v[1]); w0.y = pk2(v[2], v[3]); w0.z = pk2(v[4], v[5]); w0.w = pk2(v[6], v[7]);
    w1.x = pk2(v[8], v[9]); w1.y = pk2(v[10], v[11]); w1.z = pk2(v[12], v[13]); w1.w = pk2(v[14], v[15]);
    *(u32x4*)(xb + lane * 16) = w0; *(u32x4*)(xb + lane * 16 + 8) = w1;
}

#ifndef ROUTE_EXPT
#define ROUTE_EXPT 0
#endif
__device__ __forceinline__ void unpack16(const u32x4 w0, const u32x4 w1, float (&v)[16]) {
    v[0] = bflo(w0.x); v[1] = bfhi(w0.x); v[2] = bflo(w0.y); v[3] = bfhi(w0.y); v[4] = bflo(w0.z); v[5] = bfhi(w0.z); v[6] = bflo(w0.w); v[7] = bfhi(w0.w);
    v[8] = bflo(w1.x); v[9] = bfhi(w1.x); v[10] = bflo(w1.y); v[11] = bfhi(w1.y); v[12] = bflo(w1.z); v[13] = bfhi(w1.z); v[14] = bflo(w1.w); v[15] = bfhi(w1.w);
}
__device__ __forceinline__ void route_phase(const Frame& F, const Args& a, int layer, const bf16_t* X, bf16_t* XB, bool dummy) {
    const float* g = a.in[I_LN1G] + layer * DM; const float* bta = a.in[I_LN1B] + layer * DM;
    const float* RW = a.in[I_RW] + (size_t)layer * DM * NEXP; const float* RBs = a.in[I_RB] + layer * NEXP;
    int* slot_tk = (int*)(F.ws + WS_SLOT_TK); float* slot_g = (float*)(F.ws + WS_SLOT_G);
    gu32* cntg = F.ctl + CW_CNT + layer * 256;
    LAS float* lg = (LAS float*)(F.lds + F.wave * 8192);
    LAS unsigned* rec_e = (LAS unsigned*)(F.lds + 65536);
    LAS float* rec_g = (LAS float*)(F.lds + 65536 + 8192);
    LAS unsigned* lcnt = (LAS unsigned*)(F.lds + 65536 + 16384);
    LAS unsigned* gbase = lcnt + 64;
    const int lane = F.lane;
    for (int ub = F.bid; ub < T / 256; ub += F.G) {
        if (F.tid < 64) lcnt[F.tid] = 0u;
        __syncthreads();
        const int r0 = ub * 256 + F.wave * 32;
        LAS float* stl = (LAS float*)(F.lds + 65536 + 16384 + 512) + F.wave * 64;
        for (int r4 = 0; r4 < 32; r4 += 8) {
            u32x4 v4[8][2];
#pragma unroll
            for (int j = 0; j < 8; ++j) { const bf16_t* xr = X + (size_t)(r0 + r4 + j) * DM + lane * 16; v4[j][0] = *(const u32x4*)xr; v4[j][1] = *(const u32x4*)(xr + 8); }
#pragma unroll
            for (int j = 0; j < 8; ++j) { float v[16]; unpack16(v4[j][0], v4[j][1], v);
                float mean, rstd; ln_stats16(v, mean, rstd);
                if (lane == 0) { stl[2 * (r4 + j)] = mean; stl[2 * (r4 + j) + 1] = rstd; }
                ln_apply16(v, mean, rstd, g, bta, lane); store_row16_bf(v, XB + (size_t)(r0 + r4 + j) * DM, lane); }
        }
        LDS_WAIT(); asm volatile("" ::: "memory");
        f32x16 c0 = {}, c1 = {};
        { const bf16_t* ar = X + (size_t)(r0 + (lane & 31)) * DM + (lane >> 5) * 8;
          const bf16_t* Wh = (const bf16_t*)(F.ws + WS_W + wbuf_off(layer) + W_RH); const bf16_t* Wl = (const bf16_t*)(F.ws + WS_W + wbuf_off(layer) + W_RL);
          const int se = F.tid >> 3, sg8 = (F.tid & 7) * 16;
          u32x4 bh[2], bl[2];
          bh[0] = *(const u32x4*)(Wh + (size_t)se * DM + sg8); bh[1] = *(const u32x4*)(Wh + (size_t)se * DM + sg8 + 8); bl[0] = *(const u32x4*)(Wl + (size_t)se * DM + sg8); bl[1] = *(const u32x4*)(Wl + (size_t)se * DM + sg8 + 8);
          for (int c = 0; c < ((ROUTE_EXPT == 1 && dummy) ? 0 : 8); ++c) {
              LAS unsigned char* Bs = F.lds + (c & 1) * 34816;
              *(LAS u32x4*)(Bs + se * 272 + sg8 * 2) = bh[0]; *(LAS u32x4*)(Bs + se * 272 + sg8 * 2 + 16) = bh[1];
              *(LAS u32x4*)(Bs + 17408 + se * 272 + sg8 * 2) = bl[0]; *(LAS u32x4*)(Bs + 17408 + se * 272 + sg8 * 2 + 16) = bl[1];
              bf16x8 af[8];
#pragma unroll
              for (int st = 0; st < 8; ++st) af[st] = *(const bf16x8*)(ar + c * 128 + st * 16);
              __syncthreads();
              if (c + 1 < 8) { const size_t o = (size_t)se * DM + (c + 1) * 128 + sg8;
                  bh[0] = *(const u32x4*)(Wh + o); bh[1] = *(const u32x4*)(Wh + o + 8); bl[0] = *(const u32x4*)(Wl + o); bl[1] = *(const u32x4*)(Wl + o + 8); }
              const LAS unsigned char* bp = Bs + (lane & 31) * 272 + (lane >> 5) * 16;
#pragma unroll
              for (int st = 0; st < 8; ++st) {
                  const bf16x8 h0 = *(const LAS bf16x8*)(bp + st * 32), h1 = *(const LAS bf16x8*)(bp + 32 * 272 + st * 32);
                  const bf16x8 l0 = *(const LAS bf16x8*)(bp + 17408 + st * 32), l1 = *(const LAS bf16x8*)(bp + 17408 + 32 * 272 + st * 32);
                  c0 = __builtin_amdgcn_mfma_f32_32x32x16_bf16(af[st], h0, c0, 0, 0, 0); c1 = __builtin_amdgcn_mfma_f32_32x32x16_bf16(af[st], h1, c1, 0, 0, 0);
                  c0 = __builtin_amdgcn_mfma_f32_32x32x16_bf16(af[st], l0, c0, 0, 0, 0); c1 = __builtin_amdgcn_mfma_f32_32x32x16_bf16(af[st], l1, c1, 0, 0, 0);
              }
          }
        }
        __syncthreads();
#pragma unroll
        for (int rr = 0; rr < 16; ++rr) { const int row = (rr & 3) + 8 * (rr >> 2) + 4 * (lane >> 5); lg[row * 64 + (lane & 31)] = c0[rr]; lg[row * 64 + 32 + (lane & 31)] = c1[rr]; }
        LDS_WAIT(); asm volatile("" ::: "memory");
        const float rcs = ((const float*)(F.ws + WS_MISC))[256 + lane], rb1 = ((const float*)(F.ws + WS_MISC))[256 + 64 + lane];
        const float rbias = RBs[lane];
        for (int r = 0; r < ((ROUTE_EXPT == 2 && dummy) ? 0 : 32); ++r) {
            const float sg = sigmoidf_(stl[2 * r + 1] * (lg[r * 64 + lane] - stl[2 * r] * rcs) + rb1); const float sb = sg + rbias;
            float m1 = sb;
            m1 = fmaxf(m1, dpp_mov<DPP_X1>(m1)); m1 = fmaxf(m1, dpp_mov<DPP_X2>(m1)); m1 = fmaxf(m1, dpp_mov<DPP_HM>(m1));
            const unsigned long long eqm = __ballot(sb == m1); const int gsh = lane & ~7;
            const unsigned gm = (unsigned)(eqm >> gsh) & 0xffu; const int first = __builtin_ctz(gm);
            float m2 = ((lane & 7) == first) ? NEGBIG : sb;
            m2 = fmaxf(m2, dpp_mov<DPP_X1>(m2)); m2 = fmaxf(m2, dpp_mov<DPP_X2>(m2)); m2 = fmaxf(m2, dpp_mov<DPP_HM>(m2));
            const float gs = m1 + m2;
            int grank = 0;
#pragma unroll
            for (int q = 0; q < 8; ++q) { const float o = __builtin_bit_cast(float, __builtin_amdgcn_readlane(__builtin_bit_cast(int, gs), q * 8)); grank += (o > gs || (o == gs && q < (lane >> 3))) ? 1 : 0; }
            const float sm = (grank < 4) ? sb : NEGBIG;
            int rank = 0;
#pragma unroll
            for (int q = 0; q < 64; ++q) { const float o = __builtin_bit_cast(float, __builtin_amdgcn_readlane(__builtin_bit_cast(int, sm), q)); rank += (o > sm) ? 1 : 0; }
            bool tie = false;
#pragma unroll
            for (int k = 0; k < 8; ++k) tie |= (__popcll(__ballot(rank == k)) != 1);
            if (tie) { rank = 0;
#pragma unroll 1
                for (int q = 0; q < 64; ++q) { const float o = __builtin_bit_cast(float, __builtin_amdgcn_readlane(__builtin_bit_cast(int, sm), q)); rank += (o > sm || (o == sm && q < lane)) ? 1 : 0; } }
            const bool sel = rank < 8;
            const float ssum = wave_sum(sel ? sg : 0.f);
            if (sel) { const unsigned lp = __hip_atomic_fetch_add(&lcnt[lane], 1u, __ATOMIC_RELAXED, __HIP_MEMORY_SCOPE_WORKGROUP); const int row = F.wave * 32 + r; rec_e[row * 8 + rank] = (unsigned)lane | (lp << 8); rec_g[row * 8 + rank] = sg / ssum * 2.5f; }
        }
        __syncthreads();
        const int half = (ub * 256) / HALF_T;
        if (F.tid < 64) gbase[F.tid] = dummy ? 0u : __hip_atomic_fetch_add(cntg + half * 65 + F.tid, lcnt[F.tid], RLX_AGENT);
        __syncthreads();
        for (int i = F.tid; i < 2048; i += 512) { const unsigned re = rec_e[i]; const int e = re & 255, lp = re >> 8, v = half * 65 + e; const int pos = gbase[e] + lp;
            const int t = ub * 256 + (i >> 3);
            if (!dummy) { slot_tk[(size_t)v * HALF_T + pos] = t * 8 + (i & 7); slot_g[(size_t)v * HALF_T + pos] = rec_g[i]; } }
        __syncthreads();
    }
}

__device__ __forceinline__ void combine_phase(const Frame& F, const Args& a, int layer, int half, const bf16_t* X1, bf16_t* X2, bool dummy) {
    const bf16_t* Y = (const bf16_t*)(F.ws + WS_R + R_YTOK);
    const float* g = a.in[I_LN2G] + layer * DM; const float* bta = a.in[I_LN2B] + layer * DM;
    const int lane = F.lane;
    for (int tl = F.bid * 8 + F.wave; tl < HALF_T; tl += F.G * 8) {
        const int t = half * HALF_T + tl; float v[16];
        { const bf16_t* xr = X1 + (size_t)t * DM + lane * 16; unpack16(*(const u32x4*)xr, *(const u32x4*)(xr + 8), v); }
#pragma unroll
        for (int i = 0; i < 16; ++i) v[i] *= ALPHA;
        float m[16];
#pragma unroll
        for (int i = 0; i < 16; ++i) m[i] = 0.f;
#pragma unroll
#if Y_FP8
        for (int k = 0; k < 9; ++k) { const u32x4 w = *(const u32x4*)((const unsigned char*)Y + ((size_t)t * 9 + k) * DM + lane * 16);
            m[0] += __builtin_amdgcn_cvt_f32_fp8(w.x, 0); m[1] += __builtin_amdgcn_cvt_f32_fp8(w.x, 1); m[2] += __builtin_amdgcn_cvt_f32_fp8(w.x, 2); m[3] += __builtin_amdgcn_cvt_f32_fp8(w.x, 3);
            m[4] += __builtin_amdgcn_cvt_f32_fp8(w.y, 0); m[5] += __builtin_amdgcn_cvt_f32_fp8(w.y, 1); m[6] += __builtin_amdgcn_cvt_f32_fp8(w.y, 2); m[7] += __builtin_amdgcn_cvt_f32_fp8(w.y, 3);
            m[8] += __builtin_amdgcn_cvt_f32_fp8(w.z, 0); m[9] += __builtin_amdgcn_cvt_f32_fp8(w.z, 1); m[10] += __builtin_amdgcn_cvt_f32_fp8(w.z, 2); m[11] += __builtin_amdgcn_cvt_f32_fp8(w.z, 3);
            m[12] += __builtin_amdgcn_cvt_f32_fp8(w.w, 0); m[13] += __builtin_amdgcn_cvt_f32_fp8(w.w, 1); m[14] += __builtin_amdgcn_cvt_f32_fp8(w.w, 2); m[15] += __builtin_amdgcn_cvt_f32_fp8(w.w, 3); }
#pragma unroll
        for (int i = 0; i < 16; ++i) m[i] *= (1.0f / 32.0f);
#else
        for (int k = 0; k < 9; ++k) { const bf16_t* yr = Y + ((size_t)tl * 9 + k) * DM + lane * 16; float yv[16]; unpack16(*(const u32x4*)yr, *(const u32x4*)(yr + 8), yv);
#pragma unroll
            for (int i = 0; i < 16; ++i) m[i] += yv[i]; }
#endif
#pragma unroll
        for (int i = 0; i < 16; ++i) v[i] += m[i];
        ln_row16(v, g, bta, lane);
        if (!dummy) store_row16_bf(v, X2 + (size_t)t * DM, lane);
    }
}

constexpr int KP = 144, VP = 192;
constexpr int KT_BYTES = 64 * KP, VT_BYTES = 64 * VP, KV_BUF = KT_BYTES + VT_BYTES;
__device__ __forceinline__ int crow(int r, int hi) { return (r & 3) + 8 * (r >> 2) + 4 * hi; }
__device__ __forceinline__ s16x4 vtr(const LAS unsigned char* p) { return __builtin_bit_cast(s16x4, __builtin_amdgcn_ds_read_tr16_b64_v4i16((LAS s16x4*)p)); }

struct KVRegs { u32x4 k, v; };
__device__ __forceinline__ void kv_load(KVRegs& r, const bf16_t* Kp, const bf16_t* Vp, size_t pitch, int row0, int tid) {
    const size_t off = (size_t)(row0 + (tid >> 3)) * pitch + (tid & 7) * 8;
    r.k = *(const u32x4*)(Kp + off); r.v = *(const u32x4*)(Vp + off);
}
__device__ __forceinline__ void kv_store(const KVRegs& r, LAS unsigned char* buf, int tid) {
    *(LAS u32x4*)(buf + (tid >> 3) * KP + (tid & 7) * 16) = r.k;
    *(LAS u32x4*)(buf + KT_BYTES + (tid >> 3) * VP + (tid & 7) * 16) = r.v;
}
__device__ __forceinline__ void qk_tile(f32x16& p0, f32x16& p1, const LAS unsigned char* kt, const bf16x8 (&qf)[4], int lane) {
    const LAS unsigned char* kb = kt + (lane & 31) * KP + (lane >> 5) * 16;
    p0 = (f32x16){}; p1 = (f32x16){};
#pragma unroll
    for (int ks = 0; ks < 4; ++ks) {
        const bf16x8 k0 = *(const LAS bf16x8*)(kb + ks * 32), k1 = *(const LAS bf16x8*)(kb + 32 * KP + ks * 32);
        p0 = __builtin_amdgcn_mfma_f32_32x32x16_bf16(k0, qf[ks], p0, 0, 0, 0);
        p1 = __builtin_amdgcn_mfma_f32_32x32x16_bf16(k1, qf[ks], p1, 0, 0, 0);
    }
}
__device__ __forceinline__ bf16x8 pfrag(const f32x16& p, int s) {
    u32x4 w; w.x = pg8::cvt_pk_bf16(p[8 * s], p[8 * s + 1]); w.y = pg8::cvt_pk_bf16(p[8 * s + 2], p[8 * s + 3]); w.z = pg8::cvt_pk_bf16(p[8 * s + 4], p[8 * s + 5]); w.w = pg8::cvt_pk_bf16(p[8 * s + 6], p[8 * s + 7]);
    return __builtin_bit_cast(bf16x8, w);
}
__device__ __forceinline__ void pv_sub(f32x16& o0, f32x16& o1, const LAS unsigned char* vt, int sub, const f32x16& p, int lane) {
    const LAS unsigned char* vb = vt + (sub * 32 + (lane >> 5) * 4 + ((lane & 15) >> 2)) * VP + (16 * ((lane >> 4) & 1) + 4 * (lane & 3)) * 2;
#pragma unroll
    for (int s = 0; s < 2; ++s) {
        const bf16x8 pb = pfrag(p, s);
        const s16x4 a0 = vtr(vb + (16 * s) * VP), a1 = vtr(vb + (16 * s + 8) * VP), b0 = vtr(vb + (16 * s) * VP + 64), b1 = vtr(vb + (16 * s + 8) * VP + 64);
        const bf16x8 va = {a0[0], a0[1], a0[2], a0[3], a1[0], a1[1], a1[2], a1[3]}, vbb = {b0[0], b0[1], b0[2], b0[3], b1[0], b1[1], b1[2], b1[3]};
        o0 = __builtin_amdgcn_mfma_f32_32x32x16_bf16(va, pb, o0, 0, 0, 0);
        o1 = __builtin_amdgcn_mfma_f32_32x32x16_bf16(vbb, pb, o1, 0, 0, 0);
    }
}
__device__ __forceinline__ float max3f(float a, float b, float c) { float r; asm("v_max3_f32 %0, %1, %2, %3" : "=v"(r) : "v"(a), "v"(b), "v"(c)); return r; }
template <bool SCALED, int EXPT = 0>
__device__ __forceinline__ void softmax_pv(f32x16& p0, f32x16& p1, f32x16& o0, f32x16& o1, float& m, float& l, const LAS unsigned char* vt, int lane, bool v0 = true, bool v1 = true) {
    if (EXPT == 1) { l += p0[0]; pv_sub(o0, o1, vt, 0, p0, lane); pv_sub(o0, o1, vt, 1, p1, lane); return; }
    asm volatile("s_nop 15" : "+v"(p0), "+v"(p1));
    float mx;
    { float a = max3f(p0[0], p0[1], p0[2]), b = max3f(p1[0], p1[1], p1[2]);
      a = max3f(a, p0[3], p0[4]); b = max3f(b, p1[3], p1[4]); a = max3f(a, p0[5], p0[6]); b = max3f(b, p1[5], p1[6]);
      a = max3f(a, p0[7], p0[8]); b = max3f(b, p1[7], p1[8]); a = max3f(a, p0[9], p0[10]); b = max3f(b, p1[9], p1[10]);
      a = max3f(a, p0[11], p0[12]); b = max3f(b, p1[11], p1[12]); a = max3f(a, p0[13], p0[14]); b = max3f(b, p1[13], p1[14]);
      a = fmaxf(a, p0[15]); b = fmaxf(b, p1[15]); mx = fmaxf(v0 ? a : NEGBIG, v1 ? b : NEGBIG); }
    mx = max_x32(mx, lane);
    if (!SCALED) mx *= QK_C;
    const float mn = (mx - m > 8.0f) ? mx : m, alpha = fast_exp2(m - mn);
    const float mn0 = v0 ? mn : 1e30f, mn1 = v1 ? mn : 1e30f;
    f32x2 ls2 = {0.f, 0.f};
#pragma unroll
    for (int r = 0; r < 16; r += 2) {
        f32x2 a = {p0[r], p0[r + 1]}, b = {p1[r], p1[r + 1]};
        if (SCALED) { a = a - mn0; b = b - mn1; } else { a = a * QK_C - mn0; b = b * QK_C - mn1; }
        a[0] = fast_exp2(a[0]); a[1] = fast_exp2(a[1]); b[0] = fast_exp2(b[0]); b[1] = fast_exp2(b[1]);
        p0[r] = a[0]; p0[r + 1] = a[1]; p1[r] = b[0]; p1[r + 1] = b[1];
        ls2 += a; ls2 += b; }
    float ls = ls2[0] + ls2[1];
    ls = sum_x32(ls, lane);
    l = l * alpha + ls; m = mn;
    if (!__all(alpha == 1.0f)) { o0 *= alpha; o1 *= alpha; }
    pv_sub(o0, o1, vt, 0, p0, lane); pv_sub(o0, o1, vt, 1, p1, lane);
}
__device__ __forceinline__ void load_qf(bf16x8 (&qf)[4], const bf16_t* qrow, int lane) {
#pragma unroll
    for (int ks = 0; ks < 4; ++ks) qf[ks] = *(const bf16x8*)(qrow + 16 * ks + 8 * (lane >> 5));
}
__device__ __forceinline__ void store_ot(const f32x16& o0, const f32x16& o1, float sc, bf16_t* orow, int lane) {
    const int hi = lane >> 5;
#pragma unroll
    for (int g = 0; g < 4; ++g) {
        u32x2 w; w.x = pg8::cvt_pk_bf16(o0[4 * g] * sc, o0[4 * g + 1] * sc); w.y = pg8::cvt_pk_bf16(o0[4 * g + 2] * sc, o0[4 * g + 3] * sc); *(u32x2*)(orow + 8 * g + 4 * hi) = w;
        u32x2 x; x.x = pg8::cvt_pk_bf16(o1[4 * g] * sc, o1[4 * g + 1] * sc); x.y = pg8::cvt_pk_bf16(o1[4 * g + 2] * sc, o1[4 * g + 3] * sc); *(u32x2*)(orow + 32 + 8 * g + 4 * hi) = x;
    }
}

template <int EXPT = 0>
__device__ __forceinline__ void fox_phase(const Frame& F, const Args& a, bf16_t* O, int opitch) {
    bf16_t* H = (bf16_t*)(F.ws + WS_R + R_H); const float* DC = (const float*)(F.ws + WS_DCUM);
    const int lane = F.lane, tid = F.tid, hi = lane >> 5;
    LAS unsigned char* kvb = F.lds; LAS float* dkb = (LAS float*)(F.lds + 4 * KV_BUF);
    const int NU = NB * 16 * 8;
    for (int ui = F.bid; ui < NU; ui += F.G) {
        const int qb = 7 - (ui / (NB * 16)), bh = ui % (NB * 16), b = bh >> 4, h = bh & 15;
        const size_t rb0 = (size_t)b * SEQ;
        const bf16_t* Kp = H + rb0 * NO_PAD + 1024 + h * 64; const bf16_t* Vp = H + rb0 * NO_PAD + 2048 + h * 64;
        const int q0 = qb * 256 + F.wave * 32, tq = q0 + (lane & 31);
        bf16x8 qf[4]; load_qf(qf, H + (rb0 + tq) * NO_PAD + h * 64, lane);
        f32x16 o0 = {}, o1 = {}; float m = -1e20f, l = 0.f;
        const int ntile = qb * 4 + 4; const int wlast = (q0 + 31) >> 6;
        KVRegs krA, krB; float dkA = 0.f, dkB = 0.f;
        kv_load(krA, Kp, Vp, NO_PAD, 0, tid); if (tid < 64) dkA = DC[(rb0 + tid) * 16 + h];
        if (ntile > 1) { kv_load(krB, Kp, Vp, NO_PAD, 64, tid); if (tid < 64) dkB = DC[(rb0 + 64 + tid) * 16 + h]; }
        __syncthreads();
#define FOX_FILL(KR, DKR, T) do { const int t = (T); kv_store(KR, kvb + (t & 3) * KV_BUF, tid); if (tid < 64) dkb[(t & 3) * 64 + tid] = -DKR; } while (0)
#define FOX_NEXT(KR, DKR, T) do { const int t = (T); if (t + 2 < ntile) { kv_load(KR, Kp, Vp, NO_PAD, (t + 2) * 64, tid); if (tid < 64) DKR = DC[(rb0 + (t + 2) * 64 + tid) * 16 + h]; } } while (0)
#define FOX_COMP(T) do { const int t = (T); LAS unsigned char* buf = kvb + (t & 3) * KV_BUF; \
            if (EXPT == 2) { l += ((const LAS float*)buf)[lane]; } else if (t <= wlast) { \
                f32x16 p0, p1; qk_tile(p0, p1, buf, qf, lane); \
                const LAS float* dk = dkb + (t & 3) * 64; \
                if (64 * t + 63 <= q0) { \
                    _Pragma("unroll") for (int r = 0; r < 16; ++r) { const int kk = crow(r, hi); p0[r] = __builtin_fmaf(p0[r], QK_C, dk[kk]); p1[r] = __builtin_fmaf(p1[r], QK_C, dk[kk + 32]); } \
                } else { \
                    _Pragma("unroll") for (int r = 0; r < 16; ++r) { const int kk = crow(r, hi), key = t * 64 + kk; \
                        const float s0 = __builtin_fmaf(p0[r], QK_C, dk[kk]), s1 = __builtin_fmaf(p1[r], QK_C, dk[kk + 32]); \
                        p0[r] = (key <= tq) ? s0 : NEGBIG; p1[r] = (key + 32 <= tq) ? s1 : NEGBIG; } \
                } \
                softmax_pv<true, EXPT>(p0, p1, o0, o1, m, l, buf + KT_BYTES, lane); \
            } } while (0)
        for (int t2 = 0; t2 < ntile; t2 += 2) {
            FOX_FILL(krA, dkA, t2); FOX_FILL(krB, dkB, t2 + 1);
            __syncthreads();
            FOX_NEXT(krA, dkA, t2); FOX_NEXT(krB, dkB, t2 + 1);
            FOX_COMP(t2); FOX_COMP(t2 + 1);
        }
#undef FOX_FILL
#undef FOX_NEXT
#undef FOX_COMP
        store_ot(o0, o1, 1.0f / l, O + (rb0 + tq) * opitch + h * 64, lane);
        __syncthreads();
    }
}

template <class MaskFn>
__device__ __forceinline__ void attn_tiles(const Frame& F, unsigned tm, const bf16_t* Kp, const bf16_t* Vp, size_t pitch, const bf16x8 (&qf)[4],
                                            f32x16& o0, f32x16& o1, float& m, float& l, LAS unsigned char* kvb, MaskFn&& mask) {
    const int tid = F.tid, lane = F.lane;
    KVRegs krA, krB;
    int tA = -1, tB = -1;
    if (tm) { tA = __builtin_ctz(tm); tm &= tm - 1; kv_load(krA, Kp, Vp, pitch, tA * 64, tid); }
    if (tm) { tB = __builtin_ctz(tm); tm &= tm - 1; kv_load(krB, Kp, Vp, pitch, tB * 64, tid); }
#define ATT_TILE(KR, TV, PAR) do { const int t = TV; LAS unsigned char* buf = kvb + (PAR) * KV_BUF; \
        kv_store(KR, buf, tid); \
        __syncthreads(); \
        if (tm) { TV = __builtin_ctz(tm); tm &= tm - 1; kv_load(KR, Kp, Vp, pitch, TV * 64, tid); } else TV = -1; \
        f32x16 p0, p1; qk_tile(p0, p1, buf, qf, lane); \
        bool v0 = true, v1 = true; mask(p0, p1, t, v0, v1); \
        softmax_pv<false>(p0, p1, o0, o1, m, l, buf + KT_BYTES, lane, v0, v1); } while (0)
    while (tA >= 0) { ATT_TILE(krA, tA, 0); if (tB < 0) break; ATT_TILE(krB, tB, 1); }
#undef ATT_TILE
    __syncthreads();
}
__device__ __forceinline__ unsigned pkh(float a, float b) { const _Float16 x = (_Float16)a, y = (_Float16)b; return (unsigned)__builtin_bit_cast(unsigned short, x) | ((unsigned)__builtin_bit_cast(unsigned short, y) << 16); }
__device__ __forceinline__ float h2f(unsigned short h) { return (float)__builtin_bit_cast(_Float16, h); }
__device__ __forceinline__ float dpp_f(float x, int ctrl_sel) {
    const int v = __builtin_bit_cast(int, x); int r;
    if (ctrl_sel == 0) r = __builtin_amdgcn_update_dpp(0, v, 0xB1, 0xf, 0xf, true);
    else if (ctrl_sel == 1) r = __builtin_amdgcn_update_dpp(0, v, 0x4E, 0xf, 0xf, true);
    else r = __builtin_amdgcn_update_dpp(0, v, 0x141, 0xf, 0xf, true);
    return __builtin_bit_cast(float, r);
}

__device__ __forceinline__ void dsa_unit(const Frame& F, const Args& a, int b, int qg, bf16_t* O, int opitch) {
    bf16_t* H = (bf16_t*)(F.ws + WS_R + R_H);
    const int lane = F.lane, hi = lane >> 5, t0 = qg * 32; const size_t rb0 = (size_t)b * SEQ;
    LAS float* sc = (LAS float*)F.lds;
    LAS unsigned* bm = (LAS unsigned*)(F.lds + LDS_TAB);
    for (int hf = 0; hf < 2; ++hf) {
        const int tq0 = t0 + 16 * hf, nkt = ((tq0 + 15) >> 5) + 1;
        {
            bf16x8 qi[4][4], wf[4][2];
#pragma unroll
            for (int ct = 0; ct < 4; ++ct) { const int q = tq0 + 4 * ct + ((lane & 31) >> 3), head = lane & 7; const bf16_t* rp = H + (rb0 + q) * NE_PAD;
#pragma unroll
                for (int ks = 0; ks < 4; ++ks) qi[ct][ks] = *(const bf16x8*)(rp + EC_QI + head * 64 + 16 * ks + 8 * hi);
                const int qp = lane & 31; u32x2 w4 = {0u, 0u};
                if (qp < 4) w4 = *(const u32x2*)(H + (rb0 + tq0 + 4 * ct + qp) * NE_PAD + EC_WI + 4 * hi);
                const u32x4 s0 = {(qp == 0) ? w4.x : 0u, (qp == 0) ? w4.y : 0u, (qp == 1) ? w4.x : 0u, (qp == 1) ? w4.y : 0u};
                const u32x4 s1 = {(qp == 2) ? w4.x : 0u, (qp == 2) ? w4.y : 0u, (qp == 3) ? w4.x : 0u, (qp == 3) ? w4.y : 0u};
                wf[ct][0] = __builtin_bit_cast(bf16x8, s0); wf[ct][1] = __builtin_bit_cast(bf16x8, s1); }
            for (int kt = F.wave; kt < nkt; kt += 8) {
                bf16x8 kf[4]; { const bf16_t* kp = H + (rb0 + kt * 32 + (lane & 31)) * NE_PAD + EC_KI + 8 * hi;
#pragma unroll
                    for (int ks = 0; ks < 4; ++ks) kf[ks] = *(const bf16x8*)(kp + 16 * ks); }
#pragma unroll
                for (int ct = 0; ct < 4; ++ct) {
                    f32x16 acc = {};
#pragma unroll
                    for (int ks = 0; ks < 4; ++ks) acc = __builtin_amdgcn_mfma_f32_32x32x16_bf16(qi[ct][ks], kf[ks], acc, 0, 0, 0);
#pragma unroll
                    for (int r = 0; r < 16; ++r) acc[r] = fmaxf(acc[r], 0.f);
                    f32x16 y = {};
                    y = __builtin_amdgcn_mfma_f32_32x32x16_bf16(wf[ct][0], pfrag(acc, 0), y, 0, 0, 0);
                    y = __builtin_amdgcn_mfma_f32_32x32x16_bf16(wf[ct][1], pfrag(acc, 1), y, 0, 0, 0);
                    if (lane < 32) { LAS float* dst = sc + (4 * ct) * 2048 + kt * 32 + lane;
                        dst[0] = y[0]; dst[2048] = y[1]; dst[4096] = y[2]; dst[6144] = y[3]; }
                }
            }
        }
        __syncthreads();
        for (int q2 = 0; q2 < 2; ++q2) {
            const int ql = 2 * F.wave + q2, tq = tq0 + ql, n = tq + 1;
            unsigned u[32];
#pragma unroll
            for (int j = 0; j < 32; ++j) { const int idx = 64 * j + lane; unsigned bits = 0u;
                if (idx < n) { bits = __builtin_bit_cast(unsigned, sc[ql * 2048 + idx]); if ((bits << 1) == 0u) bits = 0u; bits ^= (bits & 0x80000000u) ? 0xffffffffu : 0x80000000u; }
                u[j] = bits; }
            unsigned thr = 0u; int need = 0; bool exact = false;
            if (n > 256) {
                const int ng = (n + 511) >> 9;
                for (int bit = 31; bit >= 0; --bit) { const unsigned cand = thr | (1u << bit); int c = 0;
#pragma unroll
                    for (int g = 0; g < 4; ++g) if (g < ng) {
#pragma unroll
                        for (int j = 8 * g; j < 8 * g + 8; ++j) c += (u[j] >= cand) ? 1 : 0; }
                    c = wave_sum_i(c);
                    if (c >= 256) { thr = cand; if (c == 256) { exact = true; break; } } }
                if (!exact) { int cgt = 0;
#pragma unroll
                    for (int j = 0; j < 32; ++j) cgt += (u[j] > thr) ? 1 : 0;
                    cgt = wave_sum_i(cgt);
                    need = 256 - cgt; }
            }
            const unsigned long long lt = (1ull << lane) - 1ull; int er = 0;
            if (exact) {
#pragma unroll
                for (int j = 0; j < 32; ++j) { const unsigned long long sm = __ballot(u[j] >= thr);
                    if (lane == 0) { bm[(16 * hf + ql) * 64 + 2 * j] = (unsigned)sm; bm[(16 * hf + ql) * 64 + 2 * j + 1] = (unsigned)(sm >> 32); } } }
            else
#pragma unroll
            for (int j = 0; j < 32; ++j) { const int idx = 64 * j + lane; bool sel;
                if (n > 256) {
                  const unsigned long long eqm = __ballot(u[j] == thr && idx < n); sel = (u[j] > thr) || (u[j] == thr && idx < n && (er + __popcll(eqm & lt)) < need); er += __popcll(eqm); }
                else sel = idx < n;
                const unsigned long long sm = __ballot(sel);
                if (lane == 0) { bm[(16 * hf + ql) * 64 + 2 * j] = (unsigned)sm; bm[(16 * hf + ql) * 64 + 2 * j + 1] = (unsigned)(sm >> 32); } }
        }
        __syncthreads();
    }
    const int tq = t0 + (lane & 31);
    bf16x8 qf[4]; load_qf(qf, H + (rb0 + tq) * NE_PAD + EC_QA + F.wave * 64, lane);
    f32x16 o0 = {}, o1 = {}; float m = -1e20f, l = 0.f;
    const int ntile = ((t0 + 31) >> 6) + 1; const unsigned tm = (ntile >= 32) ? 0xffffffffu : ((1u << ntile) - 1u);
    const LAS unsigned* bq = bm + (lane & 31) * 64;
    attn_tiles(F, tm, H + rb0 * NE_PAD + EC_KA, H + rb0 * NE_PAD + EC_VA, NE_PAD, qf, o0, o1, m, l, F.lds,
        [&](f32x16& p0, f32x16& p1, int t, bool&, bool&) { const unsigned w0 = bq[2 * t] >> (4 * hi), w1 = bq[2 * t + 1] >> (4 * hi);
#pragma unroll
            for (int r = 0; r < 16; ++r) { const int sh = (r & 3) + 8 * (r >> 2);
                p0[r] = ((w0 >> sh) & 1u) ? p0[r] : NEGBIG; p1[r] = ((w1 >> sh) & 1u) ? p1[r] : NEGBIG; } });
    store_ot(o0, o1, 1.0f / l, O + (rb0 + tq) * opitch + F.wave * 64, lane);
}

__device__ __forceinline__ void compress_item(const Frame& F, const Args& a, int layer, int item) {
    const bf16_t* H = (const bf16_t*)(F.ws + WS_R + R_H); const bf16_t* W = (const bf16_t*)(F.ws + WS_W + wbuf_off(layer));
    const int kv = item & 1, ct = (item >> 1) & 3, b = item >> 3, lane = F.lane, hi = lane >> 5;
    const bf16_t* w1t = W + (kv ? W_C1V : W_C1K) / 2; const bf16_t* w2t = W + (kv ? W_C2V : W_C2K) / 2;
    const float* bias1 = (const float*)(F.ws + WS_MISC) + kv * 64;
    bf16_t* outp = (bf16_t*)(F.ws + (kv ? WS_VC : WS_KC)) + (size_t)b * 128 * 64;
    const int col = kv ? EC_VC : EC_KC;
    LAS float* part = (LAS float*)F.lds; LAS unsigned short* hs = (LAS unsigned short*)(F.lds + 65536);
    int c = ct * 32 + (lane & 31); if (c > 126) c = 126;
    f32x16 a0 = {}, a1 = {};
#pragma unroll 8
    for (int ks = F.wave * 16; ks < F.wave * 16 + 16; ++ks) {
        const bf16x8 af = *(const bf16x8*)(H + ((size_t)b * SEQ + 16 * c + (ks >> 2)) * NE_PAD + col + 16 * (ks & 3) + 8 * hi);
        const bf16x8 b0 = *(const bf16x8*)(w1t + (size_t)(lane & 31) * 2048 + 16 * ks + 8 * hi), b1 = *(const bf16x8*)(w1t + (size_t)(32 + (lane & 31)) * 2048 + 16 * ks + 8 * hi);
        a0 = __builtin_amdgcn_mfma_f32_32x32x16_bf16(af, b0, a0, 0, 0, 0); a1 = __builtin_amdgcn_mfma_f32_32x32x16_bf16(af, b1, a1, 0, 0, 0);
    }
#pragma unroll
    for (int r = 0; r < 16; ++r) { part[F.wave * 2048 + crow(r, hi) * 64 + (lane & 31)] = a0[r]; part[F.wave * 2048 + crow(r, hi) * 64 + 32 + (lane & 31)] = a1[r]; }
    __syncthreads();
#pragma unroll
    for (int i = 0; i < 4; ++i) { const int idx = F.tid + 512 * i; float s = bias1[idx & 63];
#pragma unroll
        for (int w = 0; w < 8; ++w) s += part[w * 2048 + idx];
        const float h = s / (1.0f + __expf(-s)); hs[(idx >> 6) * 72 + (idx & 63)] = (unsigned short)f2bf(h); }
    __syncthreads();
    if (F.wave < 2) {
        const int nt = F.wave; f32x16 acc = {};
#pragma unroll
        for (int ks = 0; ks < 4; ++ks) { const bf16x8 af = *(const LAS bf16x8*)((const LAS unsigned char*)hs + (lane & 31) * 144 + (16 * ks + 8 * hi) * 2);
            const bf16x8 bf = *(const bf16x8*)(w2t + (size_t)(nt * 32 + (lane & 31)) * 64 + 16 * ks + 8 * hi);
            acc = __builtin_amdgcn_mfma_f32_32x32x16_bf16(af, bf, acc, 0, 0, 0); }
        const int n = nt * 32 + (lane & 31);
        const float* cosT = (const float*)(F.ws + WS_ROPE_COS); const float* sinT = (const float*)(F.ws + WS_ROPE_SIN);
#pragma unroll
        for (int r = 0; r < 16; ++r) { const int cg = ct * 32 + crow(r, hi); float v = acc[r];
            if (kv == 0) { const float o = dpp_mov<DPP_X1>(v); int pos = 16 * cg + 31; if (pos > SEQ - 1) pos = SEQ - 1; const float cs = cosT[pos * 32 + (n >> 1)], sn = sinT[pos * 32 + (n >> 1)];
                v = (n & 1) ? (v * cs + o * sn) : (v * cs - o * sn); }
            outp[(size_t)cg * 64 + n] = (unsigned short)((cg <= 126) ? f2bf(v) : 0u); }
    }
    __syncthreads();
}

__device__ __forceinline__ void nsa_unit(const Frame& F, const Args& a, int layer, int b, int qg, bf16_t* O, int opitch) {
    bf16_t* H = (bf16_t*)(F.ws + WS_R + R_H);
    const int lane = F.lane, hi = lane >> 5, tid = F.tid, t0 = qg * 32, cur = qg; const size_t rb0 = (size_t)b * SEQ;
    const int tq = t0 + (lane & 31);
    LAS unsigned char* kvb = F.lds;
    LAS unsigned short* slab = (LAS unsigned short*)(F.lds + 2 * KV_BUF);
    LAS float* pcs = (LAS float*)(F.lds + 2 * KV_BUF + 65536);
    LAS unsigned* selm = (LAS unsigned*)(pcs + 4096);
    const bf16_t* rowp = H + (rb0 + tq) * NE_PAD;
    bf16x8 qf[4]; load_qf(qf, rowp + EC_QB + F.wave * 64, lane);
    const float* bg = a.in[I_EV_BGATE] + (layer >> 1) * 24 + F.wave * 3;
    const float g0 = sigmoidf_(bf2f(rowp[EC_GB + F.wave * 3 + 0]) + bg[0]), g1 = sigmoidf_(bf2f(rowp[EC_GB + F.wave * 3 + 1]) + bg[1]), g2 = sigmoidf_(bf2f(rowp[EC_GB + F.wave * 3 + 2]) + bg[2]);
    { const bf16_t* kc = (const bf16_t*)(F.ws + WS_KC) + (size_t)b * 128 * 64; const bf16_t* vc = (const bf16_t*)(F.ws + WS_VC) + (size_t)b * 128 * 64;
      KVRegs r0, r1; kv_load(r0, kc, vc, 64, 0, tid); kv_load(r1, kc, vc, 64, 64, tid); kv_store(r0, kvb, tid); kv_store(r1, kvb + KV_BUF, tid); }
    __syncthreads();
    f32x16 pc[4]; f32x16 oa0 = {}, oa1 = {};
    {
        const int cmax = (tq >= 31) ? min(126, (tq - 31) >> 4) : -1;
        qk_tile(pc[0], pc[1], kvb, qf, lane); asm volatile("" ::: "memory"); qk_tile(pc[2], pc[3], kvb + KV_BUF, qf, lane); asm volatile("" ::: "memory");
        float mx = NEGBIG;
#pragma unroll
        for (int s = 0; s < 4; ++s)
#pragma unroll
            for (int r = 0; r < 16; ++r) { const int c = 32 * s + crow(r, hi); pc[s][r] = (c <= cmax) ? pc[s][r] * QK_C : NEGBIG; mx = fmaxf(mx, pc[s][r]); }
        mx = max_x32(mx, lane);
        float ls = 0.f;
#pragma unroll
        for (int s = 0; s < 4; ++s)
#pragma unroll
            for (int r = 0; r < 16; ++r) { pc[s][r] = (pc[s][r] > -1e29f) ? fast_exp2(pc[s][r] - mx) : 0.f; ls += pc[s][r]; }
        ls = sum_x32(ls, lane);
        const float inv = (ls > 0.f) ? 1.0f / ls : 0.f;
#pragma unroll
        for (int s = 0; s < 4; ++s) pc[s] *= inv;
        f32x16 c0 = {}, c1 = {};
        asm volatile("" ::: "memory");
        pv_sub(c0, c1, kvb + KT_BYTES, 0, pc[0], lane); asm volatile("" ::: "memory"); pv_sub(c0, c1, kvb + KT_BYTES, 1, pc[1], lane); asm volatile("" ::: "memory");
        pv_sub(c0, c1, kvb + KV_BUF + KT_BYTES, 0, pc[2], lane); asm volatile("" ::: "memory"); pv_sub(c0, c1, kvb + KV_BUF + KT_BYTES, 1, pc[3], lane); asm volatile("" ::: "memory");
        oa0 = c0 * g0; oa1 = c1 * g0;
    }
    { LAS unsigned short* sl = slab + F.wave * 4096 + (lane & 31) * 128 + 4 * hi;
#pragma unroll
      for (int s = 0; s < 4; ++s)
#pragma unroll
          for (int g = 0; g < 4; ++g) { u32x2 w; w.x = pkh(pc[s][4 * g], pc[s][4 * g + 1]); w.y = pkh(pc[s][4 * g + 2], pc[s][4 * g + 3]); *(LAS u32x2*)(sl + 32 * s + 8 * g) = w; } }
    __syncthreads();
#pragma unroll
    for (int i = 0; i < 8; ++i) { const int idx = tid + 512 * i; float s8 = 0.f;
#pragma unroll
        for (int w = 0; w < 8; ++w) s8 += h2f(slab[w * 4096 + idx]);
        pcs[idx] = s8; }
    __syncthreads();
#pragma unroll
    for (int qq = 0; qq < 4; ++qq) { const int q = 4 * F.wave + qq; const LAS float* pr = pcs + q * 128;
        float v = pr[2 * lane] + 0.5f * ((lane > 0 ? pr[2 * lane - 1] : 0.f) + pr[2 * lane + 1]);
        if (lane == 0 || lane == cur || lane == cur - 1) v = 1e30f - (float)lane * 1e27f; else if (lane > cur) v = NEGBIG;
        int rank = 0;
#pragma unroll
        for (int j = 0; j < 64; ++j) { const float o = __builtin_bit_cast(float, __builtin_amdgcn_readlane(__builtin_bit_cast(int, v), j)); rank += (o > v) ? 1 : 0; }
        bool tie = false;
#pragma unroll
        for (int k = 0; k < 8; ++k) tie |= (__popcll(__ballot(rank == k)) != 1);
        if (tie) { rank = 0;
#pragma unroll 1
            for (int j = 0; j < 64; ++j) { const float o = __builtin_bit_cast(float, __builtin_amdgcn_readlane(__builtin_bit_cast(int, v), j)); rank += (o > v || (o == v && j < lane)) ? 1 : 0; } }
        const unsigned long long sm = __ballot(rank < 8);
        if (lane == 0) { selm[2 * q] = (unsigned)sm; selm[2 * q + 1] = (unsigned)(sm >> 32); } }
    __syncthreads();
    LAS float* stash = (LAS float*)(F.lds + 2 * KV_BUF) + F.wave * 2048 + lane;
#pragma unroll
    for (int r = 0; r < 16; ++r) { stash[r * 64] = oa0[r]; stash[(16 + r) * 64] = oa1[r]; }
    {
        unsigned long long un = 0ull;
        { const unsigned lo = selm[2 * (lane & 31)], hh = selm[2 * (lane & 31) + 1]; unsigned ul = lo, uh = hh;
          ul |= dpp_movu<DPP_X1>(ul); ul |= dpp_movu<DPP_X2>(ul); ul |= dpp_movu<DPP_HM>(ul); ul |= dpp_movu<DPP_RM>(ul);
          uh |= dpp_movu<DPP_X1>(uh); uh |= dpp_movu<DPP_X2>(uh); uh |= dpp_movu<DPP_HM>(uh); uh |= dpp_movu<DPP_RM>(uh);
          un = ((unsigned long long)((unsigned)__builtin_amdgcn_readlane((int)uh, 0) | (unsigned)__builtin_amdgcn_readlane((int)uh, 16)) << 32) | ((unsigned)__builtin_amdgcn_readlane((int)ul, 0) | (unsigned)__builtin_amdgcn_readlane((int)ul, 16)); }
        if (cur < 63) un &= (1ull << (cur + 1)) - 1ull;
        unsigned tm = 0u;
        for (int t = 0; t <= (cur >> 1); ++t) if ((un >> (2 * t)) & 3ull) tm |= 1u << t;
        const unsigned long long mysel = ((unsigned long long)selm[2 * (lane & 31) + 1] << 32) | selm[2 * (lane & 31)];
        f32x16 s0 = {}, s1 = {}; float m = -1e20f, l = 0.f;
        attn_tiles(F, tm, H + rb0 * NE_PAD + EC_KS, H + rb0 * NE_PAD + EC_VS, NE_PAD, qf, s0, s1, m, l, kvb,
            [&](f32x16& p0, f32x16& p1, int t, bool& v0, bool& v1) { const bool b0 = (mysel >> (2 * t)) & 1ull, b1 = (mysel >> (2 * t + 1)) & 1ull;
                if (64 * t + 63 <= t0) { v0 = b0; v1 = b1; }
                else {
#pragma unroll
                    for (int r = 0; r < 16; ++r) { const int key = 64 * t + crow(r, hi);
                        p0[r] = (b0 && key <= tq) ? p0[r] : NEGBIG; p1[r] = (b1 && key + 32 <= tq) ? p1[r] : NEGBIG; } } });
        const float sc = g1 / l;
#pragma unroll
        for (int r = 0; r < 16; ++r) { stash[r * 64] += s0[r] * sc; stash[(16 + r) * 64] += s1[r] * sc; }
    }
    {
        const int tlo = (t0 >= 511) ? ((t0 - 511) >> 6) : 0, thi = (t0 + 31) >> 6;
        unsigned tm = 0u; for (int t = tlo; t <= thi; ++t) tm |= 1u << t;
        f32x16 s0 = {}, s1 = {}; float m = -1e20f, l = 0.f;
        attn_tiles(F, tm, H + rb0 * NE_PAD + EC_KW, H + rb0 * NE_PAD + EC_VW, NE_PAD, qf, s0, s1, m, l, kvb,
            [&](f32x16& p0, f32x16& p1, int t, bool&, bool&) {
                const bool interior = (64 * t + 63 <= t0) && (64 * t + 512 > t0 + 31);
                if (!interior) {
#pragma unroll
                    for (int r = 0; r < 16; ++r) { const int key = 64 * t + crow(r, hi);
                        p0[r] = (key <= tq && key + 512 > tq) ? p0[r] : NEGBIG; p1[r] = (key + 32 <= tq && key + 32 + 512 > tq) ? p1[r] : NEGBIG; } } });
        const float sc = g2 / l;
#pragma unroll
        for (int r = 0; r < 16; ++r) { oa0[r] = stash[r * 64] + s0[r] * sc; oa1[r] = stash[(16 + r) * 64] + s1[r] * sc; }
    }
    store_ot(oa0, oa1, 1.0f, O + (rb0 + tq) * opitch + F.wave * 64, lane);
    __syncthreads();
}

__device__ __forceinline__ void moe_tables(const Frame& F, int layer) {
    LAS int* cntl = (LAS int*)(F.lds + LDS_TAB); LAS int* rbs = cntl + 160;
    __syncthreads();
    if (F.tid < NV) cntl[F.tid] = ((F.tid % 65) == 64) ? HALF_T : (int)__hip_atomic_load(F.ctl + CW_CNT + layer * 256 + F.tid, RLX_AGENT);
    __syncthreads();
    if (F.tid <= NV) { int run = 0; for (int u = 0; u < F.tid; ++u) run += (cntl[u] + 255) >> 8; rbs[F.tid] = run; }
    __syncthreads();
}

constexpr int PH_PER_LAYER = 16, N_PHASES = DEPTH * PH_PER_LAYER;
__global__ void __launch_bounds__(512, 2) fwd(const float* i0, const float* i1, const float* i2, const float* i3, const float* i4, const float* i5, const float* i6, const float* i7, const float* i8, const float* i9, const float* i10, const float* i11, const float* i12, const float* i13, const float* i14, const float* i15, const float* i16, const float* i17, const float* i18, const float* i19, const float* i20, const float* i21, const float* i22, const float* i23, const float* i24, const float* i25, const float* i26, const float* i27, const float* i28, float* out_, unsigned char* ws_, int ph_lo_, int ph_hi_) {
    Args args; args.in[0] = i0; args.in[1] = i1; args.in[2] = i2; args.in[3] = i3; args.in[4] = i4; args.in[5] = i5; args.in[6] = i6; args.in[7] = i7; args.in[8] = i8; args.in[9] = i9; args.in[10] = i10; args.in[11] = i11; args.in[12] = i12; args.in[13] = i13; args.in[14] = i14; args.in[15] = i15; args.in[16] = i16; args.in[17] = i17; args.in[18] = i18; args.in[19] = i19; args.in[20] = i20; args.in[21] = i21; args.in[22] = i22; args.in[23] = i23; args.in[24] = i24; args.in[25] = i25; args.in[26] = i26; args.in[27] = i27; args.in[28] = i28; args.out = out_; args.ws = ws_; args.ph_lo = ph_lo_; args.ph_hi = ph_hi_;
    extern __shared__ __attribute__((aligned(16))) unsigned char lds_raw[];
    Frame F; F.lds = (LAS unsigned char*)lds_raw; F.tid = threadIdx.x; F.lane = F.tid & 63; F.wave = __builtin_amdgcn_readfirstlane(F.tid >> 6);
    F.G = gridDim.x; F.bid = blockIdx.x; F.ws = args.ws; F.ctl = (gu32*)(args.ws + WS_CTL);
    volatile LAS unsigned* MISC = (volatile LAS unsigned*)(F.lds + LDS_MISC);
    if (threadIdx.x < 64) MISC[threadIdx.x] = 0u;
    __syncthreads();
#if MK_ONE_LAUNCH
    constexpr int lo = 0, hi = N_PHASES; constexpr bool multi = true;
#else
    const int lo = args.ph_lo, hi = args.ph_hi; const bool multi = (hi - lo) > 1;
#endif
    XcdBarrier bar; bar.bar = (unsigned*)(F.ctl + CW_BAR); bar.x = 0; bar.st = MISC;
    if (multi) bar = xcd_barrier_post((unsigned*)(F.ctl + CW_BAR), MISC);
#ifndef PHMASK
#define PHMASK 0xffff
#endif
#define IN(k) (((PHMASK >> ((k) & 15)) & 1) && lo <= (k) && (k) < hi)
#ifndef TIMING
#define TIMING 0
#endif
#if TIMING
    if (F.tid == 0) { const unsigned long long t0_ = wall_clock64(); MISC[16] = (unsigned)t0_; MISC[17] = (unsigned)(t0_ >> 32); }
#define SEAM() do { if (multi) xcd_barrier(bar); if (blockIdx.x == 0 && F.tid == 0) { const unsigned long long tn = wall_clock64(); const unsigned long long tp = ((unsigned long long)MISC[17] << 32) | MISC[16]; \
    ((unsigned long long*)(args.ws + WS_CTL + 512 * 1024))[MISC[18]] = tn - tp; MISC[16] = (unsigned)tn; MISC[17] = (unsigned)(tn >> 32); } } while (0)
#define SETPH(k) do { if (F.tid == 0) MISC[18] = (unsigned)(k); } while (0)
#else
#define SEAM() do { if (multi) xcd_barrier(bar); } while (0)
#define SETPH(k)
#endif
#ifndef DUP_K
#define DUP_K -1
#define DUP_PAR 2
#endif
#define NREP(k) ((DUP_K == (k) && (DUP_PAR == 2 || (layer & 1) == DUP_PAR)) ? 2 : 1)
#define PF() Frame P = F; { int t_; asm volatile("v_mbcnt_lo_u32_b32 %0, -1, 0\n\tv_mbcnt_hi_u32_b32 %0, -1, %0" : "=v"(t_)); t_ += F.wave * 64; P.tid = t_; P.lane = t_ & 63; int w_ = F.wave; asm volatile("" : "+s"(w_)); P.wave = w_; GAS unsigned char* p_ = (GAS unsigned char*)args.ws; asm volatile("" : "+s"(p_)); P.ws = (unsigned char*)p_; P.ctl = (gu32*)(p_ + WS_CTL); } \
    unsigned char* ws = P.ws; bf16_t* XB = (bf16_t*)(ws + WS_XB); bf16_t* XB2 = (bf16_t*)(ws + WS_R + R_XB2); bf16_t* XD = (bf16_t*)args.out; (void)XD; bf16_t* H = (bf16_t*)(ws + WS_R + R_H); bf16_t* W = (bf16_t*)(ws + WS_W + wbuf_off(layer)); (void)XB; (void)XB2; (void)H; (void)W;
    LAS int* cntl = (LAS int*)(F.lds + LDS_TAB); LAS int* rbs = cntl + 160;
    for (int layer = 0; layer < DEPTH; ++layer) {
        const int pb = layer * PH_PER_LAYER; const bool even = (layer & 1) == 0; const int jl = layer >> 1;
        const bool ovl = (F.G == 256);
        if (IN(pb + 0) && (layer == 0 || !ovl)) { SETPH(pb + 0); PF();
            prep_weights(P, args, layer, P.bid, P.G); prep_acts(P, args, layer, layer == 0);
            SEAM(); }
        if (IN(pb + 1)) { SETPH(pb + 1); PF();
            { const bf16_t* xin = (layer == 0) ? XB : XB2;
            if (even) { pg8::DenseSched S{(const char*)xin, (const char*)(W + W_IN / 2), DM, DM, T / 256, NE_PAD / 256, P.G, P.bid};
                EpiInEven E{H, (const float*)(ws + WS_ROPE_COS), (const float*)(ws + WS_ROPE_SIN)}; pg8::gemm_phase(P.lds, S, E, P.tid); }
            else { pg8::DenseSched S{(const char*)xin, (const char*)(W + W_IN / 2), DM, DM, T / 256, NO_PAD / 256, P.G, P.bid};
                EpiInOdd E{H, (float*)(ws + WS_LOGF), args.in[I_OD_BF] + jl * 16}; pg8::gemm_phase(P.lds, S, E, P.tid); } }
            SEAM(); }
        if ((DUP_K == 1 && (DUP_PAR == 2 || (layer & 1) == DUP_PAR))) { PF();
            { const bf16_t* xin = (layer == 0) ? XB : XB2;
            if (even) { pg8::DenseSched S{(const char*)xin, (const char*)(W + W_IN / 2), DM, DM, T / 256, NE_PAD / 256, P.G, P.bid};
                EpiInEven E{H, (const float*)(ws + WS_ROPE_COS), (const float*)(ws + WS_ROPE_SIN)}; pg8::gemm_phase(P.lds, S, E, P.tid); }
            else { pg8::DenseSched S{(const char*)xin, (const char*)(W + W_IN / 2), DM, DM, T / 256, NO_PAD / 256, P.G, P.bid};
                EpiInOdd E{H, (float*)(ws + WS_LOGF), args.in[I_OD_BF] + jl * 16}; pg8::gemm_phase(P.lds, S, E, P.tid); } }
            SEAM(); }
        if (even) {
        if (IN(pb + 2)) { SETPH(pb + 2); PF();
                for (int it = P.bid; it < 256; it += P.G) compress_item(P, args, layer, it);
                for (int u0 = 0; u0 < NB * 64; u0 += P.G) { const int u = u0 + (((u0 / P.G) & 1) ? (P.G - 1 - P.bid) : P.bid); if (u >= NB * 64) continue; const int qg = 63 - (u / NB), b = u % NB; dsa_unit(P, args, b, qg, H + EC_QA, NE_PAD); }
            SEAM(); }
        if ((DUP_K == 2 && (DUP_PAR == 2 || (layer & 1) == DUP_PAR))) { PF();
                for (int u0 = 0; u0 < NB * 64; u0 += P.G) { const int u = u0 + (((u0 / P.G) & 1) ? (P.G - 1 - P.bid) : P.bid); if (u >= NB * 64) continue; const int qg = 63 - (u / NB), b = u % NB; dsa_unit(P, args, b, qg, (bf16_t*)(ws + WS_R + 568 * MiB), 1024); }
            SEAM(); }
        if (IN(pb + 3)) { SETPH(pb + 3); PF();
                for (int u0 = 0; u0 < NB * 64; u0 += P.G) { const int u = u0 + (((u0 / P.G) & 1) ? (P.G - 1 - P.bid) : P.bid); if (u >= NB * 64) continue; const int qg = 63 - (u / NB), b = u % NB; nsa_unit(P, args, layer, b, qg, H + EC_QB, NE_PAD); }
            SEAM(); }
        if ((DUP_K == 3 && (DUP_PAR == 2 || (layer & 1) == DUP_PAR))) { PF();
                for (int u0 = 0; u0 < NB * 64; u0 += P.G) { const int u = u0 + (((u0 / P.G) & 1) ? (P.G - 1 - P.bid) : P.bid); if (u >= NB * 64) continue; const int qg = 63 - (u / NB), b = u % NB; nsa_unit(P, args, layer, b, qg, (bf16_t*)(ws + WS_R + 568 * MiB) + 512, 1024); }
            SEAM(); }
        } else {
        if (IN(pb + 2)) { SETPH(pb + 2); PF();
            scan_phase(P, args);
            SEAM(); }
        if (IN(pb + 3)) { SETPH(pb + 3); PF();
                fox_phase(P, args, H, NO_PAD);
            SEAM(); }
        if ((DUP_K == 3 && (DUP_PAR == 2 || (layer & 1) == DUP_PAR))) { PF();
#ifdef FOX_EXPT
                fox_phase<FOX_EXPT>(P, args, (bf16_t*)(ws + WS_R + 568 * MiB), 1024);
#else
                fox_phase(P, args, (bf16_t*)(ws + WS_R + 568 * MiB), 1024);
#endif
            SEAM(); }
        }
        if (IN(pb + 4)) { SETPH(pb + 4); PF();
            { pg8::DenseSched S{(const char*)H, (const char*)(W + W_O / 2), even ? NE_PAD : NO_PAD, DM, T / 256, DM / 256, P.G, P.bid};
              EpiOut E{(layer == 0) ? XB : XB2, (layer == 0) ? XB2 : XB}; pg8::gemm_phase(P.lds, S, E, P.tid); }
            SEAM(); }
        if ((DUP_K == 4 && (DUP_PAR == 2 || (layer & 1) == DUP_PAR))) { PF();
            { pg8::DenseSched S{(const char*)H, (const char*)(W + W_O / 2), even ? NE_PAD : NO_PAD, DM, T / 256, DM / 256, P.G, P.bid};
              EpiOut E{(layer == 0) ? XB : XB2, (bf16_t*)(ws + WS_R + 568 * MiB)}; pg8::gemm_phase(P.lds, S, E, P.tid); }
            SEAM(); }
        if (IN(pb + 5)) { SETPH(pb + 5); PF();
            route_phase(P, args, layer, (layer == 0) ? XB2 : XB, XD, false);
            SEAM(); }
        if ((DUP_K == 5 && (DUP_PAR == 2 || (layer & 1) == DUP_PAR))) { PF();
            route_phase(P, args, layer, (layer == 0) ? XB2 : XB, (bf16_t*)(ws + WS_R + 568 * MiB), true);
            SEAM(); }
        if (IN(pb + 6)) { SETPH(pb + 6); PF();
            const bool side = ovl && layer + 1 < DEPTH;
            if (side && (P.bid >> 3) >= 32 - SIDE_PX) prep_weights(P, args, layer + 1, (P.bid & 7) * SIDE_PX + (P.bid >> 3) - (32 - SIDE_PX), 8 * SIDE_PX);
            else { moe_tables(P, layer);
              MoeSched S{(const char*)XD, (const char*)(W + W_UP / 2), DM, DM, 2, (size_t)512 * DM * 2, rbs, cntl, 0, NV - 1, 0, rbs[NV] * 2, P.G, P.bid, (const int*)(ws + WS_SLOT_TK), true, side ? 32 - SIDE_PX : (P.G >> 3)};
              EpiUp E{(bf16_t*)(ws + WS_R + R_HMID)}; pg8::gemm_phase(P.lds, S, E, P.tid); }
            SEAM(); }
        if ((DUP_K == 6 && (DUP_PAR == 2 || (layer & 1) == DUP_PAR))) { PF();
            { moe_tables(P, layer);
              MoeSched S{(const char*)XD, (const char*)(W + W_UP / 2), DM, DM, 2, (size_t)512 * DM * 2, rbs, cntl, 0, NV - 1, 0, rbs[NV] * 2, P.G, P.bid, (const int*)(ws + WS_SLOT_TK), true, P.G >> 3};
              EpiUp E{(bf16_t*)(ws + WS_R + R_HMID)}; pg8::gemm_phase(P.lds, S, E, P.tid); }
            SEAM(); }
        if (IN(pb + 7)) { SETPH(pb + 7); PF();
                { moe_tables(P, layer);
                  MoeSched S{(const char*)(ws + WS_R + R_HMID), (const char*)(W + W_DN / 2), DFF, DFF, 4, (size_t)DM * DFF * 2, rbs, cntl, 0, NV - 1, 0, rbs[NV] * 4, P.G, P.bid, (const int*)(ws + WS_SLOT_TK), false, P.G >> 3};
                  EpiDown E{(bf16_t*)(ws + WS_R + R_YTOK), (const int*)(ws + WS_SLOT_TK), (const float*)(ws + WS_SLOT_G), cntl, false}; pg8::gemm_phase(P.lds, S, E, P.tid); }
            SEAM(); }
        if (IN(pb + 8)) { SETPH(pb + 8); PF();
#pragma unroll 1
            for (int hf = 0; hf < 2; ++hf) { int h2 = hf; asm volatile("" : "+s"(h2)); combine_phase(P, args, layer, h2, XD, XB, false); } }
        if (IN(pb + 10)) { PF();
            { pg8::DenseSched S{(const char*)(ws + WS_PB), (const char*)(W + W_P / 2), 256, 256, T / 256, DM / 256, P.G, P.bid};
              EpiPleE E{(bf16_t*)(ws + WS_R + R_E), (float*)(ws + WS_SSQ)}; pg8::gemm_phase(P.lds, S, E, P.tid); }
            SEAM(); }
        if ((DUP_K == 11 && (DUP_PAR == 2 || (layer & 1) == DUP_PAR))) { PF();
            { pg8::DenseSched S{(const char*)(ws + WS_PB), (const char*)(W + W_P / 2), 256, 256, T / 256, DM / 256, P.G, P.bid};
              EpiPleE E{(bf16_t*)(ws + WS_R + R_E), (float*)(ws + WS_SSQ)}; pg8::gemm_phase(P.lds, S, E, P.tid); }
            SEAM(); }
        if (IN(pb + 12)) { SETPH(pb + 12); PF();
            { pg8::DenseSched S{(const char*)XB, (const char*)(W + W_G / 2), DM, DM, T / 256, DM / 256, P.G, P.bid};
              EpiPleG E{XB, (const bf16_t*)(ws + WS_R + R_E), (const float*)(ws + WS_SSQ), args.in[I_PNG] + layer * DM, (layer + 1 < DEPTH) ? XB2 : (bf16_t*)nullptr, (layer + 1 < DEPTH) ? (float*)nullptr : args.out};
              pg8::gemm_phase(P.lds, S, E, P.tid); }
            if (ovl && layer + 1 < DEPTH) prep_acts(P, args, layer + 1, false);
            SEAM(); }
        if ((DUP_K == 12 && (DUP_PAR == 2 || (layer & 1) == DUP_PAR))) { PF();
            { pg8::DenseSched S{(const char*)XB, (const char*)(W + W_G / 2), DM, DM, T / 256, DM / 256, P.G, P.bid};
              EpiPleG E{XB, (const bf16_t*)(ws + WS_R + R_E), (const float*)(ws + WS_SSQ), args.in[I_PNG] + layer * DM, (bf16_t*)(ws + WS_R + 568 * MiB), (float*)nullptr}; pg8::gemm_phase(P.lds, S, E, P.tid); }
            SEAM(); }
    }
#ifdef EXTRA_BAR
    for (int i_ = 0; i_ < EXTRA_BAR; ++i_) { SEAM(); }
#endif
#if TIMING
    {
        VM_WAIT(); __syncthreads(); if (multi) xcd_barrier(bar);
        float ta = 0.f, tb = 0.f;
        for (int l = 0; l < DEPTH; ++l) for (int k = 0; k < 13; ++k) { const float d = (float)((unsigned long long*)(args.ws + WS_CTL + 512 * 1024))[l * 16 + k] * 0.01f;
            if (((TA_MASK >> k) & 1) && (TA_PAR == 2 || (l & 1) == TA_PAR)) ta += d; if (((TB_MASK >> k) & 1) && (TB_PAR == 2 || (l & 1) == TB_PAR)) tb += d; }
        for (size_t i = (size_t)blockIdx.x * 512 + F.tid; i < (size_t)T * DM; i += (size_t)gridDim.x * 512) args.out[i] = ta;
        VM_WAIT(); __syncthreads(); if (multi) xcd_barrier(bar);
        if (blockIdx.x == 0 && F.tid == 0) args.out[0] = tb * 100.f;
    }
#endif
#undef IN
#undef SEAM
}

extern "C" void kernel_launch(void* const* d_in, const int* in_sizes, int n_in, void* d_out, int out_size, void* d_ws, size_t ws_size, hipStream_t stream) {
    static int grid = 0;
    if (grid == 0) {
        if (n_in != 29 || in_sizes[0] != T * DM || out_size != T * DM || ws_size < WS_END) { fprintf(stderr, "kernel_launch: unexpected shapes / workspace (n_in %d, ws %zu, need %zu)\n", n_in, ws_size, (size_t)WS_END); grid = -1; return; }
        int dev = 0, cus = 0, per_cu = 0;
        if (hipGetDevice(&dev) != hipSuccess || hipDeviceGetAttribute(&cus, hipDeviceAttributeMultiprocessorCount, dev) != hipSuccess) { grid = -1; return; }
        if (hipFuncSetAttribute((const void*)fwd, hipFuncAttributeMaxDynamicSharedMemorySize, LDS_BYTES) != hipSuccess) { fprintf(stderr, "kernel_launch: hipFuncSetAttribute failed\n"); grid = -1; return; }
        if (hipOccupancyMaxActiveBlocksPerMultiprocessor(&per_cu, (const void*)fwd, 512, LDS_BYTES) != hipSuccess || per_cu < 1) { fprintf(stderr, "kernel_launch: occupancy query says %d\n", per_cu); }
        (void)hipGetLastError();
        grid = cus;
    }
    if (grid < 0) return;
    if (hipMemsetAsync((char*)d_ws + WS_CTL, 0, CTL_BYTES, stream) != hipSuccess) return;
    Args a{};
    for (int i = 0; i < 29; ++i) a.in[i] = (const float*)d_in[i];
    a.out = (float*)d_out; a.ws = (unsigned char*)d_ws;
#if MK_ONE_LAUNCH
    a.ph_lo = 0; a.ph_hi = N_PHASES;
    hipLaunchKernelGGL(fwd, dim3(grid), dim3(512), LDS_BYTES, stream, a.in[0], a.in[1], a.in[2], a.in[3], a.in[4], a.in[5], a.in[6], a.in[7], a.in[8], a.in[9], a.in[10], a.in[11], a.in[12], a.in[13], a.in[14], a.in[15], a.in[16], a.in[17], a.in[18], a.in[19], a.in[20], a.in[21], a.in[22], a.in[23], a.in[24], a.in[25], a.in[26], a.in[27], a.in[28], a.out, a.ws, a.ph_lo, a.ph_hi);
#else
    for (int ph = 0; ph < N_PHASES; ++ph) {
        if ((ph % PH_PER_LAYER) > 12) continue;
        a.ph_lo = ph; a.ph_hi = ph + 1;
        hipLaunchKernelGGL(fwd, dim3(grid), dim3(512), LDS_BYTES, stream, a.in[0], a.in[1], a.in[2], a.in[3], a.in[4], a.in[5], a.in[6], a.in[7], a.in[8], a.in[9], a.in[10], a.in[11], a.in[12], a.in[13], a.in[14], a.in[15], a.in[16], a.in[17], a.in[18], a.in[19], a.in[20], a.in[21], a.in[22], a.in[23], a.in[24], a.in[25], a.in[26], a.in[27], a.in[28], a.out, a.ws, a.ph_lo, a.ph_hi);
    }
#endif
}
```

```cpp
#include <hip/hip_runtime.h>
#include <cstdio>
#include <cstdint>

#define LAS __attribute__((address_space(3)))
#define GAS __attribute__((address_space(1)))
typedef unsigned short bf16_t;
typedef short bf16x8 __attribute__((ext_vector_type(8)));
typedef short s16x4 __attribute__((ext_vector_type(4)));
typedef float f32x2 __attribute__((ext_vector_type(2)));
typedef float f32x4 __attribute__((ext_vector_type(4)));
typedef float f32x16 __attribute__((ext_vector_type(16)));
typedef unsigned u32x2 __attribute__((ext_vector_type(2)));
typedef unsigned u32x4 __attribute__((ext_vector_type(4)));
typedef GAS unsigned gu32;

#ifndef SIDE_PX
#define SIDE_PX 3
#endif
#ifndef Y_FP8
#define Y_FP8 1
#endif
#ifndef MK_ONE_LAUNCH
#define MK_ONE_LAUNCH 1
#endif

constexpr int DM = 1024, NB = 32, SEQ = 2048, DEPTH = 4, T = NB * SEQ;
constexpr int EVEN_COLS = 2144, ODD_COLS = 3088, NE_PAD = 2304, NO_PAD = 3328;
constexpr int NEXP = 64, NV = 130  , HALF_T = T / 2, DFF = 256;
constexpr float LN_EPS = 1e-5f, RMS_EPS = 1e-6f;
constexpr float ALPHA = 1.6817928305074290f;
constexpr float LOG2E = 1.4426950408889634f;
constexpr float QK_C = 0.125f * LOG2E;
constexpr float NEGBIG = -1e30f;

constexpr int EC_QA = 0, EC_QB = 512, EC_QI = 1024, EC_KA = 1536, EC_KI = 1600, EC_KS = 1664, EC_KW = 1728;
constexpr int EC_VA = 1792, EC_KC = 1856, EC_VC = 1920, EC_VS = 1984, EC_VW = 2048, EC_WI = 2112, EC_GB = 2120;

constexpr size_t MiB = 1u << 20;
constexpr size_t WS_CTL = 0, CTL_BYTES = 1 * MiB;
constexpr size_t WS_ROPE_COS = 1 * MiB, WS_ROPE_SIN = WS_ROPE_COS + 256 * 1024;
constexpr size_t WS_SLOT_TK = 2 * MiB;
constexpr size_t WS_SLOT_G = WS_SLOT_TK + (size_t)NV * HALF_T * 4;
constexpr size_t WS_DCUM = 38 * MiB;
constexpr size_t WS_LOGF = 42 * MiB;
constexpr size_t WS_KC = 46 * MiB, WS_VC = WS_KC + 512 * 1024;
constexpr size_t WS_SSQ = 47 * MiB;
constexpr size_t WS_PB = 51 * MiB;
constexpr size_t WS_MISC = 83 * MiB;
constexpr size_t WS_XB = 84 * MiB;
constexpr size_t WS_W = 212 * MiB, W_BUF = 128 * MiB;
constexpr size_t W_IN = 0, W_O = 7 * MiB, W_G = 9 * MiB, W_P = 11 * MiB, W_RH = 11 * MiB + 512 * 1024, W_RL = W_RH + 128 * 1024  , W_C1K = 12 * MiB, W_C1V = W_C1K + 256 * 1024, W_C2K = W_C1V + 256 * 1024, W_C2V = W_C2K + 8192;
constexpr size_t W_UP = 16 * MiB  , W_DN = 82 * MiB  ;
constexpr size_t WS_R = 468 * MiB;
constexpr size_t R_H = 0, R_HMID = 0, R_E = 0, R_YTOK = 320 * MiB, R_XB2 = 440 * MiB;
constexpr size_t WS_END = WS_R + 896 * MiB;
static_assert(Y_FP8 == 1 && R_YTOK + (size_t)T * 9 * 1024 <= 896 * MiB, "ytok");
static_assert(W_DN + 65ull * 1024 * 256 * 2 <= 128 * MiB, "w");
constexpr int CW_BAR = 4096;
constexpr int CW_CNT = 16384;
constexpr int XBW = 3456;

constexpr int RING_BYTES = 131072;
constexpr int LDS_TAB = RING_BYTES;
constexpr int LDS_MISC = RING_BYTES + 20480;
constexpr int LDS_BYTES = RING_BYTES + 20480 + 256;

#define LDS_WAIT() asm volatile("s_waitcnt lgkmcnt(0)" ::: "memory")
#define VM_WAIT() asm volatile("s_waitcnt vmcnt(0)" ::: "memory")
#define RLX_AGENT __ATOMIC_RELAXED, __HIP_MEMORY_SCOPE_AGENT
__device__ __forceinline__ unsigned f2bf(float f) { unsigned u = __builtin_bit_cast(unsigned, f); return (u + 0x7fffu + ((u >> 16) & 1u)) >> 16; }
__device__ __forceinline__ unsigned pk2(float lo, float hi) { return f2bf(lo) | (f2bf(hi) << 16); }
__device__ __forceinline__ float bf2f(unsigned short h) { return __builtin_bit_cast(float, (unsigned)h << 16); }
__device__ __forceinline__ float bflo(unsigned w) { return __builtin_bit_cast(float, w << 16); }
__device__ __forceinline__ float bfhi(unsigned w) { return __builtin_bit_cast(float, w & 0xffff0000u); }
template <int CTRL> __device__ __forceinline__ float dpp_mov(float x) { return __builtin_bit_cast(float, __builtin_amdgcn_update_dpp(0, __builtin_bit_cast(int, x), CTRL, 0xf, 0xf, true)); }
template <int CTRL> __device__ __forceinline__ unsigned dpp_movu(unsigned x) { return (unsigned)__builtin_amdgcn_update_dpp(0, (int)x, CTRL, 0xf, 0xf, true); }
#define DPP_X1 0xB1
#define DPP_X2 0x4E
#define DPP_HM 0x141
#define DPP_RM 0x140
__device__ __forceinline__ float bperm_xor(float x, int lane, int mask) { return __builtin_bit_cast(float, __builtin_amdgcn_ds_bpermute((lane ^ mask) << 2, __builtin_bit_cast(int, x))); }
__device__ __forceinline__ float sum_x32(float x, int lane) { return x + bperm_xor(x, lane, 32); }
__device__ __forceinline__ float max_x32(float x, int lane) { return fmaxf(x, bperm_xor(x, lane, 32)); }
__device__ __forceinline__ float sum_x16(float x, int lane) { return x + bperm_xor(x, lane, 16); }
__device__ __forceinline__ float wave_sum(float v) {
    v += dpp_mov<DPP_X1>(v); v += dpp_mov<DPP_X2>(v); v += dpp_mov<DPP_HM>(v); v += dpp_mov<DPP_RM>(v);
    const float r0 = __builtin_bit_cast(float, __builtin_amdgcn_readlane(__builtin_bit_cast(int, v), 0)), r1 = __builtin_bit_cast(float, __builtin_amdgcn_readlane(__builtin_bit_cast(int, v), 16)),
                r2 = __builtin_bit_cast(float, __builtin_amdgcn_readlane(__builtin_bit_cast(int, v), 32)), r3 = __builtin_bit_cast(float, __builtin_amdgcn_readlane(__builtin_bit_cast(int, v), 48));
    return (r0 + r1) + (r2 + r3);
}
__device__ __forceinline__ int wave_sum_i(int v) {
    v += __builtin_amdgcn_update_dpp(0, v, DPP_X1, 0xf, 0xf, true); v += __builtin_amdgcn_update_dpp(0, v, DPP_X2, 0xf, 0xf, true);
    v += __builtin_amdgcn_update_dpp(0, v, DPP_HM, 0xf, 0xf, true); v += __builtin_amdgcn_update_dpp(0, v, DPP_RM, 0xf, 0xf, true);
    return (__builtin_amdgcn_readlane(v, 0) + __builtin_amdgcn_readlane(v, 16)) + (__builtin_amdgcn_readlane(v, 32) + __builtin_amdgcn_readlane(v, 48));
}
__device__ __forceinline__ float fast_exp2(float x) { return __builtin_amdgcn_exp2f(x); }
__device__ __forceinline__ float sigmoidf_(float x) { return __builtin_amdgcn_rcpf(1.0f + __expf(-x)); }

#define XB_TMO      128
#define XB_XCNT(j)  (256  + 64 * (j))
#define XB_XSUB(j)  (1280 + 64 * (j))
#define XB_XGEN(j)  (2304 + 64 * (j))
#define XB_TOP      3328
#define XB_TOPGEN   3392
#define XCD_BAR_WORDS 3456
#define XB_SPIN_CAP (1u << 22)
__device__ __forceinline__ unsigned xb_ld(unsigned* p)              { return __hip_atomic_load(p, __ATOMIC_RELAXED, __HIP_MEMORY_SCOPE_AGENT); }
__device__ __forceinline__ unsigned xb_add(unsigned* p, unsigned v) { return __hip_atomic_fetch_add(p, v, __ATOMIC_RELAXED, __HIP_MEMORY_SCOPE_AGENT); }
__device__ __forceinline__ unsigned xb_xcc_id() { return (unsigned)__builtin_amdgcn_s_getreg((3 << 11) | 20) & 0xFu; }
#define XB_SPIN(cond, bar) do { unsigned _sp = 0; while (cond) { __builtin_amdgcn_s_sleep(1); \
    if ((++_sp & 255u) == 0u) { if (xb_ld(&(bar)[XB_TMO])) break; if (_sp > XB_SPIN_CAP) { atomicAdd(&(bar)[XB_TMO], 1u); break; } } } } while (0)
struct XcdBarrier { unsigned* bar; unsigned x; volatile LAS unsigned* st; };
__device__ __forceinline__ XcdBarrier xcd_barrier_post(unsigned* bar, volatile LAS unsigned* st) {
    XcdBarrier b; b.bar = bar; b.x = xb_xcc_id(); b.st = st;
    if (threadIdx.x == 0) (void)xb_add(&bar[XB_XCNT(b.x)], 1u);
    return b;
}
__device__ __forceinline__ void xcd_barrier_complete(unsigned* bar, unsigned x, unsigned& nloc, unsigned& nx) {
    const unsigned G = gridDim.x * gridDim.y * gridDim.z;
    unsigned sum, cnt, mine, sp = 0u;
    for (;;) {
        sum = 0u; cnt = 0u; mine = 0u;
#pragma unroll
        for (unsigned j = 0; j < 16; ++j) { const unsigned c = xb_ld(&bar[XB_XCNT(j)]); sum += c; cnt += (c > 0u) ? 1u : 0u; mine = (j == x) ? c : mine; }
        if (sum == G) break;
        __builtin_amdgcn_s_sleep(1);
        if ((++sp & 255u) == 0u) { if (xb_ld(&bar[XB_TMO])) break; if (sp > XB_SPIN_CAP) { atomicAdd(&bar[XB_TMO], 1u); break; } }
    }
    nloc = mine > 0u ? mine : 1u; nx = cnt > 0u ? cnt : 1u;
}
__device__ __forceinline__ void xcd_barrier(const XcdBarrier& b) {
    asm volatile("s_waitcnt vmcnt(0)" ::: "memory");
    __syncthreads();
    if (threadIdx.x == 0) {
        unsigned* bar = b.bar; unsigned bx = b.x; asm volatile("" : "+s"(bx)); asm volatile("" : "+s"(bar));
        __builtin_amdgcn_s_waitcnt(0);
        unsigned nloc = b.st[0], nx = b.st[1];
        if (nloc == 0u) { xcd_barrier_complete(bar, bx, nloc, nx); b.st[0] = nloc; b.st[1] = nx; }
        const unsigned old = xb_add(&bar[XB_XSUB(bx)], 1u);
        const unsigned gen = old / nloc;
        if (old + 1u == (gen + 1u) * nloc) {
            __builtin_amdgcn_fence(__ATOMIC_RELEASE, "agent");
            asm volatile("s_waitcnt vmcnt(0)" ::: "memory");
            const unsigned og = xb_add(&bar[XB_TOP], 1u);
            const unsigned tg = og / nx;
            if (og + 1u == (tg + 1u) * nx) xb_add(&bar[XB_TOPGEN], 1u);
            else XB_SPIN(xb_ld(&bar[XB_TOPGEN]) == tg, bar);
            __builtin_amdgcn_fence(__ATOMIC_ACQUIRE, "agent");
            xb_add(&bar[XB_XGEN(bx)], 1u);
            asm volatile("s_waitcnt vmcnt(0)" ::: "memory");
        } else {
            XB_SPIN(xb_ld(&bar[XB_XGEN(bx)]) == gen, bar);
            __builtin_amdgcn_fence(__ATOMIC_ACQUIRE, "agent");
            asm volatile("s_waitcnt vmcnt(0)" ::: "memory");
        }
    }
    __syncthreads();
}

namespace pg8 {
constexpr int BM = 256, BK = 64, HALF = 128, HTB = HALF * BK * 2, STAGE_BYTES = 8 * HTB, NXCD = 8, WGM = 8;
__host__ __device__ __forceinline__ int lds_byte(int r, int c) { const int st = (r >> 4) * 2 + (c >> 5), rr = r & 15, cc = c & 31, ob = rr * 64 + cc * 2; return st * 1024 + (ob ^ (((ob >> 9) & 1) << 5)); }
__host__ __device__ __forceinline__ void stage_rc(int b, int& R, int& C) { const int st = b / 1024, sb = b % 1024, swz = sb ^ (((sb >> 9) & 1) << 5); R = (st >> 1) * 16 + swz / 64; C = (st & 1) * 32 + (swz % 64) / 2; }
__host__ __device__ __forceinline__ int perm32(int rho) { const int n = rho >> 4, i = rho & 15; return 8 * (i >> 2) + 4 * n + (i & 3); }

struct Unit { int pm, pn, v, rb; };

__device__ __forceinline__ bool static_next(int nM, int nN, int G, int c, int i, Unit& u) {
    const int nwg = nM * nN; const long L = (long)i * G + c; if (L >= nwg) return false;
    int wgid = (int)L; { const int q = nwg / NXCD, r = nwg % NXCD, xcd = wgid % NXCD, off = wgid / NXCD; wgid = (xcd < r ? xcd * (q + 1) : r * (q + 1) + (xcd - r) * q) + off; }
    const int nig = WGM * nN, gid = wgid / nig, fm = gid * WGM, gsz = (nM - fm) < WGM ? (nM - fm) : WGM;
    u.pm = fm + ((wgid % nig) % gsz); u.pn = (wgid % nig) / gsz; u.v = 0; u.rb = 0; return true;
}
struct DenseSched {
    const char* A; const char* Bt; int lda, K, nM, nN, G, c;
    __device__ __forceinline__ bool next(int i, Unit& u) const { return static_next(nM, nN, G, c, i, u); }
    __device__ __forceinline__ const char* a_base(const Unit& u) const { return A + (size_t)u.pm * 256 * lda * 2; }
    __device__ __forceinline__ const char* b_base(const Unit& u) const { return Bt + (size_t)u.pn * 256 * K * 2; }
    __device__ __forceinline__ void a_off(const Unit&, const int (&R)[2], const int (&C)[2], unsigned (&o)[2][2]) const {
#pragma unroll
        for (int h = 0; h < 2; ++h)
#pragma unroll
            for (int i = 0; i < 2; ++i) o[h][i] = (unsigned)((h * 128 + R[i]) * lda + C[i]) * 2u;
    }
};

__device__ __forceinline__ unsigned cvt_pk_bf16(float lo, float hi) { unsigned r; asm volatile("v_cvt_pk_bf16_f32 %0, %1, %2" : "=v"(r) : "v"(lo), "v"(hi)); return r; }

template <class Epi, class Sched>
__device__ __forceinline__ void gemm_phase(LAS unsigned char* lds, const Sched& S, const Epi& E, int tid) {
    const int wid = __builtin_amdgcn_readfirstlane(tid >> 6), lane = tid & 63, wr = wid >> 2, wc = wid & 3, fr = lane & 15, fq = lane >> 4;
    const int K = S.K, nt = K / BK;
    int RR[2], CC[2]; unsigned voffB[2];
#pragma unroll
    for (int i = 0; i < 2; ++i) { int R, C; stage_rc(tid * 16 + i * 8192, R, C); const int Rb = Epi::PERM ? ((R & ~31) + perm32(R & 31)) : R;
        RR[i] = R; CC[i] = C; voffB[i] = (unsigned)(Rb * K + C) * 2u; }
    const size_t kstep = (size_t)(BK * 2);
    const size_t hstep = (size_t)HALF * K * 2;
    const unsigned ldsw = (unsigned)wid * 1024u;
    const int aoff = lds_byte(wr * 64 + fr, fq * 8), boff = lds_byte(wc * 32 + fr, fq * 8);
#define PG8_SA(b, h) (((b) * 2 + (h)) * HTB)
#define PG8_SB(b, h) ((4 + (b) * 2 + (h)) * HTB)
#define PG8_STAGE(bufoff, gbase, voff) do { _Pragma("unroll") for (int _i = 0; _i < 2; ++_i) \
        __builtin_amdgcn_global_load_lds((const unsigned*)((const char*)(gbase) + (voff)[_i]), (LAS unsigned*)(lds + (bufoff) + ldsw + _i * 8192), 16, 0, 0); } while (0)
#define PG8_LDA(dst, b, h) do { _Pragma("unroll") for (int m = 0; m < 4; ++m) _Pragma("unroll") for (int k = 0; k < 2; ++k) dst[m][k] = *(const LAS bf16x8*)(lds + PG8_SA(b, h) + aoff + m * 2048 + k * 1024); } while (0)
#define PG8_LDB(dst, b, h) do { _Pragma("unroll") for (int n = 0; n < 2; ++n) _Pragma("unroll") for (int k = 0; k < 2; ++k) dst[n][k] = *(const LAS bf16x8*)(lds + PG8_SB(b, h) + boff + n * 2048 + k * 1024); } while (0)
#define PG8_MMA(ai, bj, At, Bt) do { __builtin_amdgcn_s_setprio(1); _Pragma("unroll") for (int m = 0; m < 4; ++m) _Pragma("unroll") for (int n = 0; n < 2; ++n) _Pragma("unroll") for (int k = 0; k < 2; ++k) \
        acc[ai][bj][m][n] = __builtin_amdgcn_mfma_f32_16x16x32_bf16(Bt[n][k], At[m][k], acc[ai][bj][m][n], 0, 0, 0); __builtin_amdgcn_s_setprio(0); } while (0)
#define PG8_WAIT_V(n) asm volatile("s_waitcnt vmcnt(" #n ")" ::: "memory")
#define PG8_WAIT_L(n) asm volatile("s_waitcnt lgkmcnt(" #n ")" ::: "memory")
#define PG8_BAR __builtin_amdgcn_s_barrier()
#define PG8_SCHED __builtin_amdgcn_sched_barrier(0)
    Unit cur, nxt; int ui = 0;
    if (!S.next(0, cur)) return;
    f32x4 acc[2][2][4][2];
    float zz = 0.f; asm volatile("" : "+v"(zz));
#pragma unroll
    for (int a = 0; a < 2; ++a)
#pragma unroll
        for (int b = 0; b < 2; ++b)
#pragma unroll
            for (int m = 0; m < 4; ++m)
#pragma unroll
                for (int n = 0; n < 2; ++n) acc[a][b][m][n] = (f32x4){zz, zz, zz, zz};
    bf16x8 At[4][2], B0[2][2], B1[2][2];
    unsigned oa[2][2], on[2][2];
    S.a_off(cur, RR, CC, oa);
    const char* cA = S.a_base(cur); const char* cB = S.b_base(cur);
    PG8_STAGE(PG8_SB(0, 0), cB, voffB); PG8_STAGE(PG8_SB(0, 1), cB + hstep, voffB); PG8_STAGE(PG8_SA(0, 0), cA, oa[0]); PG8_STAGE(PG8_SA(0, 1), cA, oa[1]);
    if (wr == 1) PG8_BAR;
    PG8_WAIT_V(2); PG8_BAR;
    PG8_STAGE(PG8_SB(1, 0), cB + kstep, voffB); PG8_STAGE(PG8_SA(1, 0), cA + kstep, oa[0]); PG8_STAGE(PG8_SB(1, 1), cB + hstep + kstep, voffB);
    PG8_WAIT_V(6); PG8_BAR;
    for (;;) {
        const bool has_next = S.next(ui + 1, nxt);
        const char* nA = has_next ? S.a_base(nxt) : cA; const char* nB = has_next ? S.b_base(nxt) : cB;
        if (has_next) S.a_off(nxt, RR, CC, on);
        else {
#pragma unroll
            for (int h = 0; h < 2; ++h)
#pragma unroll
                for (int i = 0; i < 2; ++i) on[h][i] = oa[h][i];
        }
        for (int t = 0; t < nt; t += 2) {
            const bool last = (t == nt - 2);
            const char* a1 = cA + (size_t)(t + 1) * kstep;
            const char* a2 = last ? nA : cA + (size_t)(t + 2) * kstep; const char* b2 = last ? nB : cB + (size_t)(t + 2) * kstep;
            const char* a3 = a2 + kstep; const char* b3 = b2 + kstep;
            unsigned x0[2], x1[2];
#pragma unroll
            for (int i = 0; i < 2; ++i) { x0[i] = last ? on[0][i] : oa[0][i]; x1[i] = last ? on[1][i] : oa[1][i]; }
            PG8_LDB(B0, 0, 0); PG8_LDB(B1, 0, 1); PG8_SCHED; PG8_LDA(At, 0, 0); PG8_STAGE(PG8_SA(1, 1), a1, oa[1]);
            PG8_WAIT_V(8); PG8_WAIT_L(0); PG8_BAR; PG8_MMA(0, 0, At, B0); PG8_MMA(0, 1, At, B1); PG8_BAR; PG8_SCHED;
            PG8_LDA(At, 0, 1); PG8_STAGE(PG8_SB(0, 0), b2, voffB); PG8_STAGE(PG8_SB(0, 1), b2 + hstep, voffB); PG8_STAGE(PG8_SA(0, 0), a2, x0);
            PG8_WAIT_V(8); PG8_WAIT_L(0); PG8_BAR; PG8_MMA(1, 0, At, B0); PG8_MMA(1, 1, At, B1); PG8_BAR; PG8_SCHED;
            PG8_LDB(B0, 1, 0); PG8_LDB(B1, 1, 1); PG8_SCHED; PG8_LDA(At, 1, 0); PG8_STAGE(PG8_SA(0, 1), a2, x1);
            PG8_WAIT_V(8); PG8_WAIT_L(0); PG8_BAR; PG8_MMA(0, 0, At, B0); PG8_MMA(0, 1, At, B1); PG8_BAR; PG8_SCHED;
            PG8_LDA(At, 1, 1); PG8_STAGE(PG8_SB(1, 0), b3, voffB); PG8_STAGE(PG8_SB(1, 1), b3 + hstep, voffB); PG8_STAGE(PG8_SA(1, 0), a3, x0);
            PG8_WAIT_V(8); PG8_WAIT_L(0); PG8_BAR; PG8_MMA(1, 0, At, B0); PG8_MMA(1, 1, At, B1); PG8_BAR; PG8_SCHED;
        }
        if (wr == 0) PG8_BAR;
        E(acc, cur, wr, wc, fr, fq);
        if (!has_next) break;
#pragma unroll
        for (int a = 0; a < 2; ++a)
#pragma unroll
            for (int b = 0; b < 2; ++b)
#pragma unroll
                for (int m = 0; m < 4; ++m)
#pragma unroll
                    for (int n = 0; n < 2; ++n) acc[a][b][m][n] = (f32x4){zz, zz, zz, zz};
        cur = nxt; cA = nA; cB = nB; ++ui;
#pragma unroll
        for (int h = 0; h < 2; ++h)
#pragma unroll
            for (int i = 0; i < 2; ++i) oa[h][i] = on[h][i];
        if (wr == 1) PG8_BAR;
    }
    PG8_WAIT_V(0);
    PG8_BAR;
#undef PG8_SA
#undef PG8_SB
#undef PG8_STAGE
#undef PG8_LDA
#undef PG8_LDB
#undef PG8_MMA
#undef PG8_WAIT_V
#undef PG8_WAIT_L
#undef PG8_BAR
#undef PG8_SCHED
}
}

using pg8::Unit;
__device__ __forceinline__ u32x4 pack8(f32x4 a, f32x4 b) { u32x4 w; w.x = pg8::cvt_pk_bf16(a[0], a[1]); w.y = pg8::cvt_pk_bf16(a[2], a[3]); w.z = pg8::cvt_pk_bf16(b[0], b[1]); w.w = pg8::cvt_pk_bf16(b[2], b[3]); return w; }

struct EpiInEven {
    static constexpr bool PERM = true;
    bf16_t* H; const float* cosT; const float* sinT;
    __device__ __forceinline__ void operator()(const f32x4 (&acc)[2][2][4][2], const Unit& u, int wr, int wc, int fr, int fq) const {
        const int row0 = u.pm * 256 + wr * 64 + fr, col0 = u.pn * 256 + wc * 32 + 8 * fq;
        const bool rope = u.pn < 7; const int j0 = (wc & 1) * 16 + 4 * fq;
#pragma unroll
        for (int ai = 0; ai < 2; ++ai) {
            f32x4 cs[4], sn[4];
#pragma unroll
            for (int m = 0; m < 4; ++m) { const int pos = (row0 + ai * 128 + m * 16) & (SEQ - 1);
                cs[m] = (f32x4){1.f, 1.f, 1.f, 1.f}; sn[m] = (f32x4){0.f, 0.f, 0.f, 0.f};
                if (rope) { cs[m] = *(const f32x4*)(cosT + pos * 32 + j0); sn[m] = *(const f32x4*)(sinT + pos * 32 + j0); } }
#pragma unroll
            for (int m = 0; m < 4; ++m) {
                const int row = row0 + ai * 128 + m * 16; const f32x4 c = cs[m], z = sn[m];
                bf16_t* rowp = H + (size_t)row * NE_PAD + col0;
#pragma unroll
                for (int bj = 0; bj < 2; ++bj) {
                    const f32x4 v0 = acc[ai][bj][m][0], v1 = acc[ai][bj][m][1];
                    f32x4 o0, o1;
                    o0[0] = v0[0] * c[0] - v0[1] * z[0]; o0[1] = v0[1] * c[0] + v0[0] * z[0];
                    o0[2] = v0[2] * c[1] - v0[3] * z[1]; o0[3] = v0[3] * c[1] + v0[2] * z[1];
                    o1[0] = v1[0] * c[2] - v1[1] * z[2]; o1[1] = v1[1] * c[2] + v1[0] * z[2];
                    o1[2] = v1[2] * c[3] - v1[3] * z[3]; o1[3] = v1[3] * c[3] + v1[2] * z[3];
                    *(u32x4*)(rowp + bj * 128) = pack8(o0, o1);
                }
            }
        }
    }
};
struct EpiInOdd {
    static constexpr bool PERM = true;
    bf16_t* H; float* logf; const float* bf;
    __device__ __forceinline__ void operator()(const f32x4 (&acc)[2][2][4][2], const Unit& u, int wr, int wc, int fr, int fq) const {
        const int row0 = u.pm * 256 + wr * 64 + fr, col0 = u.pn * 256 + wc * 32 + 8 * fq;
        float zz = 0.f; asm volatile("" : "+v"(zz));
#pragma unroll
        for (int ai = 0; ai < 2; ++ai)
#pragma unroll
            for (int m = 0; m < 4; ++m) {
                const int row = row0 + ai * 128 + m * 16;
                bf16_t* rowp = H + (size_t)row * NO_PAD + col0;
#pragma unroll
                for (int bj = 0; bj < 2; ++bj) *(u32x4*)(rowp + bj * 128) = pack8(acc[ai][bj][m][0] + zz, acc[ai][bj][m][1] + zz);
                if (u.pn == 12 && wc == 0 && fq < 2) {
                    f32x4 r0, r1;
#pragma unroll
                    for (int j = 0; j < 4; ++j) {
                        const float x0 = acc[ai][0][m][0][j] + bf[8 * fq + j], x1 = acc[ai][0][m][1][j] + bf[8 * fq + 4 + j];
                        r0[j] = fminf(x0, 0.f) - log1pf(__expf(-fabsf(x0))); r1[j] = fminf(x1, 0.f) - log1pf(__expf(-fabsf(x1)));
                    }
                    *(f32x4*)(logf + (size_t)row * 16 + 8 * fq) = r0; *(f32x4*)(logf + (size_t)row * 16 + 8 * fq + 4) = r1;
                }
                asm volatile("" ::: "memory");
            }
    }
};
struct EpiOut {
    static constexpr bool PERM = true;
    const bf16_t* X; bf16_t* Y;
    __device__ __forceinline__ void operator()(const f32x4 (&acc)[2][2][4][2], const Unit& u, int wr, int wc, int fr, int fq) const {
        const int row0 = u.pm * 256 + wr * 64 + fr, col0 = u.pn * 256 + wc * 32 + 8 * fq;
#pragma unroll
        for (int ai = 0; ai < 2; ++ai) {
            u32x4 x[4][2];
#pragma unroll
            for (int m = 0; m < 4; ++m) { const size_t off = (size_t)(row0 + ai * 128 + m * 16) * DM + col0;
#pragma unroll
                for (int bj = 0; bj < 2; ++bj) x[m][bj] = *(const u32x4*)(X + off + bj * 128); }
#pragma unroll
            for (int m = 0; m < 4; ++m) { const size_t off = (size_t)(row0 + ai * 128 + m * 16) * DM + col0;
#pragma unroll
                for (int bj = 0; bj < 2; ++bj) { const u32x4 w = x[m][bj]; const f32x4 a0 = acc[ai][bj][m][0], a1 = acc[ai][bj][m][1];
                    const f32x4 o0 = {bflo(w.x) * ALPHA + a0[0], bfhi(w.x) * ALPHA + a0[1], bflo(w.y) * ALPHA + a0[2], bfhi(w.y) * ALPHA + a0[3]};
                    const f32x4 o1 = {bflo(w.z) * ALPHA + a1[0], bfhi(w.z) * ALPHA + a1[1], bflo(w.w) * ALPHA + a1[2], bfhi(w.w) * ALPHA + a1[3]};
                    *(u32x4*)(Y + off + bj * 128) = pack8(o0, o1); } }
        }
    }
};
struct EpiUp {
    static constexpr bool PERM = false;
    bf16_t* Hm;
    __device__ __forceinline__ void operator()(const f32x4 (&acc)[2][2][4][2], const Unit& u, int wr, int wc, int fr, int fq) const {
        const int row0 = u.pm * 256 + wr * 64 + fr, col0 = u.pn * 128 + wc * 16 + 4 * fq;
#pragma unroll
        for (int ai = 0; ai < 2; ++ai)
#pragma unroll
            for (int m = 0; m < 4; ++m) {
                bf16_t* rowp = Hm + (size_t)(row0 + ai * 128 + m * 16) * DFF + col0;
#pragma unroll
                for (int bj = 0; bj < 2; ++bj) {
                    const f32x4 a = acc[ai][bj][m][0], b = acc[ai][bj][m][1]; f32x4 h;
#pragma unroll
                    for (int j = 0; j < 4; ++j) h[j] = a[j] * b[j] * __builtin_amdgcn_rcpf(1.0f + fast_exp2(-a[j] * LOG2E));
                    u32x2 w; w.x = pg8::cvt_pk_bf16(h[0], h[1]); w.y = pg8::cvt_pk_bf16(h[2], h[3]);
                    *(u32x2*)(rowp + bj * 64) = w;
                }
            }
    }
};
struct EpiDown {
    static constexpr bool PERM = true;
    bf16_t* Y; const int* slot_tk; const float* slot_g; const LAS int* cnt; bool dense; LAS int* rc;
    __device__ __forceinline__ void operator()(const f32x4 (&acc)[2][2][4][2], const Unit& u, int wr, int wc, int fr, int fq) const {
        const int e = u.v % 65, half = u.v / 65, n = cnt[u.v];
        const int col0 = u.pn * 256 + wc * 32 + 8 * fq;
        int drow[8]; float gg[8];
        const int tagv = u.v * 4096 + u.rb + 1;
        const bool hit = !dense && (rc[wr] == tagv);
        if (hit) {
#pragma unroll
            for (int i = 0; i < 8; ++i) { const int rl = (i >> 2) * 128 + wr * 64 + (i & 3) * 16 + fr; drow[i] = rc[16 + 2 * rl]; gg[i] = __builtin_bit_cast(float, rc[16 + 2 * rl + 1]); }
        } else {
#pragma unroll
            for (int i = 0; i < 8; ++i) {
                const int pos = u.rb * 256 + (i >> 2) * 128 + wr * 64 + (i & 3) * 16 + fr;
                drow[i] = -1; gg[i] = 1.f;
                if (dense) { drow[i] = (u.pm & 63) * 256 + (i >> 2) * 128 + wr * 64 + (i & 3) * 16 + fr; }
                else if (pos < n) {
                    if (e == 64) drow[i] = (half * HALF_T + pos) * 9 + 8;
                    else { const int tk = slot_tk[(size_t)u.v * HALF_T + pos]; gg[i] = slot_g[(size_t)u.v * HALF_T + pos]; drow[i] = (tk >> 3) * 9 + (tk & 7); }
                }
            }
            if (!dense && wc == 0) {
                if (fq == 0) {
#pragma unroll
                    for (int i = 0; i < 8; ++i) { const int rl = (i >> 2) * 128 + wr * 64 + (i & 3) * 16 + fr; rc[16 + 2 * rl] = drow[i]; rc[16 + 2 * rl + 1] = __builtin_bit_cast(int, gg[i]); } }
                asm volatile("s_waitcnt lgkmcnt(0)" ::: "memory");
                if (fq == 0 && fr == 0) rc[wr] = tagv;
            }
        }
#pragma unroll
        for (int ai = 0; ai < 2; ++ai)
#pragma unroll
            for (int m = 0; m < 4; ++m) {
                const int i = ai * 4 + m;
                if (drow[i] >= 0) {
#if Y_FP8
                    const float g = gg[i] * 32.0f; unsigned char* rowp = (unsigned char*)Y + (size_t)drow[i] * DM + col0;
#pragma unroll
                    for (int bj = 0; bj < 2; ++bj) { f32x4 v0 = acc[ai][bj][m][0] * g, v1 = acc[ai][bj][m][1] * g; u32x2 w;
#pragma unroll
                        for (int q = 0; q < 4; ++q) { v0[q] = __builtin_amdgcn_fmed3f(v0[q], -416.0f, 416.0f); v1[q] = __builtin_amdgcn_fmed3f(v1[q], -416.0f, 416.0f); }
                        w.x = __builtin_amdgcn_cvt_pk_fp8_f32(v0[0], v0[1], 0u, false); w.x = __builtin_amdgcn_cvt_pk_fp8_f32(v0[2], v0[3], w.x, true);
                        w.y = __builtin_amdgcn_cvt_pk_fp8_f32(v1[0], v1[1], 0u, false); w.y = __builtin_amdgcn_cvt_pk_fp8_f32(v1[2], v1[3], w.y, true);
                        *(u32x2*)(rowp + bj * 128) = w; }
#else
                    const float g = gg[i]; bf16_t* rowp = Y + (size_t)drow[i] * DM + col0;
#pragma unroll
                    for (int bj = 0; bj < 2; ++bj) *(u32x4*)(rowp + bj * 128) = pack8(acc[ai][bj][m][0] * g, acc[ai][bj][m][1] * g);
#endif
                }
            }
    }
};
struct EpiPleE {
    static constexpr bool PERM = true;
    bf16_t* E; float* ssq;
    __device__ __forceinline__ void operator()(const f32x4 (&acc)[2][2][4][2], const Unit& u, int wr, int wc, int fr, int fq) const {
        const int row0 = u.pm * 256 + wr * 64 + fr, col0 = u.pn * 256 + wc * 32 + 8 * fq;
        float zz = 0.f; asm volatile("" : "+v"(zz));
#pragma unroll
        for (int ai = 0; ai < 2; ++ai)
#pragma unroll
            for (int m = 0; m < 4; ++m) {
                const int row = row0 + ai * 128 + m * 16;
                bf16_t* rowp = E + (size_t)row * DM + col0; float s = 0.f;
#pragma unroll
                for (int bj = 0; bj < 2; ++bj) {
                    const f32x4 a = acc[ai][bj][m][0] + zz, b = acc[ai][bj][m][1] + zz;
                    s += (a[0] * a[0] + a[1] * a[1]) + (a[2] * a[2] + a[3] * a[3]) + (b[0] * b[0] + b[1] * b[1]) + (b[2] * b[2] + b[3] * b[3]);
                    *(u32x4*)(rowp + bj * 128) = pack8(a, b);
                }
                s = sum_x16(s, fr + 16 * fq); s = sum_x32(s, fr + 16 * fq);
                if (fq == 0) ssq[(size_t)row * 16 + u.pn * 4 + wc] = s;
                asm volatile("" ::: "memory");
            }
    }
};
struct EpiPleG {
    static constexpr bool PERM = true;
    const bf16_t* X; const bf16_t* E; const float* ssq; const float* g; bf16_t* XO; float* OUTF;
    __device__ __forceinline__ void operator()(const f32x4 (&acc)[2][2][4][2], const Unit& u, int wr, int wc, int fr, int fq) const {
        const int row0 = u.pm * 256 + wr * 64 + fr, col0 = u.pn * 256 + wc * 32 + 8 * fq, lane = fr + 16 * fq;
#pragma unroll
        for (int ai = 0; ai < 2; ++ai)
#pragma unroll
            for (int mp = 0; mp < 2; ++mp) {
                u32x4 x[2][2], ew[2][2]; f32x4 sq[2];
#pragma unroll
                for (int mm = 0; mm < 2; ++mm) { const int row = row0 + ai * 128 + (2 * mp + mm) * 16; const size_t off = (size_t)row * DM + col0;
                    sq[mm] = *(const f32x4*)(ssq + (size_t)row * 16 + 4 * fq);
#pragma unroll
                    for (int bj = 0; bj < 2; ++bj) { x[mm][bj] = *(const u32x4*)(X + off + bj * 128); ew[mm][bj] = *(const u32x4*)(E + off + bj * 128); } }
#pragma unroll
                for (int mm = 0; mm < 2; ++mm) { const int m = 2 * mp + mm; const size_t off = (size_t)(row0 + ai * 128 + m * 16) * DM + col0;
                    float t = (sq[mm][0] + sq[mm][1]) + (sq[mm][2] + sq[mm][3]); t = sum_x16(t, lane); t = sum_x32(t, lane); const float r = 1.0f / sqrtf(t * (1.0f / DM) + RMS_EPS);
#pragma unroll
                    for (int bj = 0; bj < 2; ++bj) { const u32x4 xw = x[mm][bj], e = ew[mm][bj]; const f32x4 a0 = acc[ai][bj][m][0], a1 = acc[ai][bj][m][1];
                        const f32x4 g0 = *(const f32x4*)(g + col0 + bj * 128), g1 = *(const f32x4*)(g + col0 + bj * 128 + 4);
                        f32x4 o0, o1;
                        o0[0] = bflo(xw.x) + sigmoidf_(a0[0]) * (bflo(e.x) * r) * g0[0]; o0[1] = bfhi(xw.x) + sigmoidf_(a0[1]) * (bfhi(e.x) * r) * g0[1];
                        o0[2] = bflo(xw.y) + sigmoidf_(a0[2]) * (bflo(e.y) * r) * g0[2]; o0[3] = bfhi(xw.y) + sigmoidf_(a0[3]) * (bfhi(e.y) * r) * g0[3];
                        o1[0] = bflo(xw.z) + sigmoidf_(a1[0]) * (bflo(e.z) * r) * g1[0]; o1[1] = bfhi(xw.z) + sigmoidf_(a1[1]) * (bfhi(e.z) * r) * g1[1];
                        o1[2] = bflo(xw.w) + sigmoidf_(a1[2]) * (bflo(e.w) * r) * g1[2]; o1[3] = bfhi(xw.w) + sigmoidf_(a1[3]) * (bfhi(e.w) * r) * g1[3];
                        if (XO) *(u32x4*)(XO + off + bj * 128) = pack8(o0, o1);
                        if (OUTF) { *(f32x4*)(OUTF + off + bj * 128) = o0; *(f32x4*)(OUTF + off + bj * 128 + 4) = o1; } } }
            }
    }
};

struct MoeSched {
    const char* A; const char* W; int lda, K, npn; size_t wstride;
    const LAS int* rbs; const LAS int* cnt; int vlo, vhi, rb0, nunits, G, c; const int* slot_tk; bool gather; int gxl;
    __device__ __forceinline__ bool next(int i, Unit& u) const {
        const int nrb = nunits / npn;
        if ((G & 7) != 0) { const int r2 = (i / npn) * G + c; if (r2 >= nrb) return false; u.pn = i % npn; return finish(rb0 + r2, u); }
        const int chunk = (nrb + 7) >> 3, gx = gxl, x = c & 7, j = c >> 3;
        if (j >= gx) return false;
        int clen = nrb - x * chunk; clen = clen < 0 ? 0 : (clen > chunk ? chunk : clen);
        const int fr = clen / gx, ifull = fr * npn;
        int li, pn;
        if (i < ifull) { li = j + (i / npn) * gx; pn = i % npn; }
        else { const int q = (i - ifull) * gx + j; if (q >= (clen - fr * gx) * npn) return false;
               li = fr * gx + q / npn; pn = q % npn; }
        u.pn = pn; return finish(rb0 + x * chunk + li, u);
    }
    __device__ __forceinline__ bool finish(int rbg, Unit& u) const {
        int lo = vlo, hi = vhi;
        while (lo < hi) { const int mid = (lo + hi + 1) >> 1; if (rbs[mid] <= rbg) lo = mid; else hi = mid - 1; }
        u.v = lo; u.rb = rbg - rbs[lo]; u.pm = rbg; return true;
    }
    __device__ __forceinline__ const char* a_base(const Unit& u) const { return gather ? A : A + (size_t)u.pm * 256 * lda * 2; }
    __device__ __forceinline__ const char* b_base(const Unit& u) const { return W + (size_t)(u.v % 65) * wstride + (size_t)u.pn * 256 * K * 2; }
    __device__ __forceinline__ void a_off(const Unit& u, const int (&R)[2], const int (&C)[2], unsigned (&o)[2][2]) const {
        if (gather) {
            const int e = u.v % 65, half = u.v / 65, n = cnt[u.v];
#pragma unroll
            for (int h = 0; h < 2; ++h)
#pragma unroll
                for (int i = 0; i < 2; ++i) {
                    const int pos = u.rb * 256 + h * 128 + R[i]; int tok;
                    if (e == 64) tok = half * HALF_T + pos;
                    else tok = pos < n ? (slot_tk[(size_t)u.v * HALF_T + pos] >> 3) : 0;
                    o[h][i] = (unsigned)(tok * lda + C[i]) * 2u;
                    asm volatile("" : "+v"(o[h][i]));
                }
        } else {
#pragma unroll
            for (int h = 0; h < 2; ++h)
#pragma unroll
                for (int i = 0; i < 2; ++i) o[h][i] = (unsigned)((h * 128 + R[i]) * lda + C[i]) * 2u;
        }
    }
};

struct Args {
    const float* in[29]; float* out; unsigned char* ws; int ph_lo, ph_hi;
};
enum InIdx { I_X = 0, I_P, I_EV_WIN, I_EV_BGATE, I_CPK, I_CW1K, I_CW2K, I_CPV, I_CW1V, I_CW2V, I_EV_WO, I_OD_WIN, I_OD_BF, I_OD_WO,
             I_LN1G, I_LN1B, I_LN2G, I_LN2B, I_RW, I_RB, I_EW1, I_EW3, I_EW2, I_SW1, I_SW3, I_SW2, I_PWG, I_PWP, I_PNG };
__device__ __forceinline__ size_t wbuf_off(int layer) { int p = __builtin_amdgcn_readfirstlane(layer & 1); asm volatile("" : "+s"(p)); return (size_t)p * W_BUF; }
struct Frame {
    LAS unsigned char* lds; int tid, lane, wave, G, bid;
    unsigned char* ws; gu32* ctl;
};

__device__ __forceinline__ int rope_perm(int d) { return 2 * (d & 31) + (d >> 5); }
__device__ __forceinline__ int map_even(int c) {
    if (c < 512) return EC_QA + (c & ~63) + rope_perm(c & 63);
    if (c < 576) return EC_KA + rope_perm(c - 512);
    if (c < 640) return EC_VA + (c - 576);
    if (c < 1152) { const int r = c - 640; return EC_QI + (r & ~63) + rope_perm(r & 63); }
    if (c < 1216) return EC_KI + rope_perm(c - 1152);
    if (c < 1224) return EC_WI + (c - 1216);
    if (c < 1736) { const int r = c - 1224; return EC_QB + (r & ~63) + rope_perm(r & 63); }
    if (c < 2120) { const int r = c - 1736, j = r >> 6, d = r & 63;
        switch (j) { case 0: return EC_KC + d; case 1: return EC_VC + d; case 2: return EC_KS + rope_perm(d); case 3: return EC_VS + d; case 4: return EC_KW + rope_perm(d); default: return EC_VW + d; } }
    return EC_GB + (c - 2120);
}
enum MapId { MAP_ID = 0, MAP_EVEN, MAP_W1, MAP_W3, MAP_ROPE };
__device__ __forceinline__ int map_col(int id, int c) {
    switch (id) { case MAP_EVEN: return map_even(c); case MAP_W1: return 32 * (c >> 4) + (c & 15); case MAP_W3: return 32 * (c >> 4) + 16 + (c & 15); case MAP_ROPE: return rope_perm(c); default: return c; }
}
__device__ __forceinline__ void tr_load(f32x4 (&v)[16], const float* src, int ldn, int ncols, int k0, int n0, int lane) {
    const int cq = 4 * (lane & 15), rq = lane >> 4;
    const bool full = (n0 + 64 <= ncols);
#pragma unroll
    for (int i = 0; i < 16; ++i) {
        const float* p = src + (size_t)(k0 + 4 * i + rq) * ldn + n0 + cq;
        if (full) v[i] = *(const f32x4*)p;
        else { v[i][0] = (n0 + cq + 0 < ncols) ? p[0] : 0.f; v[i][1] = (n0 + cq + 1 < ncols) ? p[1] : 0.f; v[i][2] = (n0 + cq + 2 < ncols) ? p[2] : 0.f; v[i][3] = (n0 + cq + 3 < ncols) ? p[3] : 0.f; }
    }
}
__device__ __forceinline__ void tr_finish(const f32x4 (&v)[16], int ncols, bf16_t* dst, int dpitch, int k0, int n0, int mapid, LAS unsigned short* scr, int lane, const float* rscale, bool lo) {
    const int cq = 4 * (lane & 15), rq = lane >> 4;
    if (rscale == nullptr && !lo) {
#pragma unroll
        for (int i = 0; i < 16; ++i) {
#pragma unroll
            for (int j = 0; j < 4; ++j) scr[(cq + j) * 72 + 4 * i + rq] = (unsigned short)f2bf(v[i][j]); }
    } else {
#pragma unroll
        for (int i = 0; i < 16; ++i) {
            const int k = 4 * i + rq; const float rs = rscale ? rscale[k0 + k] : 1.f;
#pragma unroll
            for (int j = 0; j < 4; ++j) { float x = v[i][j] * rs; if (lo) x -= bf2f((unsigned short)f2bf(x));
                scr[(cq + j) * 72 + k] = (unsigned short)f2bf(x); }
        }
    }
    LDS_WAIT(); asm volatile("" ::: "memory");
    const int c = lane & 7;
#pragma unroll
    for (int j = 0; j < 8; ++j) { const int nl = (lane >> 3) + 8 * j, n = n0 + nl;
        const u32x4 o = *(const LAS u32x4*)(scr + nl * 72 + 8 * c);
        if (n < ncols) *(u32x4*)(dst + (size_t)map_col(mapid, n) * dpitch + k0 + 8 * c) = o; }
    LDS_WAIT(); asm volatile("" ::: "memory");
}
__device__ __forceinline__ void tr_item(const float* src, int ldn, int ncols, bf16_t* dst, int dpitch, int k0, int n0, int mapid, LAS unsigned short* scr, int lane, const float* rscale = nullptr, bool lo = false) {
    f32x4 v[16]; tr_load(v, src, ldn, ncols, k0, n0, lane); tr_finish(v, ncols, dst, dpitch, k0, n0, mapid, scr, lane, rscale, lo);
}
__device__ __forceinline__ void sincos_d(double a, float& s, float& c) {
    const double TWO_PI = 6.283185307179586476925286766559, INV = 0.15915494309189533576888376337251;
    const double k = rint(a * INV); double r = a - k * TWO_PI;
    const double r2 = r * r; double ts = 1.0, tc = 1.0;
#pragma unroll
    for (int i = 14; i >= 1; --i) { ts = 1.0 - ts * r2 / (double)((2 * i) * (2 * i + 1)); tc = 1.0 - tc * r2 / (double)((2 * i - 1) * (2 * i)); }
    s = (float)(r * ts); c = (float)tc;
}

struct TrJob { const float* src; bf16_t* dst; int K, N, ldn, dpitch, mapid; const float* rscale; int lo; };
__device__ __forceinline__ TrJob get_job(const Args& a, unsigned char* wsp, int layer, int jid) {
    const int j = layer >> 1; const bool even = (layer & 1) == 0;
    bf16_t* W = (bf16_t*)(wsp + WS_W + wbuf_off(layer));
    TrJob t; t.mapid = MAP_ID; t.rscale = nullptr; t.lo = 0;
    if (jid == 0) { if (even) { t.src = a.in[I_EV_WIN] + (size_t)j * DM * EVEN_COLS; t.N = EVEN_COLS; t.mapid = MAP_EVEN; } else { t.src = a.in[I_OD_WIN] + (size_t)j * DM * ODD_COLS; t.N = ODD_COLS; }
        t.K = DM; t.ldn = t.N; t.dst = W + W_IN / 2; t.dpitch = DM; return t; }
    if (jid == 1) { t.src = (even ? a.in[I_EV_WO] : a.in[I_OD_WO]) + (size_t)j * DM * DM; t.K = DM; t.N = DM; t.ldn = DM; t.dst = W + W_O / 2; t.dpitch = DM; return t; }
    if (jid == 2) { t.src = a.in[I_PWG] + (size_t)layer * DM * DM; t.K = DM; t.N = DM; t.ldn = DM; t.dst = W + W_G / 2; t.dpitch = DM; return t; }
    if (jid == 3) { t.src = a.in[I_PWP] + (size_t)layer * 256 * DM; t.K = 256; t.N = DM; t.ldn = DM; t.dst = W + W_P / 2; t.dpitch = 256; return t; }
    if (jid < 8) {
        const int q = jid - 4;
        if (q == 0) { t.src = a.in[I_CW1K] + (size_t)j * 2048 * 64; t.K = 2048; t.dst = W + W_C1K / 2; t.dpitch = 2048; }
        else if (q == 1) { t.src = a.in[I_CW1V] + (size_t)j * 2048 * 64; t.K = 2048; t.dst = W + W_C1V / 2; t.dpitch = 2048; }
        else if (q == 2) { t.src = a.in[I_CW2K] + (size_t)j * 64 * 64; t.K = 64; t.dst = W + W_C2K / 2; t.dpitch = 64; t.mapid = MAP_ROPE; }
        else { t.src = a.in[I_CW2V] + (size_t)j * 64 * 64; t.K = 64; t.dst = W + W_C2V / 2; t.dpitch = 64; }
        t.N = 64; t.ldn = 64; return t; }
    if (jid < 10) {
        t.src = a.in[I_RW] + (size_t)layer * DM * NEXP; t.K = DM; t.N = NEXP; t.ldn = NEXP; t.dpitch = DM; t.rscale = a.in[I_LN1G] + layer * DM; t.lo = jid - 8; t.dst = W + (t.lo ? W_RL : W_RH) / 2; return t; }
    const int r = jid - 10, e = r / 3, w = r % 3;
    if (w < 2) { const float* s = (e == 64) ? a.in[w == 0 ? I_SW1 : I_SW3] + (size_t)layer * DM * DFF : a.in[w == 0 ? I_EW1 : I_EW3] + ((size_t)layer * NEXP + e) * DM * DFF;
        t.src = s; t.K = DM; t.N = DFF; t.ldn = DFF; t.dst = W + W_UP / 2 + (size_t)e * 512 * DM; t.dpitch = DM; t.mapid = (w == 0) ? MAP_W1 : MAP_W3; return t; }
    t.src = (e == 64) ? a.in[I_SW2] + (size_t)layer * DFF * DM : a.in[I_EW2] + ((size_t)layer * NEXP + e) * DFF * DM;
    t.K = DFF; t.N = DM; t.ldn = DM; t.dst = W + W_DN / 2 + (size_t)e * DM * DFF; t.dpitch = DFF; return t;
}
constexpr int NJOBS = 10 + 65 * 3;

__device__ __forceinline__ void prep_weights(const Frame& F, const Args& a, int layer, int wid, int nw) {
    const int gw = wid * 8 + F.wave, NGW = nw * 8, gt = wid * 512 + F.tid, NGT = nw * 512;
    LAS unsigned short* scr = (LAS unsigned short*)(F.lds + F.wave * 16384);
    int base = 0;
    for (int jid = 0; jid < 10; ++jid) {
        const TrJob jb = get_job(a, F.ws, layer, jid);
        const int nblk = (jb.N + 63) / 64, nit = (jb.K / 64) * nblk;
        int first = (gw - (base % NGW) + NGW) % NGW;
        for (int it = first; it < nit; it += 2 * NGW) {
            const int it2 = it + NGW; const bool two = it2 < nit;
            f32x4 va[16], vb[16];
            tr_load(va, jb.src, jb.ldn, jb.N, 64 * (it / nblk), 64 * (it % nblk), F.lane);
            if (two) tr_load(vb, jb.src, jb.ldn, jb.N, 64 * (it2 / nblk), 64 * (it2 % nblk), F.lane);
            tr_finish(va, jb.N, jb.dst, jb.dpitch, 64 * (it / nblk), 64 * (it % nblk), jb.mapid, scr, F.lane, jb.rscale, jb.lo != 0);
            if (two) tr_finish(vb, jb.N, jb.dst, jb.dpitch, 64 * (it2 / nblk), 64 * (it2 % nblk), jb.mapid, scr, F.lane, jb.rscale, jb.lo != 0);
        }
        base += nit;
    }
    {
        constexpr int NI = 65 * 3 * 64;
        int g = (gw - (base % NGW) + NGW) % NGW;
        f32x4 va[16], vb[16]; TrJob ja, jn;
#define EXP_LOAD(V, J, G) do { J = get_job(a, F.ws, layer, 10 + ((G) >> 6)); const int it_ = (G) & 63, sh_ = (J.N == 256) ? 2 : 4; tr_load(V, J.src, J.ldn, J.N, 64 * (it_ >> sh_), 64 * (it_ & ((1 << sh_) - 1)), F.lane); } while (0)
#define EXP_FIN(V, J, G) do { const int it_ = (G) & 63, sh_ = (J.N == 256) ? 2 : 4; tr_finish(V, J.N, J.dst, J.dpitch, 64 * (it_ >> sh_), 64 * (it_ & ((1 << sh_) - 1)), J.mapid, scr, F.lane, nullptr, false); } while (0)
        if (g < NI) EXP_LOAD(va, ja, g);
        while (g < NI) {
            const int g1 = g + NGW, g2 = g + 2 * NGW;
            if (g1 < NI) EXP_LOAD(vb, jn, g1);
            EXP_FIN(va, ja, g);
            if (g1 >= NI) break;
            if (g2 < NI) EXP_LOAD(va, ja, g2);
            EXP_FIN(vb, jn, g1);
            g = g2;
        }
#undef EXP_LOAD
#undef EXP_FIN
    }
    { const int r0 = (layer & 1) ? ODD_COLS : EVEN_COLS, r1 = (layer & 1) ? NO_PAD : NE_PAD; u32x4* z = (u32x4*)(F.ws + WS_W + wbuf_off(layer) + W_IN + (size_t)r0 * DM * 2);
      const int n16 = (r1 - r0) * DM * 2 / 16; unsigned zq = 0u; asm volatile("" : "+v"(zq)); for (int i = gt; i < n16; i += NGT) z[i] = (u32x4){zq, zq, zq, zq}; }
    if ((layer & 1) == 0 && wid < 2) {
        const int j = layer >> 1; const float* pe = a.in[wid == 0 ? I_CPK : I_CPV] + (size_t)j * 2048; const float* w1 = a.in[wid == 0 ? I_CW1K : I_CW1V] + (size_t)j * 2048 * 64;
        LAS float* red = (LAS float*)(F.lds + 8 * 16384);
        __syncthreads();
        const int n = F.tid & 63, part = F.tid >> 6; float s = 0.f;
        for (int k0 = part * 256; k0 < part * 256 + 256; k0 += 32) {
            float wv[32], pv[32];
#pragma unroll
            for (int q = 0; q < 32; ++q) { wv[q] = w1[(size_t)(k0 + q) * 64 + n]; pv[q] = pe[k0 + q]; }
#pragma unroll
            for (int q = 0; q < 32; ++q) s += pv[q] * wv[q]; }
        red[part * 64 + n] = s; __syncthreads();
        if (F.tid < 64) { float tot = 0.f; for (int q = 0; q < 8; ++q) tot += red[q * 64 + F.tid]; ((float*)(F.ws + WS_MISC))[wid * 64 + F.tid] = tot; }
        __syncthreads();
    }
}
__device__ __forceinline__ void prep_acts(const Frame& F, const Args& a, int layer, bool first) {
    const int gt = F.bid * 512 + F.tid, NGT = F.G * 512;
    { const f32x4* p = (const f32x4*)(a.in[I_P] + (size_t)layer * T * 256); u32x2* o = (u32x2*)(F.ws + WS_PB);
      for (int i = gt; i < T * 256 / 4; i += NGT) { const f32x4 v = p[i]; u32x2 w; w.x = pk2(v[0], v[1]); w.y = pk2(v[2], v[3]); o[i] = w; } }
    if (first) {
        const f32x4* x = (const f32x4*)a.in[I_X]; u32x2* o = (u32x2*)(F.ws + WS_XB);
        for (int i = gt; i < T * DM / 4; i += NGT) { const f32x4 v = x[i]; u32x2 w; w.x = pk2(v[0], v[1]); w.y = pk2(v[2], v[3]); o[i] = w; }
        float* ct = (float*)(F.ws + WS_ROPE_COS); float* st = (float*)(F.ws + WS_ROPE_SIN);
        for (int i = gt; i < SEQ * 32; i += NGT) { const int pos = i >> 5, j = i & 31; double inv = 1.0;
            for (int q = 0; q < j; ++q) inv *= 0.74989420933245582730;
            const float ang = (float)pos * (float)inv; float s, c; sincos_d((double)ang, s, c); ct[i] = c; st[i] = s; }
    }
    if (F.bid == F.G - 1) {
        const float* RW = a.in[I_RW] + (size_t)layer * DM * NEXP; const float* g1 = a.in[I_LN1G] + layer * DM; const float* b1 = a.in[I_LN1B] + layer * DM;
        LAS float* red = (LAS float*)(F.lds + 8 * 16384);
        __syncthreads();
        const int n = F.tid & 63, part = F.tid >> 6; float sc = 0.f, sb = 0.f;
        for (int k0 = part * 128; k0 < part * 128 + 128; k0 += 32) {
            float wv[32];
#pragma unroll
            for (int q = 0; q < 32; ++q) wv[q] = RW[(size_t)(k0 + q) * NEXP + n];
#pragma unroll
            for (int q = 0; q < 32; ++q) { sc += g1[k0 + q] * wv[q]; sb += b1[k0 + q] * wv[q]; } }
        red[part * 64 + n] = sc; red[512 + part * 64 + n] = sb; __syncthreads();
        if (F.tid < 128) { const int o = F.tid & 63, w = F.tid >> 6; float tot = 0.f; for (int q = 0; q < 8; ++q) tot += red[w * 512 + q * 64 + o]; ((float*)(F.ws + WS_MISC))[256 + F.tid] = tot; }
        __syncthreads();
    }
}

__device__ __forceinline__ void scan_phase(const Frame& F, const Args& a) {
    const float* lf = (const float*)(F.ws + WS_LOGF); float* dc = (float*)(F.ws + WS_DCUM);
    LAS float* wsum = (LAS float*)F.lds;
    for (int s = F.bid; s < NB * 16; s += F.G) {
        const int b = s >> 4, h = s & 15; const size_t base = ((size_t)b * SEQ) * 16 + h;
        float v[4]; float run = 0.f;
#pragma unroll
        for (int i = 0; i < 4; ++i) { run += lf[base + (size_t)(F.tid * 4 + i) * 16]; v[i] = run; }
        float inc = run;
        inc += dpp_mov<0x111>(inc); inc += dpp_mov<0x112>(inc); inc += dpp_mov<0x114>(inc); inc += dpp_mov<0x118>(inc);
        { const float r0 = __builtin_bit_cast(float, __builtin_amdgcn_readlane(__builtin_bit_cast(int, inc), 15)), r1 = __builtin_bit_cast(float, __builtin_amdgcn_readlane(__builtin_bit_cast(int, inc), 31)),
                      r2 = __builtin_bit_cast(float, __builtin_amdgcn_readlane(__builtin_bit_cast(int, inc), 47));
          const int rw = F.lane >> 4; inc += (rw == 1) ? r0 : (rw == 2) ? (r0 + r1) : (rw == 3) ? ((r0 + r1) + r2) : 0.f; }
        if (F.lane == 63) wsum[F.wave] = inc;
        __syncthreads();
        float off = inc - run;
        for (int w = 0; w < F.wave; ++w) off += wsum[w];
#pragma unroll
        for (int i = 0; i < 4; ++i) dc[base + (size_t)(F.tid * 4 + i) * 16] = (v[i] + off) * LOG2E;
        __syncthreads();
    }
}

__device__ __forceinline__ void ln_row16(float (&v)[16], const float* g, const float* b, int lane) {
    float s = 0.f;
#pragma unroll
    for (int i = 0; i < 16; ++i) s += v[i];
    const float mean = wave_sum(s) * (1.f / DM); float s2 = 0.f;
#pragma unroll
    for (int i = 0; i < 16; ++i) { v[i] -= mean; s2 += v[i] * v[i]; }
    const float rstd = 1.0f / sqrtf(wave_sum(s2) * (1.f / DM) + LN_EPS);
#pragma unroll
    for (int q = 0; q < 4; ++q) { const f32x4 gg = *(const f32x4*)(g + lane * 16 + 4 * q), bb = *(const f32x4*)(b + lane * 16 + 4 * q);
#pragma unroll
        for (int i = 0; i < 4; ++i) v[4 * q + i] = v[4 * q + i] * rstd * gg[i] + bb[i]; }
}
__device__ __forceinline__ void ln_stats16(const float (&v)[16], float& mean, float& rstd) {
    float s = 0.f;
#pragma unroll
    for (int i = 0; i < 16; ++i) s += v[i];
    mean = wave_sum(s) * (1.f / DM); float s2 = 0.f;
#pragma unroll
    for (int i = 0; i < 16; ++i) { const float d = v[i] - mean; s2 += d * d; }
    rstd = 1.0f / sqrtf(wave_sum(s2) * (1.f / DM) + LN_EPS);
}
__device__ __forceinline__ void ln_apply16(float (&v)[16], float mean, float rstd, const float* g, const float* b, int lane) {
#pragma unroll
    for (int q = 0; q < 4; ++q) { const f32x4 gg = *(const f32x4*)(g + lane * 16 + 4 * q), bb = *(const f32x4*)(b + lane * 16 + 4 * q);
#pragma unroll
        for (int i = 0; i < 4; ++i) v[4 * q + i] = (v[4 * q + i] - mean) * rstd * gg[i] + bb[i]; }
}
__device__ __forceinline__ void store_row16_bf(const float (&v)[16], bf16_t* xb, int lane) {
    u32x4 w0, w1; w0.x = pk2(v[0], v[1]); w0.y = pk2(v[2], v[3]); w0.z = pk2(v[4], v[5]); w0.w = pk2(v[6], v[7]);
    w1.x = pk2(v[8], v[9]); w1.y = pk2(v[10], v[11]); w1.z = pk2(v[12], v[13]); w1.w = pk2(v[14], v[15]);
    *(u32x4*)(xb + lane * 16) = w0; *(u32x4*)(xb + lane * 16 + 8) = w1;
}
__device__ __forceinline__ void store_row16(const float (&v)[16], float* xf, bf16_t* xb, int lane) {
#pragma unroll
    for (int q = 0; q < 4; ++q) *(f32x4*)(xf + lane * 16 + 4 * q) = (f32x4){v[4 * q], v[4 * q + 1], v[4 * q + 2], v[4 * q + 3]};
    u32x4 w0, w1; w0.x = pk2(v[0], v[1]); w0.y = pk2(v[2], v[3]); w0.z = pk2(v[4], v[5]); w0.w = pk2(v[6], v[7]);
    w1.x = pk2(v[8], v[9]); w1.y = pk2(v[10], v[11]); w1.z = pk2(v[12], v[13]); w1.w = pk2(v[14], v[15]);
    *(u32x4*)(xb + lane * 16) = w0; *(u32x4*)(xb + lane * 16 + 8) = w1;
}

#ifndef ROUTE_EXPT
#define ROUTE_EXPT 0
#endif
__device__ __forceinline__ void unpack16(const u32x4 w0, const u32x4 w1, float (&v)[16]) {
    v[0] = bflo(w0.x); v[1] = bfhi(w0.x); v[2] = bflo(w0.y); v[3] = bfhi(w0.y); v[4] = bflo(w0.z); v[5] = bfhi(w0.z); v[6] = bflo(w0.w); v[7] = bfhi(w0.w);
    v[8] = bflo(w1.x); v[9] = bfhi(w1.x); v[10] = bflo(w1.y); v[11] = bfhi(w1.y); v[12] = bflo(w1.z); v[13] = bfhi(w1.z); v[14] = bflo(w1.w); v[15] = bfhi(w1.w);
}
__device__ __forceinline__ void route_phase(const Frame& F, const Args& a, int layer, const bf16_t* X, bf16_t* XB, bool dummy) {
    const float* g = a.in[I_LN1G] + layer * DM; const float* bta = a.in[I_LN1B] + layer * DM;
    const float* RW = a.in[I_RW] + (size_t)layer * DM * NEXP; const float* RBs = a.in[I_RB] + layer * NEXP;
    int* slot_tk = (int*)(F.ws + WS_SLOT_TK); float* slot_g = (float*)(F.ws + WS_SLOT_G);
    gu32* cntg = F.ctl + CW_CNT + layer * 256;
    LAS float* lg = (LAS float*)(F.lds + F.wave * 8192);
    LAS unsigned* rec_e = (LAS unsigned*)(F.lds + 65536);
    LAS float* rec_g = (LAS float*)(F.lds + 65536 + 8192);
    LAS unsigned* lcnt = (LAS unsigned*)(F.lds + 65536 + 16384);
    LAS unsigned* gbase = lcnt + 64;
    const int lane = F.lane;
    for (int ub = F.bid; ub < T / 256; ub += F.G) {
        if (F.tid < 64) lcnt[F.tid] = 0u;
        __syncthreads();
        const int r0 = ub * 256 + F.wave * 32;
        LAS float* stl = (LAS float*)(F.lds + 65536 + 16384 + 512) + F.wave * 64;
        for (int r4 = 0; r4 < 32; r4 += 8) {
            u32x4 v4[8][2];
#pragma unroll
            for (int j = 0; j < 8; ++j) { const bf16_t* xr = X + (size_t)(r0 + r4 + j) * DM + lane * 16; v4[j][0] = *(const u32x4*)xr; v4[j][1] = *(const u32x4*)(xr + 8); }
#pragma unroll
            for (int j = 0; j < 8; ++j) { float v[16]; unpack16(v4[j][0], v4[j][1], v);
                float mean, rstd; ln_stats16(v, mean, rstd);
                if (lane == 0) { stl[2 * (r4 + j)] = mean; stl[2 * (r4 + j) + 1] = rstd; }
                ln_apply16(v, mean, rstd, g, bta, lane); store_row16_bf(v, XB + (size_t)(r0 + r4 + j) * DM, lane); }
        }
        LDS_WAIT(); asm volatile("" ::: "memory");
        f32x16 c0 = {}, c1 = {};
        { const bf16_t* ar = X + (size_t)(r0 + (lane & 31)) * DM + (lane >> 5) * 8;
          const bf16_t* Wh = (const bf16_t*)(F.ws + WS_W + wbuf_off(layer) + W_RH); const bf16_t* Wl = (const bf16_t*)(F.ws + WS_W + wbuf_off(layer) + W_RL);
          const int se = F.tid >> 3, sg8 = (F.tid & 7) * 16;
          u32x4 bh[2], bl[2];
          bh[0] = *(const u32x4*)(Wh + (size_t)se * DM + sg8); bh[1] = *(const u32x4*)(Wh + (size_t)se * DM + sg8 + 8); bl[0] = *(const u32x4*)(Wl + (size_t)se * DM + sg8); bl[1] = *(const u32x4*)(Wl + (size_t)se * DM + sg8 + 8);
          for (int c = 0; c < ((ROUTE_EXPT == 1 && dummy) ? 0 : 8); ++c) {
              LAS unsigned char* Bs = F.lds + (c & 1) * 34816;
              *(LAS u32x4*)(Bs + se * 272 + sg8 * 2) = bh[0]; *(LAS u32x4*)(Bs + se * 272 + sg8 * 2 + 16) = bh[1];
              *(LAS u32x4*)(Bs + 17408 + se * 272 + sg8 * 2) = bl[0]; *(LAS u32x4*)(Bs + 17408 + se * 272 + sg8 * 2 + 16) = bl[1];
              bf16x8 af[8];
#pragma unroll
              for (int st = 0; st < 8; ++st) af[st] = *(const bf16x8*)(ar + c * 128 + st * 16);
              __syncthreads();
              if (c + 1 < 8) { const size_t o = (size_t)se * DM + (c + 1) * 128 + sg8;
                  bh[0] = *(const u32x4*)(Wh + o); bh[1] = *(const u32x4*)(Wh + o + 8); bl[0] = *(const u32x4*)(Wl + o); bl[1] = *(const u32x4*)(Wl + o + 8); }
              const LAS unsigned char* bp = Bs + (lane & 31) * 272 + (lane >> 5) * 16;
#pragma unroll
              for (int st = 0; st < 8; ++st) {
                  const bf16x8 h0 = *(const LAS bf16x8*)(bp + st * 32), h1 = *(const LAS bf16x8*)(bp + 32 * 272 + st * 32);
                  const bf16x8 l0 = *(const LAS bf16x8*)(bp + 17408 + st * 32), l1 = *(const LAS bf16x8*)(bp + 17408 + 32 * 272 + st * 32);
                  c0 = __builtin_amdgcn_mfma_f32_32x32x16_bf16(af[st], h0, c0, 0, 0, 0); c1 = __builtin_amdgcn_mfma_f32_32x32x16_bf16(af[st], h1, c1, 0, 0, 0);
                  c0 = __builtin_amdgcn_mfma_f32_32x32x16_bf16(af[st], l0, c0, 0, 0, 0); c1 = __builtin_amdgcn_mfma_f32_32x32x16_bf16(af[st], l1, c1, 0, 0, 0);
              }
          }
        }
        __syncthreads();
#pragma unroll
        for (int rr = 0; rr < 16; ++rr) { const int row = (rr & 3) + 8 * (rr >> 2) + 4 * (lane >> 5); lg[row * 64 + (lane & 31)] = c0[rr]; lg[row * 64 + 32 + (lane & 31)] = c1[rr]; }
        LDS_WAIT(); asm volatile("" ::: "memory");
        const float rcs = ((const float*)(F.ws + WS_MISC))[256 + lane], rb1 = ((const float*)(F.ws + WS_MISC))[256 + 64 + lane];
        const float rbias = RBs[lane];
        for (int r = 0; r < ((ROUTE_EXPT == 2 && dummy) ? 0 : 32); ++r) {
            const float sg = sigmoidf_(stl[2 * r + 1] * (lg[r * 64 + lane] - stl[2 * r] * rcs) + rb1); const float sb = sg + rbias;
            float m1 = sb;
            m1 = fmaxf(m1, dpp_mov<DPP_X1>(m1)); m1 = fmaxf(m1, dpp_mov<DPP_X2>(m1)); m1 = fmaxf(m1, dpp_mov<DPP_HM>(m1));
            const unsigned long long eqm = __ballot(sb == m1); const int gsh = lane & ~7;
            const unsigned gm = (unsigned)(eqm >> gsh) & 0xffu; const int first = __builtin_ctz(gm);
            float m2 = ((lane & 7) == first) ? NEGBIG : sb;
            m2 = fmaxf(m2, dpp_mov<DPP_X1>(m2)); m2 = fmaxf(m2, dpp_mov<DPP_X2>(m2)); m2 = fmaxf(m2, dpp_mov<DPP_HM>(m2));
            const float gs = m1 + m2;
            int grank = 0;
#pragma unroll
            for (int q = 0; q < 8; ++q) { const float o = __builtin_bit_cast(float, __builtin_amdgcn_readlane(__builtin_bit_cast(int, gs), q * 8)); grank += (o > gs || (o == gs && q < (lane >> 3))) ? 1 : 0; }
            const float sm = (grank < 4) ? sb : NEGBIG;
            int rank = 0;
#pragma unroll
            for (int q = 0; q < 64; ++q) { const float o = __builtin_bit_cast(float, __builtin_amdgcn_readlane(__builtin_bit_cast(int, sm), q)); rank += (o > sm) ? 1 : 0; }
            bool tie = false;
#pragma unroll
            for (int k = 0; k < 8; ++k) tie |= (__popcll(__ballot(rank == k)) != 1);
            if (tie) { rank = 0;
#pragma unroll 1
                for (int q = 0; q < 64; ++q) { const float o = __builtin_bit_cast(float, __builtin_amdgcn_readlane(__builtin_bit_cast(int, sm), q)); rank += (o > sm || (o == sm && q < lane)) ? 1 : 0; } }
            const bool sel = rank < 8;
            const float ssum = wave_sum(sel ? sg : 0.f);
            if (sel) { const unsigned lp = __hip_atomic_fetch_add(&lcnt[lane], 1u, __ATOMIC_RELAXED, __HIP_MEMORY_SCOPE_WORKGROUP); const int row = F.wave * 32 + r; rec_e[row * 8 + rank] = (unsigned)lane | (lp << 8); rec_g[row * 8 + rank] = sg / ssum * 2.5f; }
        }
        __syncthreads();
        const int half = (ub * 256) / HALF_T;
        if (F.tid < 64) gbase[F.tid] = dummy ? 0u : __hip_atomic_fetch_add(cntg + half * 65 + F.tid, lcnt[F.tid], RLX_AGENT);
        __syncthreads();
        for (int i = F.tid; i < 2048; i += 512) { const unsigned re = rec_e[i]; const int e = re & 255, lp = re >> 8, v = half * 65 + e; const int pos = gbase[e] + lp;
            const int t = ub * 256 + (i >> 3);
            if (!dummy) { slot_tk[(size_t)v * HALF_T + pos] = t * 8 + (i & 7); slot_g[(size_t)v * HALF_T + pos] = rec_g[i]; } }
        __syncthreads();
    }
}

__device__ __forceinline__ void combine_phase(const Frame& F, const Args& a, int layer, int half, const bf16_t* X1, bf16_t* X2, bool dummy) {
    const bf16_t* Y = (const bf16_t*)(F.ws + WS_R + R_YTOK);
    const float* g = a.in[I_LN2G] + layer * DM; const float* bta = a.in[I_LN2B] + layer * DM;
    const int lane = F.lane;
    for (int tl = F.bid * 8 + F.wave; tl < HALF_T; tl += F.G * 8) {
        const int t = half * HALF_T + tl; float v[16];
        { const bf16_t* xr = X1 + (size_t)t * DM + lane * 16; unpack16(*(const u32x4*)xr, *(const u32x4*)(xr + 8), v); }
#pragma unroll
        for (int i = 0; i < 16; ++i) v[i] *= ALPHA;
        float m[16];
#pragma unroll
        for (int i = 0; i < 16; ++i) m[i] = 0.f;
#pragma unroll
#if Y_FP8
        for (int k = 0; k < 9; ++k) { const u32x4 w = *(const u32x4*)((const unsigned char*)Y + ((size_t)t * 9 + k) * DM + lane * 16);
            m[0] += __builtin_amdgcn_cvt_f32_fp8(w.x, 0); m[1] += __builtin_amdgcn_cvt_f32_fp8(w.x, 1); m[2] += __builtin_amdgcn_cvt_f32_fp8(w.x, 2); m[3] += __builtin_amdgcn_cvt_f32_fp8(w.x, 3);
            m[4] += __builtin_amdgcn_cvt_f32_fp8(w.y, 0); m[5] += __builtin_amdgcn_cvt_f32_fp8(w.y, 1); m[6] += __builtin_amdgcn_cvt_f32_fp8(w.y, 2); m[7] += __builtin_amdgcn_cvt_f32_fp8(w.y, 3);
            m[8] += __builtin_amdgcn_cvt_f32_fp8(w.z, 0); m[9] += __builtin_amdgcn_cvt_f32_fp8(w.z, 1); m[10] += __builtin_amdgcn_cvt_f32_fp8(w.z, 2); m[11] += __builtin_amdgcn_cvt_f32_fp8(w.z, 3);
            m[12] += __builtin_amdgcn_cvt_f32_fp8(w.w, 0); m[13] += __builtin_amdgcn_cvt_f32_fp8(w.w, 1); m[14] += __builtin_amdgcn_cvt_f32_fp8(w.w, 2); m[15] += __builtin_amdgcn_cvt_f32_fp8(w.w, 3); }
#pragma unroll
        for (int i = 0; i < 16; ++i) m[i] *= (1.0f / 32.0f);
#else
        for (int k = 0; k < 9; ++k) { const bf16_t* yr = Y + ((size_t)tl * 9 + k) * DM + lane * 16; float yv[16]; unpack16(*(const u32x4*)yr, *(const u32x4*)(yr + 8), yv);
#pragma unroll
            for (int i = 0; i < 16; ++i) m[i] += yv[i]; }
#endif
#pragma unroll
        for (int i = 0; i < 16; ++i) v[i] += m[i];
        ln_row16(v, g, bta, lane);
        if (!dummy) store_row16_bf(v, X2 + (size_t)t * DM, lane);
    }
}

constexpr int KP = 144, VP = 192;
constexpr int KT_BYTES = 64 * KP, VT_BYTES = 64 * VP, KV_BUF = KT_BYTES + VT_BYTES;
__device__ __forceinline__ int crow(int r, int hi) { return (r & 3) + 8 * (r >> 2) + 4 * hi; }
__device__ __forceinline__ s16x4 vtr(const LAS unsigned char* p) { return __builtin_bit_cast(s16x4, __builtin_amdgcn_ds_read_tr16_b64_v4i16((LAS s16x4*)p)); }

struct KVRegs { u32x4 k, v; };
__device__ __forceinline__ void kv_load(KVRegs& r, const bf16_t* Kp, const bf16_t* Vp, size_t pitch, int row0, int tid) {
    const size_t off = (size_t)(row0 + (tid >> 3)) * pitch + (tid & 7) * 8;
    r.k = *(const u32x4*)(Kp + off); r.v = *(const u32x4*)(Vp + off);
}
__device__ __forceinline__ void kv_store(const KVRegs& r, LAS unsigned char* buf, int tid) {
    *(LAS u32x4*)(buf + (tid >> 3) * KP + (tid & 7) * 16) = r.k;
    *(LAS u32x4*)(buf + KT_BYTES + (tid >> 3) * VP + (tid & 7) * 16) = r.v;
}
__device__ __forceinline__ void qk_tile(f32x16& p0, f32x16& p1, const LAS unsigned char* kt, const bf16x8 (&qf)[4], int lane) {
    const LAS unsigned char* kb = kt + (lane & 31) * KP + (lane >> 5) * 16;
    p0 = (f32x16){}; p1 = (f32x16){};
#pragma unroll
    for (int ks = 0; ks < 4; ++ks) {
        const bf16x8 k0 = *(const LAS bf16x8*)(kb + ks * 32), k1 = *(const LAS bf16x8*)(kb + 32 * KP + ks * 32);
        p0 = __builtin_amdgcn_mfma_f32_32x32x16_bf16(k0, qf[ks], p0, 0, 0, 0);
        p1 = __builtin_amdgcn_mfma_f32_32x32x16_bf16(k1, qf[ks], p1, 0, 0, 0);
    }
}
__device__ __forceinline__ bf16x8 pfrag(const f32x16& p, int s) {
    u32x4 w; w.x = pg8::cvt_pk_bf16(p[8 * s], p[8 * s + 1]); w.y = pg8::cvt_pk_bf16(p[8 * s + 2], p[8 * s + 3]); w.z = pg8::cvt_pk_bf16(p[8 * s + 4], p[8 * s + 5]); w.w = pg8::cvt_pk_bf16(p[8 * s + 6], p[8 * s + 7]);
    return __builtin_bit_cast(bf16x8, w);
}
__device__ __forceinline__ void pv_sub(f32x16& o0, f32x16& o1, const LAS unsigned char* vt, int sub, const f32x16& p, int lane) {
    const LAS unsigned char* vb = vt + (sub * 32 + (lane >> 5) * 4 + ((lane & 15) >> 2)) * VP + (16 * ((lane >> 4) & 1) + 4 * (lane & 3)) * 2;
#pragma unroll
    for (int s = 0; s < 2; ++s) {
        const bf16x8 pb = pfrag(p, s);
        const s16x4 a0 = vtr(vb + (16 * s) * VP), a1 = vtr(vb + (16 * s + 8) * VP), b0 = vtr(vb + (16 * s) * VP + 64), b1 = vtr(vb + (16 * s + 8) * VP + 64);
        const bf16x8 va = {a0[0], a0[1], a0[2], a0[3], a1[0], a1[1], a1[2], a1[3]}, vbb = {b0[0], b0[1], b0[2], b0[3], b1[0], b1[1], b1[2], b1[3]};
        o0 = __builtin_amdgcn_mfma_f32_32x32x16_bf16(va, pb, o0, 0, 0, 0);
        o1 = __builtin_amdgcn_mfma_f32_32x32x16_bf16(vbb, pb, o1, 0, 0, 0);
    }
}
__device__ __forceinline__ float max3f(float a, float b, float c) { float r; asm("v_max3_f32 %0, %1, %2, %3" : "=v"(r) : "v"(a), "v"(b), "v"(c)); return r; }
template <bool SCALED, int EXPT = 0>
__device__ __forceinline__ void softmax_pv(f32x16& p0, f32x16& p1, f32x16& o0, f32x16& o1, float& m, float& l, const LAS unsigned char* vt, int lane, bool v0 = true, bool v1 = true) {
    if (EXPT == 1) { l += p0[0]; pv_sub(o0, o1, vt, 0, p0, lane); pv_sub(o0, o1, vt, 1, p1, lane); return; }
    asm volatile("s_nop 15" : "+v"(p0), "+v"(p1));
    float mx;
    { float a = max3f(p0[0], p0[1], p0[2]), b = max3f(p1[0], p1[1], p1[2]);
      a = max3f(a, p0[3], p0[4]); b = max3f(b, p1[3], p1[4]); a = max3f(a, p0[5], p0[6]); b = max3f(b, p1[5], p1[6]);
      a = max3f(a, p0[7], p0[8]); b = max3f(b, p1[7], p1[8]); a = max3f(a, p0[9], p0[10]); b = max3f(b, p1[9], p1[10]);
      a = max3f(a, p0[11], p0[12]); b = max3f(b, p1[11], p1[12]); a = max3f(a, p0[13], p0[14]); b = max3f(b, p1[13], p1[14]);
      a = fmaxf(a, p0[15]); b = fmaxf(b, p1[15]); mx = fmaxf(v0 ? a : NEGBIG, v1 ? b : NEGBIG); }
    mx = max_x32(mx, lane);
    if (!SCALED) mx *= QK_C;
    const float mn = (mx - m > 8.0f) ? mx : m, alpha = fast_exp2(m - mn);
    const float mn0 = v0 ? mn : 1e30f, mn1 = v1 ? mn : 1e30f;
    f32x2 ls2 = {0.f, 0.f};
#pragma unroll
    for (int r = 0; r < 16; r += 2) {
        f32x2 a = {p0[r], p0[r + 1]}, b = {p1[r], p1[r + 1]};
        if (SCALED) { a = a - mn0; b = b - mn1; } else { a = a * QK_C - mn0; b = b * QK_C - mn1; }
        a[0] = fast_exp2(a[0]); a[1] = fast_exp2(a[1]); b[0] = fast_exp2(b[0]); b[1] = fast_exp2(b[1]);
        p0[r] = a[0]; p0[r + 1] = a[1]; p1[r] = b[0]; p1[r + 1] = b[1];
        ls2 += a; ls2 += b; }
    float ls = ls2[0] + ls2[1];
    ls = sum_x32(ls, lane);
    l = l * alpha + ls; m = mn;
    if (!__all(alpha == 1.0f)) { o0 *= alpha; o1 *= alpha; }
    pv_sub(o0, o1, vt, 0, p0, lane); pv_sub(o0, o1, vt, 1, p1, lane);
}
__device__ __forceinline__ void load_qf(bf16x8 (&qf)[4], const bf16_t* qrow, int lane) {
#pragma unroll
    for (int ks = 0; ks < 4; ++ks) qf[ks] = *(const bf16x8*)(qrow + 16 * ks + 8 * (lane >> 5));
}
__device__ __forceinline__ void store_ot(const f32x16& o0, const f32x16& o1, float sc, bf16_t* orow, int lane) {
    const int hi = lane >> 5;
#pragma unroll
    for (int g = 0; g < 4; ++g) {
        u32x2 w; w.x = pg8::cvt_pk_bf16(o0[4 * g] * sc, o0[4 * g + 1] * sc); w.y = pg8::cvt_pk_bf16(o0[4 * g + 2] * sc, o0[4 * g + 3] * sc); *(u32x2*)(orow + 8 * g + 4 * hi) = w;
        u32x2 x; x.x = pg8::cvt_pk_bf16(o1[4 * g] * sc, o1[4 * g + 1] * sc); x.y = pg8::cvt_pk_bf16(o1[4 * g + 2] * sc, o1[4 * g + 3] * sc); *(u32x2*)(orow + 32 + 8 * g + 4 * hi) = x;
    }
}

template <int EXPT = 0>
__device__ __forceinline__ void fox_phase(const Frame& F, const Args& a, bf16_t* O, int opitch) {
    bf16_t* H = (bf16_t*)(F.ws + WS_R + R_H); const float* DC = (const float*)(F.ws + WS_DCUM);
    const int lane = F.lane, tid = F.tid, hi = lane >> 5;
    LAS unsigned char* kvb = F.lds; LAS float* dkb = (LAS float*)(F.lds + 4 * KV_BUF);
    const int NU = NB * 16 * 8;
    for (int ui = F.bid; ui < NU; ui += F.G) {
        const int qb = 7 - (ui / (NB * 16)), bh = ui % (NB * 16), b = bh >> 4, h = bh & 15;
        const size_t rb0 = (size_t)b * SEQ;
        const bf16_t* Kp = H + rb0 * NO_PAD + 1024 + h * 64; const bf16_t* Vp = H + rb0 * NO_PAD + 2048 + h * 64;
        const int q0 = qb * 256 + F.wave * 32, tq = q0 + (lane & 31);
        bf16x8 qf[4]; load_qf(qf, H + (rb0 + tq) * NO_PAD + h * 64, lane);
        f32x16 o0 = {}, o1 = {}; float m = -1e20f, l = 0.f;
        const int ntile = qb * 4 + 4; const int wlast = (q0 + 31) >> 6;
        KVRegs krA, krB; float dkA = 0.f, dkB = 0.f;
        kv_load(krA, Kp, Vp, NO_PAD, 0, tid); if (tid < 64) dkA = DC[(rb0 + tid) * 16 + h];
        if (ntile > 1) { kv_load(krB, Kp, Vp, NO_PAD, 64, tid); if (tid < 64) dkB = DC[(rb0 + 64 + tid) * 16 + h]; }
        __syncthreads();
#define FOX_FILL(KR, DKR, T) do { const int t = (T); kv_store(KR, kvb + (t & 3) * KV_BUF, tid); if (tid < 64) dkb[(t & 3) * 64 + tid] = -DKR; } while (0)
#define FOX_NEXT(KR, DKR, T) do { const int t = (T); if (t + 2 < ntile) { kv_load(KR, Kp, Vp, NO_PAD, (t + 2) * 64, tid); if (tid < 64) DKR = DC[(rb0 + (t + 2) * 64 + tid) * 16 + h]; } } while (0)
#define FOX_COMP(T) do { const int t = (T); LAS unsigned char* buf = kvb + (t & 3) * KV_BUF; \
            if (EXPT == 2) { l += ((const LAS float*)buf)[lane]; } else if (t <= wlast) { \
                f32x16 p0, p1; qk_tile(p0, p1, buf, qf, lane); \
                const LAS float* dk = dkb + (t & 3) * 64; \
                if (64 * t + 63 <= q0) { \
                    _Pragma("unroll") for (int r = 0; r < 16; ++r) { const int kk = crow(r, hi); p0[r] = __builtin_fmaf(p0[r], QK_C, dk[kk]); p1[r] = __builtin_fmaf(p1[r], QK_C, dk[kk + 32]); } \
                } else { \
                    _Pragma("unroll") for (int r = 0; r < 16; ++r) { const int kk = crow(r, hi), key = t * 64 + kk; \
                        const float s0 = __builtin_fmaf(p0[r], QK_C, dk[kk]), s1 = __builtin_fmaf(p1[r], QK_C, dk[kk + 32]); \
                        p0[r] = (key <= tq) ? s0 : NEGBIG; p1[r] = (key + 32 <= tq) ? s1 : NEGBIG; } \
                } \
                softmax_pv<true, EXPT>(p0, p1, o0, o1, m, l, buf + KT_BYTES, lane); \
            } } while (0)
        for (int t2 = 0; t2 < ntile; t2 += 2) {
            FOX_FILL(krA, dkA, t2); FOX_FILL(krB, dkB, t2 + 1);
            __syncthreads();
            FOX_NEXT(krA, dkA, t2); FOX_NEXT(krB, dkB, t2 + 1);
            FOX_COMP(t2); FOX_COMP(t2 + 1);
        }
#undef FOX_FILL
#undef FOX_NEXT
#undef FOX_COMP
        store_ot(o0, o1, 1.0f / l, O + (rb0 + tq) * opitch + h * 64, lane);
        __syncthreads();
    }
}

template <class MaskFn>
__device__ __forceinline__ void attn_tiles(const Frame& F, unsigned tm, const bf16_t* Kp, const bf16_t* Vp, size_t pitch, const bf16x8 (&qf)[4],
                                            f32x16& o0, f32x16& o1, float& m, float& l, LAS unsigned char* kvb, MaskFn&& mask) {
    const int tid = F.tid, lane = F.lane;
    KVRegs krA, krB;
    int tA = -1, tB = -1;
    if (tm) { tA = __builtin_ctz(tm); tm &= tm - 1; kv_load(krA, Kp, Vp, pitch, tA * 64, tid); }
    if (tm) { tB = __builtin_ctz(tm); tm &= tm - 1; kv_load(krB, Kp, Vp, pitch, tB * 64, tid); }
#define ATT_TILE(KR, TV, PAR) do { const int t = TV; LAS unsigned char* buf = kvb + (PAR) * KV_BUF; \
        kv_store(KR, buf, tid); \
        __syncthreads(); \
        if (tm) { TV = __builtin_ctz(tm); tm &= tm - 1; kv_load(KR, Kp, Vp, pitch, TV * 64, tid); } else TV = -1; \
        f32x16 p0, p1; qk_tile(p0, p1, buf, qf, lane); \
        bool v0 = true, v1 = true; mask(p0, p1, t, v0, v1); \
        softmax_pv<false>(p0, p1, o0, o1, m, l, buf + KT_BYTES, lane, v0, v1); } while (0)
    while (tA >= 0) { ATT_TILE(krA, tA, 0); if (tB < 0) break; ATT_TILE(krB, tB, 1); }
#undef ATT_TILE
    __syncthreads();
}
__device__ __forceinline__ unsigned pkh(float a, float b) { const _Float16 x = (_Float16)a, y = (_Float16)b; return (unsigned)__builtin_bit_cast(unsigned short, x) | ((unsigned)__builtin_bit_cast(unsigned short, y) << 16); }
__device__ __forceinline__ float h2f(unsigned short h) { return (float)__builtin_bit_cast(_Float16, h); }
__device__ __forceinline__ float dpp_f(float x, int ctrl_sel) {
    const int v = __builtin_bit_cast(int, x); int r;
    if (ctrl_sel == 0) r = __builtin_amdgcn_update_dpp(0, v, 0xB1, 0xf, 0xf, true);
    else if (ctrl_sel == 1) r = __builtin_amdgcn_update_dpp(0, v, 0x4E, 0xf, 0xf, true);
    else r = __builtin_amdgcn_update_dpp(0, v, 0x141, 0xf, 0xf, true);
    return __builtin_bit_cast(float, r);
}

__device__ __forceinline__ void dsa_unit(const Frame& F, const Args& a, int b, int qg, bf16_t* O, int opitch) {
    bf16_t* H = (bf16_t*)(F.ws + WS_R + R_H);
    const int lane = F.lane, hi = lane >> 5, t0 = qg * 32; const size_t rb0 = (size_t)b * SEQ;
    LAS float* sc = (LAS float*)F.lds;
    LAS unsigned* bm = (LAS unsigned*)(F.lds + LDS_TAB);
    for (int hf = 0; hf < 2; ++hf) {
        const int tq0 = t0 + 16 * hf, nkt = ((tq0 + 15) >> 5) + 1;
        {
            bf16x8 qi[4][4], wf[4][2];
#pragma unroll
            for (int ct = 0; ct < 4; ++ct) { const int q = tq0 + 4 * ct + ((lane & 31) >> 3), head = lane & 7; const bf16_t* rp = H + (rb0 + q) * NE_PAD;
#pragma unroll
                for (int ks = 0; ks < 4; ++ks) qi[ct][ks] = *(const bf16x8*)(rp + EC_QI + head * 64 + 16 * ks + 8 * hi);
                const int qp = lane & 31; u32x2 w4 = {0u, 0u};
                if (qp < 4) w4 = *(const u32x2*)(H + (rb0 + tq0 + 4 * ct + qp) * NE_PAD + EC_WI + 4 * hi);
                const u32x4 s0 = {(qp == 0) ? w4.x : 0u, (qp == 0) ? w4.y : 0u, (qp == 1) ? w4.x : 0u, (qp == 1) ? w4.y : 0u};
                const u32x4 s1 = {(qp == 2) ? w4.x : 0u, (qp == 2) ? w4.y : 0u, (qp == 3) ? w4.x : 0u, (qp == 3) ? w4.y : 0u};
                wf[ct][0] = __builtin_bit_cast(bf16x8, s0); wf[ct][1] = __builtin_bit_cast(bf16x8, s1); }
            for (int kt = F.wave; kt < nkt; kt += 8) {
                bf16x8 kf[4]; { const bf16_t* kp = H + (rb0 + kt * 32 + (lane & 31)) * NE_PAD + EC_KI + 8 * hi;
#pragma unroll
                    for (int ks = 0; ks < 4; ++ks) kf[ks] = *(const bf16x8*)(kp + 16 * ks); }
#pragma unroll
                for (int ct = 0; ct < 4; ++ct) {
                    f32x16 acc = {};
#pragma unroll
                    for (int ks = 0; ks < 4; ++ks) acc = __builtin_amdgcn_mfma_f32_32x32x16_bf16(qi[ct][ks], kf[ks], acc, 0, 0, 0);
#pragma unroll
                    for (int r = 0; r < 16; ++r) acc[r] = fmaxf(acc[r], 0.f);
                    f32x16 y = {};
                    y = __builtin_amdgcn_mfma_f32_32x32x16_bf16(wf[ct][0], pfrag(acc, 0), y, 0, 0, 0);
                    y = __builtin_amdgcn_mfma_f32_32x32x16_bf16(wf[ct][1], pfrag(acc, 1), y, 0, 0, 0);
                    if (lane < 32) { LAS float* dst = sc + (4 * ct) * 2048 + kt * 32 + lane;
                        dst[0] = y[0]; dst[2048] = y[1]; dst[4096] = y[2]; dst[6144] = y[3]; }
                }
            }
        }
        __syncthreads();
        for (int q2 = 0; q2 < 2; ++q2) {
            const int ql = 2 * F.wave + q2, tq = tq0 + ql, n = tq + 1;
            unsigned u[32];
#pragma unroll
            for (int j = 0; j < 32; ++j) { const int idx = 64 * j + lane; unsigned bits = 0u;
                if (idx < n) { bits = __builtin_bit_cast(unsigned, sc[ql * 2048 + idx]); if ((bits << 1) == 0u) bits = 0u; bits ^= (bits & 0x80000000u) ? 0xffffffffu : 0x80000000u; }
                u[j] = bits; }
            unsigned thr = 0u; int need = 0; bool exact = false;
            if (n > 256) {
                const int ng = (n + 511) >> 9;
                for (int bit = 31; bit >= 0; --bit) { const unsigned cand = thr | (1u << bit); int c = 0;
#pragma unroll
                    for (int g = 0; g < 4; ++g) if (g < ng) {
#pragma unroll
                        for (int j = 8 * g; j < 8 * g + 8; ++j) c += (u[j] >= cand) ? 1 : 0; }
                    c = wave_sum_i(c);
                    if (c >= 256) { thr = cand; if (c == 256) { exact = true; break; } } }
                if (!exact) { int cgt = 0;
#pragma unroll
                    for (int j = 0; j < 32; ++j) cgt += (u[j] > thr) ? 1 : 0;
                    cgt = wave_sum_i(cgt);
                    need = 256 - cgt; }
            }
            const unsigned long long lt = (1ull << lane) - 1ull; int er = 0;
            if (exact) {
#pragma unroll
                for (int j = 0; j < 32; ++j) { const unsigned long long sm = __ballot(u[j] >= thr);
                    if (lane == 0) { bm[(16 * hf + ql) * 64 + 2 * j] = (unsigned)sm; bm[(16 * hf + ql) * 64 + 2 * j + 1] = (unsigned)(sm >> 32); } } }
            else
#pragma unroll
            for (int j = 0; j < 32; ++j) { const int idx = 64 * j + lane; bool sel;
                if (n > 256) {
                  const unsigned long long eqm = __ballot(u[j] == thr && idx < n); sel = (u[j] > thr) || (u[j] == thr && idx < n && (er + __popcll(eqm & lt)) < need); er += __popcll(eqm); }
                else sel = idx < n;
                const unsigned long long sm = __ballot(sel);
                if (lane == 0) { bm[(16 * hf + ql) * 64 + 2 * j] = (unsigned)sm; bm[(16 * hf + ql) * 64 + 2 * j + 1] = (unsigned)(sm >> 32); } }
        }
        __syncthreads();
    }
    const int tq = t0 + (lane & 31);
    bf16x8 qf[4]; load_qf(qf, H + (rb0 + tq) * NE_PAD + EC_QA + F.wave * 64, lane);
    f32x16 o0 = {}, o1 = {}; float m = -1e20f, l = 0.f;
    const int ntile = ((t0 + 31) >> 6) + 1; const unsigned tm = (ntile >= 32) ? 0xffffffffu : ((1u << ntile) - 1u);
    const LAS unsigned* bq = bm + (lane & 31) * 64;
    attn_tiles(F, tm, H + rb0 * NE_PAD + EC_KA, H + rb0 * NE_PAD + EC_VA, NE_PAD, qf, o0, o1, m, l, F.lds,
        [&](f32x16& p0, f32x16& p1, int t, bool&, bool&) { const unsigned w0 = bq[2 * t] >> (4 * hi), w1 = bq[2 * t + 1] >> (4 * hi);
#pragma unroll
            for (int r = 0; r < 16; ++r) { const int sh = (r & 3) + 8 * (r >> 2);
                p0[r] = ((w0 >> sh) & 1u) ? p0[r] : NEGBIG; p1[r] = ((w1 >> sh) & 1u) ? p1[r] : NEGBIG; } });
    store_ot(o0, o1, 1.0f / l, O + (rb0 + tq) * opitch + F.wave * 64, lane);
}

__device__ __forceinline__ void compress_item(const Frame& F, const Args& a, int layer, int item) {
    const bf16_t* H = (const bf16_t*)(F.ws + WS_R + R_H); const bf16_t* W = (const bf16_t*)(F.ws + WS_W + wbuf_off(layer));
    const int kv = item & 1, ct = (item >> 1) & 3, b = item >> 3, lane = F.lane, hi = lane >> 5;
    const bf16_t* w1t = W + (kv ? W_C1V : W_C1K) / 2; const bf16_t* w2t = W + (kv ? W_C2V : W_C2K) / 2;
    const float* bias1 = (const float*)(F.ws + WS_MISC) + kv * 64;
    bf16_t* outp = (bf16_t*)(F.ws + (kv ? WS_VC : WS_KC)) + (size_t)b * 128 * 64;
    const int col = kv ? EC_VC : EC_KC;
    LAS float* part = (LAS float*)F.lds; LAS unsigned short* hs = (LAS unsigned short*)(F.lds + 65536);
    int c = ct * 32 + (lane & 31); if (c > 126) c = 126;
    f32x16 a0 = {}, a1 = {};
#pragma unroll 8
    for (int ks = F.wave * 16; ks < F.wave * 16 + 16; ++ks) {
        const bf16x8 af = *(const bf16x8*)(H + ((size_t)b * SEQ + 16 * c + (ks >> 2)) * NE_PAD + col + 16 * (ks & 3) + 8 * hi);
        const bf16x8 b0 = *(const bf16x8*)(w1t + (size_t)(lane & 31) * 2048 + 16 * ks + 8 * hi), b1 = *(const bf16x8*)(w1t + (size_t)(32 + (lane & 31)) * 2048 + 16 * ks + 8 * hi);
        a0 = __builtin_amdgcn_mfma_f32_32x32x16_bf16(af, b0, a0, 0, 0, 0); a1 = __builtin_amdgcn_mfma_f32_32x32x16_bf16(af, b1, a1, 0, 0, 0);
    }
#pragma unroll
    for (int r = 0; r < 16; ++r) { part[F.wave * 2048 + crow(r, hi) * 64 + (lane & 31)] = a0[r]; part[F.wave * 2048 + crow(r, hi) * 64 + 32 + (lane & 31)] = a1[r]; }
    __syncthreads();
#pragma unroll
    for (int i = 0; i < 4; ++i) { const int idx = F.tid + 512 * i; float s = bias1[idx & 63];
#pragma unroll
        for (int w = 0; w < 8; ++w) s += part[w * 2048 + idx];
        const float h = s / (1.0f + __expf(-s)); hs[(idx >> 6) * 72 + (idx & 63)] = (unsigned short)f2bf(h); }
    __syncthreads();
    if (F.wave < 2) {
        const int nt = F.wave; f32x16 acc = {};
#pragma unroll
        for (int ks = 0; ks < 4; ++ks) { const bf16x8 af = *(const LAS bf16x8*)((const LAS unsigned char*)hs + (lane & 31) * 144 + (16 * ks + 8 * hi) * 2);
            const bf16x8 bf = *(const bf16x8*)(w2t + (size_t)(nt * 32 + (lane & 31)) * 64 + 16 * ks + 8 * hi);
            acc = __builtin_amdgcn_mfma_f32_32x32x16_bf16(af, bf, acc, 0, 0, 0); }
        const int n = nt * 32 + (lane & 31);
        const float* cosT = (const float*)(F.ws + WS_ROPE_COS); const float* sinT = (const float*)(F.ws + WS_ROPE_SIN);
#pragma unroll
        for (int r = 0; r < 16; ++r) { const int cg = ct * 32 + crow(r, hi); float v = acc[r];
            if (kv == 0) { const float o = dpp_mov<DPP_X1>(v); int pos = 16 * cg + 31; if (pos > SEQ - 1) pos = SEQ - 1; const float cs = cosT[pos * 32 + (n >> 1)], sn = sinT[pos * 32 + (n >> 1)];
                v = (n & 1) ? (v * cs + o * sn) : (v * cs - o * sn); }
            outp[(size_t)cg * 64 + n] = (unsigned short)((cg <= 126) ? f2bf(v) : 0u); }
    }
    __syncthreads();
}

__device__ __forceinline__ void nsa_unit(const Frame& F, const Args& a, int layer, int b, int qg, bf16_t* O, int opitch) {
    bf16_t* H = (bf16_t*)(F.ws + WS_R + R_H);
    const int lane = F.lane, hi = lane >> 5, tid = F.tid, t0 = qg * 32, cur = qg; const size_t rb0 = (size_t)b * SEQ;
    const int tq = t0 + (lane & 31);
    LAS unsigned char* kvb = F.lds;
    LAS unsigned short* slab = (LAS unsigned short*)(F.lds + 2 * KV_BUF);
    LAS float* pcs = (LAS float*)(F.lds + 2 * KV_BUF + 65536);
    LAS unsigned* selm = (LAS unsigned*)(pcs + 4096);
    const bf16_t* rowp = H + (rb0 + tq) * NE_PAD;
    bf16x8 qf[4]; load_qf(qf, rowp + EC_QB + F.wave * 64, lane);
    const float* bg = a.in[I_EV_BGATE] + (layer >> 1) * 24 + F.wave * 3;
    const float g0 = sigmoidf_(bf2f(rowp[EC_GB + F.wave * 3 + 0]) + bg[0]), g1 = sigmoidf_(bf2f(rowp[EC_GB + F.wave * 3 + 1]) + bg[1]), g2 = sigmoidf_(bf2f(rowp[EC_GB + F.wave * 3 + 2]) + bg[2]);
    { const bf16_t* kc = (const bf16_t*)(F.ws + WS_KC) + (size_t)b * 128 * 64; const bf16_t* vc = (const bf16_t*)(F.ws + WS_VC) + (size_t)b * 128 * 64;
      KVRegs r0, r1; kv_load(r0, kc, vc, 64, 0, tid); kv_load(r1, kc, vc, 64, 64, tid); kv_store(r0, kvb, tid); kv_store(r1, kvb + KV_BUF, tid); }
    __syncthreads();
    f32x16 pc[4]; f32x16 oa0 = {}, oa1 = {};
    {
        const int cmax = (tq >= 31) ? min(126, (tq - 31) >> 4) : -1;
        qk_tile(pc[0], pc[1], kvb, qf, lane); asm volatile("" ::: "memory"); qk_tile(pc[2], pc[3], kvb + KV_BUF, qf, lane); asm volatile("" ::: "memory");
        float mx = NEGBIG;
#pragma unroll
        for (int s = 0; s < 4; ++s)
#pragma unroll
            for (int r = 0; r < 16; ++r) { const int c = 32 * s + crow(r, hi); pc[s][r] = (c <= cmax) ? pc[s][r] * QK_C : NEGBIG; mx = fmaxf(mx, pc[s][r]); }
        mx = max_x32(mx, lane);
        float ls = 0.f;
#pragma unroll
        for (int s = 0; s < 4; ++s)
#pragma unroll
            for (int r = 0; r < 16; ++r) { pc[s][r] = (pc[s][r] > -1e29f) ? fast_exp2(pc[s][r] - mx) : 0.f; ls += pc[s][r]; }
        ls = sum_x32(ls, lane);
        const float inv = (ls > 0.f) ? 1.0f / ls : 0.f;
#pragma unroll
        for (int s = 0; s < 4; ++s) pc[s] *= inv;
        f32x16 c0 = {}, c1 = {};
        asm volatile("" ::: "memory");
        pv_sub(c0, c1, kvb + KT_BYTES, 0, pc[0], lane); asm volatile("" ::: "memory"); pv_sub(c0, c1, kvb + KT_BYTES, 1, pc[1], lane); asm volatile("" ::: "memory");
        pv_sub(c0, c1, kvb + KV_BUF + KT_BYTES, 0, pc[2], lane); asm volatile("" ::: "memory"); pv_sub(c0, c1, kvb + KV_BUF + KT_BYTES, 1, pc[3], lane); asm volatile("" ::: "memory");
        oa0 = c0 * g0; oa1 = c1 * g0;
    }
    { LAS unsigned short* sl = slab + F.wave * 4096 + (lane & 31) * 128 + 4 * hi;
#pragma unroll
      for (int s = 0; s < 4; ++s)
#pragma unroll
          for (int g = 0; g < 4; ++g) { u32x2 w; w.x = pkh(pc[s][4 * g], pc[s][4 * g + 1]); w.y = pkh(pc[s][4 * g + 2], pc[s][4 * g + 3]); *(LAS u32x2*)(sl + 32 * s + 8 * g) = w; } }
    __syncthreads();
#pragma unroll
    for (int i = 0; i < 8; ++i) { const int idx = tid + 512 * i; float s8 = 0.f;
#pragma unroll
        for (int w = 0; w < 8; ++w) s8 += h2f(slab[w * 4096 + idx]);
        pcs[idx] = s8; }
    __syncthreads();
#pragma unroll
    for (int qq = 0; qq < 4; ++qq) { const int q = 4 * F.wave + qq; const LAS float* pr = pcs + q * 128;
        float v = pr[2 * lane] + 0.5f * ((lane > 0 ? pr[2 * lane - 1] : 0.f) + pr[2 * lane + 1]);
        if (lane == 0 || lane == cur || lane == cur - 1) v = 1e30f - (float)lane * 1e27f; else if (lane > cur) v = NEGBIG;
        int rank = 0;
#pragma unroll
        for (int j = 0; j < 64; ++j) { const float o = __builtin_bit_cast(float, __builtin_amdgcn_readlane(__builtin_bit_cast(int, v), j)); rank += (o > v) ? 1 : 0; }
        bool tie = false;
#pragma unroll
        for (int k = 0; k < 8; ++k) tie |= (__popcll(__ballot(rank == k)) != 1);
        if (tie) { rank = 0;
#pragma unroll 1
            for (int j = 0; j < 64; ++j) { const float o = __builtin_bit_cast(float, __builtin_amdgcn_readlane(__builtin_bit_cast(int, v), j)); rank += (o > v || (o == v && j < lane)) ? 1 : 0; } }
        const unsigned long long sm = __ballot(rank < 8);
        if (lane == 0) { selm[2 * q] = (unsigned)sm; selm[2 * q + 1] = (unsigned)(sm >> 32); } }
    __syncthreads();
    LAS float* stash = (LAS float*)(F.lds + 2 * KV_BUF) + F.wave * 2048 + lane;
#pragma unroll
    for (int r = 0; r < 16; ++r) { stash[r * 64] = oa0[r]; stash[(16 + r) * 64] = oa1[r]; }
    {
        unsigned long long un = 0ull;
        { const unsigned lo = selm[2 * (lane & 31)], hh = selm[2 * (lane & 31) + 1]; unsigned ul = lo, uh = hh;
          ul |= dpp_movu<DPP_X1>(ul); ul |= dpp_movu<DPP_X2>(ul); ul |= dpp_movu<DPP_HM>(ul); ul |= dpp_movu<DPP_RM>(ul);
          uh |= dpp_movu<DPP_X1>(uh); uh |= dpp_movu<DPP_X2>(uh); uh |= dpp_movu<DPP_HM>(uh); uh |= dpp_movu<DPP_RM>(uh);
          un = ((unsigned long long)((unsigned)__builtin_amdgcn_readlane((int)uh, 0) | (unsigned)__builtin_amdgcn_readlane((int)uh, 16)) << 32) | ((unsigned)__builtin_amdgcn_readlane((int)ul, 0) | (unsigned)__builtin_amdgcn_readlane((int)ul, 16)); }
        if (cur < 63) un &= (1ull << (cur + 1)) - 1ull;
        unsigned tm = 0u;
        for (int t = 0; t <= (cur >> 1); ++t) if ((un >> (2 * t)) & 3ull) tm |= 1u << t;
        const unsigned long long mysel = ((unsigned long long)selm[2 * (lane & 31) + 1] << 32) | selm[2 * (lane & 31)];
        f32x16 s0 = {}, s1 = {}; float m = -1e20f, l = 0.f;
        attn_tiles(F, tm, H + rb0 * NE_PAD + EC_KS, H + rb0 * NE_PAD + EC_VS, NE_PAD, qf, s0, s1, m, l, kvb,
            [&](f32x16& p0, f32x16& p1, int t, bool& v0, bool& v1) { const bool b0 = (mysel >> (2 * t)) & 1ull, b1 = (mysel >> (2 * t + 1)) & 1ull;
                if (64 * t + 63 <= t0) { v0 = b0; v1 = b1; }
                else {
#pragma unroll
                    for (int r = 0; r < 16; ++r) { const int key = 64 * t + crow(r, hi);
                        p0[r] = (b0 && key <= tq) ? p0[r] : NEGBIG; p1[r] = (b1 && key + 32 <= tq) ? p1[r] : NEGBIG; } } });
        const float sc = g1 / l;
#pragma unroll
        for (int r = 0; r < 16; ++r) { stash[r * 64] += s0[r] * sc; stash[(16 + r) * 64] += s1[r] * sc; }
    }
    {
        const int tlo = (t0 >= 511) ? ((t0 - 511) >> 6) : 0, thi = (t0 + 31) >> 6;
        unsigned tm = 0u; for (int t = tlo; t <= thi; ++t) tm |= 1u << t;
        f32x16 s0 = {}, s1 = {}; float m = -1e20f, l = 0.f;
        attn_tiles(F, tm, H + rb0 * NE_PAD + EC_KW, H + rb0 * NE_PAD + EC_VW, NE_PAD, qf, s0, s1, m, l, kvb,
            [&](f32x16& p0, f32x16& p1, int t, bool&, bool&) {
                const bool interior = (64 * t + 63 <= t0) && (64 * t + 512 > t0 + 31);
                if (!interior) {
#pragma unroll
                    for (int r = 0; r < 16; ++r) { const int key = 64 * t + crow(r, hi);
                        p0[r] = (key <= tq && key + 512 > tq) ? p0[r] : NEGBIG; p1[r] = (key + 32 <= tq && key + 32 + 512 > tq) ? p1[r] : NEGBIG; } } });
        const float sc = g2 / l;
#pragma unroll
        for (int r = 0; r < 16; ++r) { oa0[r] = stash[r * 64] + s0[r] * sc; oa1[r] = stash[(16 + r) * 64] + s1[r] * sc; }
    }
    store_ot(oa0, oa1, 1.0f, O + (rb0 + tq) * opitch + F.wave * 64, lane);
    __syncthreads();
}

__device__ __forceinline__ void moe_tables(const Frame& F, int layer) {
    LAS int* cntl = (LAS int*)(F.lds + LDS_TAB); LAS int* rbs = cntl + 160;
    __syncthreads();
    if (F.tid < NV) cntl[F.tid] = ((F.tid % 65) == 64) ? HALF_T : (int)__hip_atomic_load(F.ctl + CW_CNT + layer * 256 + F.tid, RLX_AGENT);
    __syncthreads();
    if (F.tid <= NV) { int run = 0; for (int u = 0; u < F.tid; ++u) run += (cntl[u] + 255) >> 8; rbs[F.tid] = run; }
    __syncthreads();
}

constexpr int PH_PER_LAYER = 16, N_PHASES = DEPTH * PH_PER_LAYER;
__global__ void __launch_bounds__(512, 2) fwd(const float* i0, const float* i1, const float* i2, const float* i3, const float* i4, const float* i5, const float* i6, const float* i7, const float* i8, const float* i9, const float* i10, const float* i11, const float* i12, const float* i13, const float* i14, const float* i15, const float* i16, const float* i17, const float* i18, const float* i19, const float* i20, const float* i21, const float* i22, const float* i23, const float* i24, const float* i25, const float* i26, const float* i27, const float* i28, float* out_, unsigned char* ws_, int ph_lo_, int ph_hi_) {
    Args args; args.in[0] = i0; args.in[1] = i1; args.in[2] = i2; args.in[3] = i3; args.in[4] = i4; args.in[5] = i5; args.in[6] = i6; args.in[7] = i7; args.in[8] = i8; args.in[9] = i9; args.in[10] = i10; args.in[11] = i11; args.in[12] = i12; args.in[13] = i13; args.in[14] = i14; args.in[15] = i15; args.in[16] = i16; args.in[17] = i17; args.in[18] = i18; args.in[19] = i19; args.in[20] = i20; args.in[21] = i21; args.in[22] = i22; args.in[23] = i23; args.in[24] = i24; args.in[25] = i25; args.in[26] = i26; args.in[27] = i27; args.in[28] = i28; args.out = out_; args.ws = ws_; args.ph_lo = ph_lo_; args.ph_hi = ph_hi_;
    extern __shared__ __attribute__((aligned(16))) unsigned char lds_raw[];
    Frame F; F.lds = (LAS unsigned char*)lds_raw; F.tid = threadIdx.x; F.lane = F.tid & 63; F.wave = __builtin_amdgcn_readfirstlane(F.tid >> 6);
    F.G = gridDim.x; F.bid = blockIdx.x; F.ws = args.ws; F.ctl = (gu32*)(args.ws + WS_CTL);
    volatile LAS unsigned* MISC = (volatile LAS unsigned*)(F.lds + LDS_MISC);
    if (threadIdx.x < 64) MISC[threadIdx.x] = 0u;
    __syncthreads();
#if MK_ONE_LAUNCH
    constexpr int lo = 0, hi = N_PHASES; constexpr bool multi = true;
#else
    const int lo = args.ph_lo, hi = args.ph_hi; const bool multi = (hi - lo) > 1;
#endif
    XcdBarrier bar; bar.bar = (unsigned*)(F.ctl + CW_BAR); bar.x = 0; bar.st = MISC;
    if (multi) bar = xcd_barrier_post((unsigned*)(F.ctl + CW_BAR), MISC);
#ifndef PHMASK
#define PHMASK 0xffff
#endif
#define IN(k) (((PHMASK >> ((k) & 15)) & 1) && lo <= (k) && (k) < hi)
#ifndef TIMING
#define TIMING 0
#endif
#if TIMING
    if (F.tid == 0) { const unsigned long long t0_ = wall_clock64(); MISC[16] = (unsigned)t0_; MISC[17] = (unsigned)(t0_ >> 32); }
#define SEAM() do { if (multi) xcd_barrier(bar); if (blockIdx.x == 0 && F.tid == 0) { const unsigned long long tn = wall_clock64(); const unsigned long long tp = ((unsigned long long)MISC[17] << 32) | MISC[16]; \
    ((unsigned long long*)(args.ws + WS_CTL + 512 * 1024))[MISC[18]] = tn - tp; MISC[16] = (unsigned)tn; MISC[17] = (unsigned)(tn >> 32); } } while (0)
#define SETPH(k) do { if (F.tid == 0) MISC[18] = (unsigned)(k); } while (0)
#else
#define SEAM() do { if (multi) xcd_barrier(bar); } while (0)
#define SETPH(k)
#endif
#ifndef DUP_K
#define DUP_K -1
#define DUP_PAR 2
#endif
#define NREP(k) ((DUP_K == (k) && (DUP_PAR == 2 || (layer & 1) == DUP_PAR)) ? 2 : 1)
#define PF() Frame P = F; { int t_; asm volatile("v_mbcnt_lo_u32_b32 %0, -1, 0\n\tv_mbcnt_hi_u32_b32 %0, -1, %0" : "=v"(t_)); t_ += F.wave * 64; P.tid = t_; P.lane = t_ & 63; int w_ = F.wave; asm volatile("" : "+s"(w_)); P.wave = w_; GAS unsigned char* p_ = (GAS unsigned char*)args.ws; asm volatile("" : "+s"(p_)); P.ws = (unsigned char*)p_; P.ctl = (gu32*)(p_ + WS_CTL); } \
    unsigned char* ws = P.ws; bf16_t* XB = (bf16_t*)(ws + WS_XB); bf16_t* XB2 = (bf16_t*)(ws + WS_R + R_XB2); bf16_t* XD = (bf16_t*)args.out; (void)XD; bf16_t* H = (bf16_t*)(ws + WS_R + R_H); bf16_t* W = (bf16_t*)(ws + WS_W + wbuf_off(layer)); (void)XB; (void)XB2; (void)H; (void)W;
    LAS int* cntl = (LAS int*)(F.lds + LDS_TAB); LAS int* rbs = cntl + 160;
    for (int layer = 0; layer < DEPTH; ++layer) {
        const int pb = layer * PH_PER_LAYER; const bool even = (layer & 1) == 0; const int jl = layer >> 1;
        const bool ovl = (F.G == 256);
        if (IN(pb + 0) && (layer == 0 || !ovl)) { SETPH(pb + 0); PF();
            prep_weights(P, args, layer, P.bid, P.G); prep_acts(P, args, layer, layer == 0);
            SEAM(); }
        if (IN(pb + 1)) { SETPH(pb + 1); PF();
            { const bf16_t* xin = (layer == 0) ? XB : XB2;
            if (even) { pg8::DenseSched S{(const char*)xin, (const char*)(W + W_IN / 2), DM, DM, T / 256, NE_PAD / 256, P.G, P.bid};
                EpiInEven E{H, (const float*)(ws + WS_ROPE_COS), (const float*)(ws + WS_ROPE_SIN)}; pg8::gemm_phase(P.lds, S, E, P.tid); }
            else { pg8::DenseSched S{(const char*)xin, (const char*)(W + W_IN / 2), DM, DM, T / 256, NO_PAD / 256, P.G, P.bid};
                EpiInOdd E{H, (float*)(ws + WS_LOGF), args.in[I_OD_BF] + jl * 16}; pg8::gemm_phase(P.lds, S, E, P.tid); } }
            SEAM(); }
        if ((DUP_K == 1 && (DUP_PAR == 2 || (layer & 1) == DUP_PAR))) { PF();
            { const bf16_t* xin = (layer == 0) ? XB : XB2;
            if (even) { pg8::DenseSched S{(const char*)xin, (const char*)(W + W_IN / 2), DM, DM, T / 256, NE_PAD / 256, P.G, P.bid};
                EpiInEven E{H, (const float*)(ws + WS_ROPE_COS), (const float*)(ws + WS_ROPE_SIN)}; pg8::gemm_phase(P.lds, S, E, P.tid); }
            else { pg8::DenseSched S{(const char*)xin, (const char*)(W + W_IN / 2), DM, DM, T / 256, NO_PAD / 256, P.G, P.bid};
                EpiInOdd E{H, (float*)(ws + WS_LOGF), args.in[I_OD_BF] + jl * 16}; pg8::gemm_phase(P.lds, S, E, P.tid); } }
            SEAM(); }
        if (even) {
        if (IN(pb + 2)) { SETPH(pb + 2); PF();
                for (int it = P.bid; it < 256; it += P.G) compress_item(P, args, layer, it);
                for (int u0 = 0; u0 < NB * 64; u0 += P.G) { const int u = u0 + (((u0 / P.G) & 1) ? (P.G - 1 - P.bid) : P.bid); if (u >= NB * 64) continue; const int qg = 63 - (u / NB), b = u % NB; dsa_unit(P, args, b, qg, H + EC_QA, NE_PAD); }
            SEAM(); }
        if ((DUP_K == 2 && (DUP_PAR == 2 || (layer & 1) == DUP_PAR))) { PF();
                for (int u0 = 0; u0 < NB * 64; u0 += P.G) { const int u = u0 + (((u0 / P.G) & 1) ? (P.G - 1 - P.bid) : P.bid); if (u >= NB * 64) continue; const int qg = 63 - (u / NB), b = u % NB; dsa_unit(P, args, b, qg, (bf16_t*)(ws + WS_R + 568 * MiB), 1024); }
            SEAM(); }
        if (IN(pb + 3)) { SETPH(pb + 3); PF();
                for (int u0 = 0; u0 < NB * 64; u0 += P.G) { const int u = u0 + (((u0 / P.G) & 1) ? (P.G - 1 - P.bid) : P.bid); if (u >= NB * 64) continue; const int qg = 63 - (u / NB), b = u % NB; nsa_unit(P, args, layer, b, qg, H + EC_QB, NE_PAD); }
            SEAM(); }
        if ((DUP_K == 3 && (DUP_PAR == 2 || (layer & 1) == DUP_PAR))) { PF();
                for (int u0 = 0; u0 < NB * 64; u0 += P.G) { const int u = u0 + (((u0 / P.G) & 1) ? (P.G - 1 - P.bid) : P.bid); if (u >= NB * 64) continue; const int qg = 63 - (u / NB), b = u % NB; nsa_unit(P, args, layer, b, qg, (bf16_t*)(ws + WS_R + 568 * MiB) + 512, 1024); }
            SEAM(); }
        } else {
        if (IN(pb + 2)) { SETPH(pb + 2); PF();
            scan_phase(P, args);
            SEAM(); }
        if (IN(pb + 3)) { SETPH(pb + 3); PF();
                fox_phase(P, args, H, NO_PAD);
            SEAM(); }
        if ((DUP_K == 3 && (DUP_PAR == 2 || (layer & 1) == DUP_PAR))) { PF();
#ifdef FOX_EXPT
                fox_phase<FOX_EXPT>(P, args, (bf16_t*)(ws + WS_R + 568 * MiB), 1024);
#else
                fox_phase(P, args, (bf16_t*)(ws + WS_R + 568 * MiB), 1024);
#endif
            SEAM(); }
        }
        if (IN(pb + 4)) { SETPH(pb + 4); PF();
            { pg8::DenseSched S{(const char*)H, (const char*)(W + W_O / 2), even ? NE_PAD : NO_PAD, DM, T / 256, DM / 256, P.G, P.bid};
              EpiOut E{(layer == 0) ? XB : XB2, (layer == 0) ? XB2 : XB}; pg8::gemm_phase(P.lds, S, E, P.tid); }
            SEAM(); }
        if ((DUP_K == 4 && (DUP_PAR == 2 || (layer & 1) == DUP_PAR))) { PF();
            { pg8::DenseSched S{(const char*)H, (const char*)(W + W_O / 2), even ? NE_PAD : NO_PAD, DM, T / 256, DM / 256, P.G, P.bid};
              EpiOut E{(layer == 0) ? XB : XB2, (bf16_t*)(ws + WS_R + 568 * MiB)}; pg8::gemm_phase(P.lds, S, E, P.tid); }
            SEAM(); }
        if (IN(pb + 5)) { SETPH(pb + 5); PF();
            route_phase(P, args, layer, (layer == 0) ? XB2 : XB, XD, false);
            SEAM(); }
        if ((DUP_K == 5 && (DUP_PAR == 2 || (layer & 1) == DUP_PAR))) { PF();
            route_phase(P, args, layer, (layer == 0) ? XB2 : XB, (bf16_t*)(ws + WS_R + 568 * MiB), true);
            SEAM(); }
        if (IN(pb + 6)) { SETPH(pb + 6); PF();
            const bool side = ovl && layer + 1 < DEPTH;
            if (side && (P.bid >> 3) >= 32 - SIDE_PX) prep_weights(P, args, layer + 1, (P.bid & 7) * SIDE_PX + (P.bid >> 3) - (32 - SIDE_PX), 8 * SIDE_PX);
            else { moe_tables(P, layer);
              MoeSched S{(const char*)XD, (const char*)(W + W_UP / 2), DM, DM, 2, (size_t)512 * DM * 2, rbs, cntl, 0, NV - 1, 0, rbs[NV] * 2, P.G, P.bid, (const int*)(ws + WS_SLOT_TK), true, side ? 32 - SIDE_PX : (P.G >> 3)};
              EpiUp E{(bf16_t*)(ws + WS_R + R_HMID)}; pg8::gemm_phase(P.lds, S, E, P.tid); }
            SEAM(); }
        if ((DUP_K == 6 && (DUP_PAR == 2 || (layer & 1) == DUP_PAR))) { PF();
            { moe_tables(P, layer);
              MoeSched S{(const char*)XD, (const char*)(W + W_UP / 2), DM, DM, 2, (size_t)512 * DM * 2, rbs, cntl, 0, NV - 1, 0, rbs[NV] * 2, P.G, P.bid, (const int*)(ws + WS_SLOT_TK), true, P.G >> 3};
              EpiUp E{(bf16_t*)(ws + WS_R + R_HMID)}; pg8::gemm_phase(P.lds, S, E, P.tid); }
            SEAM(); }
        if (IN(pb + 7)) { SETPH(pb + 7); PF();
                { LAS int* rcache = (LAS int*)(P.lds + LDS_TAB + 4096); if (P.tid < 2) rcache[P.tid] = 0;
                  moe_tables(P, layer);
                  MoeSched S{(const char*)(ws + WS_R + R_HMID), (const char*)(W + W_DN / 2), DFF, DFF, 4, (size_t)DM * DFF * 2, rbs, cntl, 0, NV - 1, 0, rbs[NV] * 4, P.G, P.bid, (const int*)(ws + WS_SLOT_TK), false, P.G >> 3};
                  EpiDown E{(bf16_t*)(ws + WS_R + R_YTOK), (const int*)(ws + WS_SLOT_TK), (const float*)(ws + WS_SLOT_G), cntl, false, rcache}; pg8::gemm_phase(P.lds, S, E, P.tid); }
            SEAM(); }
        if (IN(pb + 8)) { SETPH(pb + 8); PF();
#pragma unroll 1
            for (int hf = 0; hf < 2; ++hf) { int h2 = hf; asm volatile("" : "+s"(h2)); combine_phase(P, args, layer, h2, XD, XB, false); } }
        if (IN(pb + 10)) { PF();
            { pg8::DenseSched S{(const char*)(ws + WS_PB), (const char*)(W + W_P / 2), 256, 256, T / 256, DM / 256, P.G, P.bid};
              EpiPleE E{(bf16_t*)(ws + WS_R + R_E), (float*)(ws + WS_SSQ)}; pg8::gemm_phase(P.lds, S, E, P.tid); }
            SEAM(); }
        if ((DUP_K == 11 && (DUP_PAR == 2 || (layer & 1) == DUP_PAR))) { PF();
            { pg8::DenseSched S{(const char*)(ws + WS_PB), (const char*)(W + W_P / 2), 256, 256, T / 256, DM / 256, P.G, P.bid};
              EpiPleE E{(bf16_t*)(ws + WS_R + R_E), (float*)(ws + WS_SSQ)}; pg8::gemm_phase(P.lds, S, E, P.tid); }
            SEAM(); }
        if (IN(pb + 12)) { SETPH(pb + 12); PF();
            { pg8::DenseSched S{(const char*)XB, (const char*)(W + W_G / 2), DM, DM, T / 256, DM / 256, P.G, P.bid};
              EpiPleG E{XB, (const bf16_t*)(ws + WS_R + R_E), (const float*)(ws + WS_SSQ), args.in[I_PNG] + layer * DM, (layer + 1 < DEPTH) ? XB2 : (bf16_t*)nullptr, (layer + 1 < DEPTH) ? (float*)nullptr : args.out};
              pg8::gemm_phase(P.lds, S, E, P.tid); }
            if (ovl && layer + 1 < DEPTH) prep_acts(P, args, layer + 1, false);
            SEAM(); }
        if ((DUP_K == 12 && (DUP_PAR == 2 || (layer & 1) == DUP_PAR))) { PF();
            { pg8::DenseSched S{(const char*)XB, (const char*)(W + W_G / 2), DM, DM, T / 256, DM / 256, P.G, P.bid};
              EpiPleG E{XB, (const bf16_t*)(ws + WS_R + R_E), (const float*)(ws + WS_SSQ), args.in[I_PNG] + layer * DM, (bf16_t*)(ws + WS_R + 568 * MiB), (float*)nullptr}; pg8::gemm_phase(P.lds, S, E, P.tid); }
            SEAM(); }
    }
#ifdef EXTRA_BAR
    for (int i_ = 0; i_ < EXTRA_BAR; ++i_) { SEAM(); }
#endif
#if TIMING
    {
        VM_WAIT(); __syncthreads(); if (multi) xcd_barrier(bar);
        float ta = 0.f, tb = 0.f;
        for (int l = 0; l < DEPTH; ++l) for (int k = 0; k < 13; ++k) { const float d = (float)((unsigned long long*)(args.ws + WS_CTL + 512 * 1024))[l * 16 + k] * 0.01f;
            if (((TA_MASK >> k) & 1) && (TA_PAR == 2 || (l & 1) == TA_PAR)) ta += d; if (((TB_MASK >> k) & 1) && (TB_PAR == 2 || (l & 1) == TB_PAR)) tb += d; }
        for (size_t i = (size_t)blockIdx.x * 512 + F.tid; i < (size_t)T * DM; i += (size_t)gridDim.x * 512) args.out[i] = ta;
        VM_WAIT(); __syncthreads(); if (multi) xcd_barrier(bar);
        if (blockIdx.x == 0 && F.tid == 0) args.out[0] = tb * 100.f;
    }
#endif
#undef IN
#undef SEAM
}

extern "C" void kernel_launch(void* const* d_in, const int* in_sizes, int n_in, void* d_out, int out_size, void* d_ws, size_t ws_size, hipStream_t stream) {
    static int grid = 0;
    if (grid == 0) {
        if (n_in != 29 || in_sizes[0] != T * DM || out_size != T * DM || ws_size < WS_END) { fprintf(stderr, "kernel_launch: unexpected shapes / workspace (n_in %d, ws %zu, need %zu)\n", n_in, ws_size, (size_t)WS_END); grid = -1; return; }
        int dev = 0, cus = 0, per_cu = 0;
        if (hipGetDevice(&dev) != hipSuccess || hipDeviceGetAttribute(&cus, hipDeviceAttributeMultiprocessorCount, dev) != hipSuccess) { grid = -1; return; }
        if (hipFuncSetAttribute((const void*)fwd, hipFuncAttributeMaxDynamicSharedMemorySize, LDS_BYTES) != hipSuccess) { fprintf(stderr, "kernel_launch: hipFuncSetAttribute failed\n"); grid = -1; return; }
        if (hipOccupancyMaxActiveBlocksPerMultiprocessor(&per_cu, (const void*)fwd, 512, LDS_BYTES) != hipSuccess || per_cu < 1) { fprintf(stderr, "kernel_launch: occupancy query says %d\n", per_cu); }
        (void)hipGetLastError();
        grid = cus;
    }
    if (grid < 0) return;
    if (hipMemsetAsync((char*)d_ws + WS_CTL, 0, CTL_BYTES, stream) != hipSuccess) return;
    Args a{};
    for (int i = 0; i < 29; ++i) a.in[i] = (const float*)d_in[i];
    a.out = (float*)d_out; a.ws = (unsigned char*)d_ws;
#if MK_ONE_LAUNCH
    a.ph_lo = 0; a.ph_hi = N_PHASES;
    hipLaunchKernelGGL(fwd, dim3(grid), dim3(512), LDS_BYTES, stream, a.in[0], a.in[1], a.in[2], a.in[3], a.in[4], a.in[5], a.in[6], a.in[7], a.in[8], a.in[9], a.in[10], a.in[11], a.in[12], a.in[13], a.in[14], a.in[15], a.in[16], a.in[17], a.in[18], a.in[19], a.in[20], a.in[21], a.in[22], a.in[23], a.in[24], a.in[25], a.in[26], a.in[27], a.in[28], a.out, a.ws, a.ph_lo, a.ph_hi);
#else
    for (int ph = 0; ph < N_PHASES; ++ph) {
        if ((ph % PH_PER_LAYER) > 12) continue;
        a.ph_lo = ph; a.ph_hi = ph + 1;
        hipLaunchKernelGGL(fwd, dim3(grid), dim3(512), LDS_BYTES, stream, a.in[0], a.in[1], a.in[2], a.in[3], a.in[4], a.in[5], a.in[6], a.in[7], a.in[8], a.in[9], a.in[10], a.in[11], a.in[12], a.in[13], a.in[14], a.in[15], a.in[16], a.in[17], a.in[18], a.in[19], a.in[20], a.in[21], a.in[22], a.in[23], a.in[24], a.in[25], a.in[26], a.in[27], a.in[28], a.out, a.ws, a.ph_lo, a.ph_hi);
    }
#endif
}
```

```cpp
#include <hip/hip_runtime.h>
#include <cstdio>
#include <cstdint>

#define LAS __attribute__((address_space(3)))
#define GAS __attribute__((address_space(1)))
typedef unsigned short bf16_t;
typedef short bf16x8 __attribute__((ext_vector_type(8)));
typedef short s16x4 __attribute__((ext_vector_type(4)));
typedef float f32x2 __attribute__((ext_vector_type(2)));
typedef float f32x4 __attribute__((ext_vector_type(4)));
typedef float f32x16 __attribute__((ext_vector_type(16)));
typedef unsigned u32x2 __attribute__((ext_vector_type(2)));
typedef unsigned u32x4 __attribute__((ext_vector_type(4)));
typedef GAS unsigned gu32;

#ifndef SIDE_PX
#define SIDE_PX 3
#endif
#ifndef Y_FP8
#define Y_FP8 1
#endif
#ifndef MK_ONE_LAUNCH
#define MK_ONE_LAUNCH 1
#endif

constexpr int DM = 1024, NB = 32, SEQ = 2048, DEPTH = 4, T = NB * SEQ;
constexpr int EVEN_COLS = 2144, ODD_COLS = 3088, NE_PAD = 2304, NO_PAD = 3328;
constexpr int NEXP = 64, NV = 130  , HALF_T = T / 2, DFF = 256;
constexpr float LN_EPS = 1e-5f, RMS_EPS = 1e-6f;
constexpr float ALPHA = 1.6817928305074290f;
constexpr float LOG2E = 1.4426950408889634f;
constexpr float QK_C = 0.125f * LOG2E;
constexpr float NEGBIG = -1e30f;

constexpr int EC_QA = 0, EC_QB = 512, EC_QI = 1024, EC_KA = 1536, EC_KI = 1600, EC_KS = 1664, EC_KW = 1728;
constexpr int EC_VA = 1792, EC_KC = 1856, EC_VC = 1920, EC_VS = 1984, EC_VW = 2048, EC_WI = 2112, EC_GB = 2120;

constexpr size_t MiB = 1u << 20;
constexpr size_t WS_CTL = 0, CTL_BYTES = 1 * MiB;
constexpr size_t WS_ROPE_COS = 1 * MiB, WS_ROPE_SIN = WS_ROPE_COS + 256 * 1024;
constexpr size_t WS_SLOT_TK = 2 * MiB;
constexpr size_t WS_SLOT_G = WS_SLOT_TK + (size_t)NV * HALF_T * 4;
constexpr size_t WS_DCUM = 38 * MiB;
constexpr size_t WS_LOGF = 42 * MiB;
constexpr size_t WS_KC = 46 * MiB, WS_VC = WS_KC + 512 * 1024;
constexpr size_t WS_SSQ = 47 * MiB;
constexpr size_t WS_PB = 51 * MiB;
constexpr size_t WS_MISC = 83 * MiB;
constexpr size_t WS_XB = 84 * MiB;
constexpr size_t WS_W = 212 * MiB, W_BUF = 128 * MiB;
constexpr size_t W_IN = 0, W_O = 7 * MiB, W_G = 9 * MiB, W_P = 11 * MiB, W_RH = 11 * MiB + 512 * 1024, W_RL = W_RH + 128 * 1024  , W_C1K = 12 * MiB, W_C1V = W_C1K + 256 * 1024, W_C2K = W_C1V + 256 * 1024, W_C2V = W_C2K + 8192;
constexpr size_t W_UP = 16 * MiB  , W_DN = 82 * MiB  ;
constexpr size_t WS_R = 468 * MiB;
constexpr size_t R_H = 0, R_HMID = 0, R_E = 0, R_YTOK = 320 * MiB, R_XB2 = 440 * MiB;
constexpr size_t WS_END = WS_R + 896 * MiB;
static_assert(Y_FP8 == 1 && R_YTOK + (size_t)T * 9 * 1024 <= 896 * MiB, "ytok");
static_assert(W_DN + 65ull * 1024 * 256 * 2 <= 128 * MiB, "w");
constexpr int CW_BAR = 4096;
constexpr int CW_CNT = 16384;
constexpr int XBW = 3456;

constexpr int RING_BYTES = 131072;
constexpr int LDS_TAB = RING_BYTES;
constexpr int LDS_MISC = RING_BYTES + 20480;
constexpr int LDS_BYTES = RING_BYTES + 20480 + 256;

#define LDS_WAIT() asm volatile("s_waitcnt lgkmcnt(0)" ::: "memory")
#define VM_WAIT() asm volatile("s_waitcnt vmcnt(0)" ::: "memory")
#define RLX_AGENT __ATOMIC_RELAXED, __HIP_MEMORY_SCOPE_AGENT
__device__ __forceinline__ unsigned f2bf(float f) { unsigned u = __builtin_bit_cast(unsigned, f); return (u + 0x7fffu + ((u >> 16) & 1u)) >> 16; }
__device__ __forceinline__ unsigned pk2(float lo, float hi) { return f2bf(lo) | (f2bf(hi) << 16); }
__device__ __forceinline__ float bf2f(unsigned short h) { return __builtin_bit_cast(float, (unsigned)h << 16); }
__device__ __forceinline__ float bflo(unsigned w) { return __builtin_bit_cast(float, w << 16); }
__device__ __forceinline__ float bfhi(unsigned w) { return __builtin_bit_cast(float, w & 0xffff0000u); }
template <int CTRL> __device__ __forceinline__ float dpp_mov(float x) { return __builtin_bit_cast(float, __builtin_amdgcn_update_dpp(0, __builtin_bit_cast(int, x), CTRL, 0xf, 0xf, true)); }
template <int CTRL> __device__ __forceinline__ unsigned dpp_movu(unsigned x) { return (unsigned)__builtin_amdgcn_update_dpp(0, (int)x, CTRL, 0xf, 0xf, true); }
#define DPP_X1 0xB1
#define DPP_X2 0x4E
#define DPP_HM 0x141
#define DPP_RM 0x140
__device__ __forceinline__ float bperm_xor(float x, int lane, int mask) { return __builtin_bit_cast(float, __builtin_amdgcn_ds_bpermute((lane ^ mask) << 2, __builtin_bit_cast(int, x))); }
__device__ __forceinline__ float sum_x32(float x, int lane) { return x + bperm_xor(x, lane, 32); }
__device__ __forceinline__ float max_x32(float x, int lane) { return fmaxf(x, bperm_xor(x, lane, 32)); }
__device__ __forceinline__ float sum_x16(float x, int lane) { return x + bperm_xor(x, lane, 16); }
__device__ __forceinline__ float wave_sum(float v) {
    v += dpp_mov<DPP_X1>(v); v += dpp_mov<DPP_X2>(v); v += dpp_mov<DPP_HM>(v); v += dpp_mov<DPP_RM>(v);
    const float r0 = __builtin_bit_cast(float, __builtin_amdgcn_readlane(__builtin_bit_cast(int, v), 0)), r1 = __builtin_bit_cast(float, __builtin_amdgcn_readlane(__builtin_bit_cast(int, v), 16)),
                r2 = __builtin_bit_cast(float, __builtin_amdgcn_readlane(__builtin_bit_cast(int, v), 32)), r3 = __builtin_bit_cast(float, __builtin_amdgcn_readlane(__builtin_bit_cast(int, v), 48));
    return (r0 + r1) + (r2 + r3);
}
__device__ __forceinline__ int wave_sum_i(int v) {
    v += __builtin_amdgcn_update_dpp(0, v, DPP_X1, 0xf, 0xf, true); v += __builtin_amdgcn_update_dpp(0, v, DPP_X2, 0xf, 0xf, true);
    v += __builtin_amdgcn_update_dpp(0, v, DPP_HM, 0xf, 0xf, true); v += __builtin_amdgcn_update_dpp(0, v, DPP_RM, 0xf, 0xf, true);
    return (__builtin_amdgcn_readlane(v, 0) + __builtin_amdgcn_readlane(v, 16)) + (__builtin_amdgcn_readlane(v, 32) + __builtin_amdgcn_readlane(v, 48));
}
__device__ __forceinline__ float fast_exp2(float x) { return __builtin_amdgcn_exp2f(x); }
__device__ __forceinline__ float sigmoidf_(float x) { return __builtin_amdgcn_rcpf(1.0f + __expf(-x)); }

#define XB_TMO      128
#define XB_XCNT(j)  (256  + 64 * (j))
#define XB_XSUB(j)  (1280 + 64 * (j))
#define XB_XGEN(j)  (2304 + 64 * (j))
#define XB_TOP      3328
#define XB_TOPGEN   3392
#define XCD_BAR_WORDS 3456
#define XB_SPIN_CAP (1u << 22)
__device__ __forceinline__ unsigned xb_ld(unsigned* p)              { return __hip_atomic_load(p, __ATOMIC_RELAXED, __HIP_MEMORY_SCOPE_AGENT); }
__device__ __forceinline__ unsigned xb_add(unsigned* p, unsigned v) { return __hip_atomic_fetch_add(p, v, __ATOMIC_RELAXED, __HIP_MEMORY_SCOPE_AGENT); }
__device__ __forceinline__ unsigned xb_xcc_id() { return (unsigned)__builtin_amdgcn_s_getreg((3 << 11) | 20) & 0xFu; }
#define XB_SPIN(cond, bar) do { unsigned _sp = 0; while (cond) { __builtin_amdgcn_s_sleep(1); \
    if ((++_sp & 255u) == 0u) { if (xb_ld(&(bar)[XB_TMO])) break; if (_sp > XB_SPIN_CAP) { atomicAdd(&(bar)[XB_TMO], 1u); break; } } } } while (0)
struct XcdBarrier { unsigned* bar; unsigned x; volatile LAS unsigned* st; };
__device__ __forceinline__ XcdBarrier xcd_barrier_post(unsigned* bar, volatile LAS unsigned* st) {
    XcdBarrier b; b.bar = bar; b.x = xb_xcc_id(); b.st = st;
    if (threadIdx.x == 0) (void)xb_add(&bar[XB_XCNT(b.x)], 1u);
    return b;
}
__device__ __forceinline__ void xcd_barrier_complete(unsigned* bar, unsigned x, unsigned& nloc, unsigned& nx) {
    const unsigned G = gridDim.x * gridDim.y * gridDim.z;
    unsigned sum, cnt, mine, sp = 0u;
    for (;;) {
        sum = 0u; cnt = 0u; mine = 0u;
#pragma unroll
        for (unsigned j = 0; j < 16; ++j) { const unsigned c = xb_ld(&bar[XB_XCNT(j)]); sum += c; cnt += (c > 0u) ? 1u : 0u; mine = (j == x) ? c : mine; }
        if (sum == G) break;
        __builtin_amdgcn_s_sleep(1);
        if ((++sp & 255u) == 0u) { if (xb_ld(&bar[XB_TMO])) break; if (sp > XB_SPIN_CAP) { atomicAdd(&bar[XB_TMO], 1u); break; } }
    }
    nloc = mine > 0u ? mine : 1u; nx = cnt > 0u ? cnt : 1u;
}
__device__ __forceinline__ void xcd_barrier(const XcdBarrier& b) {
    asm volatile("s_waitcnt vmcnt(0)" ::: "memory");
    __syncthreads();
    if (threadIdx.x == 0) {
        unsigned* bar = b.bar; unsigned bx = b.x; asm volatile("" : "+s"(bx)); asm volatile("" : "+s"(bar));
        __builtin_amdgcn_s_waitcnt(0);
        unsigned nloc = b.st[0], nx = b.st[1];
        if (nloc == 0u) { xcd_barrier_complete(bar, bx, nloc, nx); b.st[0] = nloc; b.st[1] = nx; }
        const unsigned old = xb_add(&bar[XB_XSUB(bx)], 1u);
        const unsigned gen = old / nloc;
        if (old + 1u == (gen + 1u) * nloc) {
            __builtin_amdgcn_fence(__ATOMIC_RELEASE, "agent");
            asm volatile("s_waitcnt vmcnt(0)" ::: "memory");
            const unsigned og = xb_add(&bar[XB_TOP], 1u);
            const unsigned tg = og / nx;
            if (og + 1u == (tg + 1u) * nx) xb_add(&bar[XB_TOPGEN], 1u);
            else XB_SPIN(xb_ld(&bar[XB_TOPGEN]) == tg, bar);
            __builtin_amdgcn_fence(__ATOMIC_ACQUIRE, "agent");
            xb_add(&bar[XB_XGEN(bx)], 1u);
            asm volatile("s_waitcnt vmcnt(0)" ::: "memory");
        } else {
            XB_SPIN(xb_ld(&bar[XB_XGEN(bx)]) == gen, bar);
            __builtin_amdgcn_fence(__ATOMIC_ACQUIRE, "agent");
            asm volatile("s_waitcnt vmcnt(0)" ::: "memory");
        }
    }
    __syncthreads();
}

namespace pg8 {
constexpr int BM = 256, BK = 64, HALF = 128, HTB = HALF * BK * 2, STAGE_BYTES = 8 * HTB, NXCD = 8, WGM = 8;
__host__ __device__ __forceinline__ int lds_byte(int r, int c) { const int st = (r >> 4) * 2 + (c >> 5), rr = r & 15, cc = c & 31, ob = rr * 64 + cc * 2; return st * 1024 + (ob ^ (((ob >> 9) & 1) << 5)); }
__host__ __device__ __forceinline__ void stage_rc(int b, int& R, int& C) { const int st = b / 1024, sb = b % 1024, swz = sb ^ (((sb >> 9) & 1) << 5); R = (st >> 1) * 16 + swz / 64; C = (st & 1) * 32 + (swz % 64) / 2; }
__host__ __device__ __forceinline__ int perm32(int rho) { const int n = rho >> 4, i = rho & 15; return 8 * (i >> 2) + 4 * n + (i & 3); }

struct Unit { int pm, pn, v, rb; };

__device__ __forceinline__ bool static_next(int nM, int nN, int G, int c, int i, Unit& u) {
    const int nwg = nM * nN; const long L = (long)i * G + c; if (L >= nwg) return false;
    int wgid = (int)L; { const int q = nwg / NXCD, r = nwg % NXCD, xcd = wgid % NXCD, off = wgid / NXCD; wgid = (xcd < r ? xcd * (q + 1) : r * (q + 1) + (xcd - r) * q) + off; }
    const int nig = WGM * nN, gid = wgid / nig, fm = gid * WGM, gsz = (nM - fm) < WGM ? (nM - fm) : WGM;
    u.pm = fm + ((wgid % nig) % gsz); u.pn = (wgid % nig) / gsz; u.v = 0; u.rb = 0; return true;
}
struct DenseSched {
    const char* A; const char* Bt; int lda, K, nM, nN, G, c;
    __device__ __forceinline__ bool next(int i, Unit& u) const { return static_next(nM, nN, G, c, i, u); }
    __device__ __forceinline__ bool same_rows(const Unit&, const Unit&) const { return false; }
    __device__ __forceinline__ const char* a_base(const Unit& u) const { return A + (size_t)u.pm * 256 * lda * 2; }
    __device__ __forceinline__ const char* b_base(const Unit& u) const { return Bt + (size_t)u.pn * 256 * K * 2; }
    __device__ __forceinline__ void a_off(const Unit&, const int (&R)[2], const int (&C)[2], unsigned (&o)[2][2]) const {
#pragma unroll
        for (int h = 0; h < 2; ++h)
#pragma unroll
            for (int i = 0; i < 2; ++i) o[h][i] = (unsigned)((h * 128 + R[i]) * lda + C[i]) * 2u;
    }
};

__device__ __forceinline__ unsigned cvt_pk_bf16(float lo, float hi) { unsigned r; asm volatile("v_cvt_pk_bf16_f32 %0, %1, %2" : "=v"(r) : "v"(lo), "v"(hi)); return r; }

template <class Epi, class Sched>
__device__ __forceinline__ void gemm_phase(LAS unsigned char* lds, const Sched& S, const Epi& E, int tid) {
    const int wid = __builtin_amdgcn_readfirstlane(tid >> 6), lane = tid & 63, wr = wid >> 2, wc = wid & 3, fr = lane & 15, fq = lane >> 4;
    const int K = S.K, nt = K / BK;
    int RR[2], CC[2]; unsigned voffB[2];
#pragma unroll
    for (int i = 0; i < 2; ++i) { int R, C; stage_rc(tid * 16 + i * 8192, R, C); const int Rb = Epi::PERM ? ((R & ~31) + perm32(R & 31)) : R;
        RR[i] = R; CC[i] = C; voffB[i] = (unsigned)(Rb * K + C) * 2u; }
    const size_t kstep = (size_t)(BK * 2);
    const size_t hstep = (size_t)HALF * K * 2;
    const unsigned ldsw = (unsigned)wid * 1024u;
    const int aoff = lds_byte(wr * 64 + fr, fq * 8), boff = lds_byte(wc * 32 + fr, fq * 8);
#define PG8_SA(b, h) (((b) * 2 + (h)) * HTB)
#define PG8_SB(b, h) ((4 + (b) * 2 + (h)) * HTB)
#define PG8_STAGE(bufoff, gbase, voff) do { _Pragma("unroll") for (int _i = 0; _i < 2; ++_i) \
        __builtin_amdgcn_global_load_lds((const unsigned*)((const char*)(gbase) + (voff)[_i]), (LAS unsigned*)(lds + (bufoff) + ldsw + _i * 8192), 16, 0, 0); } while (0)
#define PG8_LDA(dst, b, h) do { _Pragma("unroll") for (int m = 0; m < 4; ++m) _Pragma("unroll") for (int k = 0; k < 2; ++k) dst[m][k] = *(const LAS bf16x8*)(lds + PG8_SA(b, h) + aoff + m * 2048 + k * 1024); } while (0)
#define PG8_LDB(dst, b, h) do { _Pragma("unroll") for (int n = 0; n < 2; ++n) _Pragma("unroll") for (int k = 0; k < 2; ++k) dst[n][k] = *(const LAS bf16x8*)(lds + PG8_SB(b, h) + boff + n * 2048 + k * 1024); } while (0)
#define PG8_MMA(ai, bj, At, Bt) do { __builtin_amdgcn_s_setprio(1); _Pragma("unroll") for (int m = 0; m < 4; ++m) _Pragma("unroll") for (int n = 0; n < 2; ++n) _Pragma("unroll") for (int k = 0; k < 2; ++k) \
        acc[ai][bj][m][n] = __builtin_amdgcn_mfma_f32_16x16x32_bf16(Bt[n][k], At[m][k], acc[ai][bj][m][n], 0, 0, 0); __builtin_amdgcn_s_setprio(0); } while (0)
#define PG8_WAIT_V(n) asm volatile("s_waitcnt vmcnt(" #n ")" ::: "memory")
#define PG8_WAIT_L(n) asm volatile("s_waitcnt lgkmcnt(" #n ")" ::: "memory")
#define PG8_BAR __builtin_amdgcn_s_barrier()
#define PG8_SCHED __builtin_amdgcn_sched_barrier(0)
    Unit cur, nxt; int ui = 0;
    if (!S.next(0, cur)) return;
    f32x4 acc[2][2][4][2];
    float zz = 0.f; asm volatile("" : "+v"(zz));
#pragma unroll
    for (int a = 0; a < 2; ++a)
#pragma unroll
        for (int b = 0; b < 2; ++b)
#pragma unroll
            for (int m = 0; m < 4; ++m)
#pragma unroll
                for (int n = 0; n < 2; ++n) acc[a][b][m][n] = (f32x4){zz, zz, zz, zz};
    bf16x8 At[4][2], B0[2][2], B1[2][2];
    unsigned oa[2][2], on[2][2];
    S.a_off(cur, RR, CC, oa);
    const char* cA = S.a_base(cur); const char* cB = S.b_base(cur);
    PG8_STAGE(PG8_SB(0, 0), cB, voffB); PG8_STAGE(PG8_SB(0, 1), cB + hstep, voffB); PG8_STAGE(PG8_SA(0, 0), cA, oa[0]); PG8_STAGE(PG8_SA(0, 1), cA, oa[1]);
    if (wr == 1) PG8_BAR;
    PG8_WAIT_V(2); PG8_BAR;
    PG8_STAGE(PG8_SB(1, 0), cB + kstep, voffB); PG8_STAGE(PG8_SA(1, 0), cA + kstep, oa[0]); PG8_STAGE(PG8_SB(1, 1), cB + hstep + kstep, voffB);
    PG8_WAIT_V(6); PG8_BAR;
    for (;;) {
        const bool has_next = S.next(ui + 1, nxt);
        const char* nA = has_next ? S.a_base(nxt) : cA; const char* nB = has_next ? S.b_base(nxt) : cB;
        if (has_next && !S.same_rows(cur, nxt)) S.a_off(nxt, RR, CC, on);
        else {
#pragma unroll
            for (int h = 0; h < 2; ++h)
#pragma unroll
                for (int i = 0; i < 2; ++i) on[h][i] = oa[h][i];
        }
        for (int t = 0; t < nt; t += 2) {
            const bool last = (t == nt - 2);
            const char* a1 = cA + (size_t)(t + 1) * kstep;
            const char* a2 = last ? nA : cA + (size_t)(t + 2) * kstep; const char* b2 = last ? nB : cB + (size_t)(t + 2) * kstep;
            const char* a3 = a2 + kstep; const char* b3 = b2 + kstep;
            unsigned x0[2], x1[2];
#pragma unroll
            for (int i = 0; i < 2; ++i) { x0[i] = last ? on[0][i] : oa[0][i]; x1[i] = last ? on[1][i] : oa[1][i]; }
            PG8_LDB(B0, 0, 0); PG8_LDB(B1, 0, 1); PG8_SCHED; PG8_LDA(At, 0, 0); PG8_STAGE(PG8_SA(1, 1), a1, oa[1]);
            PG8_WAIT_V(8); PG8_WAIT_L(0); PG8_BAR; PG8_MMA(0, 0, At, B0); PG8_MMA(0, 1, At, B1); PG8_BAR; PG8_SCHED;
            PG8_LDA(At, 0, 1); PG8_STAGE(PG8_SB(0, 0), b2, voffB); PG8_STAGE(PG8_SB(0, 1), b2 + hstep, voffB); PG8_STAGE(PG8_SA(0, 0), a2, x0);
            PG8_WAIT_V(8); PG8_WAIT_L(0); PG8_BAR; PG8_MMA(1, 0, At, B0); PG8_MMA(1, 1, At, B1); PG8_BAR; PG8_SCHED;
            PG8_LDB(B0, 1, 0); PG8_LDB(B1, 1, 1); PG8_SCHED; PG8_LDA(At, 1, 0); PG8_STAGE(PG8_SA(0, 1), a2, x1);
            PG8_WAIT_V(8); PG8_WAIT_L(0); PG8_BAR; PG8_MMA(0, 0, At, B0); PG8_MMA(0, 1, At, B1); PG8_BAR; PG8_SCHED;
            PG8_LDA(At, 1, 1); PG8_STAGE(PG8_SB(1, 0), b3, voffB); PG8_STAGE(PG8_SB(1, 1), b3 + hstep, voffB); PG8_STAGE(PG8_SA(1, 0), a3, x0);
            PG8_WAIT_V(8); PG8_WAIT_L(0); PG8_BAR; PG8_MMA(1, 0, At, B0); PG8_MMA(1, 1, At, B1); PG8_BAR; PG8_SCHED;
        }
        if (wr == 0) PG8_BAR;
        E(acc, cur, wr, wc, fr, fq);
        if (!has_next) break;
#pragma unroll
        for (int a = 0; a < 2; ++a)
#pragma unroll
            for (int b = 0; b < 2; ++b)
#pragma unroll
                for (int m = 0; m < 4; ++m)
#pragma unroll
                    for (int n = 0; n < 2; ++n) acc[a][b][m][n] = (f32x4){zz, zz, zz, zz};
        cur = nxt; cA = nA; cB = nB; ++ui;
#pragma unroll
        for (int h = 0; h < 2; ++h)
#pragma unroll
            for (int i = 0; i < 2; ++i) oa[h][i] = on[h][i];
        if (wr == 1) PG8_BAR;
    }
    PG8_WAIT_V(0);
    PG8_BAR;
#undef PG8_SA
#undef PG8_SB
#undef PG8_STAGE
#undef PG8_LDA
#undef PG8_LDB
#undef PG8_MMA
#undef PG8_WAIT_V
#undef PG8_WAIT_L
#undef PG8_BAR
#undef PG8_SCHED
}
}

using pg8::Unit;
__device__ __forceinline__ u32x4 pack8(f32x4 a, f32x4 b) { u32x4 w; w.x = pg8::cvt_pk_bf16(a[0], a[1]); w.y = pg8::cvt_pk_bf16(a[2], a[3]); w.z = pg8::cvt_pk_bf16(b[0], b[1]); w.w = pg8::cvt_pk_bf16(b[2], b[3]); return w; }

struct EpiInEven {
    static constexpr bool PERM = true;
    bf16_t* H; const float* cosT; const float* sinT;
    __device__ __forceinline__ void operator()(const f32x4 (&acc)[2][2][4][2], const Unit& u, int wr, int wc, int fr, int fq) const {
        const int row0 = u.pm * 256 + wr * 64 + fr, col0 = u.pn * 256 + wc * 32 + 8 * fq;
        const bool rope = u.pn < 7; const int j0 = (wc & 1) * 16 + 4 * fq;
#pragma unroll
        for (int ai = 0; ai < 2; ++ai) {
            f32x4 cs[4], sn[4];
#pragma unroll
            for (int m = 0; m < 4; ++m) { const int pos = (row0 + ai * 128 + m * 16) & (SEQ - 1);
                cs[m] = (f32x4){1.f, 1.f, 1.f, 1.f}; sn[m] = (f32x4){0.f, 0.f, 0.f, 0.f};
                if (rope) { cs[m] = *(const f32x4*)(cosT + pos * 32 + j0); sn[m] = *(const f32x4*)(sinT + pos * 32 + j0); } }
#pragma unroll
            for (int m = 0; m < 4; ++m) {
                const int row = row0 + ai * 128 + m * 16; const f32x4 c = cs[m], z = sn[m];
                bf16_t* rowp = H + (size_t)row * NE_PAD + col0;
#pragma unroll
                for (int bj = 0; bj < 2; ++bj) {
                    const f32x4 v0 = acc[ai][bj][m][0], v1 = acc[ai][bj][m][1];
                    f32x4 o0, o1;
                    o0[0] = v0[0] * c[0] - v0[1] * z[0]; o0[1] = v0[1] * c[0] + v0[0] * z[0];
                    o0[2] = v0[2] * c[1] - v0[3] * z[1]; o0[3] = v0[3] * c[1] + v0[2] * z[1];
                    o1[0] = v1[0] * c[2] - v1[1] * z[2]; o1[1] = v1[1] * c[2] + v1[0] * z[2];
                    o1[2] = v1[2] * c[3] - v1[3] * z[3]; o1[3] = v1[3] * c[3] + v1[2] * z[3];
                    *(u32x4*)(rowp + bj * 128) = pack8(o0, o1);
                }
            }
        }
    }
};
struct EpiInOdd {
    static constexpr bool PERM = true;
    bf16_t* H; float* logf; const float* bf;
    __device__ __forceinline__ void operator()(const f32x4 (&acc)[2][2][4][2], const Unit& u, int wr, int wc, int fr, int fq) const {
        const int row0 = u.pm * 256 + wr * 64 + fr, col0 = u.pn * 256 + wc * 32 + 8 * fq;
        float zz = 0.f; asm volatile("" : "+v"(zz));
#pragma unroll
        for (int ai = 0; ai < 2; ++ai)
#pragma unroll
            for (int m = 0; m < 4; ++m) {
                const int row = row0 + ai * 128 + m * 16;
                bf16_t* rowp = H + (size_t)row * NO_PAD + col0;
#pragma unroll
                for (int bj = 0; bj < 2; ++bj) *(u32x4*)(rowp + bj * 128) = pack8(acc[ai][bj][m][0] + zz, acc[ai][bj][m][1] + zz);
                if (u.pn == 12 && wc == 0 && fq < 2) {
                    f32x4 r0, r1;
#pragma unroll
                    for (int j = 0; j < 4; ++j) {
                        const float x0 = acc[ai][0][m][0][j] + bf[8 * fq + j], x1 = acc[ai][0][m][1][j] + bf[8 * fq + 4 + j];
                        r0[j] = fminf(x0, 0.f) - log1pf(__expf(-fabsf(x0))); r1[j] = fminf(x1, 0.f) - log1pf(__expf(-fabsf(x1)));
                    }
                    *(f32x4*)(logf + (size_t)row * 16 + 8 * fq) = r0; *(f32x4*)(logf + (size_t)row * 16 + 8 * fq + 4) = r1;
                }
                asm volatile("" ::: "memory");
            }
    }
};
struct EpiOut {
    static constexpr bool PERM = true;
    const bf16_t* X; bf16_t* Y;
    __device__ __forceinline__ void operator()(const f32x4 (&acc)[2][2][4][2], const Unit& u, int wr, int wc, int fr, int fq) const {
        const int row0 = u.pm * 256 + wr * 64 + fr, col0 = u.pn * 256 + wc * 32 + 8 * fq;
#pragma unroll
        for (int ai = 0; ai < 2; ++ai) {
            u32x4 x[4][2];
#pragma unroll
            for (int m = 0; m < 4; ++m) { const size_t off = (size_t)(row0 + ai * 128 + m * 16) * DM + col0;
#pragma unroll
                for (int bj = 0; bj < 2; ++bj) x[m][bj] = *(const u32x4*)(X + off + bj * 128); }
#pragma unroll
            for (int m = 0; m < 4; ++m) { const size_t off = (size_t)(row0 + ai * 128 + m * 16) * DM + col0;
#pragma unroll
                for (int bj = 0; bj < 2; ++bj) { const u32x4 w = x[m][bj]; const f32x4 a0 = acc[ai][bj][m][0], a1 = acc[ai][bj][m][1];
                    const f32x4 o0 = {bflo(w.x) * ALPHA + a0[0], bfhi(w.x) * ALPHA + a0[1], bflo(w.y) * ALPHA + a0[2], bfhi(w.y) * ALPHA + a0[3]};
                    const f32x4 o1 = {bflo(w.z) * ALPHA + a1[0], bfhi(w.z) * ALPHA + a1[1], bflo(w.w) * ALPHA + a1[2], bfhi(w.w) * ALPHA + a1[3]};
                    *(u32x4*)(Y + off + bj * 128) = pack8(o0, o1); } }
        }
    }
};
struct EpiUp {
    static constexpr bool PERM = false;
    bf16_t* Hm;
    __device__ __forceinline__ void operator()(const f32x4 (&acc)[2][2][4][2], const Unit& u, int wr, int wc, int fr, int fq) const {
        const int row0 = u.pm * 256 + wr * 64 + fr, col0 = u.pn * 128 + wc * 16 + 4 * fq;
#pragma unroll
        for (int ai = 0; ai < 2; ++ai)
#pragma unroll
            for (int m = 0; m < 4; ++m) {
                bf16_t* rowp = Hm + (size_t)(row0 + ai * 128 + m * 16) * DFF + col0;
#pragma unroll
                for (int bj = 0; bj < 2; ++bj) {
                    const f32x4 a = acc[ai][bj][m][0], b = acc[ai][bj][m][1]; f32x4 h;
#pragma unroll
                    for (int j = 0; j < 4; ++j) h[j] = a[j] * b[j] * __builtin_amdgcn_rcpf(1.0f + fast_exp2(-a[j] * LOG2E));
                    u32x2 w; w.x = pg8::cvt_pk_bf16(h[0], h[1]); w.y = pg8::cvt_pk_bf16(h[2], h[3]);
                    *(u32x2*)(rowp + bj * 64) = w;
                }
            }
    }
};
struct EpiDown {
    static constexpr bool PERM = true;
    bf16_t* Y; const int* slot_tk; const float* slot_g; const LAS int* cnt; bool dense; LAS int* rc;
    __device__ __forceinline__ void operator()(const f32x4 (&acc)[2][2][4][2], const Unit& u, int wr, int wc, int fr, int fq) const {
        const int e = u.v % 65, half = u.v / 65, n = cnt[u.v];
        const int col0 = u.pn * 256 + wc * 32 + 8 * fq;
        int drow[8]; float gg[8];
        const int tagv = u.v * 4096 + u.rb + 1;
        const bool hit = !dense && (rc[wr] == tagv);
        if (hit) {
#pragma unroll
            for (int i = 0; i < 8; ++i) { const int rl = (i >> 2) * 128 + wr * 64 + (i & 3) * 16 + fr; drow[i] = rc[16 + 2 * rl]; gg[i] = __builtin_bit_cast(float, rc[16 + 2 * rl + 1]); }
        } else {
#pragma unroll
            for (int i = 0; i < 8; ++i) {
                const int pos = u.rb * 256 + (i >> 2) * 128 + wr * 64 + (i & 3) * 16 + fr;
                drow[i] = -1; gg[i] = 1.f;
                if (dense) { drow[i] = (u.pm & 63) * 256 + (i >> 2) * 128 + wr * 64 + (i & 3) * 16 + fr; }
                else if (pos < n) {
                    if (e == 64) drow[i] = (half * HALF_T + pos) * 9 + 8;
                    else { const int tk = slot_tk[(size_t)u.v * HALF_T + pos]; gg[i] = slot_g[(size_t)u.v * HALF_T + pos]; drow[i] = (tk >> 3) * 9 + (tk & 7); }
                }
            }
            if (!dense && wc == 0) {
                if (fq == 0) {
#pragma unroll
                    for (int i = 0; i < 8; ++i) { const int rl = (i >> 2) * 128 + wr * 64 + (i & 3) * 16 + fr; rc[16 + 2 * rl] = drow[i]; rc[16 + 2 * rl + 1] = __builtin_bit_cast(int, gg[i]); } }
                asm volatile("s_waitcnt lgkmcnt(0)" ::: "memory");
                if (fq == 0 && fr == 0) rc[wr] = tagv;
            }
        }
#pragma unroll
        for (int ai = 0; ai < 2; ++ai)
#pragma unroll
            for (int m = 0; m < 4; ++m) {
                const int i = ai * 4 + m;
                if (drow[i] >= 0) {
#if Y_FP8
                    const float g = gg[i] * 32.0f; unsigned char* rowp = (unsigned char*)Y + (size_t)drow[i] * DM + col0;
#pragma unroll
                    for (int bj = 0; bj < 2; ++bj) { f32x4 v0 = acc[ai][bj][m][0] * g, v1 = acc[ai][bj][m][1] * g; u32x2 w;
#pragma unroll
                        for (int q = 0; q < 4; ++q) { v0[q] = __builtin_amdgcn_fmed3f(v0[q], -416.0f, 416.0f); v1[q] = __builtin_amdgcn_fmed3f(v1[q], -416.0f, 416.0f); }
                        w.x = __builtin_amdgcn_cvt_pk_fp8_f32(v0[0], v0[1], 0u, false); w.x = __builtin_amdgcn_cvt_pk_fp8_f32(v0[2], v0[3], w.x, true);
                        w.y = __builtin_amdgcn_cvt_pk_fp8_f32(v1[0], v1[1], 0u, false); w.y = __builtin_amdgcn_cvt_pk_fp8_f32(v1[2], v1[3], w.y, true);
                        *(u32x2*)(rowp + bj * 128) = w; }
#else
                    const float g = gg[i]; bf16_t* rowp = Y + (size_t)drow[i] * DM + col0;
#pragma unroll
                    for (int bj = 0; bj < 2; ++bj) *(u32x4*)(rowp + bj * 128) = pack8(acc[ai][bj][m][0] * g, acc[ai][bj][m][1] * g);
#endif
                }
            }
    }
};
struct EpiPleE {
    static constexpr bool PERM = true;
    bf16_t* E; float* ssq;
    __device__ __forceinline__ void operator()(const f32x4 (&acc)[2][2][4][2], const Unit& u, int wr, int wc, int fr, int fq) const {
        const int row0 = u.pm * 256 + wr * 64 + fr, col0 = u.pn * 256 + wc * 32 + 8 * fq;
        float zz = 0.f; asm volatile("" : "+v"(zz));
#pragma unroll
        for (int ai = 0; ai < 2; ++ai)
#pragma unroll
            for (int m = 0; m < 4; ++m) {
                const int row = row0 + ai * 128 + m * 16;
                bf16_t* rowp = E + (size_t)row * DM + col0; float s = 0.f;
#pragma unroll
                for (int bj = 0; bj < 2; ++bj) {
                    const f32x4 a = acc[ai][bj][m][0] + zz, b = acc[ai][bj][m][1] + zz;
                    s += (a[0] * a[0] + a[1] * a[1]) + (a[2] * a[2] + a[3] * a[3]) + (b[0] * b[0] + b[1] * b[1]) + (b[2] * b[2] + b[3] * b[3]);
                    *(u32x4*)(rowp + bj * 128) = pack8(a, b);
                }
                s = sum_x16(s, fr + 16 * fq); s = sum_x32(s, fr + 16 * fq);
                if (fq == 0) ssq[(size_t)row * 16 + u.pn * 4 + wc] = s;
                asm volatile("" ::: "memory");
            }
    }
};
struct EpiPleG {
    static constexpr bool PERM = true;
    const bf16_t* X; const bf16_t* E; const float* ssq; const float* g; bf16_t* XO; float* OUTF;
    __device__ __forceinline__ void operator()(const f32x4 (&acc)[2][2][4][2], const Unit& u, int wr, int wc, int fr, int fq) const {
        const int row0 = u.pm * 256 + wr * 64 + fr, col0 = u.pn * 256 + wc * 32 + 8 * fq, lane = fr + 16 * fq;
#pragma unroll
        for (int ai = 0; ai < 2; ++ai)
#pragma unroll
            for (int mp = 0; mp < 2; ++mp) {
                u32x4 x[2][2], ew[2][2]; f32x4 sq[2];
#pragma unroll
                for (int mm = 0; mm < 2; ++mm) { const int row = row0 + ai * 128 + (2 * mp + mm) * 16; const size_t off = (size_t)row * DM + col0;
                    sq[mm] = *(const f32x4*)(ssq + (size_t)row * 16 + 4 * fq);
#pragma unroll
                    for (int bj = 0; bj < 2; ++bj) { x[mm][bj] = *(const u32x4*)(X + off + bj * 128); ew[mm][bj] = *(const u32x4*)(E + off + bj * 128); } }
#pragma unroll
                for (int mm = 0; mm < 2; ++mm) { const int m = 2 * mp + mm; const size_t off = (size_t)(row0 + ai * 128 + m * 16) * DM + col0;
                    float t = (sq[mm][0] + sq[mm][1]) + (sq[mm][2] + sq[mm][3]); t = sum_x16(t, lane); t = sum_x32(t, lane); const float r = 1.0f / sqrtf(t * (1.0f / DM) + RMS_EPS);
#pragma unroll
                    for (int bj = 0; bj < 2; ++bj) { const u32x4 xw = x[mm][bj], e = ew[mm][bj]; const f32x4 a0 = acc[ai][bj][m][0], a1 = acc[ai][bj][m][1];
                        const f32x4 g0 = *(const f32x4*)(g + col0 + bj * 128), g1 = *(const f32x4*)(g + col0 + bj * 128 + 4);
                        f32x4 o0, o1;
                        o0[0] = bflo(xw.x) + sigmoidf_(a0[0]) * (bflo(e.x) * r) * g0[0]; o0[1] = bfhi(xw.x) + sigmoidf_(a0[1]) * (bfhi(e.x) * r) * g0[1];
                        o0[2] = bflo(xw.y) + sigmoidf_(a0[2]) * (bflo(e.y) * r) * g0[2]; o0[3] = bfhi(xw.y) + sigmoidf_(a0[3]) * (bfhi(e.y) * r) * g0[3];
                        o1[0] = bflo(xw.z) + sigmoidf_(a1[0]) * (bflo(e.z) * r) * g1[0]; o1[1] = bfhi(xw.z) + sigmoidf_(a1[1]) * (bfhi(e.z) * r) * g1[1];
                        o1[2] = bflo(xw.w) + sigmoidf_(a1[2]) * (bflo(e.w) * r) * g1[2]; o1[3] = bfhi(xw.w) + sigmoidf_(a1[3]) * (bfhi(e.w) * r) * g1[3];
                        if (XO) *(u32x4*)(XO + off + bj * 128) = pack8(o0, o1);
                        if (OUTF) { *(f32x4*)(OUTF + off + bj * 128) = o0; *(f32x4*)(OUTF + off + bj * 128 + 4) = o1; } } }
            }
    }
};

struct MoeSched {
    const char* A; const char* W; int lda, K, npn; size_t wstride;
    const LAS int* rbs; const LAS int* cnt; int vlo, vhi, rb0, nunits, G, c; const int* slot_tk; bool gather; int gxl;
    __device__ __forceinline__ bool next(int i, Unit& u) const {
        const int nrb = nunits / npn;
        if ((G & 7) != 0) { const int r2 = (i / npn) * G + c; if (r2 >= nrb) return false; u.pn = i % npn; return finish(rb0 + r2, u); }
        const int chunk = (nrb + 7) >> 3, gx = gxl, x = c & 7, j = c >> 3;
        if (j >= gx) return false;
        int clen = nrb - x * chunk; clen = clen < 0 ? 0 : (clen > chunk ? chunk : clen);
        const int fr = clen / gx, ifull = fr * npn;
        int li, pn;
        if (i < ifull) { li = j + (i / npn) * gx; pn = i % npn; }
        else { const int q = (i - ifull) * gx + j; if (q >= (clen - fr * gx) * npn) return false;
               li = fr * gx + q / npn; pn = q % npn; }
        u.pn = pn; return finish(rb0 + x * chunk + li, u);
    }
    __device__ __forceinline__ bool finish(int rbg, Unit& u) const {
        int lo = vlo, hi = vhi;
        while (lo < hi) { const int mid = (lo + hi + 1) >> 1; if (rbs[mid] <= rbg) lo = mid; else hi = mid - 1; }
        u.v = lo; u.rb = rbg - rbs[lo]; u.pm = rbg; return true;
    }
    __device__ __forceinline__ bool same_rows(const Unit& u, const Unit& w) const { return gather && u.v == w.v && u.rb == w.rb; }
    __device__ __forceinline__ const char* a_base(const Unit& u) const { return gather ? A : A + (size_t)u.pm * 256 * lda * 2; }
    __device__ __forceinline__ const char* b_base(const Unit& u) const { return W + (size_t)(u.v % 65) * wstride + (size_t)u.pn * 256 * K * 2; }
    __device__ __forceinline__ void a_off(const Unit& u, const int (&R)[2], const int (&C)[2], unsigned (&o)[2][2]) const {
        if (gather) {
            const int e = u.v % 65, half = u.v / 65, n = cnt[u.v];
#pragma unroll
            for (int h = 0; h < 2; ++h)
#pragma unroll
                for (int i = 0; i < 2; ++i) {
                    const int pos = u.rb * 256 + h * 128 + R[i]; int tok;
                    if (e == 64) tok = half * HALF_T + pos;
                    else tok = pos < n ? (slot_tk[(size_t)u.v * HALF_T + pos] >> 3) : 0;
                    o[h][i] = (unsigned)(tok * lda + C[i]) * 2u;
                    asm volatile("" : "+v"(o[h][i]));
                }
        } else {
#pragma unroll
            for (int h = 0; h < 2; ++h)
#pragma unroll
                for (int i = 0; i < 2; ++i) o[h][i] = (unsigned)((h * 128 + R[i]) * lda + C[i]) * 2u;
        }
    }
};

struct Args {
    const float* in[29]; float* out; unsigned char* ws; int ph_lo, ph_hi;
};
enum InIdx { I_X = 0, I_P, I_EV_WIN, I_EV_BGATE, I_CPK, I_CW1K, I_CW2K, I_CPV, I_CW1V, I_CW2V, I_EV_WO, I_OD_WIN, I_OD_BF, I_OD_WO,
             I_LN1G, I_LN1B, I_LN2G, I_LN2B, I_RW, I_RB, I_EW1, I_EW3, I_EW2, I_SW1, I_SW3, I_SW2, I_PWG, I_PWP, I_PNG };
__device__ __forceinline__ size_t wbuf_off(int layer) { int p = __builtin_amdgcn_readfirstlane(layer & 1); asm volatile("" : "+s"(p)); return (size_t)p * W_BUF; }
struct Frame {
    LAS unsigned char* lds; int tid, lane, wave, G, bid;
    unsigned char* ws; gu32* ctl;
};

__device__ __forceinline__ int rope_perm(int d) { return 2 * (d & 31) + (d >> 5); }
__device__ __forceinline__ int map_even(int c) {
    if (c < 512) return EC_QA + (c & ~63) + rope_perm(c & 63);
    if (c < 576) return EC_KA + rope_perm(c - 512);
    if (c < 640) return EC_VA + (c - 576);
    if (c < 1152) { const int r = c - 640; return EC_QI + (r & ~63) + rope_perm(r & 63); }
    if (c < 1216) return EC_KI + rope_perm(c - 1152);
    if (c < 1224) return EC_WI + (c - 1216);
    if (c < 1736) { const int r = c - 1224; return EC_QB + (r & ~63) + rope_perm(r & 63); }
    if (c < 2120) { const int r = c - 1736, j = r >> 6, d = r & 63;
        switch (j) { case 0: return EC_KC + d; case 1: return EC_VC + d; case 2: return EC_KS + rope_perm(d); case 3: return EC_VS + d; case 4: return EC_KW + rope_perm(d); default: return EC_VW + d; } }
    return EC_GB + (c - 2120);
}
enum MapId { MAP_ID = 0, MAP_EVEN, MAP_W1, MAP_W3, MAP_ROPE };
__device__ __forceinline__ int map_col(int id, int c) {
    switch (id) { case MAP_EVEN: return map_even(c); case MAP_W1: return 32 * (c >> 4) + (c & 15); case MAP_W3: return 32 * (c >> 4) + 16 + (c & 15); case MAP_ROPE: return rope_perm(c); default: return c; }
}
__device__ __forceinline__ void tr_load(f32x4 (&v)[16], const float* src, int ldn, int ncols, int k0, int n0, int lane) {
    const int cq = 4 * (lane & 15), rq = lane >> 4;
    const bool full = (n0 + 64 <= ncols);
#pragma unroll
    for (int i = 0; i < 16; ++i) {
        const float* p = src + (size_t)(k0 + 4 * i + rq) * ldn + n0 + cq;
        if (full) v[i] = *(const f32x4*)p;
        else { v[i][0] = (n0 + cq + 0 < ncols) ? p[0] : 0.f; v[i][1] = (n0 + cq + 1 < ncols) ? p[1] : 0.f; v[i][2] = (n0 + cq + 2 < ncols) ? p[2] : 0.f; v[i][3] = (n0 + cq + 3 < ncols) ? p[3] : 0.f; }
    }
}
__device__ __forceinline__ void tr_finish(const f32x4 (&v)[16], int ncols, bf16_t* dst, int dpitch, int k0, int n0, int mapid, LAS unsigned short* scr, int lane, const float* rscale, bool lo) {
    const int cq = 4 * (lane & 15), rq = lane >> 4;
    if (rscale == nullptr && !lo) {
#pragma unroll
        for (int i = 0; i < 16; ++i) {
#pragma unroll
            for (int j = 0; j < 4; ++j) scr[(cq + j) * 72 + 4 * i + rq] = (unsigned short)f2bf(v[i][j]); }
    } else {
#pragma unroll
        for (int i = 0; i < 16; ++i) {
            const int k = 4 * i + rq; const float rs = rscale ? rscale[k0 + k] : 1.f;
#pragma unroll
            for (int j = 0; j < 4; ++j) { float x = v[i][j] * rs; if (lo) x -= bf2f((unsigned short)f2bf(x));
                scr[(cq + j) * 72 + k] = (unsigned short)f2bf(x); }
        }
    }
    LDS_WAIT(); asm volatile("" ::: "memory");
    const int c = lane & 7;
#pragma unroll
    for (int j = 0; j < 8; ++j) { const int nl = (lane >> 3) + 8 * j, n = n0 + nl;
        const u32x4 o = *(const LAS u32x4*)(scr + nl * 72 + 8 * c);
        if (n < ncols) *(u32x4*)(dst + (size_t)map_col(mapid, n) * dpitch + k0 + 8 * c) = o; }
    LDS_WAIT(); asm volatile("" ::: "memory");
}
__device__ __forceinline__ void tr_item(const float* src, int ldn, int ncols, bf16_t* dst, int dpitch, int k0, int n0, int mapid, LAS unsigned short* scr, int lane, const float* rscale = nullptr, bool lo = false) {
    f32x4 v[16]; tr_load(v, src, ldn, ncols, k0, n0, lane); tr_finish(v, ncols, dst, dpitch, k0, n0, mapid, scr, lane, rscale, lo);
}
__device__ __forceinline__ void sincos_d(double a, float& s, float& c) {
    const double TWO_PI = 6.283185307179586476925286766559, INV = 0.15915494309189533576888376337251;
    const double k = rint(a * INV); double r = a - k * TWO_PI;
    const double r2 = r * r; double ts = 1.0, tc = 1.0;
#pragma unroll
    for (int i = 14; i >= 1; --i) { ts = 1.0 - ts * r2 / (double)((2 * i) * (2 * i + 1)); tc = 1.0 - tc * r2 / (double)((2 * i - 1) * (2 * i)); }
    s = (float)(r * ts); c = (float)tc;
}

struct TrJob { const float* src; bf16_t* dst; int K, N, ldn, dpitch, mapid; const float* rscale; int lo; };
__device__ __forceinline__ TrJob get_job(const Args& a, unsigned char* wsp, int layer, int jid) {
    const int j = layer >> 1; const bool even = (layer & 1) == 0;
    bf16_t* W = (bf16_t*)(wsp + WS_W + wbuf_off(layer));
    TrJob t; t.mapid = MAP_ID; t.rscale = nullptr; t.lo = 0;
    if (jid == 0) { if (even) { t.src = a.in[I_EV_WIN] + (size_t)j * DM * EVEN_COLS; t.N = EVEN_COLS; t.mapid = MAP_EVEN; } else { t.src = a.in[I_OD_WIN] + (size_t)j * DM * ODD_COLS; t.N = ODD_COLS; }
        t.K = DM; t.ldn = t.N; t.dst = W + W_IN / 2; t.dpitch = DM; return t; }
    if (jid == 1) { t.src = (even ? a.in[I_EV_WO] : a.in[I_OD_WO]) + (size_t)j * DM * DM; t.K = DM; t.N = DM; t.ldn = DM; t.dst = W + W_O / 2; t.dpitch = DM; return t; }
    if (jid == 2) { t.src = a.in[I_PWG] + (size_t)layer * DM * DM; t.K = DM; t.N = DM; t.ldn = DM; t.dst = W + W_G / 2; t.dpitch = DM; return t; }
    if (jid == 3) { t.src = a.in[I_PWP] + (size_t)layer * 256 * DM; t.K = 256; t.N = DM; t.ldn = DM; t.dst = W + W_P / 2; t.dpitch = 256; return t; }
    if (jid < 8) {
        const int q = jid - 4;
        if (q == 0) { t.src = a.in[I_CW1K] + (size_t)j * 2048 * 64; t.K = 2048; t.dst = W + W_C1K / 2; t.dpitch = 2048; }
        else if (q == 1) { t.src = a.in[I_CW1V] + (size_t)j * 2048 * 64; t.K = 2048; t.dst = W + W_C1V / 2; t.dpitch = 2048; }
        else if (q == 2) { t.src = a.in[I_CW2K] + (size_t)j * 64 * 64; t.K = 64; t.dst = W + W_C2K / 2; t.dpitch = 64; t.mapid = MAP_ROPE; }
        else { t.src = a.in[I_CW2V] + (size_t)j * 64 * 64; t.K = 64; t.dst = W + W_C2V / 2; t.dpitch = 64; }
        t.N = 64; t.ldn = 64; return t; }
    if (jid < 10) {
        t.src = a.in[I_RW] + (size_t)layer * DM * NEXP; t.K = DM; t.N = NEXP; t.ldn = NEXP; t.dpitch = DM; t.rscale = a.in[I_LN1G] + layer * DM; t.lo = jid - 8; t.dst = W + (t.lo ? W_RL : W_RH) / 2; return t; }
    const int r = jid - 10, e = r / 3, w = r % 3;
    if (w < 2) { const float* s = (e == 64) ? a.in[w == 0 ? I_SW1 : I_SW3] + (size_t)layer * DM * DFF : a.in[w == 0 ? I_EW1 : I_EW3] + ((size_t)layer * NEXP + e) * DM * DFF;
        t.src = s; t.K = DM; t.N = DFF; t.ldn = DFF; t.dst = W + W_UP / 2 + (size_t)e * 512 * DM; t.dpitch = DM; t.mapid = (w == 0) ? MAP_W1 : MAP_W3; return t; }
    t.src = (e == 64) ? a.in[I_SW2] + (size_t)layer * DFF * DM : a.in[I_EW2] + ((size_t)layer * NEXP + e) * DFF * DM;
    t.K = DFF; t.N = DM; t.ldn = DM; t.dst = W + W_DN / 2 + (size_t)e * DM * DFF; t.dpitch = DFF; return t;
}
constexpr int NJOBS = 10 + 65 * 3;

__device__ __forceinline__ void prep_weights(const Frame& F, const Args& a, int layer, int wid, int nw) {
    const int gw = wid * 8 + F.wave, NGW = nw * 8, gt = wid * 512 + F.tid, NGT = nw * 512;
    LAS unsigned short* scr = (LAS unsigned short*)(F.lds + F.wave * 16384);
    int base = 0;
    for (int jid = 0; jid < 10; ++jid) {
        const TrJob jb = get_job(a, F.ws, layer, jid);
        const int nblk = (jb.N + 63) / 64, nit = (jb.K / 64) * nblk;
        int first = (gw - (base % NGW) + NGW) % NGW;
        for (int it = first; it < nit; it += 2 * NGW) {
            const int it2 = it + NGW; const bool two = it2 < nit;
            f32x4 va[16], vb[16];
            tr_load(va, jb.src, jb.ldn, jb.N, 64 * (it / nblk), 64 * (it % nblk), F.lane);
            if (two) tr_load(vb, jb.src, jb.ldn, jb.N, 64 * (it2 / nblk), 64 * (it2 % nblk), F.lane);
            tr_finish(va, jb.N, jb.dst, jb.dpitch, 64 * (it / nblk), 64 * (it % nblk), jb.mapid, scr, F.lane, jb.rscale, jb.lo != 0);
            if (two) tr_finish(vb, jb.N, jb.dst, jb.dpitch, 64 * (it2 / nblk), 64 * (it2 % nblk), jb.mapid, scr, F.lane, jb.rscale, jb.lo != 0);
        }
        base += nit;
    }
    {
        constexpr int NI = 65 * 3 * 64;
        int g = (gw - (base % NGW) + NGW) % NGW;
        f32x4 va[16], vb[16]; TrJob ja, jn;
#define EXP_LOAD(V, J, G) do { J = get_job(a, F.ws, layer, 10 + ((G) >> 6)); const int it_ = (G) & 63, sh_ = (J.N == 256) ? 2 : 4; tr_load(V, J.src, J.ldn, J.N, 64 * (it_ >> sh_), 64 * (it_ & ((1 << sh_) - 1)), F.lane); } while (0)
#define EXP_FIN(V, J, G) do { const int it_ = (G) & 63, sh_ = (J.N == 256) ? 2 : 4; tr_finish(V, J.N, J.dst, J.dpitch, 64 * (it_ >> sh_), 64 * (it_ & ((1 << sh_) - 1)), J.mapid, scr, F.lane, nullptr, false); } while (0)
        if (g < NI) EXP_LOAD(va, ja, g);
        while (g < NI) {
            const int g1 = g + NGW, g2 = g + 2 * NGW;
            if (g1 < NI) EXP_LOAD(vb, jn, g1);
            EXP_FIN(va, ja, g);
            if (g1 >= NI) break;
            if (g2 < NI) EXP_LOAD(va, ja, g2);
            EXP_FIN(vb, jn, g1);
            g = g2;
        }
#undef EXP_LOAD
#undef EXP_FIN
    }
    { const int r0 = (layer & 1) ? ODD_COLS : EVEN_COLS, r1 = (layer & 1) ? NO_PAD : NE_PAD; u32x4* z = (u32x4*)(F.ws + WS_W + wbuf_off(layer) + W_IN + (size_t)r0 * DM * 2);
      const int n16 = (r1 - r0) * DM * 2 / 16; unsigned zq = 0u; asm volatile("" : "+v"(zq)); for (int i = gt; i < n16; i += NGT) z[i] = (u32x4){zq, zq, zq, zq}; }
    if ((layer & 1) == 0 && wid < 2) {
        const int j = layer >> 1; const float* pe = a.in[wid == 0 ? I_CPK : I_CPV] + (size_t)j * 2048; const float* w1 = a.in[wid == 0 ? I_CW1K : I_CW1V] + (size_t)j * 2048 * 64;
        LAS float* red = (LAS float*)(F.lds + 8 * 16384);
        __syncthreads();
        const int n = F.tid & 63, part = F.tid >> 6; float s = 0.f;
        for (int k0 = part * 256; k0 < part * 256 + 256; k0 += 32) {
            float wv[32], pv[32];
#pragma unroll
            for (int q = 0; q < 32; ++q) { wv[q] = w1[(size_t)(k0 + q) * 64 + n]; pv[q] = pe[k0 + q]; }
#pragma unroll
            for (int q = 0; q < 32; ++q) s += pv[q] * wv[q]; }
        red[part * 64 + n] = s; __syncthreads();
        if (F.tid < 64) { float tot = 0.f; for (int q = 0; q < 8; ++q) tot += red[q * 64 + F.tid]; ((float*)(F.ws + WS_MISC))[wid * 64 + F.tid] = tot; }
        __syncthreads();
    }
}
__device__ __forceinline__ void prep_acts(const Frame& F, const Args& a, int layer, bool first) {
    const int gt = F.bid * 512 + F.tid, NGT = F.G * 512;
    { const f32x4* p = (const f32x4*)(a.in[I_P] + (size_t)layer * T * 256); u32x2* o = (u32x2*)(F.ws + WS_PB);
      for (int i = gt; i < T * 256 / 4; i += NGT) { const f32x4 v = p[i]; u32x2 w; w.x = pk2(v[0], v[1]); w.y = pk2(v[2], v[3]); o[i] = w; } }
    if (first) {
        const f32x4* x = (const f32x4*)a.in[I_X]; u32x2* o = (u32x2*)(F.ws + WS_XB);
        for (int i = gt; i < T * DM / 4; i += NGT) { const f32x4 v = x[i]; u32x2 w; w.x = pk2(v[0], v[1]); w.y = pk2(v[2], v[3]); o[i] = w; }
        float* ct = (float*)(F.ws + WS_ROPE_COS); float* st = (float*)(F.ws + WS_ROPE_SIN);
        for (int i = gt; i < SEQ * 32; i += NGT) { const int pos = i >> 5, j = i & 31; double inv = 1.0;
            for (int q = 0; q < j; ++q) inv *= 0.74989420933245582730;
            const float ang = (float)pos * (float)inv; float s, c; sincos_d((double)ang, s, c); ct[i] = c; st[i] = s; }
    }
    if (F.bid == F.G - 1) {
        const float* RW = a.in[I_RW] + (size_t)layer * DM * NEXP; const float* g1 = a.in[I_LN1G] + layer * DM; const float* b1 = a.in[I_LN1B] + layer * DM;
        LAS float* red = (LAS float*)(F.lds + 8 * 16384);
        __syncthreads();
        const int n = F.tid & 63, part = F.tid >> 6; float sc = 0.f, sb = 0.f;
        for (int k0 = part * 128; k0 < part * 128 + 128; k0 += 32) {
            float wv[32];
#pragma unroll
            for (int q = 0; q < 32; ++q) wv[q] = RW[(size_t)(k0 + q) * NEXP + n];
#pragma unroll
            for (int q = 0; q < 32; ++q) { sc += g1[k0 + q] * wv[q]; sb += b1[k0 + q] * wv[q]; } }
        red[part * 64 + n] = sc; red[512 + part * 64 + n] = sb; __syncthreads();
        if (F.tid < 128) { const int o = F.tid & 63, w = F.tid >> 6; float tot = 0.f; for (int q = 0; q < 8; ++q) tot += red[w * 512 + q * 64 + o]; ((float*)(F.ws + WS_MISC))[256 + F.tid] = tot; }
        __syncthreads();
    }
}

__device__ __forceinline__ void scan_phase(const Frame& F, const Args& a) {
    const float* lf = (const float*)(F.ws + WS_LOGF); float* dc = (float*)(F.ws + WS_DCUM);
    LAS float* wsum = (LAS float*)F.lds;
    for (int s = F.bid; s < NB * 16; s += F.G) {
        const int b = s >> 4, h = s & 15; const size_t base = ((size_t)b * SEQ) * 16 + h;
        float v[4]; float run = 0.f;
#pragma unroll
        for (int i = 0; i < 4; ++i) { run += lf[base + (size_t)(F.tid * 4 + i) * 16]; v[i] = run; }
        float inc = run;
        inc += dpp_mov<0x111>(inc); inc += dpp_mov<0x112>(inc); inc += dpp_mov<0x114>(inc); inc += dpp_mov<0x118>(inc);
        { const float r0 = __builtin_bit_cast(float, __builtin_amdgcn_readlane(__builtin_bit_cast(int, inc), 15)), r1 = __builtin_bit_cast(float, __builtin_amdgcn_readlane(__builtin_bit_cast(int, inc), 31)),
                      r2 = __builtin_bit_cast(float, __builtin_amdgcn_readlane(__builtin_bit_cast(int, inc), 47));
          const int rw = F.lane >> 4; inc += (rw == 1) ? r0 : (rw == 2) ? (r0 + r1) : (rw == 3) ? ((r0 + r1) + r2) : 0.f; }
        if (F.lane == 63) wsum[F.wave] = inc;
        __syncthreads();
        float off = inc - run;
        for (int w = 0; w < F.wave; ++w) off += wsum[w];
#pragma unroll
        for (int i = 0; i < 4; ++i) dc[base + (size_t)(F.tid * 4 + i) * 16] = (v[i] + off) * LOG2E;
        __syncthreads();
    }
}

__device__ __forceinline__ void ln_row16(float (&v)[16], const float* g, const float* b, int lane) {
    float s = 0.f;
#pragma unroll
    for (int i = 0; i < 16; ++i) s += v[i];
    const float mean = wave_sum(s) * (1.f / DM); float s2 = 0.f;
#pragma unroll
    for (int i = 0; i < 16; ++i) { v[i] -= mean; s2 += v[i] * v[i]; }
    const float rstd = 1.0f / sqrtf(wave_sum(s2) * (1.f / DM) + LN_EPS);
#pragma unroll
    for (int q = 0; q < 4; ++q) { const f32x4 gg = *(const f32x4*)(g + lane * 16 + 4 * q), bb = *(const f32x4*)(b + lane * 16 + 4 * q);
#pragma unroll
        for (int i = 0; i < 4; ++i) v[4 * q + i] = v[4 * q + i] * rstd * gg[i] + bb[i]; }
}
__device__ __forceinline__ void ln_stats16(const float (&v)[16], float& mean, float& rstd) {
    float s = 0.f;
#pragma unroll
    for (int i = 0; i < 16; ++i) s += v[i];
    mean = wave_sum(s) * (1.f / DM); float s2 = 0.f;
#pragma unroll
    for (int i = 0; i < 16; ++i) { const float d = v[i] - mean; s2 += d * d; }
    rstd = 1.0f / sqrtf(wave_sum(s2) * (1.f / DM) + LN_EPS);
}
__device__ __forceinline__ void ln_apply16(float (&v)[16], float mean, float rstd, const float* g, const float* b, int lane) {
#pragma unroll
    for (int q = 0; q < 4; ++q) { const f32x4 gg = *(const f32x4*)(g + lane * 16 + 4 * q), bb = *(const f32x4*)(b + lane * 16 + 4 * q);
#pragma unroll
        for (int i = 0; i < 4; ++i) v[4 * q + i] = (v[4 * q + i] - mean) * rstd * gg[i] + bb[i]; }
}
__device__ __forceinline__ void store_row16_bf(const float (&v)[16], bf16_t* xb, int lane) {
    u32x4 w0, w1; w0.x = pk2(v[0], v[1]); w0.y = pk2(v[2], v[3]); w0.z = pk2(v[4], v[5]); w0.w = pk2(v[6], v[7]);
    w1.x = pk2(v[8], v[9]); w1.y = pk2(v[10], v[11]); w1.z = pk2(v[12], v[13]); w1.w = pk2(v[14], v[15]);
    *(u32x4*)(xb + lane * 16) = w0; *(u32x4*)(xb + lane * 16 + 8) = w1;
}
__device__ __forceinline__ void store_row16(const float (&v)[16], float* xf, bf16_t* xb, int lane) {
#pragma unroll
    for (int q = 0; q < 4; ++q) *(f32x4*)(xf + lane * 16 + 4 * q) = (f32x4){v[4 * q], v[4 * q + 1], v[4 * q + 2], v[4 * q + 3]};
    u32x4 w0, w1; w0.x = pk2(v[0], v[1]); w0.y = pk2(v[2], v[3]); w0.z = pk2(v[4], v[5]); w0.w = pk2(v[6], v[7]);
    w1.x = pk2(v[8], v[9]); w1.y = pk2(v[10], v[11]); w1.z = pk2(v[12], v[13]); w1.w = pk2(v[14], v[15]);
    *(u32x4*)(xb + lane * 16) = w0; *(u32x4*)(xb + lane * 16 + 8) = w1;
}

#ifndef ROUTE_EXPT
#define ROUTE_EXPT 0
#endif
__device__ __forceinline__ void unpack16(const u32x4 w0, const u32x4 w1, float (&v)[16]) {
    v[0] = bflo(w0.x); v[1] = bfhi(w0.x); v[2] = bflo(w0.y); v[3] = bfhi(w0.y); v[4] = bflo(w0.z); v[5] = bfhi(w0.z); v[6] = bflo(w0.w); v[7] = bfhi(w0.w);
    v[8] = bflo(w1.x); v[9] = bfhi(w1.x); v[10] = bflo(w1.y); v[11] = bfhi(w1.y); v[12] = bflo(w1.z); v[13] = bfhi(w1.z); v[14] = bflo(w1.w); v[15] = bfhi(w1.w);
}
__device__ __forceinline__ void route_phase(const Frame& F, const Args& a, int layer, const bf16_t* X, bf16_t* XB, bool dummy) {
    const float* g = a.in[I_LN1G] + layer * DM; const float* bta = a.in[I_LN1B] + layer * DM;
    const float* RW = a.in[I_RW] + (size_t)layer * DM * NEXP; const float* RBs = a.in[I_RB] + layer * NEXP;
    int* slot_tk = (int*)(F.ws + WS_SLOT_TK); float* slot_g = (float*)(F.ws + WS_SLOT_G);
    gu32* cntg = F.ctl + CW_CNT + layer * 256;
    LAS float* lg = (LAS float*)(F.lds + F.wave * 8192);
    LAS unsigned* rec_e = (LAS unsigned*)(F.lds + 65536);
    LAS float* rec_g = (LAS float*)(F.lds + 65536 + 8192);
    LAS unsigned* lcnt = (LAS unsigned*)(F.lds + 65536 + 16384);
    LAS unsigned* gbase = lcnt + 64;
    const int lane = F.lane;
    for (int ub = F.bid; ub < T / 256; ub += F.G) {
        if (F.tid < 64) lcnt[F.tid] = 0u;
        __syncthreads();
        const int r0 = ub * 256 + F.wave * 32;
        LAS float* stl = (LAS float*)(F.lds + 65536 + 16384 + 512) + F.wave * 64;
        for (int r4 = 0; r4 < 32; r4 += 8) {
            u32x4 v4[8][2];
#pragma unroll
            for (int j = 0; j < 8; ++j) { const bf16_t* xr = X + (size_t)(r0 + r4 + j) * DM + lane * 16; v4[j][0] = *(const u32x4*)xr; v4[j][1] = *(const u32x4*)(xr + 8); }
#pragma unroll
            for (int j = 0; j < 8; ++j) { float v[16]; unpack16(v4[j][0], v4[j][1], v);
                float mean, rstd; ln_stats16(v, mean, rstd);
                if (lane == 0) { stl[2 * (r4 + j)] = mean; stl[2 * (r4 + j) + 1] = rstd; }
                ln_apply16(v, mean, rstd, g, bta, lane); store_row16_bf(v, XB + (size_t)(r0 + r4 + j) * DM, lane); }
        }
        LDS_WAIT(); asm volatile("" ::: "memory");
        f32x16 c0 = {}, c1 = {};
        { const bf16_t* ar = X + (size_t)(r0 + (lane & 31)) * DM + (lane >> 5) * 8;
          const bf16_t* Wh = (const bf16_t*)(F.ws + WS_W + wbuf_off(layer) + W_RH); const bf16_t* Wl = (const bf16_t*)(F.ws + WS_W + wbuf_off(layer) + W_RL);
          const int se = F.tid >> 3, sg8 = (F.tid & 7) * 16;
          u32x4 bh[2], bl[2];
          bh[0] = *(const u32x4*)(Wh + (size_t)se * DM + sg8); bh[1] = *(const u32x4*)(Wh + (size_t)se * DM + sg8 + 8); bl[0] = *(const u32x4*)(Wl + (size_t)se * DM + sg8); bl[1] = *(const u32x4*)(Wl + (size_t)se * DM + sg8 + 8);
          for (int c = 0; c < ((ROUTE_EXPT == 1 && dummy) ? 0 : 8); ++c) {
              LAS unsigned char* Bs = F.lds + (c & 1) * 34816;
              *(LAS u32x4*)(Bs + se * 272 + sg8 * 2) = bh[0]; *(LAS u32x4*)(Bs + se * 272 + sg8 * 2 + 16) = bh[1];
              *(LAS u32x4*)(Bs + 17408 + se * 272 + sg8 * 2) = bl[0]; *(LAS u32x4*)(Bs + 17408 + se * 272 + sg8 * 2 + 16) = bl[1];
              bf16x8 af[8];
#pragma unroll
              for (int st = 0; st < 8; ++st) af[st] = *(const bf16x8*)(ar + c * 128 + st * 16);
              __syncthreads();
              if (c + 1 < 8) { const size_t o = (size_t)se * DM + (c + 1) * 128 + sg8;
                  bh[0] = *(const u32x4*)(Wh + o); bh[1] = *(const u32x4*)(Wh + o + 8); bl[0] = *(const u32x4*)(Wl + o); bl[1] = *(const u32x4*)(Wl + o + 8); }
              const LAS unsigned char* bp = Bs + (lane & 31) * 272 + (lane >> 5) * 16;
#pragma unroll
              for (int st = 0; st < 8; ++st) {
                  const bf16x8 h0 = *(const LAS bf16x8*)(bp + st * 32), h1 = *(const LAS bf16x8*)(bp + 32 * 272 + st * 32);
                  const bf16x8 l0 = *(const LAS bf16x8*)(bp + 17408 + st * 32), l1 = *(const LAS bf16x8*)(bp + 17408 + 32 * 272 + st * 32);
                  c0 = __builtin_amdgcn_mfma_f32_32x32x16_bf16(af[st], h0, c0, 0, 0, 0); c1 = __builtin_amdgcn_mfma_f32_32x32x16_bf16(af[st], h1, c1, 0, 0, 0);
                  c0 = __builtin_amdgcn_mfma_f32_32x32x16_bf16(af[st], l0, c0, 0, 0, 0); c1 = __builtin_amdgcn_mfma_f32_32x32x16_bf16(af[st], l1, c1, 0, 0, 0);
              }
          }
        }
        __syncthreads();
#pragma unroll
        for (int rr = 0; rr < 16; ++rr) { const int row = (rr & 3) + 8 * (rr >> 2) + 4 * (lane >> 5); lg[row * 64 + (lane & 31)] = c0[rr]; lg[row * 64 + 32 + (lane & 31)] = c1[rr]; }
        LDS_WAIT(); asm volatile("" ::: "memory");
        const float rcs = ((const float*)(F.ws + WS_MISC))[256 + lane], rb1 = ((const float*)(F.ws + WS_MISC))[256 + 64 + lane];
        const float rbias = RBs[lane];
        for (int r = 0; r < ((ROUTE_EXPT == 2 && dummy) ? 0 : 32); ++r) {
            const float sg = sigmoidf_(stl[2 * r + 1] * (lg[r * 64 + lane] - stl[2 * r] * rcs) + rb1); const float sb = sg + rbias;
            float m1 = sb;
            m1 = fmaxf(m1, dpp_mov<DPP_X1>(m1)); m1 = fmaxf(m1, dpp_mov<DPP_X2>(m1)); m1 = fmaxf(m1, dpp_mov<DPP_HM>(m1));
            const unsigned long long eqm = __ballot(sb == m1); const int gsh = lane & ~7;
            const unsigned gm = (unsigned)(eqm >> gsh) & 0xffu; const int first = __builtin_ctz(gm);
            float m2 = ((lane & 7) == first) ? NEGBIG : sb;
            m2 = fmaxf(m2, dpp_mov<DPP_X1>(m2)); m2 = fmaxf(m2, dpp_mov<DPP_X2>(m2)); m2 = fmaxf(m2, dpp_mov<DPP_HM>(m2));
            const float gs = m1 + m2;
            int grank = 0;
#pragma unroll
            for (int q = 0; q < 8; ++q) { const float o = __builtin_bit_cast(float, __builtin_amdgcn_readlane(__builtin_bit_cast(int, gs), q * 8)); grank += (o > gs || (o == gs && q < (lane >> 3))) ? 1 : 0; }
            const float sm = (grank < 4) ? sb : NEGBIG;
            int rank = 0;
#pragma unroll
            for (int q = 0; q < 64; ++q) { const float o = __builtin_bit_cast(float, __builtin_amdgcn_readlane(__builtin_bit_cast(int, sm), q)); rank += (o > sm) ? 1 : 0; }
            bool tie = false;
#pragma unroll
            for (int k = 0; k < 8; ++k) tie |= (__popcll(__ballot(rank == k)) != 1);
            if (tie) { rank = 0;
#pragma unroll 1
                for (int q = 0; q < 64; ++q) { const float o = __builtin_bit_cast(float, __builtin_amdgcn_readlane(__builtin_bit_cast(int, sm), q)); rank += (o > sm || (o == sm && q < lane)) ? 1 : 0; } }
            const bool sel = rank < 8;
            const float ssum = wave_sum(sel ? sg : 0.f);
            if (sel) { const unsigned lp = __hip_atomic_fetch_add(&lcnt[lane], 1u, __ATOMIC_RELAXED, __HIP_MEMORY_SCOPE_WORKGROUP); const int row = F.wave * 32 + r; rec_e[row * 8 + rank] = (unsigned)lane | (lp << 8); rec_g[row * 8 + rank] = sg / ssum * 2.5f; }
        }
        __syncthreads();
        const int half = (ub * 256) / HALF_T;
        if (F.tid < 64) gbase[F.tid] = dummy ? 0u : __hip_atomic_fetch_add(cntg + half * 65 + F.tid, lcnt[F.tid], RLX_AGENT);
        __syncthreads();
        for (int i = F.tid; i < 2048; i += 512) { const unsigned re = rec_e[i]; const int e = re & 255, lp = re >> 8, v = half * 65 + e; const int pos = gbase[e] + lp;
            const int t = ub * 256 + (i >> 3);
            if (!dummy) { slot_tk[(size_t)v * HALF_T + pos] = t * 8 + (i & 7); slot_g[(size_t)v * HALF_T + pos] = rec_g[i]; } }
        __syncthreads();
    }
}

__device__ __forceinline__ void combine_phase(const Frame& F, const Args& a, int layer, int half, const bf16_t* X1, bf16_t* X2, bool dummy) {
    const bf16_t* Y = (const bf16_t*)(F.ws + WS_R + R_YTOK);
    const float* g = a.in[I_LN2G] + layer * DM; const float* bta = a.in[I_LN2B] + layer * DM;
    const int lane = F.lane;
    for (int tl = F.bid * 8 + F.wave; tl < HALF_T; tl += F.G * 8) {
        const int t = half * HALF_T + tl; float v[16];
        { const bf16_t* xr = X1 + (size_t)t * DM + lane * 16; unpack16(*(const u32x4*)xr, *(const u32x4*)(xr + 8), v); }
#pragma unroll
        for (int i = 0; i < 16; ++i) v[i] *= ALPHA;
        float m[16];
#pragma unroll
        for (int i = 0; i < 16; ++i) m[i] = 0.f;
#pragma unroll
#if Y_FP8
        for (int k = 0; k < 9; ++k) { const u32x4 w = *(const u32x4*)((const unsigned char*)Y + ((size_t)t * 9 + k) * DM + lane * 16);
            m[0] += __builtin_amdgcn_cvt_f32_fp8(w.x, 0); m[1] += __builtin_amdgcn_cvt_f32_fp8(w.x, 1); m[2] += __builtin_amdgcn_cvt_f32_fp8(w.x, 2); m[3] += __builtin_amdgcn_cvt_f32_fp8(w.x, 3);
            m[4] += __builtin_amdgcn_cvt_f32_fp8(w.y, 0); m[5] += __builtin_amdgcn_cvt_f32_fp8(w.y, 1); m[6] += __builtin_amdgcn_cvt_f32_fp8(w.y, 2); m[7] += __builtin_amdgcn_cvt_f32_fp8(w.y, 3);
            m[8] += __builtin_amdgcn_cvt_f32_fp8(w.z, 0); m[9] += __builtin_amdgcn_cvt_f32_fp8(w.z, 1); m[10] += __builtin_amdgcn_cvt_f32_fp8(w.z, 2); m[11] += __builtin_amdgcn_cvt_f32_fp8(w.z, 3);
            m[12] += __builtin_amdgcn_cvt_f32_fp8(w.w, 0); m[13] += __builtin_amdgcn_cvt_f32_fp8(w.w, 1); m[14] += __builtin_amdgcn_cvt_f32_fp8(w.w, 2); m[15] += __builtin_amdgcn_cvt_f32_fp8(w.w, 3); }
#pragma unroll
        for (int i = 0; i < 16; ++i) m[i] *= (1.0f / 32.0f);
#else
        for (int k = 0; k < 9; ++k) { const bf16_t* yr = Y + ((size_t)tl * 9 + k) * DM + lane * 16; float yv[16]; unpack16(*(const u32x4*)yr, *(const u32x4*)(yr + 8), yv);
#pragma unroll
            for (int i = 0; i < 16; ++i) m[i] += yv[i]; }
#endif
#pragma unroll
        for (int i = 0; i < 16; ++i) v[i] += m[i];
        ln_row16(v, g, bta, lane);
        if (!dummy) store_row16_bf(v, X2 + (size_t)t * DM, lane);
    }
}

constexpr int KP = 144, VP = 192;
constexpr int KT_BYTES = 64 * KP, VT_BYTES = 64 * VP, KV_BUF = KT_BYTES + VT_BYTES;
__device__ __forceinline__ int crow(int r, int hi) { return (r & 3) + 8 * (r >> 2) + 4 * hi; }
__device__ __forceinline__ s16x4 vtr(const LAS unsigned char* p) { return __builtin_bit_cast(s16x4, __builtin_amdgcn_ds_read_tr16_b64_v4i16((LAS s16x4*)p)); }

struct KVRegs { u32x4 k, v; };
__device__ __forceinline__ void kv_load(KVRegs& r, const bf16_t* Kp, const bf16_t* Vp, size_t pitch, int row0, int tid) {
    const size_t off = (size_t)(row0 + (tid >> 3)) * pitch + (tid & 7) * 8;
    r.k = *(const u32x4*)(Kp + off); r.v = *(const u32x4*)(Vp + off);
}
__device__ __forceinline__ void kv_store(const KVRegs& r, LAS unsigned char* buf, int tid) {
    *(LAS u32x4*)(buf + (tid >> 3) * KP + (tid & 7) * 16) = r.k;
    *(LAS u32x4*)(buf + KT_BYTES + (tid >> 3) * VP + (tid & 7) * 16) = r.v;
}
__device__ __forceinline__ void qk_tile(f32x16& p0, f32x16& p1, const LAS unsigned char* kt, const bf16x8 (&qf)[4], int lane) {
    const LAS unsigned char* kb = kt + (lane & 31) * KP + (lane >> 5) * 16;
    p0 = (f32x16){}; p1 = (f32x16){};
#pragma unroll
    for (int ks = 0; ks < 4; ++ks) {
        const bf16x8 k0 = *(const LAS bf16x8*)(kb + ks * 32), k1 = *(const LAS bf16x8*)(kb + 32 * KP + ks * 32);
        p0 = __builtin_amdgcn_mfma_f32_32x32x16_bf16(k0, qf[ks], p0, 0, 0, 0);
        p1 = __builtin_amdgcn_mfma_f32_32x32x16_bf16(k1, qf[ks], p1, 0, 0, 0);
    }
}
__device__ __forceinline__ bf16x8 pfrag(const f32x16& p, int s) {
    u32x4 w; w.x = pg8::cvt_pk_bf16(p[8 * s], p[8 * s + 1]); w.y = pg8::cvt_pk_bf16(p[8 * s + 2], p[8 * s + 3]); w.z = pg8::cvt_pk_bf16(p[8 * s + 4], p[8 * s + 5]); w.w = pg8::cvt_pk_bf16(p[8 * s + 6], p[8 * s + 7]);
    return __builtin_bit_cast(bf16x8, w);
}
__device__ __forceinline__ void pv_sub(f32x16& o0, f32x16& o1, const LAS unsigned char* vt, int sub, const f32x16& p, int lane) {
    const LAS unsigned char* vb = vt + (sub * 32 + (lane >> 5) * 4 + ((lane & 15) >> 2)) * VP + (16 * ((lane >> 4) & 1) + 4 * (lane & 3)) * 2;
#pragma unroll
    for (int s = 0; s < 2; ++s) {
        const bf16x8 pb = pfrag(p, s);
        const s16x4 a0 = vtr(vb + (16 * s) * VP), a1 = vtr(vb + (16 * s + 8) * VP), b0 = vtr(vb + (16 * s) * VP + 64), b1 = vtr(vb + (16 * s + 8) * VP + 64);
        const bf16x8 va = {a0[0], a0[1], a0[2], a0[3], a1[0], a1[1], a1[2], a1[3]}, vbb = {b0[0], b0[1], b0[2], b0[3], b1[0], b1[1], b1[2], b1[3]};
        o0 = __builtin_amdgcn_mfma_f32_32x32x16_bf16(va, pb, o0, 0, 0, 0);
        o1 = __builtin_amdgcn_mfma_f32_32x32x16_bf16(vbb, pb, o1, 0, 0, 0);
    }
}
__device__ __forceinline__ float max3f(float a, float b, float c) { float r; asm("v_max3_f32 %0, %1, %2, %3" : "=v"(r) : "v"(a), "v"(b), "v"(c)); return r; }
template <bool SCALED, int EXPT = 0>
__device__ __forceinline__ void softmax_pv(f32x16& p0, f32x16& p1, f32x16& o0, f32x16& o1, float& m, float& l, const LAS unsigned char* vt, int lane, bool v0 = true, bool v1 = true) {
    if (EXPT == 1) { l += p0[0]; pv_sub(o0, o1, vt, 0, p0, lane); pv_sub(o0, o1, vt, 1, p1, lane); return; }
    asm volatile("s_nop 15" : "+v"(p0), "+v"(p1));
    float mx;
    { float a = max3f(p0[0], p0[1], p0[2]), b = max3f(p1[0], p1[1], p1[2]);
      a = max3f(a, p0[3], p0[4]); b = max3f(b, p1[3], p1[4]); a = max3f(a, p0[5], p0[6]); b = max3f(b, p1[5], p1[6]);
      a = max3f(a, p0[7], p0[8]); b = max3f(b, p1[7], p1[8]); a = max3f(a, p0[9], p0[10]); b = max3f(b, p1[9], p1[10]);
      a = max3f(a, p0[11], p0[12]); b = max3f(b, p1[11], p1[12]); a = max3f(a, p0[13], p0[14]); b = max3f(b, p1[13], p1[14]);
      a = fmaxf(a, p0[15]); b = fmaxf(b, p1[15]); mx = fmaxf(v0 ? a : NEGBIG, v1 ? b : NEGBIG); }
    mx = max_x32(mx, lane);
    if (!SCALED) mx *= QK_C;
    const float mn = (mx - m > 8.0f) ? mx : m, alpha = fast_exp2(m - mn);
    const float mn0 = v0 ? mn : 1e30f, mn1 = v1 ? mn : 1e30f;
    f32x2 ls2 = {0.f, 0.f};
#pragma unroll
    for (int r = 0; r < 16; r += 2) {
        f32x2 a = {p0[r], p0[r + 1]}, b = {p1[r], p1[r + 1]};
        if (SCALED) { a = a - mn0; b = b - mn1; } else { a = a * QK_C - mn0; b = b * QK_C - mn1; }
        a[0] = fast_exp2(a[0]); a[1] = fast_exp2(a[1]); b[0] = fast_exp2(b[0]); b[1] = fast_exp2(b[1]);
        p0[r] = a[0]; p0[r + 1] = a[1]; p1[r] = b[0]; p1[r + 1] = b[1];
        ls2 += a; ls2 += b; }
    float ls = ls2[0] + ls2[1];
    ls = sum_x32(ls, lane);
    l = l * alpha + ls; m = mn;
    if (!__all(alpha == 1.0f)) { o0 *= alpha; o1 *= alpha; }
    pv_sub(o0, o1, vt, 0, p0, lane); pv_sub(o0, o1, vt, 1, p1, lane);
}
__device__ __forceinline__ void load_qf(bf16x8 (&qf)[4], const bf16_t* qrow, int lane) {
#pragma unroll
    for (int ks = 0; ks < 4; ++ks) qf[ks] = *(const bf16x8*)(qrow + 16 * ks + 8 * (lane >> 5));
}
__device__ __forceinline__ void store_ot(const f32x16& o0, const f32x16& o1, float sc, bf16_t* orow, int lane) {
    const int hi = lane >> 5;
#pragma unroll
    for (int g = 0; g < 4; ++g) {
        u32x2 w; w.x = pg8::cvt_pk_bf16(o0[4 * g] * sc, o0[4 * g + 1] * sc); w.y = pg8::cvt_pk_bf16(o0[4 * g + 2] * sc, o0[4 * g + 3] * sc); *(u32x2*)(orow + 8 * g + 4 * hi) = w;
        u32x2 x; x.x = pg8::cvt_pk_bf16(o1[4 * g] * sc, o1[4 * g + 1] * sc); x.y = pg8::cvt_pk_bf16(o1[4 * g + 2] * sc, o1[4 * g + 3] * sc); *(u32x2*)(orow + 32 + 8 * g + 4 * hi) = x;
    }
}

template <int EXPT = 0>
__device__ __forceinline__ void fox_phase(const Frame& F, const Args& a, bf16_t* O, int opitch) {
    bf16_t* H = (bf16_t*)(F.ws + WS_R + R_H); const float* DC = (const float*)(F.ws + WS_DCUM);
    const int lane = F.lane, tid = F.tid, hi = lane >> 5;
    LAS unsigned char* kvb = F.lds; LAS float* dkb = (LAS float*)(F.lds + 4 * KV_BUF);
    const int NU = NB * 16 * 8;
    for (int ui = F.bid; ui < NU; ui += F.G) {
        const int qb = 7 - (ui / (NB * 16)), bh = ui % (NB * 16), b = bh >> 4, h = bh & 15;
        const size_t rb0 = (size_t)b * SEQ;
        const bf16_t* Kp = H + rb0 * NO_PAD + 1024 + h * 64; const bf16_t* Vp = H + rb0 * NO_PAD + 2048 + h * 64;
        const int q0 = qb * 256 + F.wave * 32, tq = q0 + (lane & 31);
        bf16x8 qf[4]; load_qf(qf, H + (rb0 + tq) * NO_PAD + h * 64, lane);
        f32x16 o0 = {}, o1 = {}; float m = -1e20f, l = 0.f;
        const int ntile = qb * 4 + 4; const int wlast = (q0 + 31) >> 6;
        KVRegs krA, krB; float dkA = 0.f, dkB = 0.f;
        kv_load(krA, Kp, Vp, NO_PAD, 0, tid); if (tid < 64) dkA = DC[(rb0 + tid) * 16 + h];
        if (ntile > 1) { kv_load(krB, Kp, Vp, NO_PAD, 64, tid); if (tid < 64) dkB = DC[(rb0 + 64 + tid) * 16 + h]; }
        __syncthreads();
#define FOX_FILL(KR, DKR, T) do { const int t = (T); kv_store(KR, kvb + (t & 3) * KV_BUF, tid); if (tid < 64) dkb[(t & 3) * 64 + tid] = -DKR; } while (0)
#define FOX_NEXT(KR, DKR, T) do { const int t = (T); if (t + 2 < ntile) { kv_load(KR, Kp, Vp, NO_PAD, (t + 2) * 64, tid); if (tid < 64) DKR = DC[(rb0 + (t + 2) * 64 + tid) * 16 + h]; } } while (0)
#define FOX_COMP(T) do { const int t = (T); LAS unsigned char* buf = kvb + (t & 3) * KV_BUF; \
            if (EXPT == 2) { l += ((const LAS float*)buf)[lane]; } else if (t <= wlast) { \
                f32x16 p0, p1; qk_tile(p0, p1, buf, qf, lane); \
                const LAS float* dk = dkb + (t & 3) * 64; \
                if (64 * t + 63 <= q0) { \
                    _Pragma("unroll") for (int r = 0; r < 16; ++r) { const int kk = crow(r, hi); p0[r] = __builtin_fmaf(p0[r], QK_C, dk[kk]); p1[r] = __builtin_fmaf(p1[r], QK_C, dk[kk + 32]); } \
                } else { \
                    _Pragma("unroll") for (int r = 0; r < 16; ++r) { const int kk = crow(r, hi), key = t * 64 + kk; \
                        const float s0 = __builtin_fmaf(p0[r], QK_C, dk[kk]), s1 = __builtin_fmaf(p1[r], QK_C, dk[kk + 32]); \
                        p0[r] = (key <= tq) ? s0 : NEGBIG; p1[r] = (key + 32 <= tq) ? s1 : NEGBIG; } \
                } \
                softmax_pv<true, EXPT>(p0, p1, o0, o1, m, l, buf + KT_BYTES, lane); \
            } } while (0)
        for (int t2 = 0; t2 < ntile; t2 += 2) {
            FOX_FILL(krA, dkA, t2); FOX_FILL(krB, dkB, t2 + 1);
            __syncthreads();
            FOX_NEXT(krA, dkA, t2); FOX_NEXT(krB, dkB, t2 + 1);
            FOX_COMP(t2); FOX_COMP(t2 + 1);
        }
#undef FOX_FILL
#undef FOX_NEXT
#undef FOX_COMP
        store_ot(o0, o1, 1.0f / l, O + (rb0 + tq) * opitch + h * 64, lane);
        __syncthreads();
    }
}

template <class MaskFn>
__device__ __forceinline__ void attn_tiles(const Frame& F, unsigned tm, const bf16_t* Kp, const bf16_t* Vp, size_t pitch, const bf16x8 (&qf)[4],
                                            f32x16& o0, f32x16& o1, float& m, float& l, LAS unsigned char* kvb, MaskFn&& mask) {
    const int tid = F.tid, lane = F.lane;
    KVRegs krA, krB;
    int tA = -1, tB = -1;
    if (tm) { tA = __builtin_ctz(tm); tm &= tm - 1; kv_load(krA, Kp, Vp, pitch, tA * 64, tid); }
    if (tm) { tB = __builtin_ctz(tm); tm &= tm - 1; kv_load(krB, Kp, Vp, pitch, tB * 64, tid); }
#define ATT_TILE(KR, TV, PAR) do { const int t = TV; LAS unsigned char* buf = kvb + (PAR) * KV_BUF; \
        kv_store(KR, buf, tid); \
        __syncthreads(); \
        if (tm) { TV = __builtin_ctz(tm); tm &= tm - 1; kv_load(KR, Kp, Vp, pitch, TV * 64, tid); } else TV = -1; \
        f32x16 p0, p1; qk_tile(p0, p1, buf, qf, lane); \
        bool v0 = true, v1 = true; mask(p0, p1, t, v0, v1); \
        softmax_pv<false>(p0, p1, o0, o1, m, l, buf + KT_BYTES, lane, v0, v1); } while (0)
    while (tA >= 0) { ATT_TILE(krA, tA, 0); if (tB < 0) break; ATT_TILE(krB, tB, 1); }
#undef ATT_TILE
    __syncthreads();
}
__device__ __forceinline__ unsigned pkh(float a, float b) { const _Float16 x = (_Float16)a, y = (_Float16)b; return (unsigned)__builtin_bit_cast(unsigned short, x) | ((unsigned)__builtin_bit_cast(unsigned short, y) << 16); }
__device__ __forceinline__ float h2f(unsigned short h) { return (float)__builtin_bit_cast(_Float16, h); }
__device__ __forceinline__ float dpp_f(float x, int ctrl_sel) {
    const int v = __builtin_bit_cast(int, x); int r;
    if (ctrl_sel == 0) r = __builtin_amdgcn_update_dpp(0, v, 0xB1, 0xf, 0xf, true);
    else if (ctrl_sel == 1) r = __builtin_amdgcn_update_dpp(0, v, 0x4E, 0xf, 0xf, true);
    else r = __builtin_amdgcn_update_dpp(0, v, 0x141, 0xf, 0xf, true);
    return __builtin_bit_cast(float, r);
}

__device__ __forceinline__ void dsa_unit(const Frame& F, const Args& a, int b, int qg, bf16_t* O, int opitch) {
    bf16_t* H = (bf16_t*)(F.ws + WS_R + R_H);
    const int lane = F.lane, hi = lane >> 5, t0 = qg * 32; const size_t rb0 = (size_t)b * SEQ;
    LAS float* sc = (LAS float*)F.lds;
    LAS unsigned* bm = (LAS unsigned*)(F.lds + LDS_TAB);
    for (int hf = 0; hf < 2; ++hf) {
        const int tq0 = t0 + 16 * hf, nkt = ((tq0 + 15) >> 5) + 1;
        {
            bf16x8 qi[4][4], wf[4][2];
#pragma unroll
            for (int ct = 0; ct < 4; ++ct) { const int q = tq0 + 4 * ct + ((lane & 31) >> 3), head = lane & 7; const bf16_t* rp = H + (rb0 + q) * NE_PAD;
#pragma unroll
                for (int ks = 0; ks < 4; ++ks) qi[ct][ks] = *(const bf16x8*)(rp + EC_QI + head * 64 + 16 * ks + 8 * hi);
                const int qp = lane & 31; u32x2 w4 = {0u, 0u};
                if (qp < 4) w4 = *(const u32x2*)(H + (rb0 + tq0 + 4 * ct + qp) * NE_PAD + EC_WI + 4 * hi);
                const u32x4 s0 = {(qp == 0) ? w4.x : 0u, (qp == 0) ? w4.y : 0u, (qp == 1) ? w4.x : 0u, (qp == 1) ? w4.y : 0u};
                const u32x4 s1 = {(qp == 2) ? w4.x : 0u, (qp == 2) ? w4.y : 0u, (qp == 3) ? w4.x : 0u, (qp == 3) ? w4.y : 0u};
                wf[ct][0] = __builtin_bit_cast(bf16x8, s0); wf[ct][1] = __builtin_bit_cast(bf16x8, s1); }
            for (int kt = F.wave; kt < nkt; kt += 8) {
                bf16x8 kf[4]; { const bf16_t* kp = H + (rb0 + kt * 32 + (lane & 31)) * NE_PAD + EC_KI + 8 * hi;
#pragma unroll
                    for (int ks = 0; ks < 4; ++ks) kf[ks] = *(const bf16x8*)(kp + 16 * ks); }
#pragma unroll
                for (int ct = 0; ct < 4; ++ct) {
                    f32x16 acc = {};
#pragma unroll
                    for (int ks = 0; ks < 4; ++ks) acc = __builtin_amdgcn_mfma_f32_32x32x16_bf16(qi[ct][ks], kf[ks], acc, 0, 0, 0);
#pragma unroll
                    for (int r = 0; r < 16; ++r) acc[r] = fmaxf(acc[r], 0.f);
                    f32x16 y = {};
                    y = __builtin_amdgcn_mfma_f32_32x32x16_bf16(wf[ct][0], pfrag(acc, 0), y, 0, 0, 0);
                    y = __builtin_amdgcn_mfma_f32_32x32x16_bf16(wf[ct][1], pfrag(acc, 1), y, 0, 0, 0);
                    if (lane < 32) { LAS float* dst = sc + (4 * ct) * 2048 + kt * 32 + lane;
                        dst[0] = y[0]; dst[2048] = y[1]; dst[4096] = y[2]; dst[6144] = y[3]; }
                }
            }
        }
        __syncthreads();
        for (int q2 = 0; q2 < 2; ++q2) {
            const int ql = 2 * F.wave + q2, tq = tq0 + ql, n = tq + 1;
            unsigned u[32];
#pragma unroll
            for (int j = 0; j < 32; ++j) { const int idx = 64 * j + lane; unsigned bits = 0u;
                if (idx < n) { bits = __builtin_bit_cast(unsigned, sc[ql * 2048 + idx]); if ((bits << 1) == 0u) bits = 0u; bits ^= (bits & 0x80000000u) ? 0xffffffffu : 0x80000000u; }
                u[j] = bits; }
            unsigned thr = 0u; int need = 0; bool exact = false;
            if (n > 256) {
                const int ng = (n + 511) >> 9;
                for (int bit = 31; bit >= 0; --bit) { const unsigned cand = thr | (1u << bit); int c = 0;
#pragma unroll
                    for (int g = 0; g < 4; ++g) if (g < ng) {
#pragma unroll
                        for (int j = 8 * g; j < 8 * g + 8; ++j) c += (u[j] >= cand) ? 1 : 0; }
                    c = wave_sum_i(c);
                    if (c >= 256) { thr = cand; if (c == 256) { exact = true; break; } } }
                if (!exact) { int cgt = 0;
#pragma unroll
                    for (int j = 0; j < 32; ++j) cgt += (u[j] > thr) ? 1 : 0;
                    cgt = wave_sum_i(cgt);
                    need = 256 - cgt; }
            }
            const unsigned long long lt = (1ull << lane) - 1ull; int er = 0;
            if (exact) {
#pragma unroll
                for (int j = 0; j < 32; ++j) { const unsigned long long sm = __ballot(u[j] >= thr);
                    if (lane == 0) { bm[(16 * hf + ql) * 64 + 2 * j] = (unsigned)sm; bm[(16 * hf + ql) * 64 + 2 * j + 1] = (unsigned)(sm >> 32); } } }
            else
#pragma unroll
            for (int j = 0; j < 32; ++j) { const int idx = 64 * j + lane; bool sel;
                if (n > 256) {
                  const unsigned long long eqm = __ballot(u[j] == thr && idx < n); sel = (u[j] > thr) || (u[j] == thr && idx < n && (er + __popcll(eqm & lt)) < need); er += __popcll(eqm); }
                else sel = idx < n;
                const unsigned long long sm = __ballot(sel);
                if (lane == 0) { bm[(16 * hf + ql) * 64 + 2 * j] = (unsigned)sm; bm[(16 * hf + ql) * 64 + 2 * j + 1] = (unsigned)(sm >> 32); } }
        }
        __syncthreads();
    }
    const int tq = t0 + (lane & 31);
    bf16x8 qf[4]; load_qf(qf, H + (rb0 + tq) * NE_PAD + EC_QA + F.wave * 64, lane);
    f32x16 o0 = {}, o1 = {}; float m = -1e20f, l = 0.f;
    const int ntile = ((t0 + 31) >> 6) + 1; const unsigned tm = (ntile >= 32) ? 0xffffffffu : ((1u << ntile) - 1u);
    const LAS unsigned* bq = bm + (lane & 31) * 64;
    attn_tiles(F, tm, H + rb0 * NE_PAD + EC_KA, H + rb0 * NE_PAD + EC_VA, NE_PAD, qf, o0, o1, m, l, F.lds,
        [&](f32x16& p0, f32x16& p1, int t, bool&, bool&) { const unsigned w0 = bq[2 * t] >> (4 * hi), w1 = bq[2 * t + 1] >> (4 * hi);
#pragma unroll
            for (int r = 0; r < 16; ++r) { const int sh = (r & 3) + 8 * (r >> 2);
                p0[r] = ((w0 >> sh) & 1u) ? p0[r] : NEGBIG; p1[r] = ((w1 >> sh) & 1u) ? p1[r] : NEGBIG; } });
    store_ot(o0, o1, 1.0f / l, O + (rb0 + tq) * opitch + F.wave * 64, lane);
}

__device__ __forceinline__ void compress_item(const Frame& F, const Args& a, int layer, int item) {
    const bf16_t* H = (const bf16_t*)(F.ws + WS_R + R_H); const bf16_t* W = (const bf16_t*)(F.ws + WS_W + wbuf_off(layer));
    const int kv = item & 1, ct = (item >> 1) & 3, b = item >> 3, lane = F.lane, hi = lane >> 5;
    const bf16_t* w1t = W + (kv ? W_C1V : W_C1K) / 2; const bf16_t* w2t = W + (kv ? W_C2V : W_C2K) / 2;
    const float* bias1 = (const float*)(F.ws + WS_MISC) + kv * 64;
    bf16_t* outp = (bf16_t*)(F.ws + (kv ? WS_VC : WS_KC)) + (size_t)b * 128 * 64;
    const int col = kv ? EC_VC : EC_KC;
    LAS float* part = (LAS float*)F.lds; LAS unsigned short* hs = (LAS unsigned short*)(F.lds + 65536);
    int c = ct * 32 + (lane & 31); if (c > 126) c = 126;
    f32x16 a0 = {}, a1 = {};
#pragma unroll 8
    for (int ks = F.wave * 16; ks < F.wave * 16 + 16; ++ks) {
        const bf16x8 af = *(const bf16x8*)(H + ((size_t)b * SEQ + 16 * c + (ks >> 2)) * NE_PAD + col + 16 * (ks & 3) + 8 * hi);
        const bf16x8 b0 = *(const bf16x8*)(w1t + (size_t)(lane & 31) * 2048 + 16 * ks + 8 * hi), b1 = *(const bf16x8*)(w1t + (size_t)(32 + (lane & 31)) * 2048 + 16 * ks + 8 * hi);
        a0 = __builtin_amdgcn_mfma_f32_32x32x16_bf16(af, b0, a0, 0, 0, 0); a1 = __builtin_amdgcn_mfma_f32_32x32x16_bf16(af, b1, a1, 0, 0, 0);
    }
#pragma unroll
    for (int r = 0; r < 16; ++r) { part[F.wave * 2048 + crow(r, hi) * 64 + (lane & 31)] = a0[r]; part[F.wave * 2048 + crow(r, hi) * 64 + 32 + (lane & 31)] = a1[r]; }
    __syncthreads();
#pragma unroll
    for (int i = 0; i < 4; ++i) { const int idx = F.tid + 512 * i; float s = bias1[idx & 63];
#pragma unroll
        for (int w = 0; w < 8; ++w) s += part[w * 2048 + idx];
        const float h = s / (1.0f + __expf(-s)); hs[(idx >> 6) * 72 + (idx & 63)] = (unsigned short)f2bf(h); }
    __syncthreads();
    if (F.wave < 2) {
        const int nt = F.wave; f32x16 acc = {};
#pragma unroll
        for (int ks = 0; ks < 4; ++ks) { const bf16x8 af = *(const LAS bf16x8*)((const LAS unsigned char*)hs + (lane & 31) * 144 + (16 * ks + 8 * hi) * 2);
            const bf16x8 bf = *(const bf16x8*)(w2t + (size_t)(nt * 32 + (lane & 31)) * 64 + 16 * ks + 8 * hi);
            acc = __builtin_amdgcn_mfma_f32_32x32x16_bf16(af, bf, acc, 0, 0, 0); }
        const int n = nt * 32 + (lane & 31);
        const float* cosT = (const float*)(F.ws + WS_ROPE_COS); const float* sinT = (const float*)(F.ws + WS_ROPE_SIN);
#pragma unroll
        for (int r = 0; r < 16; ++r) { const int cg = ct * 32 + crow(r, hi); float v = acc[r];
            if (kv == 0) { const float o = dpp_mov<DPP_X1>(v); int pos = 16 * cg + 31; if (pos > SEQ - 1) pos = SEQ - 1; const float cs = cosT[pos * 32 + (n >> 1)], sn = sinT[pos * 32 + (n >> 1)];
                v = (n & 1) ? (v * cs + o * sn) : (v * cs - o * sn); }
            outp[(size_t)cg * 64 + n] = (unsigned short)((cg <= 126) ? f2bf(v) : 0u); }
    }
    __syncthreads();
}

__device__ __forceinline__ void nsa_unit(const Frame& F, const Args& a, int layer, int b, int qg, bf16_t* O, int opitch) {
    bf16_t* H = (bf16_t*)(F.ws + WS_R + R_H);
    const int lane = F.lane, hi = lane >> 5, tid = F.tid, t0 = qg * 32, cur = qg; const size_t rb0 = (size_t)b * SEQ;
    const int tq = t0 + (lane & 31);
    LAS unsigned char* kvb = F.lds;
    LAS unsigned short* slab = (LAS unsigned short*)(F.lds + 2 * KV_BUF);
    LAS float* pcs = (LAS float*)(F.lds + 2 * KV_BUF + 65536);
    LAS unsigned* selm = (LAS unsigned*)(pcs + 4096);
    const bf16_t* rowp = H + (rb0 + tq) * NE_PAD;
    bf16x8 qf[4]; load_qf(qf, rowp + EC_QB + F.wave * 64, lane);
    const float* bg = a.in[I_EV_BGATE] + (layer >> 1) * 24 + F.wave * 3;
    const float g0 = sigmoidf_(bf2f(rowp[EC_GB + F.wave * 3 + 0]) + bg[0]), g1 = sigmoidf_(bf2f(rowp[EC_GB + F.wave * 3 + 1]) + bg[1]), g2 = sigmoidf_(bf2f(rowp[EC_GB + F.wave * 3 + 2]) + bg[2]);
    { const bf16_t* kc = (const bf16_t*)(F.ws + WS_KC) + (size_t)b * 128 * 64; const bf16_t* vc = (const bf16_t*)(F.ws + WS_VC) + (size_t)b * 128 * 64;
      KVRegs r0, r1; kv_load(r0, kc, vc, 64, 0, tid); kv_load(r1, kc, vc, 64, 64, tid); kv_store(r0, kvb, tid); kv_store(r1, kvb + KV_BUF, tid); }
    __syncthreads();
    f32x16 pc[4]; f32x16 oa0 = {}, oa1 = {};
    {
        const int cmax = (tq >= 31) ? min(126, (tq - 31) >> 4) : -1;
        qk_tile(pc[0], pc[1], kvb, qf, lane); asm volatile("" ::: "memory"); qk_tile(pc[2], pc[3], kvb + KV_BUF, qf, lane); asm volatile("" ::: "memory");
        float mx = NEGBIG;
#pragma unroll
        for (int s = 0; s < 4; ++s)
#pragma unroll
            for (int r = 0; r < 16; ++r) { const int c = 32 * s + crow(r, hi); pc[s][r] = (c <= cmax) ? pc[s][r] * QK_C : NEGBIG; mx = fmaxf(mx, pc[s][r]); }
        mx = max_x32(mx, lane);
        float ls = 0.f;
#pragma unroll
        for (int s = 0; s < 4; ++s)
#pragma unroll
            for (int r = 0; r < 16; ++r) { pc[s][r] = (pc[s][r] > -1e29f) ? fast_exp2(pc[s][r] - mx) : 0.f; ls += pc[s][r]; }
        ls = sum_x32(ls, lane);
        const float inv = (ls > 0.f) ? 1.0f / ls : 0.f;
#pragma unroll
        for (int s = 0; s < 4; ++s) pc[s] *= inv;
        f32x16 c0 = {}, c1 = {};
        asm volatile("" ::: "memory");
        pv_sub(c0, c1, kvb + KT_BYTES, 0, pc[0], lane); asm volatile("" ::: "memory"); pv_sub(c0, c1, kvb + KT_BYTES, 1, pc[1], lane); asm volatile("" ::: "memory");
        pv_sub(c0, c1, kvb + KV_BUF + KT_BYTES, 0, pc[2], lane); asm volatile("" ::: "memory"); pv_sub(c0, c1, kvb + KV_BUF + KT_BYTES, 1, pc[3], lane); asm volatile("" ::: "memory");
        oa0 = c0 * g0; oa1 = c1 * g0;
    }
    { LAS unsigned short* sl = slab + F.wave * 4096 + (lane & 31) * 128 + 4 * hi;
#pragma unroll
      for (int s = 0; s < 4; ++s)
#pragma unroll
          for (int g = 0; g < 4; ++g) { u32x2 w; w.x = pkh(pc[s][4 * g], pc[s][4 * g + 1]); w.y = pkh(pc[s][4 * g + 2], pc[s][4 * g + 3]); *(LAS u32x2*)(sl + 32 * s + 8 * g) = w; } }
    __syncthreads();
#pragma unroll
    for (int i = 0; i < 8; ++i) { const int idx = tid + 512 * i; float s8 = 0.f;
#pragma unroll
        for (int w = 0; w < 8; ++w) s8 += h2f(slab[w * 4096 + idx]);
        pcs[idx] = s8; }
    __syncthreads();
#pragma unroll
    for (int qq = 0; qq < 4; ++qq) { const int q = 4 * F.wave + qq; const LAS float* pr = pcs + q * 128;
        float v = pr[2 * lane] + 0.5f * ((lane > 0 ? pr[2 * lane - 1] : 0.f) + pr[2 * lane + 1]);
        if (lane == 0 || lane == cur || lane == cur - 1) v = 1e30f - (float)lane * 1e27f; else if (lane > cur) v = NEGBIG;
        int rank = 0;
#pragma unroll
        for (int j = 0; j < 64; ++j) { const float o = __builtin_bit_cast(float, __builtin_amdgcn_readlane(__builtin_bit_cast(int, v), j)); rank += (o > v) ? 1 : 0; }
        bool tie = false;
#pragma unroll
        for (int k = 0; k < 8; ++k) tie |= (__popcll(__ballot(rank == k)) != 1);
        if (tie) { rank = 0;
#pragma unroll 1
            for (int j = 0; j < 64; ++j) { const float o = __builtin_bit_cast(float, __builtin_amdgcn_readlane(__builtin_bit_cast(int, v), j)); rank += (o > v || (o == v && j < lane)) ? 1 : 0; } }
        const unsigned long long sm = __ballot(rank < 8);
        if (lane == 0) { selm[2 * q] = (unsigned)sm; selm[2 * q + 1] = (unsigned)(sm >> 32); } }
    __syncthreads();
    LAS float* stash = (LAS float*)(F.lds + 2 * KV_BUF) + F.wave * 2048 + lane;
#pragma unroll
    for (int r = 0; r < 16; ++r) { stash[r * 64] = oa0[r]; stash[(16 + r) * 64] = oa1[r]; }
    {
        unsigned long long un = 0ull;
        { const unsigned lo = selm[2 * (lane & 31)], hh = selm[2 * (lane & 31) + 1]; unsigned ul = lo, uh = hh;
          ul |= dpp_movu<DPP_X1>(ul); ul |= dpp_movu<DPP_X2>(ul); ul |= dpp_movu<DPP_HM>(ul); ul |= dpp_movu<DPP_RM>(ul);
          uh |= dpp_movu<DPP_X1>(uh); uh |= dpp_movu<DPP_X2>(uh); uh |= dpp_movu<DPP_HM>(uh); uh |= dpp_movu<DPP_RM>(uh);
          un = ((unsigned long long)((unsigned)__builtin_amdgcn_readlane((int)uh, 0) | (unsigned)__builtin_amdgcn_readlane((int)uh, 16)) << 32) | ((unsigned)__builtin_amdgcn_readlane((int)ul, 0) | (unsigned)__builtin_amdgcn_readlane((int)ul, 16)); }
        if (cur < 63) un &= (1ull << (cur + 1)) - 1ull;
        unsigned tm = 0u;
        for (int t = 0; t <= (cur >> 1); ++t) if ((un >> (2 * t)) & 3ull) tm |= 1u << t;
        const unsigned long long mysel = ((unsigned long long)selm[2 * (lane & 31) + 1] << 32) | selm[2 * (lane & 31)];
        f32x16 s0 = {}, s1 = {}; float m = -1e20f, l = 0.f;
        attn_tiles(F, tm, H + rb0 * NE_PAD + EC_KS, H + rb0 * NE_PAD + EC_VS, NE_PAD, qf, s0, s1, m, l, kvb,
            [&](f32x16& p0, f32x16& p1, int t, bool& v0, bool& v1) { const bool b0 = (mysel >> (2 * t)) & 1ull, b1 = (mysel >> (2 * t + 1)) & 1ull;
                if (64 * t + 63 <= t0) { v0 = b0; v1 = b1; }
                else {
#pragma unroll
                    for (int r = 0; r < 16; ++r) { const int key = 64 * t + crow(r, hi);
                        p0[r] = (b0 && key <= tq) ? p0[r] : NEGBIG; p1[r] = (b1 && key + 32 <= tq) ? p1[r] : NEGBIG; } } });
        const float sc = g1 / l;
#pragma unroll
        for (int r = 0; r < 16; ++r) { stash[r * 64] += s0[r] * sc; stash[(16 + r) * 64] += s1[r] * sc; }
    }
    {
        const int tlo = (t0 >= 511) ? ((t0 - 511) >> 6) : 0, thi = (t0 + 31) >> 6;
        unsigned tm = 0u; for (int t = tlo; t <= thi; ++t) tm |= 1u << t;
        f32x16 s0 = {}, s1 = {}; float m = -1e20f, l = 0.f;
        attn_tiles(F, tm, H + rb0 * NE_PAD + EC_KW, H + rb0 * NE_PAD + EC_VW, NE_PAD, qf, s0, s1, m, l, kvb,
            [&](f32x16& p0, f32x16& p1, int t, bool&, bool&) {
                const bool interior = (64 * t + 63 <= t0) && (64 * t + 512 > t0 + 31);
                if (!interior) {
#pragma unroll
                    for (int r = 0; r < 16; ++r) { const int key = 64 * t + crow(r, hi);
                        p0[r] = (key <= tq && key + 512 > tq) ? p0[r] : NEGBIG; p1[r] = (key + 32 <= tq && key + 32 + 512 > tq) ? p1[r] : NEGBIG; } } });
        const float sc = g2 / l;
#pragma unroll
        for (int r = 0; r < 16; ++r) { oa0[r] = stash[r * 64] + s0[r] * sc; oa1[r] = stash[(16 + r) * 64] + s1[r] * sc; }
    }
    store_ot(oa0, oa1, 1.0f, O + (rb0 + tq) * opitch + F.wave * 64, lane);
    __syncthreads();
}

__device__ __forceinline__ void moe_tables(const Frame& F, int layer) {
    LAS int* cntl = (LAS int*)(F.lds + LDS_TAB); LAS int* rbs = cntl + 160;
    __syncthreads();
    if (F.tid < NV) cntl[F.tid] = ((F.tid % 65) == 64) ? HALF_T : (int)__hip_atomic_load(F.ctl + CW_CNT + layer * 256 + F.tid, RLX_AGENT);
    __syncthreads();
    if (F.tid <= NV) { int run = 0; for (int u = 0; u < F.tid; ++u) run += (cntl[u] + 255) >> 8; rbs[F.tid] = run; }
    __syncthreads();
}

constexpr int PH_PER_LAYER = 16, N_PHASES = DEPTH * PH_PER_LAYER;
__global__ void __launch_bounds__(512, 2) fwd(const float* i0, const float* i1, const float* i2, const float* i3, const float* i4, const float* i5, const float* i6, const float* i7, const float* i8, const float* i9, const float* i10, const float* i11, const float* i12, const float* i13, const float* i14, const float* i15, const float* i16, const float* i17, const float* i18, const float* i19, const float* i20, const float* i21, const float* i22, const float* i23, const float* i24, const float* i25, const float* i26, const float* i27, const float* i28, float* out_, unsigned char* ws_, int ph_lo_, int ph_hi_) {
    Args args; args.in[0] = i0; args.in[1] = i1; args.in[2] = i2; args.in[3] = i3; args.in[4] = i4; args.in[5] = i5; args.in[6] = i6; args.in[7] = i7; args.in[8] = i8; args.in[9] = i9; args.in[10] = i10; args.in[11] = i11; args.in[12] = i12; args.in[13] = i13; args.in[14] = i14; args.in[15] = i15; args.in[16] = i16; args.in[17] = i17; args.in[18] = i18; args.in[19] = i19; args.in[20] = i20; args.in[21] = i21; args.in[22] = i22; args.in[23] = i23; args.in[24] = i24; args.in[25] = i25; args.in[26] = i26; args.in[27] = i27; args.in[28] = i28; args.out = out_; args.ws = ws_; args.ph_lo = ph_lo_; args.ph_hi = ph_hi_;
    extern __shared__ __attribute__((aligned(16))) unsigned char lds_raw[];
    Frame F; F.lds = (LAS unsigned char*)lds_raw; F.tid = threadIdx.x; F.lane = F.tid & 63; F.wave = __builtin_amdgcn_readfirstlane(F.tid >> 6);
    F.G = gridDim.x; F.bid = blockIdx.x; F.ws = args.ws; F.ctl = (gu32*)(args.ws + WS_CTL);
    volatile LAS unsigned* MISC = (volatile LAS unsigned*)(F.lds + LDS_MISC);
    if (threadIdx.x < 64) MISC[threadIdx.x] = 0u;
    __syncthreads();
#if MK_ONE_LAUNCH
    constexpr int lo = 0, hi = N_PHASES; constexpr bool multi = true;
#else
    const int lo = args.ph_lo, hi = args.ph_hi; const bool multi = (hi - lo) > 1;
#endif
    XcdBarrier bar; bar.bar = (unsigned*)(F.ctl + CW_BAR); bar.x = 0; bar.st = MISC;
    if (multi) bar = xcd_barrier_post((unsigned*)(F.ctl + CW_BAR), MISC);
#ifndef PHMASK
#define PHMASK 0xffff
#endif
#define IN(k) (((PHMASK >> ((k) & 15)) & 1) && lo <= (k) && (k) < hi)
#ifndef TIMING
#define TIMING 0
#endif
#if TIMING
    if (F.tid == 0) { const unsigned long long t0_ = wall_clock64(); MISC[16] = (unsigned)t0_; MISC[17] = (unsigned)(t0_ >> 32); }
#define SEAM() do { if (multi) xcd_barrier(bar); if (blockIdx.x == 0 && F.tid == 0) { const unsigned long long tn = wall_clock64(); const unsigned long long tp = ((unsigned long long)MISC[17] << 32) | MISC[16]; \
    ((unsigned long long*)(args.ws + WS_CTL + 512 * 1024))[MISC[18]] = tn - tp; MISC[16] = (unsigned)tn; MISC[17] = (unsigned)(tn >> 32); } } while (0)
#define SETPH(k) do { if (F.tid == 0) MISC[18] = (unsigned)(k); } while (0)
#else
#define SEAM() do { if (multi) xcd_barrier(bar); } while (0)
#define SETPH(k)
#endif
#ifndef DUP_K
#define DUP_K -1
#define DUP_PAR 2
#endif
#define NREP(k) ((DUP_K == (k) && (DUP_PAR == 2 || (layer & 1) == DUP_PAR)) ? 2 : 1)
#define PF() Frame P = F; { int t_; asm volatile("v_mbcnt_lo_u32_b32 %0, -1, 0\n\tv_mbcnt_hi_u32_b32 %0, -1, %0" : "=v"(t_)); t_ += F.wave * 64; P.tid = t_; P.lane = t_ & 63; int w_ = F.wave; asm volatile("" : "+s"(w_)); P.wave = w_; GAS unsigned char* p_ = (GAS unsigned char*)args.ws; asm volatile("" : "+s"(p_)); P.ws = (unsigned char*)p_; P.ctl = (gu32*)(p_ + WS_CTL); } \
    unsigned char* ws = P.ws; bf16_t* XB = (bf16_t*)(ws + WS_XB); bf16_t* XB2 = (bf16_t*)(ws + WS_R + R_XB2); bf16_t* XD = (bf16_t*)args.out; (void)XD; bf16_t* H = (bf16_t*)(ws + WS_R + R_H); bf16_t* W = (bf16_t*)(ws + WS_W + wbuf_off(layer)); (void)XB; (void)XB2; (void)H; (void)W;
    LAS int* cntl = (LAS int*)(F.lds + LDS_TAB); LAS int* rbs = cntl + 160;
    for (int layer = 0; layer < DEPTH; ++layer) {
        const int pb = layer * PH_PER_LAYER; const bool even = (layer & 1) == 0; const int jl = layer >> 1;
        const bool ovl = (F.G == 256);
        if (IN(pb + 0) && (layer == 0 || !ovl)) { SETPH(pb + 0); PF();
            prep_weights(P, args, layer, P.bid, P.G); prep_acts(P, args, layer, layer == 0);
            SEAM(); }
        if (IN(pb + 1)) { SETPH(pb + 1); PF();
            { const bf16_t* xin = (layer == 0) ? XB : XB2;
            if (even) { pg8::DenseSched S{(const char*)xin, (const char*)(W + W_IN / 2), DM, DM, T / 256, NE_PAD / 256, P.G, P.bid};
                EpiInEven E{H, (const float*)(ws + WS_ROPE_COS), (const float*)(ws + WS_ROPE_SIN)}; pg8::gemm_phase(P.lds, S, E, P.tid); }
            else { pg8::DenseSched S{(const char*)xin, (const char*)(W + W_IN / 2), DM, DM, T / 256, NO_PAD / 256, P.G, P.bid};
                EpiInOdd E{H, (float*)(ws + WS_LOGF), args.in[I_OD_BF] + jl * 16}; pg8::gemm_phase(P.lds, S, E, P.tid); } }
            SEAM(); }
        if ((DUP_K == 1 && (DUP_PAR == 2 || (layer & 1) == DUP_PAR))) { PF();
            { const bf16_t* xin = (layer == 0) ? XB : XB2;
            if (even) { pg8::DenseSched S{(const char*)xin, (const char*)(W + W_IN / 2), DM, DM, T / 256, NE_PAD / 256, P.G, P.bid};
                EpiInEven E{H, (const float*)(ws + WS_ROPE_COS), (const float*)(ws + WS_ROPE_SIN)}; pg8::gemm_phase(P.lds, S, E, P.tid); }
            else { pg8::DenseSched S{(const char*)xin, (const char*)(W + W_IN / 2), DM, DM, T / 256, NO_PAD / 256, P.G, P.bid};
                EpiInOdd E{H, (float*)(ws + WS_LOGF), args.in[I_OD_BF] + jl * 16}; pg8::gemm_phase(P.lds, S, E, P.tid); } }
            SEAM(); }
        if (even) {
        if (IN(pb + 2)) { SETPH(pb + 2); PF();
                for (int it = P.bid; it < 256; it += P.G) compress_item(P, args, layer, it);
                for (int u0 = 0; u0 < NB * 64; u0 += P.G) { const int u = u0 + (((u0 / P.G) & 1) ? (P.G - 1 - P.bid) : P.bid); if (u >= NB * 64) continue; const int qg = 63 - (u / NB), b = u % NB; dsa_unit(P, args, b, qg, H + EC_QA, NE_PAD); }
            SEAM(); }
        if ((DUP_K == 2 && (DUP_PAR == 2 || (layer & 1) == DUP_PAR))) { PF();
                for (int u0 = 0; u0 < NB * 64; u0 += P.G) { const int u = u0 + (((u0 / P.G) & 1) ? (P.G - 1 - P.bid) : P.bid); if (u >= NB * 64) continue; const int qg = 63 - (u / NB), b = u % NB; dsa_unit(P, args, b, qg, (bf16_t*)(ws + WS_R + 568 * MiB), 1024); }
            SEAM(); }
        if (IN(pb + 3)) { SETPH(pb + 3); PF();
                for (int u0 = 0; u0 < NB * 64; u0 += P.G) { const int u = u0 + (((u0 / P.G) & 1) ? (P.G - 1 - P.bid) : P.bid); if (u >= NB * 64) continue; const int qg = 63 - (u / NB), b = u % NB; nsa_unit(P, args, layer, b, qg, H + EC_QB, NE_PAD); }
            SEAM(); }
        if ((DUP_K == 3 && (DUP_PAR == 2 || (layer & 1) == DUP_PAR))) { PF();
                for (int u0 = 0; u0 < NB * 64; u0 += P.G) { const int u = u0 + (((u0 / P.G) & 1) ? (P.G - 1 - P.bid) : P.bid); if (u >= NB * 64) continue; const int qg = 63 - (u / NB), b = u % NB; nsa_unit(P, args, layer, b, qg, (bf16_t*)(ws + WS_R + 568 * MiB) + 512, 1024); }
            SEAM(); }
        } else {
        if (IN(pb + 2)) { SETPH(pb + 2); PF();
            scan_phase(P, args);
            SEAM(); }
        if (IN(pb + 3)) { SETPH(pb + 3); PF();
                fox_phase(P, args, H, NO_PAD);
            SEAM(); }
        if ((DUP_K == 3 && (DUP_PAR == 2 || (layer & 1) == DUP_PAR))) { PF();
#ifdef FOX_EXPT
                fox_phase<FOX_EXPT>(P, args, (bf16_t*)(ws + WS_R + 568 * MiB), 1024);
#else
                fox_phase(P, args, (bf16_t*)(ws + WS_R + 568 * MiB), 1024);
#endif
            SEAM(); }
        }
        if (IN(pb + 4)) { SETPH(pb + 4); PF();
            { pg8::DenseSched S{(const char*)H, (const char*)(W + W_O / 2), even ? NE_PAD : NO_PAD, DM, T / 256, DM / 256, P.G, P.bid};
              EpiOut E{(layer == 0) ? XB : XB2, (layer == 0) ? XB2 : XB}; pg8::gemm_phase(P.lds, S, E, P.tid); }
            SEAM(); }
        if ((DUP_K == 4 && (DUP_PAR == 2 || (layer & 1) == DUP_PAR))) { PF();
            { pg8::DenseSched S{(const char*)H, (const char*)(W + W_O / 2), even ? NE_PAD : NO_PAD, DM, T / 256, DM / 256, P.G, P.bid};
              EpiOut E{(layer == 0) ? XB : XB2, (bf16_t*)(ws + WS_R + 568 * MiB)}; pg8::gemm_phase(P.lds, S, E, P.tid); }
            SEAM(); }
        if (IN(pb + 5)) { SETPH(pb + 5); PF();
            route_phase(P, args, layer, (layer == 0) ? XB2 : XB, XD, false);
            SEAM(); }
        if ((DUP_K == 5 && (DUP_PAR == 2 || (layer & 1) == DUP_PAR))) { PF();
            route_phase(P, args, layer, (layer == 0) ? XB2 : XB, (bf16_t*)(ws + WS_R + 568 * MiB), true);
            SEAM(); }
        if (IN(pb + 6)) { SETPH(pb + 6); PF();
            const bool side = ovl && layer + 1 < DEPTH;
            if (side && (P.bid >> 3) >= 32 - SIDE_PX) prep_weights(P, args, layer + 1, (P.bid & 7) * SIDE_PX + (P.bid >> 3) - (32 - SIDE_PX), 8 * SIDE_PX);
            else { moe_tables(P, layer);
              MoeSched S{(const char*)XD, (const char*)(W + W_UP / 2), DM, DM, 2, (size_t)512 * DM * 2, rbs, cntl, 0, NV - 1, 0, rbs[NV] * 2, P.G, P.bid, (const int*)(ws + WS_SLOT_TK), true, side ? 32 - SIDE_PX : (P.G >> 3)};
              EpiUp E{(bf16_t*)(ws + WS_R + R_HMID)}; pg8::gemm_phase(P.lds, S, E, P.tid); }
            SEAM(); }
        if ((DUP_K == 6 && (DUP_PAR == 2 || (layer & 1) == DUP_PAR))) { PF();
            { moe_tables(P, layer);
              MoeSched S{(const char*)XD, (const char*)(W + W_UP / 2), DM, DM, 2, (size_t)512 * DM * 2, rbs, cntl, 0, NV - 1, 0, rbs[NV] * 2, P.G, P.bid, (const int*)(ws + WS_SLOT_TK), true, P.G >> 3};
              EpiUp E{(bf16_t*)(ws + WS_R + R_HMID)}; pg8::gemm_phase(P.lds, S, E, P.tid); }
            SEAM(); }
        if (IN(pb + 7)) { SETPH(pb + 7); PF();
                { LAS int* rcache = (LAS int*)(P.lds + LDS_TAB + 4096); if (P.tid < 2) rcache[P.tid] = 0;
                  moe_tables(P, layer);
                  MoeSched S{(const char*)(ws + WS_R + R_HMID), (const char*)(W + W_DN / 2), DFF, DFF, 4, (size_t)DM * DFF * 2, rbs, cntl, 0, NV - 1, 0, rbs[NV] * 4, P.G, P.bid, (const int*)(ws + WS_SLOT_TK), false, P.G >> 3};
                  EpiDown E{(bf16_t*)(ws + WS_R + R_YTOK), (const int*)(ws + WS_SLOT_TK), (const float*)(ws + WS_SLOT_G), cntl, false, rcache}; pg8::gemm_phase(P.lds, S, E, P.tid); }
            SEAM(); }
        if (IN(pb + 8)) { SETPH(pb + 8); PF();
#pragma unroll 1
            for (int hf = 0; hf < 2; ++hf) { int h2 = hf; asm volatile("" : "+s"(h2)); combine_phase(P, args, layer, h2, XD, XB, false); } }
        if (IN(pb + 10)) { PF();
            { pg8::DenseSched S{(const char*)(ws + WS_PB), (const char*)(W + W_P / 2), 256, 256, T / 256, DM / 256, P.G, P.bid};
              EpiPleE E{(bf16_t*)(ws + WS_R + R_E), (float*)(ws + WS_SSQ)}; pg8::gemm_phase(P.lds, S, E, P.tid); }
            SEAM(); }
        if ((DUP_K == 11 && (DUP_PAR == 2 || (layer & 1) == DUP_PAR))) { PF();
            { pg8::DenseSched S{(const char*)(ws + WS_PB), (const char*)(W + W_P / 2), 256, 256, T / 256, DM / 256, P.G, P.bid};
              EpiPleE E{(bf16_t*)(ws + WS_R + R_E), (float*)(ws + WS_SSQ)}; pg8::gemm_phase(P.lds, S, E, P.tid); }
            SEAM(); }
        if (IN(pb + 12)) { SETPH(pb + 12); PF();
            { pg8::DenseSched S{(const char*)XB, (const char*)(W + W_G / 2), DM, DM, T / 256, DM / 256, P.G, P.bid};
              EpiPleG E{XB, (const bf16_t*)(ws + WS_R + R_E), (const float*)(ws + WS_SSQ), args.in[I_PNG] + layer * DM, (layer + 1 < DEPTH) ? XB2 : (bf16_t*)nullptr, (layer + 1 < DEPTH) ? (float*)nullptr : args.out};
              pg8::gemm_phase(P.lds, S, E, P.tid); }
            if (ovl && layer + 1 < DEPTH) prep_acts(P, args, layer + 1, false);
            SEAM(); }
        if ((DUP_K == 12 && (DUP_PAR == 2 || (layer & 1) == DUP_PAR))) { PF();
            { pg8::DenseSched S{(const char*)XB, (const char*)(W + W_G / 2), DM, DM, T / 256, DM / 256, P.G, P.bid};
              EpiPleG E{XB, (const bf16_t*)(ws + WS_R + R_E), (const float*)(ws + WS_SSQ), args.in[I_PNG] + layer * DM, (bf16_t*)(ws + WS_R + 568 * MiB), (float*)nullptr}; pg8::gemm_phase(P.lds, S, E, P.tid); }
            SEAM(); }
    }
#ifdef EXTRA_BAR
    for (int i_ = 0; i_ < EXTRA_BAR; ++i_) { SEAM(); }
#endif
#if TIMING
    {
        VM_WAIT(); __syncthreads(); if (multi) xcd_barrier(bar);
        float ta = 0.f, tb = 0.f;
        for (int l = 0; l < DEPTH; ++l) for (int k = 0; k < 13; ++k) { const float d = (float)((unsigned long long*)(args.ws + WS_CTL + 512 * 1024))[l * 16 + k] * 0.01f;
            if (((TA_MASK >> k) & 1) && (TA_PAR == 2 || (l & 1) == TA_PAR)) ta += d; if (((TB_MASK >> k) & 1) && (TB_PAR == 2 || (l & 1) == TB_PAR)) tb += d; }
        for (size_t i = (size_t)blockIdx.x * 512 + F.tid; i < (size_t)T * DM; i += (size_t)gridDim.x * 512) args.out[i] = ta;
        VM_WAIT(); __syncthreads(); if (multi) xcd_barrier(bar);
        if (blockIdx.x == 0 && F.tid == 0) args.out[0] = tb * 100.f;
    }
#endif
#undef IN
#undef SEAM
}

extern "C" void kernel_launch(void* const* d_in, const int* in_sizes, int n_in, void* d_out, int out_size, void* d_ws, size_t ws_size, hipStream_t stream) {
    static int grid = 0;
    if (grid == 0) {
        if (n_in != 29 || in_sizes[0] != T * DM || out_size != T * DM || ws_size < WS_END) { fprintf(stderr, "kernel_launch: unexpected shapes / workspace (n_in %d, ws %zu, need %zu)\n", n_in, ws_size, (size_t)WS_END); grid = -1; return; }
        int dev = 0, cus = 0, per_cu = 0;
        if (hipGetDevice(&dev) != hipSuccess || hipDeviceGetAttribute(&cus, hipDeviceAttributeMultiprocessorCount, dev) != hipSuccess) { grid = -1; return; }
        if (hipFuncSetAttribute((const void*)fwd, hipFuncAttributeMaxDynamicSharedMemorySize, LDS_BYTES) != hipSuccess) { fprintf(stderr, "kernel_launch: hipFuncSetAttribute failed\n"); grid = -1; return; }
        if (hipOccupancyMaxActiveBlocksPerMultiprocessor(&per_cu, (const void*)fwd, 512, LDS_BYTES) != hipSuccess || per_cu < 1) { fprintf(stderr, "kernel_launch: occupancy query says %d\n", per_cu); }
        (void)hipGetLastError();
        grid = cus;
    }
    if (grid < 0) return;
    if (hipMemsetAsync((char*)d_ws + WS_CTL, 0, CTL_BYTES, stream) != hipSuccess) return;
    Args a{};
    for (int i = 0; i < 29; ++i) a.in[i] = (const float*)d_in[i];
    a.out = (float*)d_out; a.ws = (unsigned char*)d_ws;
#if MK_ONE_LAUNCH
    a.ph_lo = 0; a.ph_hi = N_PHASES;
    hipLaunchKernelGGL(fwd, dim3(grid), dim3(512), LDS_BYTES, stream, a.in[0], a.in[1], a.in[2], a.in[3], a.in[4], a.in[5], a.in[6], a.in[7], a.in[8], a.in[9], a.in[10], a.in[11], a.in[12], a.in[13], a.in[14], a.in[15], a.in[16], a.in[17], a.in[18], a.in[19], a.in[20], a.in[21], a.in[22], a.in[23], a.in[24], a.in[25], a.in[26], a.in[27], a.in[28], a.out, a.ws, a.ph_lo, a.ph_hi);
#else
    for (int ph = 0; ph < N_PHASES; ++ph) {
        if ((ph % PH_PER_LAYER) > 12) continue;
        a.ph_lo = ph; a.ph_hi = ph + 1;
        hipLaunchKernelGGL(fwd, dim3(grid), dim3(512), LDS_BYTES, stream, a.in[0], a.in[1], a.in[2], a.in[3], a.in[4], a.in[5], a.in[6], a.in[7], a.in[8], a.in[9], a.in[10], a.in[11], a.in[12], a.in[13], a.in[14], a.in[15], a.in[16], a.in[17], a.in[18], a.in[19], a.in[20], a.in[21], a.in[22], a.in[23], a.in[24], a.in[25], a.in[26], a.in[27], a.in[28], a.out, a.ws, a.ph_lo, a.ph_hi);
    }
#endif
}
```

```cpp
#include <hip/hip_runtime.h>
#include <cstdio>
#include <cstdint>

#define LAS __attribute__((address_space(3)))
#define GAS __attribute__((address_space(1)))
typedef unsigned short bf16_t;
typedef short bf16x8 __attribute__((ext_vector_type(8)));
typedef short s16x4 __attribute__((ext_vector_type(4)));
typedef float f32x2 __attribute__((ext_vector_type(2)));
typedef float f32x4 __attribute__((ext_vector_type(4)));
typedef float f32x16 __attribute__((ext_vector_type(16)));
typedef unsigned u32x2 __attribute__((ext_vector_type(2)));
typedef unsigned u32x4 __attribute__((ext_vector_type(4)));
typedef GAS unsigned gu32;

#ifndef SIDE_PX
#define SIDE_PX 3
#endif
#ifndef Y_FP8
#define Y_FP8 1
#endif
#ifndef MK_ONE_LAUNCH
#define MK_ONE_LAUNCH 1
#endif

constexpr int DM = 1024, NB = 32, SEQ = 2048, DEPTH = 4, T = NB * SEQ;
constexpr int EVEN_COLS = 2144, ODD_COLS = 3088, NE_PAD = 2304, NO_PAD = 3328;
constexpr int NEXP = 64, NV = 130  , HALF_T = T / 2, DFF = 256;
constexpr float LN_EPS = 1e-5f, RMS_EPS = 1e-6f;
constexpr float ALPHA = 1.6817928305074290f;
constexpr float LOG2E = 1.4426950408889634f;
constexpr float QK_C = 0.125f * LOG2E;
constexpr float NEGBIG = -1e30f;

constexpr int EC_QA = 0, EC_QB = 512, EC_QI = 1024, EC_KA = 1536, EC_KI = 1600, EC_KS = 1664, EC_KW = 1728;
constexpr int EC_VA = 1792, EC_KC = 1856, EC_VC = 1920, EC_VS = 1984, EC_VW = 2048, EC_WI = 2112, EC_GB = 2120;

constexpr size_t MiB = 1u << 20;
constexpr size_t WS_CTL = 0, CTL_BYTES = 1 * MiB;
constexpr size_t WS_ROPE_COS = 1 * MiB, WS_ROPE_SIN = WS_ROPE_COS + 256 * 1024;
constexpr size_t WS_SLOT_TK = 2 * MiB;
constexpr size_t WS_SLOT_G = WS_SLOT_TK + (size_t)NV * HALF_T * 4;
constexpr size_t WS_DCUM = 38 * MiB;
constexpr size_t WS_LOGF = 42 * MiB;
constexpr size_t WS_KC = 46 * MiB, WS_VC = WS_KC + 512 * 1024;
constexpr size_t WS_SSQ = 47 * MiB;
constexpr size_t WS_PB = 51 * MiB;
constexpr size_t WS_MISC = 83 * MiB;
constexpr size_t WS_XB = 84 * MiB;
constexpr size_t WS_W = 212 * MiB, W_BUF = 128 * MiB;
constexpr size_t W_IN = 0, W_O = 7 * MiB, W_G = 9 * MiB, W_P = 11 * MiB, W_RH = 11 * MiB + 512 * 1024, W_RL = W_RH + 128 * 1024  , W_C1K = 12 * MiB, W_C1V = W_C1K + 256 * 1024, W_C2K = W_C1V + 256 * 1024, W_C2V = W_C2K + 8192;
constexpr size_t W_UP = 16 * MiB  , W_DN = 82 * MiB  ;
constexpr size_t WS_R = 468 * MiB;
constexpr size_t R_H = 0, R_HMID = 0, R_E = 0, R_YTOK = 320 * MiB, R_XB2 = 440 * MiB;
constexpr size_t WS_END = WS_R + 896 * MiB;
static_assert(Y_FP8 == 1 && R_YTOK + (size_t)T * 9 * 1024 <= 896 * MiB, "ytok");
static_assert(W_DN + 65ull * 1024 * 256 * 2 <= 128 * MiB, "w");
constexpr int CW_BAR = 4096;
constexpr int CW_CNT = 16384;
constexpr int XBW = 3456;

constexpr int RING_BYTES = 131072;
constexpr int LDS_TAB = RING_BYTES;
constexpr int LDS_MISC = RING_BYTES + 20480;
constexpr int LDS_BYTES = RING_BYTES + 20480 + 256;

#define LDS_WAIT() asm volatile("s_waitcnt lgkmcnt(0)" ::: "memory")
#define VM_WAIT() asm volatile("s_waitcnt vmcnt(0)" ::: "memory")
#define RLX_AGENT __ATOMIC_RELAXED, __HIP_MEMORY_SCOPE_AGENT
__device__ __forceinline__ unsigned f2bf(float f) { unsigned u = __builtin_bit_cast(unsigned, f); return (u + 0x7fffu + ((u >> 16) & 1u)) >> 16; }
__device__ __forceinline__ unsigned pk2(float lo, float hi) { return f2bf(lo) | (f2bf(hi) << 16); }
__device__ __forceinline__ float bf2f(unsigned short h) { return __builtin_bit_cast(float, (unsigned)h << 16); }
__device__ __forceinline__ float bflo(unsigned w) { return __builtin_bit_cast(float, w << 16); }
__device__ __forceinline__ float bfhi(unsigned w) { return __builtin_bit_cast(float, w & 0xffff0000u); }
template <int CTRL> __device__ __forceinline__ float dpp_mov(float x) { return __builtin_bit_cast(float, __builtin_amdgcn_update_dpp(0, __builtin_bit_cast(int, x), CTRL, 0xf, 0xf, true)); }
template <int CTRL> __device__ __forceinline__ unsigned dpp_movu(unsigned x) { return (unsigned)__builtin_amdgcn_update_dpp(0, (int)x, CTRL, 0xf, 0xf, true); }
#define DPP_X1 0xB1
#define DPP_X2 0x4E
#define DPP_HM 0x141
#define DPP_RM 0x140
__device__ __forceinline__ float bperm_xor(float x, int lane, int mask) { return __builtin_bit_cast(float, __builtin_amdgcn_ds_bpermute((lane ^ mask) << 2, __builtin_bit_cast(int, x))); }
__device__ __forceinline__ float sum_x32(float x, int lane) { return x + bperm_xor(x, lane, 32); }
__device__ __forceinline__ float max_x32(float x, int lane) { return fmaxf(x, bperm_xor(x, lane, 32)); }
__device__ __forceinline__ float sum_x16(float x, int lane) { return x + bperm_xor(x, lane, 16); }
__device__ __forceinline__ float wave_sum(float v) {
    v += dpp_mov<DPP_X1>(v); v += dpp_mov<DPP_X2>(v); v += dpp_mov<DPP_HM>(v); v += dpp_mov<DPP_RM>(v);
    const float r0 = __builtin_bit_cast(float, __builtin_amdgcn_readlane(__builtin_bit_cast(int, v), 0)), r1 = __builtin_bit_cast(float, __builtin_amdgcn_readlane(__builtin_bit_cast(int, v), 16)),
                r2 = __builtin_bit_cast(float, __builtin_amdgcn_readlane(__builtin_bit_cast(int, v), 32)), r3 = __builtin_bit_cast(float, __builtin_amdgcn_readlane(__builtin_bit_cast(int, v), 48));
    return (r0 + r1) + (r2 + r3);
}
__device__ __forceinline__ int wave_sum_i(int v) {
    v += __builtin_amdgcn_update_dpp(0, v, DPP_X1, 0xf, 0xf, true); v += __builtin_amdgcn_update_dpp(0, v, DPP_X2, 0xf, 0xf, true);
    v += __builtin_amdgcn_update_dpp(0, v, DPP_HM, 0xf, 0xf, true); v += __builtin_amdgcn_update_dpp(0, v, DPP_RM, 0xf, 0xf, true);
    return (__builtin_amdgcn_readlane(v, 0) + __builtin_amdgcn_readlane(v, 16)) + (__builtin_amdgcn_readlane(v, 32) + __builtin_amdgcn_readlane(v, 48));
}
__device__ __forceinline__ float fast_exp2(float x) { return __builtin_amdgcn_exp2f(x); }
__device__ __forceinline__ float sigmoidf_(float x) { return __builtin_amdgcn_rcpf(1.0f + __expf(-x)); }

#define XB_TMO      128
#define XB_XCNT(j)  (256  + 64 * (j))
#define XB_XSUB(j)  (1280 + 64 * (j))
#define XB_XGEN(j)  (2304 + 64 * (j))
#define XB_TOP      3328
#define XB_TOPGEN   3392
#define XCD_BAR_WORDS 3456
#define XB_SPIN_CAP (1u << 22)
__device__ __forceinline__ unsigned xb_ld(unsigned* p)              { return __hip_atomic_load(p, __ATOMIC_RELAXED, __HIP_MEMORY_SCOPE_AGENT); }
__device__ __forceinline__ unsigned xb_add(unsigned* p, unsigned v) { return __hip_atomic_fetch_add(p, v, __ATOMIC_RELAXED, __HIP_MEMORY_SCOPE_AGENT); }
__device__ __forceinline__ unsigned xb_xcc_id() { return (unsigned)__builtin_amdgcn_s_getreg((3 << 11) | 20) & 0xFu; }
#define XB_SPIN(cond, bar) do { unsigned _sp = 0; while (cond) { __builtin_amdgcn_s_sleep(1); \
    if ((++_sp & 255u) == 0u) { if (xb_ld(&(bar)[XB_TMO])) break; if (_sp > XB_SPIN_CAP) { atomicAdd(&(bar)[XB_TMO], 1u); break; } } } } while (0)
struct XcdBarrier { unsigned* bar; unsigned x; volatile LAS unsigned* st; };
__device__ __forceinline__ XcdBarrier xcd_barrier_post(unsigned* bar, volatile LAS unsigned* st) {
    XcdBarrier b; b.bar = bar; b.x = xb_xcc_id(); b.st = st;
    if (threadIdx.x == 0) (void)xb_add(&bar[XB_XCNT(b.x)], 1u);
    return b;
}
__device__ __forceinline__ void xcd_barrier_complete(unsigned* bar, unsigned x, unsigned& nloc, unsigned& nx) {
    const unsigned G = gridDim.x * gridDim.y * gridDim.z;
    unsigned sum, cnt, mine, sp = 0u;
    for (;;) {
        sum = 0u; cnt = 0u; mine = 0u;
#pragma unroll
        for (unsigned j = 0; j < 16; ++j) { const unsigned c = xb_ld(&bar[XB_XCNT(j)]); sum += c; cnt += (c > 0u) ? 1u : 0u; mine = (j == x) ? c : mine; }
        if (sum == G) break;
        __builtin_amdgcn_s_sleep(1);
        if ((++sp & 255u) == 0u) { if (xb_ld(&bar[XB_TMO])) break; if (sp > XB_SPIN_CAP) { atomicAdd(&bar[XB_TMO], 1u); break; } }
    }
    nloc = mine > 0u ? mine : 1u; nx = cnt > 0u ? cnt : 1u;
}
__device__ __forceinline__ void xcd_barrier(const XcdBarrier& b) {
    asm volatile("s_waitcnt vmcnt(0)" ::: "memory");
    __syncthreads();
    if (threadIdx.x == 0) {
        unsigned* bar = b.bar; unsigned bx = b.x; asm volatile("" : "+s"(bx)); asm volatile("" : "+s"(bar));
        __builtin_amdgcn_s_waitcnt(0);
        unsigned nloc = b.st[0], nx = b.st[1];
        if (nloc == 0u) { xcd_barrier_complete(bar, bx, nloc, nx); b.st[0] = nloc; b.st[1] = nx; }
        const unsigned old = xb_add(&bar[XB_XSUB(bx)], 1u);
        const unsigned gen = old / nloc;
        if (old + 1u == (gen + 1u) * nloc) {
            __builtin_amdgcn_fence(__ATOMIC_RELEASE, "agent");
            asm volatile("s_waitcnt vmcnt(0)" ::: "memory");
            const unsigned og = xb_add(&bar[XB_TOP], 1u);
            const unsigned tg = og / nx;
            if (og + 1u == (tg + 1u) * nx) xb_add(&bar[XB_TOPGEN], 1u);
            else XB_SPIN(xb_ld(&bar[XB_TOPGEN]) == tg, bar);
            __builtin_amdgcn_fence(__ATOMIC_ACQUIRE, "agent");
            xb_add(&bar[XB_XGEN(bx)], 1u);
            asm volatile("s_waitcnt vmcnt(0)" ::: "memory");
        } else {
            XB_SPIN(xb_ld(&bar[XB_XGEN(bx)]) == gen, bar);
            __builtin_amdgcn_fence(__ATOMIC_ACQUIRE, "agent");
            asm volatile("s_waitcnt vmcnt(0)" ::: "memory");
        }
    }
    __syncthreads();
}

namespace pg8 {
constexpr int BM = 256, BK = 64, HALF = 128, HTB = HALF * BK * 2, STAGE_BYTES = 8 * HTB, NXCD = 8, WGM = 8;
__host__ __device__ __forceinline__ int lds_byte(int r, int c) { const int st = (r >> 4) * 2 + (c >> 5), rr = r & 15, cc = c & 31, ob = rr * 64 + cc * 2; return st * 1024 + (ob ^ (((ob >> 9) & 1) << 5)); }
__host__ __device__ __forceinline__ void stage_rc(int b, int& R, int& C) { const int st = b / 1024, sb = b % 1024, swz = sb ^ (((sb >> 9) & 1) << 5); R = (st >> 1) * 16 + swz / 64; C = (st & 1) * 32 + (swz % 64) / 2; }
__host__ __device__ __forceinline__ int perm32(int rho) { const int n = rho >> 4, i = rho & 15; return 8 * (i >> 2) + 4 * n + (i & 3); }

struct Unit { int pm, pn, v, rb; };

__device__ __forceinline__ bool static_next(int nM, int nN, int G, int c, int i, Unit& u) {
    const int nwg = nM * nN; const long L = (long)i * G + c; if (L >= nwg) return false;
    int wgid = (int)L; { const int q = nwg / NXCD, r = nwg % NXCD, xcd = wgid % NXCD, off = wgid / NXCD; wgid = (xcd < r ? xcd * (q + 1) : r * (q + 1) + (xcd - r) * q) + off; }
    const int nig = WGM * nN, gid = wgid / nig, fm = gid * WGM, gsz = (nM - fm) < WGM ? (nM - fm) : WGM;
    u.pm = fm + ((wgid % nig) % gsz); u.pn = (wgid % nig) / gsz; u.v = 0; u.rb = 0; return true;
}
struct DenseSched {
    const char* A; const char* Bt; int lda, K, nM, nN, G, c;
    __device__ __forceinline__ bool next(int i, Unit& u) const { return static_next(nM, nN, G, c, i, u); }
    __device__ __forceinline__ bool next_after(int i, const Unit&, Unit& u) const { return next(i, u); }
    __device__ __forceinline__ bool same_rows(const Unit&, const Unit&) const { return false; }
    __device__ __forceinline__ const char* a_base(const Unit& u) const { return A + (size_t)u.pm * 256 * lda * 2; }
    __device__ __forceinline__ const char* b_base(const Unit& u) const { return Bt + (size_t)u.pn * 256 * K * 2; }
    __device__ __forceinline__ void a_off(const Unit&, const int (&R)[2], const int (&C)[2], unsigned (&o)[2][2]) const {
#pragma unroll
        for (int h = 0; h < 2; ++h)
#pragma unroll
            for (int i = 0; i < 2; ++i) o[h][i] = (unsigned)((h * 128 + R[i]) * lda + C[i]) * 2u;
    }
};

__device__ __forceinline__ unsigned cvt_pk_bf16(float lo, float hi) { unsigned r; asm volatile("v_cvt_pk_bf16_f32 %0, %1, %2" : "=v"(r) : "v"(lo), "v"(hi)); return r; }

template <class Epi, class Sched>
__device__ __forceinline__ void gemm_phase(LAS unsigned char* lds, const Sched& S, const Epi& E, int tid) {
    const int wid = __builtin_amdgcn_readfirstlane(tid >> 6), lane = tid & 63, wr = wid >> 2, wc = wid & 3, fr = lane & 15, fq = lane >> 4;
    const int K = S.K, nt = K / BK;
    int RR[2], CC[2]; unsigned voffB[2];
#pragma unroll
    for (int i = 0; i < 2; ++i) { int R, C; stage_rc(tid * 16 + i * 8192, R, C); const int Rb = Epi::PERM ? ((R & ~31) + perm32(R & 31)) : R;
        RR[i] = R; CC[i] = C; voffB[i] = (unsigned)(Rb * K + C) * 2u; }
    const size_t kstep = (size_t)(BK * 2);
    const size_t hstep = (size_t)HALF * K * 2;
    const unsigned ldsw = (unsigned)wid * 1024u;
    const int aoff = lds_byte(wr * 64 + fr, fq * 8), boff = lds_byte(wc * 32 + fr, fq * 8);
#define PG8_SA(b, h) (((b) * 2 + (h)) * HTB)
#define PG8_SB(b, h) ((4 + (b) * 2 + (h)) * HTB)
#define PG8_STAGE(bufoff, gbase, voff) do { _Pragma("unroll") for (int _i = 0; _i < 2; ++_i) \
        __builtin_amdgcn_global_load_lds((const unsigned*)((const char*)(gbase) + (voff)[_i]), (LAS unsigned*)(lds + (bufoff) + ldsw + _i * 8192), 16, 0, 0); } while (0)
#define PG8_LDA(dst, b, h) do { _Pragma("unroll") for (int m = 0; m < 4; ++m) _Pragma("unroll") for (int k = 0; k < 2; ++k) dst[m][k] = *(const LAS bf16x8*)(lds + PG8_SA(b, h) + aoff + m * 2048 + k * 1024); } while (0)
#define PG8_LDB(dst, b, h) do { _Pragma("unroll") for (int n = 0; n < 2; ++n) _Pragma("unroll") for (int k = 0; k < 2; ++k) dst[n][k] = *(const LAS bf16x8*)(lds + PG8_SB(b, h) + boff + n * 2048 + k * 1024); } while (0)
#define PG8_MMA(ai, bj, At, Bt) do { __builtin_amdgcn_s_setprio(1); _Pragma("unroll") for (int m = 0; m < 4; ++m) _Pragma("unroll") for (int n = 0; n < 2; ++n) _Pragma("unroll") for (int k = 0; k < 2; ++k) \
        acc[ai][bj][m][n] = __builtin_amdgcn_mfma_f32_16x16x32_bf16(Bt[n][k], At[m][k], acc[ai][bj][m][n], 0, 0, 0); __builtin_amdgcn_s_setprio(0); } while (0)
#define PG8_WAIT_V(n) asm volatile("s_waitcnt vmcnt(" #n ")" ::: "memory")
#define PG8_WAIT_L(n) asm volatile("s_waitcnt lgkmcnt(" #n ")" ::: "memory")
#define PG8_BAR __builtin_amdgcn_s_barrier()
#define PG8_SCHED __builtin_amdgcn_sched_barrier(0)
    Unit cur, nxt; int ui = 0;
    if (!S.next(0, cur)) return;
    f32x4 acc[2][2][4][2];
    float zz = 0.f; asm volatile("" : "+v"(zz));
#pragma unroll
    for (int a = 0; a < 2; ++a)
#pragma unroll
        for (int b = 0; b < 2; ++b)
#pragma unroll
            for (int m = 0; m < 4; ++m)
#pragma unroll
                for (int n = 0; n < 2; ++n) acc[a][b][m][n] = (f32x4){zz, zz, zz, zz};
    bf16x8 At[4][2], B0[2][2], B1[2][2];
    unsigned oa[2][2], on[2][2];
    S.a_off(cur, RR, CC, oa);
    const char* cA = S.a_base(cur); const char* cB = S.b_base(cur);
    PG8_STAGE(PG8_SB(0, 0), cB, voffB); PG8_STAGE(PG8_SB(0, 1), cB + hstep, voffB); PG8_STAGE(PG8_SA(0, 0), cA, oa[0]); PG8_STAGE(PG8_SA(0, 1), cA, oa[1]);
    if (wr == 1) PG8_BAR;
    PG8_WAIT_V(2); PG8_BAR;
    PG8_STAGE(PG8_SB(1, 0), cB + kstep, voffB); PG8_STAGE(PG8_SA(1, 0), cA + kstep, oa[0]); PG8_STAGE(PG8_SB(1, 1), cB + hstep + kstep, voffB);
    PG8_WAIT_V(6); PG8_BAR;
    for (;;) {
        const bool has_next = S.next_after(ui + 1, cur, nxt);
        const char* nA = has_next ? S.a_base(nxt) : cA; const char* nB = has_next ? S.b_base(nxt) : cB;
        if (has_next && !S.same_rows(cur, nxt)) S.a_off(nxt, RR, CC, on);
        else {
#pragma unroll
            for (int h = 0; h < 2; ++h)
#pragma unroll
                for (int i = 0; i < 2; ++i) on[h][i] = oa[h][i];
        }
        for (int t = 0; t < nt; t += 2) {
            const bool last = (t == nt - 2);
            const char* a1 = cA + (size_t)(t + 1) * kstep;
            const char* a2 = last ? nA : cA + (size_t)(t + 2) * kstep; const char* b2 = last ? nB : cB + (size_t)(t + 2) * kstep;
            const char* a3 = a2 + kstep; const char* b3 = b2 + kstep;
            unsigned x0[2], x1[2];
#pragma unroll
            for (int i = 0; i < 2; ++i) { x0[i] = last ? on[0][i] : oa[0][i]; x1[i] = last ? on[1][i] : oa[1][i]; }
            PG8_LDB(B0, 0, 0); PG8_LDB(B1, 0, 1); PG8_SCHED; PG8_LDA(At, 0, 0); PG8_STAGE(PG8_SA(1, 1), a1, oa[1]);
            PG8_WAIT_V(8); PG8_WAIT_L(0); PG8_BAR; PG8_MMA(0, 0, At, B0); PG8_MMA(0, 1, At, B1); PG8_BAR; PG8_SCHED;
            PG8_LDA(At, 0, 1); PG8_STAGE(PG8_SB(0, 0), b2, voffB); PG8_STAGE(PG8_SB(0, 1), b2 + hstep, voffB); PG8_STAGE(PG8_SA(0, 0), a2, x0);
            PG8_WAIT_V(8); PG8_WAIT_L(0); PG8_BAR; PG8_MMA(1, 0, At, B0); PG8_MMA(1, 1, At, B1); PG8_BAR; PG8_SCHED;
            PG8_LDB(B0, 1, 0); PG8_LDB(B1, 1, 1); PG8_SCHED; PG8_LDA(At, 1, 0); PG8_STAGE(PG8_SA(0, 1), a2, x1);
            PG8_WAIT_V(8); PG8_WAIT_L(0); PG8_BAR; PG8_MMA(0, 0, At, B0); PG8_MMA(0, 1, At, B1); PG8_BAR; PG8_SCHED;
            PG8_LDA(At, 1, 1); PG8_STAGE(PG8_SB(1, 0), b3, voffB); PG8_STAGE(PG8_SB(1, 1), b3 + hstep, voffB); PG8_STAGE(PG8_SA(1, 0), a3, x0);
            PG8_WAIT_V(8); PG8_WAIT_L(0); PG8_BAR; PG8_MMA(1, 0, At, B0); PG8_MMA(1, 1, At, B1); PG8_BAR; PG8_SCHED;
        }
        if (wr == 0) PG8_BAR;
        E(acc, cur, wr, wc, fr, fq);
        if (!has_next) break;
#pragma unroll
        for (int a = 0; a < 2; ++a)
#pragma unroll
            for (int b = 0; b < 2; ++b)
#pragma unroll
                for (int m = 0; m < 4; ++m)
#pragma unroll
                    for (int n = 0; n < 2; ++n) acc[a][b][m][n] = (f32x4){zz, zz, zz, zz};
        cur = nxt; cA = nA; cB = nB; ++ui;
#pragma unroll
        for (int h = 0; h < 2; ++h)
#pragma unroll
            for (int i = 0; i < 2; ++i) oa[h][i] = on[h][i];
        if (wr == 1) PG8_BAR;
    }
    PG8_WAIT_V(0);
    PG8_BAR;
#undef PG8_SA
#undef PG8_SB
#undef PG8_STAGE
#undef PG8_LDA
#undef PG8_LDB
#undef PG8_MMA
#undef PG8_WAIT_V
#undef PG8_WAIT_L
#undef PG8_BAR
#undef PG8_SCHED
}
}

using pg8::Unit;
__device__ __forceinline__ u32x4 pack8(f32x4 a, f32x4 b) { u32x4 w; w.x = pg8::cvt_pk_bf16(a[0], a[1]); w.y = pg8::cvt_pk_bf16(a[2], a[3]); w.z = pg8::cvt_pk_bf16(b[0], b[1]); w.w = pg8::cvt_pk_bf16(b[2], b[3]); return w; }

struct EpiInEven {
    static constexpr bool PERM = true;
    bf16_t* H; const float* cosT; const float* sinT;
    __device__ __forceinline__ void operator()(const f32x4 (&acc)[2][2][4][2], const Unit& u, int wr, int wc, int fr, int fq) const {
        const int row0 = u.pm * 256 + wr * 64 + fr, col0 = u.pn * 256 + wc * 32 + 8 * fq;
        const bool rope = u.pn < 7; const int j0 = (wc & 1) * 16 + 4 * fq;
#pragma unroll
        for (int ai = 0; ai < 2; ++ai) {
            f32x4 cs[4], sn[4];
#pragma unroll
            for (int m = 0; m < 4; ++m) { const int pos = (row0 + ai * 128 + m * 16) & (SEQ - 1);
                cs[m] = (f32x4){1.f, 1.f, 1.f, 1.f}; sn[m] = (f32x4){0.f, 0.f, 0.f, 0.f};
                if (rope) { cs[m] = *(const f32x4*)(cosT + pos * 32 + j0); sn[m] = *(const f32x4*)(sinT + pos * 32 + j0); } }
#pragma unroll
            for (int m = 0; m < 4; ++m) {
                const int row = row0 + ai * 128 + m * 16; const f32x4 c = cs[m], z = sn[m];
                bf16_t* rowp = H + (size_t)row * NE_PAD + col0;
#pragma unroll
                for (int bj = 0; bj < 2; ++bj) {
                    const f32x4 v0 = acc[ai][bj][m][0], v1 = acc[ai][bj][m][1];
                    f32x4 o0, o1;
                    o0[0] = v0[0] * c[0] - v0[1] * z[0]; o0[1] = v0[1] * c[0] + v0[0] * z[0];
                    o0[2] = v0[2] * c[1] - v0[3] * z[1]; o0[3] = v0[3] * c[1] + v0[2] * z[1];
                    o1[0] = v1[0] * c[2] - v1[1] * z[2]; o1[1] = v1[1] * c[2] + v1[0] * z[2];
                    o1[2] = v1[2] * c[3] - v1[3] * z[3]; o1[3] = v1[3] * c[3] + v1[2] * z[3];
                    *(u32x4*)(rowp + bj * 128) = pack8(o0, o1);
                }
            }
        }
    }
};
struct EpiInOdd {
    static constexpr bool PERM = true;
    bf16_t* H; float* logf; const float* bf;
    __device__ __forceinline__ void operator()(const f32x4 (&acc)[2][2][4][2], const Unit& u, int wr, int wc, int fr, int fq) const {
        const int row0 = u.pm * 256 + wr * 64 + fr, col0 = u.pn * 256 + wc * 32 + 8 * fq;
        float zz = 0.f; asm volatile("" : "+v"(zz));
#pragma unroll
        for (int ai = 0; ai < 2; ++ai)
#pragma unroll
            for (int m = 0; m < 4; ++m) {
                const int row = row0 + ai * 128 + m * 16;
                bf16_t* rowp = H + (size_t)row * NO_PAD + col0;
#pragma unroll
                for (int bj = 0; bj < 2; ++bj) *(u32x4*)(rowp + bj * 128) = pack8(acc[ai][bj][m][0] + zz, acc[ai][bj][m][1] + zz);
                if (u.pn == 12 && wc == 0 && fq < 2) {
                    f32x4 r0, r1;
#pragma unroll
                    for (int j = 0; j < 4; ++j) {
                        const float x0 = acc[ai][0][m][0][j] + bf[8 * fq + j], x1 = acc[ai][0][m][1][j] + bf[8 * fq + 4 + j];
                        r0[j] = fminf(x0, 0.f) - log1pf(__expf(-fabsf(x0))); r1[j] = fminf(x1, 0.f) - log1pf(__expf(-fabsf(x1)));
                    }
                    *(f32x4*)(logf + (size_t)row * 16 + 8 * fq) = r0; *(f32x4*)(logf + (size_t)row * 16 + 8 * fq + 4) = r1;
                }
                asm volatile("" ::: "memory");
            }
    }
};
struct EpiOut {
    static constexpr bool PERM = true;
    const bf16_t* X; bf16_t* Y;
    __device__ __forceinline__ void operator()(const f32x4 (&acc)[2][2][4][2], const Unit& u, int wr, int wc, int fr, int fq) const {
        const int row0 = u.pm * 256 + wr * 64 + fr, col0 = u.pn * 256 + wc * 32 + 8 * fq;
#pragma unroll
        for (int ai = 0; ai < 2; ++ai) {
            u32x4 x[4][2];
#pragma unroll
            for (int m = 0; m < 4; ++m) { const size_t off = (size_t)(row0 + ai * 128 + m * 16) * DM + col0;
#pragma unroll
                for (int bj = 0; bj < 2; ++bj) x[m][bj] = *(const u32x4*)(X + off + bj * 128); }
#pragma unroll
            for (int m = 0; m < 4; ++m) { const size_t off = (size_t)(row0 + ai * 128 + m * 16) * DM + col0;
#pragma unroll
                for (int bj = 0; bj < 2; ++bj) { const u32x4 w = x[m][bj]; const f32x4 a0 = acc[ai][bj][m][0], a1 = acc[ai][bj][m][1];
                    const f32x4 o0 = {bflo(w.x) * ALPHA + a0[0], bfhi(w.x) * ALPHA + a0[1], bflo(w.y) * ALPHA + a0[2], bfhi(w.y) * ALPHA + a0[3]};
                    const f32x4 o1 = {bflo(w.z) * ALPHA + a1[0], bfhi(w.z) * ALPHA + a1[1], bflo(w.w) * ALPHA + a1[2], bfhi(w.w) * ALPHA + a1[3]};
                    *(u32x4*)(Y + off + bj * 128) = pack8(o0, o1); } }
        }
    }
};
struct EpiUp {
    static constexpr bool PERM = false;
    bf16_t* Hm;
    __device__ __forceinline__ void operator()(const f32x4 (&acc)[2][2][4][2], const Unit& u, int wr, int wc, int fr, int fq) const {
        const int row0 = u.pm * 256 + wr * 64 + fr, col0 = u.pn * 128 + wc * 16 + 4 * fq;
#pragma unroll
        for (int ai = 0; ai < 2; ++ai)
#pragma unroll
            for (int m = 0; m < 4; ++m) {
                bf16_t* rowp = Hm + (size_t)(row0 + ai * 128 + m * 16) * DFF + col0;
#pragma unroll
                for (int bj = 0; bj < 2; ++bj) {
                    const f32x4 a = acc[ai][bj][m][0], b = acc[ai][bj][m][1]; f32x4 h;
#pragma unroll
                    for (int j = 0; j < 4; ++j) h[j] = a[j] * b[j] * __builtin_amdgcn_rcpf(1.0f + fast_exp2(-a[j] * LOG2E));
                    u32x2 w; w.x = pg8::cvt_pk_bf16(h[0], h[1]); w.y = pg8::cvt_pk_bf16(h[2], h[3]);
                    *(u32x2*)(rowp + bj * 64) = w;
                }
            }
    }
};
struct EpiDown {
    static constexpr bool PERM = true;
    bf16_t* Y; const int* slot_tk; const float* slot_g; const LAS int* cnt; bool dense; LAS int* rc;
    __device__ __forceinline__ void operator()(const f32x4 (&acc)[2][2][4][2], const Unit& u, int wr, int wc, int fr, int fq) const {
        const int e = u.v % 65, half = u.v / 65, n = cnt[u.v];
        const int col0 = u.pn * 256 + wc * 32 + 8 * fq;
        int drow[8]; float gg[8];
        const int tagv = u.v * 4096 + u.rb + 1;
        const bool hit = !dense && (rc[wr] == tagv);
        if (hit) {
#pragma unroll
            for (int i = 0; i < 8; ++i) { const int rl = (i >> 2) * 128 + wr * 64 + (i & 3) * 16 + fr; drow[i] = rc[16 + 2 * rl]; gg[i] = __builtin_bit_cast(float, rc[16 + 2 * rl + 1]); }
        } else {
#pragma unroll
            for (int i = 0; i < 8; ++i) {
                const int pos = u.rb * 256 + (i >> 2) * 128 + wr * 64 + (i & 3) * 16 + fr;
                drow[i] = -1; gg[i] = 1.f;
                if (dense) { drow[i] = (u.pm & 63) * 256 + (i >> 2) * 128 + wr * 64 + (i & 3) * 16 + fr; }
                else if (pos < n) {
                    if (e == 64) drow[i] = (half * HALF_T + pos) * 9 + 8;
                    else { const int tk = slot_tk[(size_t)u.v * HALF_T + pos]; gg[i] = slot_g[(size_t)u.v * HALF_T + pos]; drow[i] = (tk >> 3) * 9 + (tk & 7); }
                }
            }
            if (!dense && wc == 0) {
                if (fq == 0) {
#pragma unroll
                    for (int i = 0; i < 8; ++i) { const int rl = (i >> 2) * 128 + wr * 64 + (i & 3) * 16 + fr; rc[16 + 2 * rl] = drow[i]; rc[16 + 2 * rl + 1] = __builtin_bit_cast(int, gg[i]); } }
                asm volatile("s_waitcnt lgkmcnt(0)" ::: "memory");
                if (fq == 0 && fr == 0) rc[wr] = tagv;
            }
        }
#pragma unroll
        for (int ai = 0; ai < 2; ++ai)
#pragma unroll
            for (int m = 0; m < 4; ++m) {
                const int i = ai * 4 + m;
                if (drow[i] >= 0) {
#if Y_FP8
                    const float g = gg[i] * 32.0f; unsigned char* rowp = (unsigned char*)Y + (size_t)drow[i] * DM + col0;
#pragma unroll
                    for (int bj = 0; bj < 2; ++bj) { f32x4 v0 = acc[ai][bj][m][0] * g, v1 = acc[ai][bj][m][1] * g; u32x2 w;
#pragma unroll
                        for (int q = 0; q < 4; ++q) { v0[q] = __builtin_amdgcn_fmed3f(v0[q], -416.0f, 416.0f); v1[q] = __builtin_amdgcn_fmed3f(v1[q], -416.0f, 416.0f); }
                        w.x = __builtin_amdgcn_cvt_pk_fp8_f32(v0[0], v0[1], 0u, false); w.x = __builtin_amdgcn_cvt_pk_fp8_f32(v0[2], v0[3], w.x, true);
                        w.y = __builtin_amdgcn_cvt_pk_fp8_f32(v1[0], v1[1], 0u, false); w.y = __builtin_amdgcn_cvt_pk_fp8_f32(v1[2], v1[3], w.y, true);
                        *(u32x2*)(rowp + bj * 128) = w; }
#else
                    const float g = gg[i]; bf16_t* rowp = Y + (size_t)drow[i] * DM + col0;
#pragma unroll
                    for (int bj = 0; bj < 2; ++bj) *(u32x4*)(rowp + bj * 128) = pack8(acc[ai][bj][m][0] * g, acc[ai][bj][m][1] * g);
#endif
                }
            }
    }
};
struct EpiPleE {
    static constexpr bool PERM = true;
    bf16_t* E; float* ssq;
    __device__ __forceinline__ void operator()(const f32x4 (&acc)[2][2][4][2], const Unit& u, int wr, int wc, int fr, int fq) const {
        const int row0 = u.pm * 256 + wr * 64 + fr, col0 = u.pn * 256 + wc * 32 + 8 * fq;
        float zz = 0.f; asm volatile("" : "+v"(zz));
#pragma unroll
        for (int ai = 0; ai < 2; ++ai)
#pragma unroll
            for (int m = 0; m < 4; ++m) {
                const int row = row0 + ai * 128 + m * 16;
                bf16_t* rowp = E + (size_t)row * DM + col0; float s = 0.f;
#pragma unroll
                for (int bj = 0; bj < 2; ++bj) {
                    const f32x4 a = acc[ai][bj][m][0] + zz, b = acc[ai][bj][m][1] + zz;
                    s += (a[0] * a[0] + a[1] * a[1]) + (a[2] * a[2] + a[3] * a[3]) + (b[0] * b[0] + b[1] * b[1]) + (b[2] * b[2] + b[3] * b[3]);
                    *(u32x4*)(rowp + bj * 128) = pack8(a, b);
                }
                s = sum_x16(s, fr + 16 * fq); s = sum_x32(s, fr + 16 * fq);
                if (fq == 0) ssq[(size_t)row * 16 + u.pn * 4 + wc] = s;
                asm volatile("" ::: "memory");
            }
    }
};
struct EpiPleG {
    static constexpr bool PERM = true;
    const bf16_t* X; const bf16_t* E; const float* ssq; const float* g; bf16_t* XO; float* OUTF;
    __device__ __forceinline__ void operator()(const f32x4 (&acc)[2][2][4][2], const Unit& u, int wr, int wc, int fr, int fq) const {
        const int row0 = u.pm * 256 + wr * 64 + fr, col0 = u.pn * 256 + wc * 32 + 8 * fq, lane = fr + 16 * fq;
#pragma unroll
        for (int ai = 0; ai < 2; ++ai)
#pragma unroll
            for (int mp = 0; mp < 2; ++mp) {
                u32x4 x[2][2], ew[2][2]; f32x4 sq[2];
#pragma unroll
                for (int mm = 0; mm < 2; ++mm) { const int row = row0 + ai * 128 + (2 * mp + mm) * 16; const size_t off = (size_t)row * DM + col0;
                    sq[mm] = *(const f32x4*)(ssq + (size_t)row * 16 + 4 * fq);
#pragma unroll
                    for (int bj = 0; bj < 2; ++bj) { x[mm][bj] = *(const u32x4*)(X + off + bj * 128); ew[mm][bj] = *(const u32x4*)(E + off + bj * 128); } }
#pragma unroll
                for (int mm = 0; mm < 2; ++mm) { const int m = 2 * mp + mm; const size_t off = (size_t)(row0 + ai * 128 + m * 16) * DM + col0;
                    float t = (sq[mm][0] + sq[mm][1]) + (sq[mm][2] + sq[mm][3]); t = sum_x16(t, lane); t = sum_x32(t, lane); const float r = 1.0f / sqrtf(t * (1.0f / DM) + RMS_EPS);
#pragma unroll
                    for (int bj = 0; bj < 2; ++bj) { const u32x4 xw = x[mm][bj], e = ew[mm][bj]; const f32x4 a0 = acc[ai][bj][m][0], a1 = acc[ai][bj][m][1];
                        const f32x4 g0 = *(const f32x4*)(g + col0 + bj * 128), g1 = *(const f32x4*)(g + col0 + bj * 128 + 4);
                        f32x4 o0, o1;
                        o0[0] = bflo(xw.x) + sigmoidf_(a0[0]) * (bflo(e.x) * r) * g0[0]; o0[1] = bfhi(xw.x) + sigmoidf_(a0[1]) * (bfhi(e.x) * r) * g0[1];
                        o0[2] = bflo(xw.y) + sigmoidf_(a0[2]) * (bflo(e.y) * r) * g0[2]; o0[3] = bfhi(xw.y) + sigmoidf_(a0[3]) * (bfhi(e.y) * r) * g0[3];
                        o1[0] = bflo(xw.z) + sigmoidf_(a1[0]) * (bflo(e.z) * r) * g1[0]; o1[1] = bfhi(xw.z) + sigmoidf_(a1[1]) * (bfhi(e.z) * r) * g1[1];
                        o1[2] = bflo(xw.w) + sigmoidf_(a1[2]) * (bflo(e.w) * r) * g1[2]; o1[3] = bfhi(xw.w) + sigmoidf_(a1[3]) * (bfhi(e.w) * r) * g1[3];
                        if (XO) *(u32x4*)(XO + off + bj * 128) = pack8(o0, o1);
                        if (OUTF) { *(f32x4*)(OUTF + off + bj * 128) = o0; *(f32x4*)(OUTF + off + bj * 128 + 4) = o1; } } }
            }
    }
};

struct MoeSched {
    const char* A; const char* W; int lda, K, npn; size_t wstride;
    const LAS int* rbs; const LAS int* cnt; int vlo, vhi, rb0, nunits, G, c; const int* slot_tk; bool gather; int gxl;
    __device__ __forceinline__ bool next(int i, Unit& u) const {
        const int nrb = nunits / npn;
        if ((G & 7) != 0) { const int r2 = (i / npn) * G + c; if (r2 >= nrb) return false; u.pn = i % npn; return finish(rb0 + r2, u); }
        const int chunk = (nrb + 7) >> 3, gx = gxl, x = c & 7, j = c >> 3;
        if (j >= gx) return false;
        int clen = nrb - x * chunk; clen = clen < 0 ? 0 : (clen > chunk ? chunk : clen);
        const int fr = clen / gx, ifull = fr * npn;
        int li, pn;
        if (i < ifull) { li = j + (i / npn) * gx; pn = i % npn; }
        else { const int q = (i - ifull) * gx + j; if (q >= (clen - fr * gx) * npn) return false;
               li = fr * gx + q / npn; pn = q % npn; }
        u.pn = pn; return finish(rb0 + x * chunk + li, u);
    }
    __device__ __forceinline__ bool next_after(int i, const Unit& prev, Unit& u) const {
        if ((G & 7) != 0 || (npn & (npn - 1)) != 0) return next(i, u);
        if (prev.pn + 1 < npn && (i & (npn - 1)) == prev.pn + 1) {
            if (i < nfull()) { u = prev; u.pn = prev.pn + 1; return true; }
        }
        return next(i, u);
    }
    __device__ __forceinline__ int nfull() const {
        const int nrb = nunits / npn, chunk = (nrb + 7) >> 3, x = c & 7;
        int clen = nrb - x * chunk; clen = clen < 0 ? 0 : (clen > chunk ? chunk : clen);
        return (clen / gxl) * npn;
    }
    __device__ __forceinline__ bool finish(int rbg, Unit& u) const {
        int lo = vlo, hi = vhi;
        while (lo < hi) { const int mid = (lo + hi + 1) >> 1; if (rbs[mid] <= rbg) lo = mid; else hi = mid - 1; }
        u.v = lo; u.rb = rbg - rbs[lo]; u.pm = rbg; return true;
    }
    __device__ __forceinline__ bool same_rows(const Unit& u, const Unit& w) const { return gather && u.v == w.v && u.rb == w.rb; }
    __device__ __forceinline__ const char* a_base(const Unit& u) const { return gather ? A : A + (size_t)u.pm * 256 * lda * 2; }
    __device__ __forceinline__ const char* b_base(const Unit& u) const { return W + (size_t)(u.v % 65) * wstride + (size_t)u.pn * 256 * K * 2; }
    __device__ __forceinline__ void a_off(const Unit& u, const int (&R)[2], const int (&C)[2], unsigned (&o)[2][2]) const {
        if (gather) {
            const int e = u.v % 65, half = u.v / 65, n = cnt[u.v];
#pragma unroll
            for (int h = 0; h < 2; ++h)
#pragma unroll
                for (int i = 0; i < 2; ++i) {
                    const int pos = u.rb * 256 + h * 128 + R[i]; int tok;
                    if (e == 64) tok = half * HALF_T + pos;
                    else tok = pos < n ? (slot_tk[(size_t)u.v * HALF_T + pos] >> 3) : 0;
                    o[h][i] = (unsigned)(tok * lda + C[i]) * 2u;
                    asm volatile("" : "+v"(o[h][i]));
                }
        } else {
#pragma unroll
            for (int h = 0; h < 2; ++h)
#pragma unroll
                for (int i = 0; i < 2; ++i) o[h][i] = (unsigned)((h * 128 + R[i]) * lda + C[i]) * 2u;
        }
    }
};

struct Args {
    const float* in[29]; float* out; unsigned char* ws; int ph_lo, ph_hi;
};
enum InIdx { I_X = 0, I_P, I_EV_WIN, I_EV_BGATE, I_CPK, I_CW1K, I_CW2K, I_CPV, I_CW1V, I_CW2V, I_EV_WO, I_OD_WIN, I_OD_BF, I_OD_WO,
             I_LN1G, I_LN1B, I_LN2G, I_LN2B, I_RW, I_RB, I_EW1, I_EW3, I_EW2, I_SW1, I_SW3, I_SW2, I_PWG, I_PWP, I_PNG };
__device__ __forceinline__ size_t wbuf_off(int layer) { int p = __builtin_amdgcn_readfirstlane(layer & 1); asm volatile("" : "+s"(p)); return (size_t)p * W_BUF; }
struct Frame {
    LAS unsigned char* lds; int tid, lane, wave, G, bid;
    unsigned char* ws; gu32* ctl;
};

__device__ __forceinline__ int rope_perm(int d) { return 2 * (d & 31) + (d >> 5); }
__device__ __forceinline__ int map_even(int c) {
    if (c < 512) return EC_QA + (c & ~63) + rope_perm(c & 63);
    if (c < 576) return EC_KA + rope_perm(c - 512);
    if (c < 640) return EC_VA + (c - 576);
    if (c < 1152) { const int r = c - 640; return EC_QI + (r & ~63) + rope_perm(r & 63); }
    if (c < 1216) return EC_KI + rope_perm(c - 1152);
    if (c < 1224) return EC_WI + (c - 1216);
    if (c < 1736) { const int r = c - 1224; return EC_QB + (r & ~63) + rope_perm(r & 63); }
    if (c < 2120) { const int r = c - 1736, j = r >> 6, d = r & 63;
        switch (j) { case 0: return EC_KC + d; case 1: return EC_VC + d; case 2: return EC_KS + rope_perm(d); case 3: return EC_VS + d; case 4: return EC_KW + rope_perm(d); default: return EC_VW + d; } }
    return EC_GB + (c - 2120);
}
enum MapId { MAP_ID = 0, MAP_EVEN, MAP_W1, MAP_W3, MAP_ROPE };
__device__ __forceinline__ int map_col(int id, int c) {
    switch (id) { case MAP_EVEN: return map_even(c); case MAP_W1: return 32 * (c >> 4) + (c & 15); case MAP_W3: return 32 * (c >> 4) + 16 + (c & 15); case MAP_ROPE: return rope_perm(c); default: return c; }
}
__device__ __forceinline__ void tr_load(f32x4 (&v)[16], const float* src, int ldn, int ncols, int k0, int n0, int lane) {
    const int cq = 4 * (lane & 15), rq = lane >> 4;
    const bool full = (n0 + 64 <= ncols);
#pragma unroll
    for (int i = 0; i < 16; ++i) {
        const float* p = src + (size_t)(k0 + 4 * i + rq) * ldn + n0 + cq;
        if (full) v[i] = *(const f32x4*)p;
        else { v[i][0] = (n0 + cq + 0 < ncols) ? p[0] : 0.f; v[i][1] = (n0 + cq + 1 < ncols) ? p[1] : 0.f; v[i][2] = (n0 + cq + 2 < ncols) ? p[2] : 0.f; v[i][3] = (n0 + cq + 3 < ncols) ? p[3] : 0.f; }
    }
}
__device__ __forceinline__ void tr_finish(const f32x4 (&v)[16], int ncols, bf16_t* dst, int dpitch, int k0, int n0, int mapid, LAS unsigned short* scr, int lane, const float* rscale, bool lo) {
    const int cq = 4 * (lane & 15), rq = lane >> 4;
    if (rscale == nullptr && !lo) {
#pragma unroll
        for (int i = 0; i < 16; ++i) {
#pragma unroll
            for (int j = 0; j < 4; ++j) scr[(cq + j) * 72 + 4 * i + rq] = (unsigned short)f2bf(v[i][j]); }
    } else {
#pragma unroll
        for (int i = 0; i < 16; ++i) {
            const int k = 4 * i + rq; const float rs = rscale ? rscale[k0 + k] : 1.f;
#pragma unroll
            for (int j = 0; j < 4; ++j) { float x = v[i][j] * rs; if (lo) x -= bf2f((unsigned short)f2bf(x));
                scr[(cq + j) * 72 + k] = (unsigned short)f2bf(x); }
        }
    }
    LDS_WAIT(); asm volatile("" ::: "memory");
    const int c = lane & 7;
#pragma unroll
    for (int j = 0; j < 8; ++j) { const int nl = (lane >> 3) + 8 * j, n = n0 + nl;
        const u32x4 o = *(const LAS u32x4*)(scr + nl * 72 + 8 * c);
        if (n < ncols) *(u32x4*)(dst + (size_t)map_col(mapid, n) * dpitch + k0 + 8 * c) = o; }
    LDS_WAIT(); asm volatile("" ::: "memory");
}
__device__ __forceinline__ void tr_item(const float* src, int ldn, int ncols, bf16_t* dst, int dpitch, int k0, int n0, int mapid, LAS unsigned short* scr, int lane, const float* rscale = nullptr, bool lo = false) {
    f32x4 v[16]; tr_load(v, src, ldn, ncols, k0, n0, lane); tr_finish(v, ncols, dst, dpitch, k0, n0, mapid, scr, lane, rscale, lo);
}
__device__ __forceinline__ void sincos_d(double a, float& s, float& c) {
    const double TWO_PI = 6.283185307179586476925286766559, INV = 0.15915494309189533576888376337251;
    const double k = rint(a * INV); double r = a - k * TWO_PI;
    const double r2 = r * r; double ts = 1.0, tc = 1.0;
#pragma unroll
    for (int i = 14; i >= 1; --i) { ts = 1.0 - ts * r2 / (double)((2 * i) * (2 * i + 1)); tc = 1.0 - tc * r2 / (double)((2 * i - 1) * (2 * i)); }
    s = (float)(r * ts); c = (float)tc;
}

struct TrJob { const float* src; bf16_t* dst; int K, N, ldn, dpitch, mapid; const float* rscale; int lo; };
__device__ __forceinline__ TrJob get_job(const Args& a, unsigned char* wsp, int layer, int jid) {
    const int j = layer >> 1; const bool even = (layer & 1) == 0;
    bf16_t* W = (bf16_t*)(wsp + WS_W + wbuf_off(layer));
    TrJob t; t.mapid = MAP_ID; t.rscale = nullptr; t.lo = 0;
    if (jid == 0) { if (even) { t.src = a.in[I_EV_WIN] + (size_t)j * DM * EVEN_COLS; t.N = EVEN_COLS; t.mapid = MAP_EVEN; } else { t.src = a.in[I_OD_WIN] + (size_t)j * DM * ODD_COLS; t.N = ODD_COLS; }
        t.K = DM; t.ldn = t.N; t.dst = W + W_IN / 2; t.dpitch = DM; return t; }
    if (jid == 1) { t.src = (even ? a.in[I_EV_WO] : a.in[I_OD_WO]) + (size_t)j * DM * DM; t.K = DM; t.N = DM; t.ldn = DM; t.dst = W + W_O / 2; t.dpitch = DM; return t; }
    if (jid == 2) { t.src = a.in[I_PWG] + (size_t)layer * DM * DM; t.K = DM; t.N = DM; t.ldn = DM; t.dst = W + W_G / 2; t.dpitch = DM; return t; }
    if (jid == 3) { t.src = a.in[I_PWP] + (size_t)layer * 256 * DM; t.K = 256; t.N = DM; t.ldn = DM; t.dst = W + W_P / 2; t.dpitch = 256; return t; }
    if (jid < 8) {
        const int q = jid - 4;
        if (q == 0) { t.src = a.in[I_CW1K] + (size_t)j * 2048 * 64; t.K = 2048; t.dst = W + W_C1K / 2; t.dpitch = 2048; }
        else if (q == 1) { t.src = a.in[I_CW1V] + (size_t)j * 2048 * 64; t.K = 2048; t.dst = W + W_C1V / 2; t.dpitch = 2048; }
        else if (q == 2) { t.src = a.in[I_CW2K] + (size_t)j * 64 * 64; t.K = 64; t.dst = W + W_C2K / 2; t.dpitch = 64; t.mapid = MAP_ROPE; }
        else { t.src = a.in[I_CW2V] + (size_t)j * 64 * 64; t.K = 64; t.dst = W + W_C2V / 2; t.dpitch = 64; }
        t.N = 64; t.ldn = 64; return t; }
    if (jid < 10) {
        t.src = a.in[I_RW] + (size_t)layer * DM * NEXP; t.K = DM; t.N = NEXP; t.ldn = NEXP; t.dpitch = DM; t.rscale = a.in[I_LN1G] + layer * DM; t.lo = jid - 8; t.dst = W + (t.lo ? W_RL : W_RH) / 2; return t; }
    const int r = jid - 10, e = r / 3, w = r % 3;
    if (w < 2) { const float* s = (e == 64) ? a.in[w == 0 ? I_SW1 : I_SW3] + (size_t)layer * DM * DFF : a.in[w == 0 ? I_EW1 : I_EW3] + ((size_t)layer * NEXP + e) * DM * DFF;
        t.src = s; t.K = DM; t.N = DFF; t.ldn = DFF; t.dst = W + W_UP / 2 + (size_t)e * 512 * DM; t.dpitch = DM; t.mapid = (w == 0) ? MAP_W1 : MAP_W3; return t; }
    t.src = (e == 64) ? a.in[I_SW2] + (size_t)layer * DFF * DM : a.in[I_EW2] + ((size_t)layer * NEXP + e) * DFF * DM;
    t.K = DFF; t.N = DM; t.ldn = DM; t.dst = W + W_DN / 2 + (size_t)e * DM * DFF; t.dpitch = DFF; return t;
}
constexpr int NJOBS = 10 + 65 * 3;

__device__ __forceinline__ void prep_weights(const Frame& F, const Args& a, int layer, int wid, int nw) {
    const int gw = wid * 8 + F.wave, NGW = nw * 8, gt = wid * 512 + F.tid, NGT = nw * 512;
    LAS unsigned short* scr = (LAS unsigned short*)(F.lds + F.wave * 16384);
    int base = 0;
    for (int jid = 0; jid < 10; ++jid) {
        const TrJob jb = get_job(a, F.ws, layer, jid);
        const int nblk = (jb.N + 63) / 64, nit = (jb.K / 64) * nblk;
        int first = (gw - (base % NGW) + NGW) % NGW;
        for (int it = first; it < nit; it += 2 * NGW) {
            const int it2 = it + NGW; const bool two = it2 < nit;
            f32x4 va[16], vb[16];
            tr_load(va, jb.src, jb.ldn, jb.N, 64 * (it / nblk), 64 * (it % nblk), F.lane);
            if (two) tr_load(vb, jb.src, jb.ldn, jb.N, 64 * (it2 / nblk), 64 * (it2 % nblk), F.lane);
            tr_finish(va, jb.N, jb.dst, jb.dpitch, 64 * (it / nblk), 64 * (it % nblk), jb.mapid, scr, F.lane, jb.rscale, jb.lo != 0);
            if (two) tr_finish(vb, jb.N, jb.dst, jb.dpitch, 64 * (it2 / nblk), 64 * (it2 % nblk), jb.mapid, scr, F.lane, jb.rscale, jb.lo != 0);
        }
        base += nit;
    }
    {
        constexpr int NI = 65 * 3 * 64;
        int g = (gw - (base % NGW) + NGW) % NGW;
        f32x4 va[16], vb[16]; TrJob ja, jn;
#define EXP_LOAD(V, J, G) do { J = get_job(a, F.ws, layer, 10 + ((G) >> 6)); const int it_ = (G) & 63, sh_ = (J.N == 256) ? 2 : 4; tr_load(V, J.src, J.ldn, J.N, 64 * (it_ >> sh_), 64 * (it_ & ((1 << sh_) - 1)), F.lane); } while (0)
#define EXP_FIN(V, J, G) do { const int it_ = (G) & 63, sh_ = (J.N == 256) ? 2 : 4; tr_finish(V, J.N, J.dst, J.dpitch, 64 * (it_ >> sh_), 64 * (it_ & ((1 << sh_) - 1)), J.mapid, scr, F.lane, nullptr, false); } while (0)
        if (g < NI) EXP_LOAD(va, ja, g);
        while (g < NI) {
            const int g1 = g + NGW, g2 = g + 2 * NGW;
            if (g1 < NI) EXP_LOAD(vb, jn, g1);
            EXP_FIN(va, ja, g);
            if (g1 >= NI) break;
            if (g2 < NI) EXP_LOAD(va, ja, g2);
            EXP_FIN(vb, jn, g1);
            g = g2;
        }
#undef EXP_LOAD
#undef EXP_FIN
    }
    { const int r0 = (layer & 1) ? ODD_COLS : EVEN_COLS, r1 = (layer & 1) ? NO_PAD : NE_PAD; u32x4* z = (u32x4*)(F.ws + WS_W + wbuf_off(layer) + W_IN + (size_t)r0 * DM * 2);
      const int n16 = (r1 - r0) * DM * 2 / 16; unsigned zq = 0u; asm volatile("" : "+v"(zq)); for (int i = gt; i < n16; i += NGT) z[i] = (u32x4){zq, zq, zq, zq}; }
    if ((layer & 1) == 0 && wid < 2) {
        const int j = layer >> 1; const float* pe = a.in[wid == 0 ? I_CPK : I_CPV] + (size_t)j * 2048; const float* w1 = a.in[wid == 0 ? I_CW1K : I_CW1V] + (size_t)j * 2048 * 64;
        LAS float* red = (LAS float*)(F.lds + 8 * 16384);
        __syncthreads();
        const int n = F.tid & 63, part = F.tid >> 6; float s = 0.f;
        for (int k0 = part * 256; k0 < part * 256 + 256; k0 += 32) {
            float wv[32], pv[32];
#pragma unroll
            for (int q = 0; q < 32; ++q) { wv[q] = w1[(size_t)(k0 + q) * 64 + n]; pv[q] = pe[k0 + q]; }
#pragma unroll
            for (int q = 0; q < 32; ++q) s += pv[q] * wv[q]; }
        red[part * 64 + n] = s; __syncthreads();
        if (F.tid < 64) { float tot = 0.f; for (int q = 0; q < 8; ++q) tot += red[q * 64 + F.tid]; ((float*)(F.ws + WS_MISC))[wid * 64 + F.tid] = tot; }
        __syncthreads();
    }
}
__device__ __forceinline__ void prep_acts(const Frame& F, const Args& a, int layer, bool first) {
    const int gt = F.bid * 512 + F.tid, NGT = F.G * 512;
    { const f32x4* p = (const f32x4*)(a.in[I_P] + (size_t)layer * T * 256); u32x2* o = (u32x2*)(F.ws + WS_PB);
      for (int i = gt; i < T * 256 / 4; i += NGT) { const f32x4 v = p[i]; u32x2 w; w.x = pk2(v[0], v[1]); w.y = pk2(v[2], v[3]); o[i] = w; } }
    if (first) {
        const f32x4* x = (const f32x4*)a.in[I_X]; u32x2* o = (u32x2*)(F.ws + WS_XB);
        for (int i = gt; i < T * DM / 4; i += NGT) { const f32x4 v = x[i]; u32x2 w; w.x = pk2(v[0], v[1]); w.y = pk2(v[2], v[3]); o[i] = w; }
        float* ct = (float*)(F.ws + WS_ROPE_COS); float* st = (float*)(F.ws + WS_ROPE_SIN);
        for (int i = gt; i < SEQ * 32; i += NGT) { const int pos = i >> 5, j = i & 31; double inv = 1.0;
            for (int q = 0; q < j; ++q) inv *= 0.74989420933245582730;
            const float ang = (float)pos * (float)inv; float s, c; sincos_d((double)ang, s, c); ct[i] = c; st[i] = s; }
    }
    if (F.bid == F.G - 1) {
        const float* RW = a.in[I_RW] + (size_t)layer * DM * NEXP; const float* g1 = a.in[I_LN1G] + layer * DM; const float* b1 = a.in[I_LN1B] + layer * DM;
        LAS float* red = (LAS float*)(F.lds + 8 * 16384);
        __syncthreads();
        const int n = F.tid & 63, part = F.tid >> 6; float sc = 0.f, sb = 0.f;
        for (int k0 = part * 128; k0 < part * 128 + 128; k0 += 32) {
            float wv[32];
#pragma unroll
            for (int q = 0; q < 32; ++q) wv[q] = RW[(size_t)(k0 + q) * NEXP + n];
#pragma unroll
            for (int q = 0; q < 32; ++q) { sc += g1[k0 + q] * wv[q]; sb += b1[k0 + q] * wv[q]; } }
        red[part * 64 + n] = sc; red[512 + part * 64 + n] = sb; __syncthreads();
        if (F.tid < 128) { const int o = F.tid & 63, w = F.tid >> 6; float tot = 0.f; for (int q = 0; q < 8; ++q) tot += red[w * 512 + q * 64 + o]; ((float*)(F.ws + WS_MISC))[256 + F.tid] = tot; }
        __syncthreads();
    }
}

__device__ __forceinline__ void scan_phase(const Frame& F, const Args& a) {
    const float* lf = (const float*)(F.ws + WS_LOGF); float* dc = (float*)(F.ws + WS_DCUM);
    LAS float* wsum = (LAS float*)F.lds;
    for (int s = F.bid; s < NB * 16; s += F.G) {
        const int b = s >> 4, h = s & 15; const size_t base = ((size_t)b * SEQ) * 16 + h;
        float v[4]; float run = 0.f;
#pragma unroll
        for (int i = 0; i < 4; ++i) { run += lf[base + (size_t)(F.tid * 4 + i) * 16]; v[i] = run; }
        float inc = run;
        inc += dpp_mov<0x111>(inc); inc += dpp_mov<0x112>(inc); inc += dpp_mov<0x114>(inc); inc += dpp_mov<0x118>(inc);
        { const float r0 = __builtin_bit_cast(float, __builtin_amdgcn_readlane(__builtin_bit_cast(int, inc), 15)), r1 = __builtin_bit_cast(float, __builtin_amdgcn_readlane(__builtin_bit_cast(int, inc), 31)),
                      r2 = __builtin_bit_cast(float, __builtin_amdgcn_readlane(__builtin_bit_cast(int, inc), 47));
          const int rw = F.lane >> 4; inc += (rw == 1) ? r0 : (rw == 2) ? (r0 + r1) : (rw == 3) ? ((r0 + r1) + r2) : 0.f; }
        if (F.lane == 63) wsum[F.wave] = inc;
        __syncthreads();
        float off = inc - run;
        for (int w = 0; w < F.wave; ++w) off += wsum[w];
#pragma unroll
        for (int i = 0; i < 4; ++i) dc[base + (size_t)(F.tid * 4 + i) * 16] = (v[i] + off) * LOG2E;
        __syncthreads();
    }
}

__device__ __forceinline__ void ln_row16(float (&v)[16], const float* g, const float* b, int lane) {
    float s = 0.f;
#pragma unroll
    for (int i = 0; i < 16; ++i) s += v[i];
    const float mean = wave_sum(s) * (1.f / DM); float s2 = 0.f;
#pragma unroll
    for (int i = 0; i < 16; ++i) { v[i] -= mean; s2 += v[i] * v[i]; }
    const float rstd = 1.0f / sqrtf(wave_sum(s2) * (1.f / DM) + LN_EPS);
#pragma unroll
    for (int q = 0; q < 4; ++q) { const f32x4 gg = *(const f32x4*)(g + lane * 16 + 4 * q), bb = *(const f32x4*)(b + lane * 16 + 4 * q);
#pragma unroll
        for (int i = 0; i < 4; ++i) v[4 * q + i] = v[4 * q + i] * rstd * gg[i] + bb[i]; }
}
__device__ __forceinline__ void ln_stats16(const float (&v)[16], float& mean, float& rstd) {
    float s = 0.f;
#pragma unroll
    for (int i = 0; i < 16; ++i) s += v[i];
    mean = wave_sum(s) * (1.f / DM); float s2 = 0.f;
#pragma unroll
    for (int i = 0; i < 16; ++i) { const float d = v[i] - mean; s2 += d * d; }
    rstd = 1.0f / sqrtf(wave_sum(s2) * (1.f / DM) + LN_EPS);
}
__device__ __forceinline__ void ln_apply16(float (&v)[16], float mean, float rstd, const float* g, const float* b, int lane) {
#pragma unroll
    for (int q = 0; q < 4; ++q) { const f32x4 gg = *(const f32x4*)(g + lane * 16 + 4 * q), bb = *(const f32x4*)(b + lane * 16 + 4 * q);
#pragma unroll
        for (int i = 0; i < 4; ++i) v[4 * q + i] = (v[4 * q + i] - mean) * rstd * gg[i] + bb[i]; }
}
__device__ __forceinline__ void store_row16_bf(const float (&v)[16], bf16_t* xb, int lane) {
    u32x4 w0, w1; w0.x = pk2(v[0], v[1]); w0.y = pk2(v[2], v[3]); w0.z = pk2(v[4], v[5]); w0.w = pk2(v[6], v[7]);
    w1.x = pk2(v[8], v[9]); w1.y = pk2(v[10], v[11]); w1.z = pk2(v[12], v[13]); w1.w = pk2(v[14], v[15]);
    *(u32x4*)(xb + lane * 16) = w0; *(u32x4*)(xb + lane * 16 + 8) = w1;
}
__device__ __forceinline__ void store_row16(const float (&v)[16], float* xf, bf16_t* xb, int lane) {
#pragma unroll
    for (int q = 0; q < 4; ++q) *(f32x4*)(xf + lane * 16 + 4 * q) = (f32x4){v[4 * q], v[4 * q + 1], v[4 * q + 2], v[4 * q + 3]};
    u32x4 w0, w1; w0.x = pk2(v[0], v[1]); w0.y = pk2(v[2], v[3]); w0.z = pk2(v[4], v[5]); w0.w = pk2(v[6], v[7]);
    w1.x = pk2(v[8], v[9]); w1.y = pk2(v[10], v[11]); w1.z = pk2(v[12], v[13]); w1.w = pk2(v[14], v[15]);
    *(u32x4*)(xb + lane * 16) = w0; *(u32x4*)(xb + lane * 16 + 8) = w1;
}

#ifndef ROUTE_EXPT
#define ROUTE_EXPT 0
#endif
__device__ __forceinline__ void unpack16(const u32x4 w0, const u32x4 w1, float (&v)[16]) {
    v[0] = bflo(w0.x); v[1] = bfhi(w0.x); v[2] = bflo(w0.y); v[3] = bfhi(w0.y); v[4] = bflo(w0.z); v[5] = bfhi(w0.z); v[6] = bflo(w0.w); v[7] = bfhi(w0.w);
    v[8] = bflo(w1.x); v[9] = bfhi(w1.x); v[10] = bflo(w1.y); v[11] = bfhi(w1.y); v[12] = bflo(w1.z); v[13] = bfhi(w1.z); v[14] = bflo(w1.w); v[15] = bfhi(w1.w);
}
__device__ __forceinline__ void route_phase(const Frame& F, const Args& a, int layer, const bf16_t* X, bf16_t* XB, bool dummy) {
    const float* g = a.in[I_LN1G] + layer * DM; const float* bta = a.in[I_LN1B] + layer * DM;
    const float* RW = a.in[I_RW] + (size_t)layer * DM * NEXP; const float* RBs = a.in[I_RB] + layer * NEXP;
    int* slot_tk = (int*)(F.ws + WS_SLOT_TK); float* slot_g = (float*)(F.ws + WS_SLOT_G);
    gu32* cntg = F.ctl + CW_CNT + layer * 256;
    LAS float* lg = (LAS float*)(F.lds + F.wave * 8192);
    LAS unsigned* rec_e = (LAS unsigned*)(F.lds + 65536);
    LAS float* rec_g = (LAS float*)(F.lds + 65536 + 8192);
    LAS unsigned* lcnt = (LAS unsigned*)(F.lds + 65536 + 16384);
    LAS unsigned* gbase = lcnt + 64;
    const int lane = F.lane;
    for (int ub = F.bid; ub < T / 256; ub += F.G) {
        if (F.tid < 64) lcnt[F.tid] = 0u;
        __syncthreads();
        const int r0 = ub * 256 + F.wave * 32;
        LAS float* stl = (LAS float*)(F.lds + 65536 + 16384 + 512) + F.wave * 64;
        for (int r4 = 0; r4 < 32; r4 += 8) {
            u32x4 v4[8][2];
#pragma unroll
            for (int j = 0; j < 8; ++j) { const bf16_t* xr = X + (size_t)(r0 + r4 + j) * DM + lane * 16; v4[j][0] = *(const u32x4*)xr; v4[j][1] = *(const u32x4*)(xr + 8); }
#pragma unroll
            for (int j = 0; j < 8; ++j) { float v[16]; unpack16(v4[j][0], v4[j][1], v);
                float mean, rstd; ln_stats16(v, mean, rstd);
                if (lane == 0) { stl[2 * (r4 + j)] = mean; stl[2 * (r4 + j) + 1] = rstd; }
                ln_apply16(v, mean, rstd, g, bta, lane); store_row16_bf(v, XB + (size_t)(r0 + r4 + j) * DM, lane); }
        }
        LDS_WAIT(); asm volatile("" ::: "memory");
        f32x16 c0 = {}, c1 = {};
        { const bf16_t* ar = X + (size_t)(r0 + (lane & 31)) * DM + (lane >> 5) * 8;
          const bf16_t* Wh = (const bf16_t*)(F.ws + WS_W + wbuf_off(layer) + W_RH); const bf16_t* Wl = (const bf16_t*)(F.ws + WS_W + wbuf_off(layer) + W_RL);
          const int se = F.tid >> 3, sg8 = (F.tid & 7) * 16;
          u32x4 bh[2], bl[2];
          bh[0] = *(const u32x4*)(Wh + (size_t)se * DM + sg8); bh[1] = *(const u32x4*)(Wh + (size_t)se * DM + sg8 + 8); bl[0] = *(const u32x4*)(Wl + (size_t)se * DM + sg8); bl[1] = *(const u32x4*)(Wl + (size_t)se * DM + sg8 + 8);
          for (int c = 0; c < ((ROUTE_EXPT == 1 && dummy) ? 0 : 8); ++c) {
              LAS unsigned char* Bs = F.lds + (c & 1) * 34816;
              *(LAS u32x4*)(Bs + se * 272 + sg8 * 2) = bh[0]; *(LAS u32x4*)(Bs + se * 272 + sg8 * 2 + 16) = bh[1];
              *(LAS u32x4*)(Bs + 17408 + se * 272 + sg8 * 2) = bl[0]; *(LAS u32x4*)(Bs + 17408 + se * 272 + sg8 * 2 + 16) = bl[1];
              bf16x8 af[8];
#pragma unroll
              for (int st = 0; st < 8; ++st) af[st] = *(const bf16x8*)(ar + c * 128 + st * 16);
              __syncthreads();
              if (c + 1 < 8) { const size_t o = (size_t)se * DM + (c + 1) * 128 + sg8;
                  bh[0] = *(const u32x4*)(Wh + o); bh[1] = *(const u32x4*)(Wh + o + 8); bl[0] = *(const u32x4*)(Wl + o); bl[1] = *(const u32x4*)(Wl + o + 8); }
              const LAS unsigned char* bp = Bs + (lane & 31) * 272 + (lane >> 5) * 16;
#pragma unroll
              for (int st = 0; st < 8; ++st) {
                  const bf16x8 h0 = *(const LAS bf16x8*)(bp + st * 32), h1 = *(const LAS bf16x8*)(bp + 32 * 272 + st * 32);
                  const bf16x8 l0 = *(const LAS bf16x8*)(bp + 17408 + st * 32), l1 = *(const LAS bf16x8*)(bp + 17408 + 32 * 272 + st * 32);
                  c0 = __builtin_amdgcn_mfma_f32_32x32x16_bf16(af[st], h0, c0, 0, 0, 0); c1 = __builtin_amdgcn_mfma_f32_32x32x16_bf16(af[st], h1, c1, 0, 0, 0);
                  c0 = __builtin_amdgcn_mfma_f32_32x32x16_bf16(af[st], l0, c0, 0, 0, 0); c1 = __builtin_amdgcn_mfma_f32_32x32x16_bf16(af[st], l1, c1, 0, 0, 0);
              }
          }
        }
        __syncthreads();
#pragma unroll
        for (int rr = 0; rr < 16; ++rr) { const int row = (rr & 3) + 8 * (rr >> 2) + 4 * (lane >> 5); lg[row * 64 + (lane & 31)] = c0[rr]; lg[row * 64 + 32 + (lane & 31)] = c1[rr]; }
        LDS_WAIT(); asm volatile("" ::: "memory");
        const float rcs = ((const float*)(F.ws + WS_MISC))[256 + lane], rb1 = ((const float*)(F.ws + WS_MISC))[256 + 64 + lane];
        const float rbias = RBs[lane];
        for (int r = 0; r < ((ROUTE_EXPT == 2 && dummy) ? 0 : 32); ++r) {
            const float sg = sigmoidf_(stl[2 * r + 1] * (lg[r * 64 + lane] - stl[2 * r] * rcs) + rb1); const float sb = sg + rbias;
            float m1 = sb;
            m1 = fmaxf(m1, dpp_mov<DPP_X1>(m1)); m1 = fmaxf(m1, dpp_mov<DPP_X2>(m1)); m1 = fmaxf(m1, dpp_mov<DPP_HM>(m1));
            const unsigned long long eqm = __ballot(sb == m1); const int gsh = lane & ~7;
            const unsigned gm = (unsigned)(eqm >> gsh) & 0xffu; const int first = __builtin_ctz(gm);
            float m2 = ((lane & 7) == first) ? NEGBIG : sb;
            m2 = fmaxf(m2, dpp_mov<DPP_X1>(m2)); m2 = fmaxf(m2, dpp_mov<DPP_X2>(m2)); m2 = fmaxf(m2, dpp_mov<DPP_HM>(m2));
            const float gs = m1 + m2;
            int grank = 0;
#pragma unroll
            for (int q = 0; q < 8; ++q) { const float o = __builtin_bit_cast(float, __builtin_amdgcn_readlane(__builtin_bit_cast(int, gs), q * 8)); grank += (o > gs || (o == gs && q < (lane >> 3))) ? 1 : 0; }
            const float sm = (grank < 4) ? sb : NEGBIG;
            int rank = 0;
#pragma unroll
            for (int q = 0; q < 64; ++q) { const float o = __builtin_bit_cast(float, __builtin_amdgcn_readlane(__builtin_bit_cast(int, sm), q)); rank += (o > sm) ? 1 : 0; }
            bool tie = false;
#pragma unroll
            for (int k = 0; k < 8; ++k) tie |= (__popcll(__ballot(rank == k)) != 1);
            if (tie) { rank = 0;
#pragma unroll 1
                for (int q = 0; q < 64; ++q) { const float o = __builtin_bit_cast(float, __builtin_amdgcn_readlane(__builtin_bit_cast(int, sm), q)); rank += (o > sm || (o == sm && q < lane)) ? 1 : 0; } }
            const bool sel = rank < 8;
            const float ssum = wave_sum(sel ? sg : 0.f);
            if (sel) { const unsigned lp = __hip_atomic_fetch_add(&lcnt[lane], 1u, __ATOMIC_RELAXED, __HIP_MEMORY_SCOPE_WORKGROUP); const int row = F.wave * 32 + r; rec_e[row * 8 + rank] = (unsigned)lane | (lp << 8); rec_g[row * 8 + rank] = sg / ssum * 2.5f; }
        }
        __syncthreads();
        const int half = (ub * 256) / HALF_T;
        if (F.tid < 64) gbase[F.tid] = dummy ? 0u : __hip_atomic_fetch_add(cntg + half * 65 + F.tid, lcnt[F.tid], RLX_AGENT);
        __syncthreads();
        for (int i = F.tid; i < 2048; i += 512) { const unsigned re = rec_e[i]; const int e = re & 255, lp = re >> 8, v = half * 65 + e; const int pos = gbase[e] + lp;
            const int t = ub * 256 + (i >> 3);
            if (!dummy) { slot_tk[(size_t)v * HALF_T + pos] = t * 8 + (i & 7); slot_g[(size_t)v * HALF_T + pos] = rec_g[i]; } }
        __syncthreads();
    }
}

__device__ __forceinline__ void combine_phase(const Frame& F, const Args& a, int layer, int half, const bf16_t* X1, bf16_t* X2, bool dummy) {
    const bf16_t* Y = (const bf16_t*)(F.ws + WS_R + R_YTOK);
    const float* g = a.in[I_LN2G] + layer * DM; const float* bta = a.in[I_LN2B] + layer * DM;
    const int lane = F.lane;
    for (int tl = F.bid * 8 + F.wave; tl < HALF_T; tl += F.G * 8) {
        const int t = half * HALF_T + tl; float v[16];
        { const bf16_t* xr = X1 + (size_t)t * DM + lane * 16; unpack16(*(const u32x4*)xr, *(const u32x4*)(xr + 8), v); }
#pragma unroll
        for (int i = 0; i < 16; ++i) v[i] *= ALPHA;
        float m[16];
#pragma unroll
        for (int i = 0; i < 16; ++i) m[i] = 0.f;
#pragma unroll
#if Y_FP8
        for (int k = 0; k < 9; ++k) { const u32x4 w = *(const u32x4*)((const unsigned char*)Y + ((size_t)t * 9 + k) * DM + lane * 16);
            m[0] += __builtin_amdgcn_cvt_f32_fp8(w.x, 0); m[1] += __builtin_amdgcn_cvt_f32_fp8(w.x, 1); m[2] += __builtin_amdgcn_cvt_f32_fp8(w.x, 2); m[3] += __builtin_amdgcn_cvt_f32_fp8(w.x, 3);
            m[4] += __builtin_amdgcn_cvt_f32_fp8(w.y, 0); m[5] += __builtin_amdgcn_cvt_f32_fp8(w.y, 1); m[6] += __builtin_amdgcn_cvt_f32_fp8(w.y, 2); m[7] += __builtin_amdgcn_cvt_f32_fp8(w.y, 3);
            m[8] += __builtin_amdgcn_cvt_f32_fp8(w.z, 0); m[9] += __builtin_amdgcn_cvt_f32_fp8(w.z, 1); m[10] += __builtin_amdgcn_cvt_f32_fp8(w.z, 2); m[11] += __builtin_amdgcn_cvt_f32_fp8(w.z, 3);
            m[12] += __builtin_amdgcn_cvt_f32_fp8(w.w, 0); m[13] += __builtin_amdgcn_cvt_f32_fp8(w.w, 1); m[14] += __builtin_amdgcn_cvt_f32_fp8(w.w, 2); m[15] += __builtin_amdgcn_cvt_f32_fp8(w.w, 3); }
#pragma unroll
        for (int i = 0; i < 16; ++i) m[i] *= (1.0f / 32.0f);
#else
        for (int k = 0; k < 9; ++k) { const bf16_t* yr = Y + ((size_t)tl * 9 + k) * DM + lane * 16; float yv[16]; unpack16(*(const u32x4*)yr, *(const u32x4*)(yr + 8), yv);
#pragma unroll
            for (int i = 0; i < 16; ++i) m[i] += yv[i]; }
#endif
#pragma unroll
        for (int i = 0; i < 16; ++i) v[i] += m[i];
        ln_row16(v, g, bta, lane);
        if (!dummy) store_row16_bf(v, X2 + (size_t)t * DM, lane);
    }
}

constexpr int KP = 144, VP = 192;
constexpr int KT_BYTES = 64 * KP, VT_BYTES = 64 * VP, KV_BUF = KT_BYTES + VT_BYTES;
__device__ __forceinline__ int crow(int r, int hi) { return (r & 3) + 8 * (r >> 2) + 4 * hi; }
__device__ __forceinline__ s16x4 vtr(const LAS unsigned char* p) { return __builtin_bit_cast(s16x4, __builtin_amdgcn_ds_read_tr16_b64_v4i16((LAS s16x4*)p)); }

struct KVRegs { u32x4 k, v; };
__device__ __forceinline__ void kv_load(KVRegs& r, const bf16_t* Kp, const bf16_t* Vp, size_t pitch, int row0, int tid) {
    const size_t off = (size_t)(row0 + (tid >> 3)) * pitch + (tid & 7) * 8;
    r.k = *(const u32x4*)(Kp + off); r.v = *(const u32x4*)(Vp + off);
}
__device__ __forceinline__ void kv_store(const KVRegs& r, LAS unsigned char* buf, int tid) {
    *(LAS u32x4*)(buf + (tid >> 3) * KP + (tid & 7) * 16) = r.k;
    *(LAS u32x4*)(buf + KT_BYTES + (tid >> 3) * VP + (tid & 7) * 16) = r.v;
}
__device__ __forceinline__ void qk_tile(f32x16& p0, f32x16& p1, const LAS unsigned char* kt, const bf16x8 (&qf)[4], int lane) {
    const LAS unsigned char* kb = kt + (lane & 31) * KP + (lane >> 5) * 16;
    p0 = (f32x16){}; p1 = (f32x16){};
#pragma unroll
    for (int ks = 0; ks < 4; ++ks) {
        const bf16x8 k0 = *(const LAS bf16x8*)(kb + ks * 32), k1 = *(const LAS bf16x8*)(kb + 32 * KP + ks * 32);
        p0 = __builtin_amdgcn_mfma_f32_32x32x16_bf16(k0, qf[ks], p0, 0, 0, 0);
        p1 = __builtin_amdgcn_mfma_f32_32x32x16_bf16(k1, qf[ks], p1, 0, 0, 0);
    }
}
__device__ __forceinline__ bf16x8 pfrag(const f32x16& p, int s) {
    u32x4 w; w.x = pg8::cvt_pk_bf16(p[8 * s], p[8 * s + 1]); w.y = pg8::cvt_pk_bf16(p[8 * s + 2], p[8 * s + 3]); w.z = pg8::cvt_pk_bf16(p[8 * s + 4], p[8 * s + 5]); w.w = pg8::cvt_pk_bf16(p[8 * s + 6], p[8 * s + 7]);
    return __builtin_bit_cast(bf16x8, w);
}
__device__ __forceinline__ void pv_sub(f32x16& o0, f32x16& o1, const LAS unsigned char* vt, int sub, const f32x16& p, int lane) {
    const LAS unsigned char* vb = vt + (sub * 32 + (lane >> 5) * 4 + ((lane & 15) >> 2)) * VP + (16 * ((lane >> 4) & 1) + 4 * (lane & 3)) * 2;
#pragma unroll
    for (int s = 0; s < 2; ++s) {
        const bf16x8 pb = pfrag(p, s);
        const s16x4 a0 = vtr(vb + (16 * s) * VP), a1 = vtr(vb + (16 * s + 8) * VP), b0 = vtr(vb + (16 * s) * VP + 64), b1 = vtr(vb + (16 * s + 8) * VP + 64);
        const bf16x8 va = {a0[0], a0[1], a0[2], a0[3], a1[0], a1[1], a1[2], a1[3]}, vbb = {b0[0], b0[1], b0[2], b0[3], b1[0], b1[1], b1[2], b1[3]};
        o0 = __builtin_amdgcn_mfma_f32_32x32x16_bf16(va, pb, o0, 0, 0, 0);
        o1 = __builtin_amdgcn_mfma_f32_32x32x16_bf16(vbb, pb, o1, 0, 0, 0);
    }
}
__device__ __forceinline__ float max3f(float a, float b, float c) { float r; asm("v_max3_f32 %0, %1, %2, %3" : "=v"(r) : "v"(a), "v"(b), "v"(c)); return r; }
template <bool SCALED, int EXPT = 0>
__device__ __forceinline__ void softmax_pv(f32x16& p0, f32x16& p1, f32x16& o0, f32x16& o1, float& m, float& l, const LAS unsigned char* vt, int lane, bool v0 = true, bool v1 = true) {
    if (EXPT == 1) { l += p0[0]; pv_sub(o0, o1, vt, 0, p0, lane); pv_sub(o0, o1, vt, 1, p1, lane); return; }
    asm volatile("s_nop 15" : "+v"(p0), "+v"(p1));
    float mx;
    { float a = max3f(p0[0], p0[1], p0[2]), b = max3f(p1[0], p1[1], p1[2]);
      a = max3f(a, p0[3], p0[4]); b = max3f(b, p1[3], p1[4]); a = max3f(a, p0[5], p0[6]); b = max3f(b, p1[5], p1[6]);
      a = max3f(a, p0[7], p0[8]); b = max3f(b, p1[7], p1[8]); a = max3f(a, p0[9], p0[10]); b = max3f(b, p1[9], p1[10]);
      a = max3f(a, p0[11], p0[12]); b = max3f(b, p1[11], p1[12]); a = max3f(a, p0[13], p0[14]); b = max3f(b, p1[13], p1[14]);
      a = fmaxf(a, p0[15]); b = fmaxf(b, p1[15]); mx = fmaxf(v0 ? a : NEGBIG, v1 ? b : NEGBIG); }
    mx = max_x32(mx, lane);
    if (!SCALED) mx *= QK_C;
    const float mn = (mx - m > 8.0f) ? mx : m, alpha = fast_exp2(m - mn);
    const float mn0 = v0 ? mn : 1e30f, mn1 = v1 ? mn : 1e30f;
    f32x2 ls2 = {0.f, 0.f};
#pragma unroll
    for (int r = 0; r < 16; r += 2) {
        f32x2 a = {p0[r], p0[r + 1]}, b = {p1[r], p1[r + 1]};
        if (SCALED) { a = a - mn0; b = b - mn1; } else { a = a * QK_C - mn0; b = b * QK_C - mn1; }
        a[0] = fast_exp2(a[0]); a[1] = fast_exp2(a[1]); b[0] = fast_exp2(b[0]); b[1] = fast_exp2(b[1]);
        p0[r] = a[0]; p0[r + 1] = a[1]; p1[r] = b[0]; p1[r + 1] = b[1];
        ls2 += a; ls2 += b; }
    float ls = ls2[0] + ls2[1];
    ls = sum_x32(ls, lane);
    l = l * alpha + ls; m = mn;
    if (!__all(alpha == 1.0f)) { o0 *= alpha; o1 *= alpha; }
    pv_sub(o0, o1, vt, 0, p0, lane); pv_sub(o0, o1, vt, 1, p1, lane);
}
__device__ __forceinline__ void load_qf(bf16x8 (&qf)[4], const bf16_t* qrow, int lane) {
#pragma unroll
    for (int ks = 0; ks < 4; ++ks) qf[ks] = *(const bf16x8*)(qrow + 16 * ks + 8 * (lane >> 5));
}
__device__ __forceinline__ void store_ot(const f32x16& o0, const f32x16& o1, float sc, bf16_t* orow, int lane) {
    const int hi = lane >> 5;
#pragma unroll
    for (int g = 0; g < 4; ++g) {
        u32x2 w; w.x = pg8::cvt_pk_bf16(o0[4 * g] * sc, o0[4 * g + 1] * sc); w.y = pg8::cvt_pk_bf16(o0[4 * g + 2] * sc, o0[4 * g + 3] * sc); *(u32x2*)(orow + 8 * g + 4 * hi) = w;
        u32x2 x; x.x = pg8::cvt_pk_bf16(o1[4 * g] * sc, o1[4 * g + 1] * sc); x.y = pg8::cvt_pk_bf16(o1[4 * g + 2] * sc, o1[4 * g + 3] * sc); *(u32x2*)(orow + 32 + 8 * g + 4 * hi) = x;
    }
}

template <int EXPT = 0>
__device__ __forceinline__ void fox_phase(const Frame& F, const Args& a, bf16_t* O, int opitch) {
    bf16_t* H = (bf16_t*)(F.ws + WS_R + R_H); const float* DC = (const float*)(F.ws + WS_DCUM);
    const int lane = F.lane, tid = F.tid, hi = lane >> 5;
    LAS unsigned char* kvb = F.lds; LAS float* dkb = (LAS float*)(F.lds + 4 * KV_BUF);
    const int NU = NB * 16 * 8;
    for (int ui = F.bid; ui < NU; ui += F.G) {
        const int qb = 7 - (ui / (NB * 16)), bh = ui % (NB * 16), b = bh >> 4, h = bh & 15;
        const size_t rb0 = (size_t)b * SEQ;
        const bf16_t* Kp = H + rb0 * NO_PAD + 1024 + h * 64; const bf16_t* Vp = H + rb0 * NO_PAD + 2048 + h * 64;
        const int q0 = qb * 256 + F.wave * 32, tq = q0 + (lane & 31);
        bf16x8 qf[4]; load_qf(qf, H + (rb0 + tq) * NO_PAD + h * 64, lane);
        f32x16 o0 = {}, o1 = {}; float m = -1e20f, l = 0.f;
        const int ntile = qb * 4 + 4; const int wlast = (q0 + 31) >> 6;
        KVRegs krA, krB; float dkA = 0.f, dkB = 0.f;
        kv_load(krA, Kp, Vp, NO_PAD, 0, tid); if (tid < 64) dkA = DC[(rb0 + tid) * 16 + h];
        if (ntile > 1) { kv_load(krB, Kp, Vp, NO_PAD, 64, tid); if (tid < 64) dkB = DC[(rb0 + 64 + tid) * 16 + h]; }
        __syncthreads();
#define FOX_FILL(KR, DKR, T) do { const int t = (T); kv_store(KR, kvb + (t & 3) * KV_BUF, tid); if (tid < 64) dkb[(t & 3) * 64 + tid] = -DKR; } while (0)
#define FOX_NEXT(KR, DKR, T) do { const int t = (T); if (t + 2 < ntile) { kv_load(KR, Kp, Vp, NO_PAD, (t + 2) * 64, tid); if (tid < 64) DKR = DC[(rb0 + (t + 2) * 64 + tid) * 16 + h]; } } while (0)
#define FOX_COMP(T) do { const int t = (T); LAS unsigned char* buf = kvb + (t & 3) * KV_BUF; \
            if (EXPT == 2) { l += ((const LAS float*)buf)[lane]; } else if (t <= wlast) { \
                f32x16 p0, p1; qk_tile(p0, p1, buf, qf, lane); \
                const LAS float* dk = dkb + (t & 3) * 64; \
                if (64 * t + 63 <= q0) { \
                    _Pragma("unroll") for (int r = 0; r < 16; ++r) { const int kk = crow(r, hi); p0[r] = __builtin_fmaf(p0[r], QK_C, dk[kk]); p1[r] = __builtin_fmaf(p1[r], QK_C, dk[kk + 32]); } \
                } else { \
                    _Pragma("unroll") for (int r = 0; r < 16; ++r) { const int kk = crow(r, hi), key = t * 64 + kk; \
                        const float s0 = __builtin_fmaf(p0[r], QK_C, dk[kk]), s1 = __builtin_fmaf(p1[r], QK_C, dk[kk + 32]); \
                        p0[r] = (key <= tq) ? s0 : NEGBIG; p1[r] = (key + 32 <= tq) ? s1 : NEGBIG; } \
                } \
                softmax_pv<true, EXPT>(p0, p1, o0, o1, m, l, buf + KT_BYTES, lane); \
            } } while (0)
        for (int t2 = 0; t2 < ntile; t2 += 2) {
            FOX_FILL(krA, dkA, t2); FOX_FILL(krB, dkB, t2 + 1);
            __syncthreads();
            FOX_NEXT(krA, dkA, t2); FOX_NEXT(krB, dkB, t2 + 1);
            FOX_COMP(t2); FOX_COMP(t2 + 1);
        }
#undef FOX_FILL
#undef FOX_NEXT
#undef FOX_COMP
        store_ot(o0, o1, 1.0f / l, O + (rb0 + tq) * opitch + h * 64, lane);
        __syncthreads();
    }
}

template <class MaskFn>
__device__ __forceinline__ void attn_tiles(const Frame& F, unsigned tm, const bf16_t* Kp, const bf16_t* Vp, size_t pitch, const bf16x8 (&qf)[4],
                                            f32x16& o0, f32x16& o1, float& m, float& l, LAS unsigned char* kvb, MaskFn&& mask) {
    const int tid = F.tid, lane = F.lane;
    KVRegs krA, krB;
    int tA = -1, tB = -1;
    if (tm) { tA = __builtin_ctz(tm); tm &= tm - 1; kv_load(krA, Kp, Vp, pitch, tA * 64, tid); }
    if (tm) { tB = __builtin_ctz(tm); tm &= tm - 1; kv_load(krB, Kp, Vp, pitch, tB * 64, tid); }
#define ATT_TILE(KR, TV, PAR) do { const int t = TV; LAS unsigned char* buf = kvb + (PAR) * KV_BUF; \
        kv_store(KR, buf, tid); \
        __syncthreads(); \
        if (tm) { TV = __builtin_ctz(tm); tm &= tm - 1; kv_load(KR, Kp, Vp, pitch, TV * 64, tid); } else TV = -1; \
        f32x16 p0, p1; qk_tile(p0, p1, buf, qf, lane); \
        bool v0 = true, v1 = true; mask(p0, p1, t, v0, v1); \
        softmax_pv<false>(p0, p1, o0, o1, m, l, buf + KT_BYTES, lane, v0, v1); } while (0)
    while (tA >= 0) { ATT_TILE(krA, tA, 0); if (tB < 0) break; ATT_TILE(krB, tB, 1); }
#undef ATT_TILE
    __syncthreads();
}
__device__ __forceinline__ unsigned pkh(float a, float b) { const _Float16 x = (_Float16)a, y = (_Float16)b; return (unsigned)__builtin_bit_cast(unsigned short, x) | ((unsigned)__builtin_bit_cast(unsigned short, y) << 16); }
__device__ __forceinline__ float h2f(unsigned short h) { return (float)__builtin_bit_cast(_Float16, h); }
__device__ __forceinline__ float dpp_f(float x, int ctrl_sel) {
    const int v = __builtin_bit_cast(int, x); int r;
    if (ctrl_sel == 0) r = __builtin_amdgcn_update_dpp(0, v, 0xB1, 0xf, 0xf, true);
    else if (ctrl_sel == 1) r = __builtin_amdgcn_update_dpp(0, v, 0x4E, 0xf, 0xf, true);
    else r = __builtin_amdgcn_update_dpp(0, v, 0x141, 0xf, 0xf, true);
    return __builtin_bit_cast(float, r);
}

__device__ __forceinline__ void dsa_unit(const Frame& F, const Args& a, int b, int qg, bf16_t* O, int opitch) {
    bf16_t* H = (bf16_t*)(F.ws + WS_R + R_H);
    const int lane = F.lane, hi = lane >> 5, t0 = qg * 32; const size_t rb0 = (size_t)b * SEQ;
    LAS float* sc = (LAS float*)F.lds;
    LAS unsigned* bm = (LAS unsigned*)(F.lds + LDS_TAB);
    for (int hf = 0; hf < 2; ++hf) {
        const int tq0 = t0 + 16 * hf, nkt = ((tq0 + 15) >> 5) + 1;
        {
            bf16x8 qi[4][4], wf[4][2];
#pragma unroll
            for (int ct = 0; ct < 4; ++ct) { const int q = tq0 + 4 * ct + ((lane & 31) >> 3), head = lane & 7; const bf16_t* rp = H + (rb0 + q) * NE_PAD;
#pragma unroll
                for (int ks = 0; ks < 4; ++ks) qi[ct][ks] = *(const bf16x8*)(rp + EC_QI + head * 64 + 16 * ks + 8 * hi);
                const int qp = lane & 31; u32x2 w4 = {0u, 0u};
                if (qp < 4) w4 = *(const u32x2*)(H + (rb0 + tq0 + 4 * ct + qp) * NE_PAD + EC_WI + 4 * hi);
                const u32x4 s0 = {(qp == 0) ? w4.x : 0u, (qp == 0) ? w4.y : 0u, (qp == 1) ? w4.x : 0u, (qp == 1) ? w4.y : 0u};
                const u32x4 s1 = {(qp == 2) ? w4.x : 0u, (qp == 2) ? w4.y : 0u, (qp == 3) ? w4.x : 0u, (qp == 3) ? w4.y : 0u};
                wf[ct][0] = __builtin_bit_cast(bf16x8, s0); wf[ct][1] = __builtin_bit_cast(bf16x8, s1); }
            for (int kt = F.wave; kt < nkt; kt += 8) {
                bf16x8 kf[4]; { const bf16_t* kp = H + (rb0 + kt * 32 + (lane & 31)) * NE_PAD + EC_KI + 8 * hi;
#pragma unroll
                    for (int ks = 0; ks < 4; ++ks) kf[ks] = *(const bf16x8*)(kp + 16 * ks); }
#pragma unroll
                for (int ct = 0; ct < 4; ++ct) {
                    f32x16 acc = {};
#pragma unroll
                    for (int ks = 0; ks < 4; ++ks) acc = __builtin_amdgcn_mfma_f32_32x32x16_bf16(qi[ct][ks], kf[ks], acc, 0, 0, 0);
#pragma unroll
                    for (int r = 0; r < 16; ++r) acc[r] = fmaxf(acc[r], 0.f);
                    f32x16 y = {};
                    y = __builtin_amdgcn_mfma_f32_32x32x16_bf16(wf[ct][0], pfrag(acc, 0), y, 0, 0, 0);
                    y = __builtin_amdgcn_mfma_f32_32x32x16_bf16(wf[ct][1], pfrag(acc, 1), y, 0, 0, 0);
                    if (lane < 32) { LAS float* dst = sc + (4 * ct) * 2048 + kt * 32 + lane;
                        dst[0] = y[0]; dst[2048] = y[1]; dst[4096] = y[2]; dst[6144] = y[3]; }
                }
            }
        }
        __syncthreads();
        for (int q2 = 0; q2 < 2; ++q2) {
            const int ql = 2 * F.wave + q2, tq = tq0 + ql, n = tq + 1;
            unsigned u[32];
#pragma unroll
            for (int j = 0; j < 32; ++j) { const int idx = 64 * j + lane; unsigned bits = 0u;
                if (idx < n) { bits = __builtin_bit_cast(unsigned, sc[ql * 2048 + idx]); if ((bits << 1) == 0u) bits = 0u; bits ^= (bits & 0x80000000u) ? 0xffffffffu : 0x80000000u; }
                u[j] = bits; }
            unsigned thr = 0u; int need = 0; bool exact = false;
            if (n > 256) {
                const int ng = (n + 511) >> 9;
                for (int bit = 31; bit >= 0; --bit) { const unsigned cand = thr | (1u << bit); int c = 0;
#pragma unroll
                    for (int g = 0; g < 4; ++g) if (g < ng) {
#pragma unroll
                        for (int j = 8 * g; j < 8 * g + 8; ++j) c += (u[j] >= cand) ? 1 : 0; }
                    c = wave_sum_i(c);
                    if (c >= 256) { thr = cand; if (c == 256) { exact = true; break; } } }
                if (!exact) { int cgt = 0;
#pragma unroll
                    for (int j = 0; j < 32; ++j) cgt += (u[j] > thr) ? 1 : 0;
                    cgt = wave_sum_i(cgt);
                    need = 256 - cgt; }
            }
            const unsigned long long lt = (1ull << lane) - 1ull; int er = 0;
            if (exact) {
#pragma unroll
                for (int j = 0; j < 32; ++j) { const unsigned long long sm = __ballot(u[j] >= thr);
                    if (lane == 0) { bm[(16 * hf + ql) * 64 + 2 * j] = (unsigned)sm; bm[(16 * hf + ql) * 64 + 2 * j + 1] = (unsigned)(sm >> 32); } } }
            else
#pragma unroll
            for (int j = 0; j < 32; ++j) { const int idx = 64 * j + lane; bool sel;
                if (n > 256) {
                  const unsigned long long eqm = __ballot(u[j] == thr && idx < n); sel = (u[j] > thr) || (u[j] == thr && idx < n && (er + __popcll(eqm & lt)) < need); er += __popcll(eqm); }
                else sel = idx < n;
                const unsigned long long sm = __ballot(sel);
                if (lane == 0) { bm[(16 * hf + ql) * 64 + 2 * j] = (unsigned)sm; bm[(16 * hf + ql) * 64 + 2 * j + 1] = (unsigned)(sm >> 32); } }
        }
        __syncthreads();
    }
    const int tq = t0 + (lane & 31);
    bf16x8 qf[4]; load_qf(qf, H + (rb0 + tq) * NE_PAD + EC_QA + F.wave * 64, lane);
    f32x16 o0 = {}, o1 = {}; float m = -1e20f, l = 0.f;
    const int ntile = ((t0 + 31) >> 6) + 1; const unsigned tm = (ntile >= 32) ? 0xffffffffu : ((1u << ntile) - 1u);
    const LAS unsigned* bq = bm + (lane & 31) * 64;
    attn_tiles(F, tm, H + rb0 * NE_PAD + EC_KA, H + rb0 * NE_PAD + EC_VA, NE_PAD, qf, o0, o1, m, l, F.lds,
        [&](f32x16& p0, f32x16& p1, int t, bool&, bool&) { const unsigned w0 = bq[2 * t] >> (4 * hi), w1 = bq[2 * t + 1] >> (4 * hi);
#pragma unroll
            for (int r = 0; r < 16; ++r) { const int sh = (r & 3) + 8 * (r >> 2);
                p0[r] = ((w0 >> sh) & 1u) ? p0[r] : NEGBIG; p1[r] = ((w1 >> sh) & 1u) ? p1[r] : NEGBIG; } });
    store_ot(o0, o1, 1.0f / l, O + (rb0 + tq) * opitch + F.wave * 64, lane);
}

__device__ __forceinline__ void compress_item(const Frame& F, const Args& a, int layer, int item) {
    const bf16_t* H = (const bf16_t*)(F.ws + WS_R + R_H); const bf16_t* W = (const bf16_t*)(F.ws + WS_W + wbuf_off(layer));
    const int kv = item & 1, ct = (item >> 1) & 3, b = item >> 3, lane = F.lane, hi = lane >> 5;
    const bf16_t* w1t = W + (kv ? W_C1V : W_C1K) / 2; const bf16_t* w2t = W + (kv ? W_C2V : W_C2K) / 2;
    const float* bias1 = (const float*)(F.ws + WS_MISC) + kv * 64;
    bf16_t* outp = (bf16_t*)(F.ws + (kv ? WS_VC : WS_KC)) + (size_t)b * 128 * 64;
    const int col = kv ? EC_VC : EC_KC;
    LAS float* part = (LAS float*)F.lds; LAS unsigned short* hs = (LAS unsigned short*)(F.lds + 65536);
    int c = ct * 32 + (lane & 31); if (c > 126) c = 126;
    f32x16 a0 = {}, a1 = {};
#pragma unroll 8
    for (int ks = F.wave * 16; ks < F.wave * 16 + 16; ++ks) {
        const bf16x8 af = *(const bf16x8*)(H + ((size_t)b * SEQ + 16 * c + (ks >> 2)) * NE_PAD + col + 16 * (ks & 3) + 8 * hi);
        const bf16x8 b0 = *(const bf16x8*)(w1t + (size_t)(lane & 31) * 2048 + 16 * ks + 8 * hi), b1 = *(const bf16x8*)(w1t + (size_t)(32 + (lane & 31)) * 2048 + 16 * ks + 8 * hi);
        a0 = __builtin_amdgcn_mfma_f32_32x32x16_bf16(af, b0, a0, 0, 0, 0); a1 = __builtin_amdgcn_mfma_f32_32x32x16_bf16(af, b1, a1, 0, 0, 0);
    }
#pragma unroll
    for (int r = 0; r < 16; ++r) { part[F.wave * 2048 + crow(r, hi) * 64 + (lane & 31)] = a0[r]; part[F.wave * 2048 + crow(r, hi) * 64 + 32 + (lane & 31)] = a1[r]; }
    __syncthreads();
#pragma unroll
    for (int i = 0; i < 4; ++i) { const int idx = F.tid + 512 * i; float s = bias1[idx & 63];
#pragma unroll
        for (int w = 0; w < 8; ++w) s += part[w * 2048 + idx];
        const float h = s / (1.0f + __expf(-s)); hs[(idx >> 6) * 72 + (idx & 63)] = (unsigned short)f2bf(h); }
    __syncthreads();
    if (F.wave < 2) {
        const int nt = F.wave; f32x16 acc = {};
#pragma unroll
        for (int ks = 0; ks < 4; ++ks) { const bf16x8 af = *(const LAS bf16x8*)((const LAS unsigned char*)hs + (lane & 31) * 144 + (16 * ks + 8 * hi) * 2);
            const bf16x8 bf = *(const bf16x8*)(w2t + (size_t)(nt * 32 + (lane & 31)) * 64 + 16 * ks + 8 * hi);
            acc = __builtin_amdgcn_mfma_f32_32x32x16_bf16(af, bf, acc, 0, 0, 0); }
        const int n = nt * 32 + (lane & 31);
        const float* cosT = (const float*)(F.ws + WS_ROPE_COS); const float* sinT = (const float*)(F.ws + WS_ROPE_SIN);
#pragma unroll
        for (int r = 0; r < 16; ++r) { const int cg = ct * 32 + crow(r, hi); float v = acc[r];
            if (kv == 0) { const float o = dpp_mov<DPP_X1>(v); int pos = 16 * cg + 31; if (pos > SEQ - 1) pos = SEQ - 1; const float cs = cosT[pos * 32 + (n >> 1)], sn = sinT[pos * 32 + (n >> 1)];
                v = (n & 1) ? (v * cs + o * sn) : (v * cs - o * sn); }
            outp[(size_t)cg * 64 + n] = (unsigned short)((cg <= 126) ? f2bf(v) : 0u); }
    }
    __syncthreads();
}

__device__ __forceinline__ void nsa_unit(const Frame& F, const Args& a, int layer, int b, int qg, bf16_t* O, int opitch) {
    bf16_t* H = (bf16_t*)(F.ws + WS_R + R_H);
    const int lane = F.lane, hi = lane >> 5, tid = F.tid, t0 = qg * 32, cur = qg; const size_t rb0 = (size_t)b * SEQ;
    const int tq = t0 + (lane & 31);
    LAS unsigned char* kvb = F.lds;
    LAS unsigned short* slab = (LAS unsigned short*)(F.lds + 2 * KV_BUF);
    LAS float* pcs = (LAS float*)(F.lds + 2 * KV_BUF + 65536);
    LAS unsigned* selm = (LAS unsigned*)(pcs + 4096);
    const bf16_t* rowp = H + (rb0 + tq) * NE_PAD;
    bf16x8 qf[4]; load_qf(qf, rowp + EC_QB + F.wave * 64, lane);
    const float* bg = a.in[I_EV_BGATE] + (layer >> 1) * 24 + F.wave * 3;
    const float g0 = sigmoidf_(bf2f(rowp[EC_GB + F.wave * 3 + 0]) + bg[0]), g1 = sigmoidf_(bf2f(rowp[EC_GB + F.wave * 3 + 1]) + bg[1]), g2 = sigmoidf_(bf2f(rowp[EC_GB + F.wave * 3 + 2]) + bg[2]);
    { const bf16_t* kc = (const bf16_t*)(F.ws + WS_KC) + (size_t)b * 128 * 64; const bf16_t* vc = (const bf16_t*)(F.ws + WS_VC) + (size_t)b * 128 * 64;
      KVRegs r0, r1; kv_load(r0, kc, vc, 64, 0, tid); kv_load(r1, kc, vc, 64, 64, tid); kv_store(r0, kvb, tid); kv_store(r1, kvb + KV_BUF, tid); }
    __syncthreads();
    f32x16 pc[4]; f32x16 oa0 = {}, oa1 = {};
    {
        const int cmax = (tq >= 31) ? min(126, (tq - 31) >> 4) : -1;
        qk_tile(pc[0], pc[1], kvb, qf, lane); asm volatile("" ::: "memory"); qk_tile(pc[2], pc[3], kvb + KV_BUF, qf, lane); asm volatile("" ::: "memory");
        float mx = NEGBIG;
#pragma unroll
        for (int s = 0; s < 4; ++s)
#pragma unroll
            for (int r = 0; r < 16; ++r) { const int c = 32 * s + crow(r, hi); pc[s][r] = (c <= cmax) ? pc[s][r] * QK_C : NEGBIG; mx = fmaxf(mx, pc[s][r]); }
        mx = max_x32(mx, lane);
        float ls = 0.f;
#pragma unroll
        for (int s = 0; s < 4; ++s)
#pragma unroll
            for (int r = 0; r < 16; ++r) { pc[s][r] = (pc[s][r] > -1e29f) ? fast_exp2(pc[s][r] - mx) : 0.f; ls += pc[s][r]; }
        ls = sum_x32(ls, lane);
        const float inv = (ls > 0.f) ? 1.0f / ls : 0.f;
#pragma unroll
        for (int s = 0; s < 4; ++s) pc[s] *= inv;
        f32x16 c0 = {}, c1 = {};
        asm volatile("" ::: "memory");
        pv_sub(c0, c1, kvb + KT_BYTES, 0, pc[0], lane); asm volatile("" ::: "memory"); pv_sub(c0, c1, kvb + KT_BYTES, 1, pc[1], lane); asm volatile("" ::: "memory");
        pv_sub(c0, c1, kvb + KV_BUF + KT_BYTES, 0, pc[2], lane); asm volatile("" ::: "memory"); pv_sub(c0, c1, kvb + KV_BUF + KT_BYTES, 1, pc[3], lane); asm volatile("" ::: "memory");
        oa0 = c0 * g0; oa1 = c1 * g0;
    }
    { LAS unsigned short* sl = slab + F.wave * 4096 + (lane & 31) * 128 + 4 * hi;
#pragma unroll
      for (int s = 0; s < 4; ++s)
#pragma unroll
          for (int g = 0; g < 4; ++g) { u32x2 w; w.x = pkh(pc[s][4 * g], pc[s][4 * g + 1]); w.y = pkh(pc[s][4 * g + 2], pc[s][4 * g + 3]); *(LAS u32x2*)(sl + 32 * s + 8 * g) = w; } }
    __syncthreads();
#pragma unroll
    for (int i = 0; i < 8; ++i) { const int idx = tid + 512 * i; float s8 = 0.f;
#pragma unroll
        for (int w = 0; w < 8; ++w) s8 += h2f(slab[w * 4096 + idx]);
        pcs[idx] = s8; }
    __syncthreads();
#pragma unroll
    for (int qq = 0; qq < 4; ++qq) { const int q = 4 * F.wave + qq; const LAS float* pr = pcs + q * 128;
        float v = pr[2 * lane] + 0.5f * ((lane > 0 ? pr[2 * lane - 1] : 0.f) + pr[2 * lane + 1]);
        if (lane == 0 || lane == cur || lane == cur - 1) v = 1e30f - (float)lane * 1e27f; else if (lane > cur) v = NEGBIG;
        int rank = 0;
#pragma unroll
        for (int j = 0; j < 64; ++j) { const float o = __builtin_bit_cast(float, __builtin_amdgcn_readlane(__builtin_bit_cast(int, v), j)); rank += (o > v) ? 1 : 0; }
        bool tie = false;
#pragma unroll
        for (int k = 0; k < 8; ++k) tie |= (__popcll(__ballot(rank == k)) != 1);
        if (tie) { rank = 0;
#pragma unroll 1
            for (int j = 0; j < 64; ++j) { const float o = __builtin_bit_cast(float, __builtin_amdgcn_readlane(__builtin_bit_cast(int, v), j)); rank += (o > v || (o == v && j < lane)) ? 1 : 0; } }
        const unsigned long long sm = __ballot(rank < 8);
        if (lane == 0) { selm[2 * q] = (unsigned)sm; selm[2 * q + 1] = (unsigned)(sm >> 32); } }
    __syncthreads();
    LAS float* stash = (LAS float*)(F.lds + 2 * KV_BUF) + F.wave * 2048 + lane;
#pragma unroll
    for (int r = 0; r < 16; ++r) { stash[r * 64] = oa0[r]; stash[(16 + r) * 64] = oa1[r]; }
    {
        unsigned long long un = 0ull;
        { const unsigned lo = selm[2 * (lane & 31)], hh = selm[2 * (lane & 31) + 1]; unsigned ul = lo, uh = hh;
          ul |= dpp_movu<DPP_X1>(ul); ul |= dpp_movu<DPP_X2>(ul); ul |= dpp_movu<DPP_HM>(ul); ul |= dpp_movu<DPP_RM>(ul);
          uh |= dpp_movu<DPP_X1>(uh); uh |= dpp_movu<DPP_X2>(uh); uh |= dpp_movu<DPP_HM>(uh); uh |= dpp_movu<DPP_RM>(uh);
          un = ((unsigned long long)((unsigned)__builtin_amdgcn_readlane((int)uh, 0) | (unsigned)__builtin_amdgcn_readlane((int)uh, 16)) << 32) | ((unsigned)__builtin_amdgcn_readlane((int)ul, 0) | (unsigned)__builtin_amdgcn_readlane((int)ul, 16)); }
        if (cur < 63) un &= (1ull << (cur + 1)) - 1ull;
        unsigned tm = 0u;
        for (int t = 0; t <= (cur >> 1); ++t) if ((un >> (2 * t)) & 3ull) tm |= 1u << t;
        const unsigned long long mysel = ((unsigned long long)selm[2 * (lane & 31) + 1] << 32) | selm[2 * (lane & 31)];
        f32x16 s0 = {}, s1 = {}; float m = -1e20f, l = 0.f;
        attn_tiles(F, tm, H + rb0 * NE_PAD + EC_KS, H + rb0 * NE_PAD + EC_VS, NE_PAD, qf, s0, s1, m, l, kvb,
            [&](f32x16& p0, f32x16& p1, int t, bool& v0, bool& v1) { const bool b0 = (mysel >> (2 * t)) & 1ull, b1 = (mysel >> (2 * t + 1)) & 1ull;
                if (64 * t + 63 <= t0) { v0 = b0; v1 = b1; }
                else {
#pragma unroll
                    for (int r = 0; r < 16; ++r) { const int key = 64 * t + crow(r, hi);
                        p0[r] = (b0 && key <= tq) ? p0[r] : NEGBIG; p1[r] = (b1 && key + 32 <= tq) ? p1[r] : NEGBIG; } } });
        const float sc = g1 / l;
#pragma unroll
        for (int r = 0; r < 16; ++r) { stash[r * 64] += s0[r] * sc; stash[(16 + r) * 64] += s1[r] * sc; }
    }
    {
        const int tlo = (t0 >= 511) ? ((t0 - 511) >> 6) : 0, thi = (t0 + 31) >> 6;
        unsigned tm = 0u; for (int t = tlo; t <= thi; ++t) tm |= 1u << t;
        f32x16 s0 = {}, s1 = {}; float m = -1e20f, l = 0.f;
        attn_tiles(F, tm, H + rb0 * NE_PAD + EC_KW, H + rb0 * NE_PAD + EC_VW, NE_PAD, qf, s0, s1, m, l, kvb,
            [&](f32x16& p0, f32x16& p1, int t, bool&, bool&) {
                const bool interior = (64 * t + 63 <= t0) && (64 * t + 512 > t0 + 31);
                if (!interior) {
#pragma unroll
                    for (int r = 0; r < 16; ++r) { const int key = 64 * t + crow(r, hi);
                        p0[r] = (key <= tq && key + 512 > tq) ? p0[r] : NEGBIG; p1[r] = (key + 32 <= tq && key + 32 + 512 > tq) ? p1[r] : NEGBIG; } } });
        const float sc = g2 / l;
#pragma unroll
        for (int r = 0; r < 16; ++r) { oa0[r] = stash[r * 64] + s0[r] * sc; oa1[r] = stash[(16 + r) * 64] + s1[r] * sc; }
    }
    store_ot(oa0, oa1, 1.0f, O + (rb0 + tq) * opitch + F.wave * 64, lane);
    __syncthreads();
}

__device__ __forceinline__ void moe_tables(const Frame& F, int layer) {
    LAS int* cntl = (LAS int*)(F.lds + LDS_TAB); LAS int* rbs = cntl + 160;
    __syncthreads();
    if (F.tid < NV) cntl[F.tid] = ((F.tid % 65) == 64) ? HALF_T : (int)__hip_atomic_load(F.ctl + CW_CNT + layer * 256 + F.tid, RLX_AGENT);
    __syncthreads();
    if (F.tid <= NV) { int run = 0; for (int u = 0; u < F.tid; ++u) run += (cntl[u] + 255) >> 8; rbs[F.tid] = run; }
    __syncthreads();
}

constexpr int PH_PER_LAYER = 16, N_PHASES = DEPTH * PH_PER_LAYER;
__global__ void __launch_bounds__(512, 2) fwd(const float* i0, const float* i1, const float* i2, const float* i3, const float* i4, const float* i5, const float* i6, const float* i7, const float* i8, const float* i9, const float* i10, const float* i11, const float* i12, const float* i13, const float* i14, const float* i15, const float* i16, const float* i17, const float* i18, const float* i19, const float* i20, const float* i21, const float* i22, const float* i23, const float* i24, const float* i25, const float* i26, const float* i27, const float* i28, float* out_, unsigned char* ws_, int ph_lo_, int ph_hi_) {
    Args args; args.in[0] = i0; args.in[1] = i1; args.in[2] = i2; args.in[3] = i3; args.in[4] = i4; args.in[5] = i5; args.in[6] = i6; args.in[7] = i7; args.in[8] = i8; args.in[9] = i9; args.in[10] = i10; args.in[11] = i11; args.in[12] = i12; args.in[13] = i13; args.in[14] = i14; args.in[15] = i15; args.in[16] = i16; args.in[17] = i17; args.in[18] = i18; args.in[19] = i19; args.in[20] = i20; args.in[21] = i21; args.in[22] = i22; args.in[23] = i23; args.in[24] = i24; args.in[25] = i25; args.in[26] = i26; args.in[27] = i27; args.in[28] = i28; args.out = out_; args.ws = ws_; args.ph_lo = ph_lo_; args.ph_hi = ph_hi_;
    extern __shared__ __attribute__((aligned(16))) unsigned char lds_raw[];
    Frame F; F.lds = (LAS unsigned char*)lds_raw; F.tid = threadIdx.x; F.lane = F.tid & 63; F.wave = __builtin_amdgcn_readfirstlane(F.tid >> 6);
    F.G = gridDim.x; F.bid = blockIdx.x; F.ws = args.ws; F.ctl = (gu32*)(args.ws + WS_CTL);
    volatile LAS unsigned* MISC = (volatile LAS unsigned*)(F.lds + LDS_MISC);
    if (threadIdx.x < 64) MISC[threadIdx.x] = 0u;
    __syncthreads();
#if MK_ONE_LAUNCH
    constexpr int lo = 0, hi = N_PHASES; constexpr bool multi = true;
#else
    const int lo = args.ph_lo, hi = args.ph_hi; const bool multi = (hi - lo) > 1;
#endif
    XcdBarrier bar; bar.bar = (unsigned*)(F.ctl + CW_BAR); bar.x = 0; bar.st = MISC;
    if (multi) bar = xcd_barrier_post((unsigned*)(F.ctl + CW_BAR), MISC);
#ifndef PHMASK
#define PHMASK 0xffff
#endif
#define IN(k) (((PHMASK >> ((k) & 15)) & 1) && lo <= (k) && (k) < hi)
#ifndef TIMING
#define TIMING 0
#endif
#if TIMING
    if (F.tid == 0) { const unsigned long long t0_ = wall_clock64(); MISC[16] = (unsigned)t0_; MISC[17] = (unsigned)(t0_ >> 32); }
#define SEAM() do { if (multi) xcd_barrier(bar); if (blockIdx.x == 0 && F.tid == 0) { const unsigned long long tn = wall_clock64(); const unsigned long long tp = ((unsigned long long)MISC[17] << 32) | MISC[16]; \
    ((unsigned long long*)(args.ws + WS_CTL + 512 * 1024))[MISC[18]] = tn - tp; MISC[16] = (unsigned)tn; MISC[17] = (unsigned)(tn >> 32); } } while (0)
#define SETPH(k) do { if (F.tid == 0) MISC[18] = (unsigned)(k); } while (0)
#else
#define SEAM() do { if (multi) xcd_barrier(bar); } while (0)
#define SETPH(k)
#endif
#ifndef DUP_K
#define DUP_K -1
#define DUP_PAR 2
#endif
#define NREP(k) ((DUP_K == (k) && (DUP_PAR == 2 || (layer & 1) == DUP_PAR)) ? 2 : 1)
#define PF() Frame P = F; { int t_; asm volatile("v_mbcnt_lo_u32_b32 %0, -1, 0\n\tv_mbcnt_hi_u32_b32 %0, -1, %0" : "=v"(t_)); t_ += F.wave * 64; P.tid = t_; P.lane = t_ & 63; int w_ = F.wave; asm volatile("" : "+s"(w_)); P.wave = w_; GAS unsigned char* p_ = (GAS unsigned char*)args.ws; asm volatile("" : "+s"(p_)); P.ws = (unsigned char*)p_; P.ctl = (gu32*)(p_ + WS_CTL); } \
    unsigned char* ws = P.ws; bf16_t* XB = (bf16_t*)(ws + WS_XB); bf16_t* XB2 = (bf16_t*)(ws + WS_R + R_XB2); bf16_t* XD = (bf16_t*)args.out; (void)XD; bf16_t* H = (bf16_t*)(ws + WS_R + R_H); bf16_t* W = (bf16_t*)(ws + WS_W + wbuf_off(layer)); (void)XB; (void)XB2; (void)H; (void)W;
    LAS int* cntl = (LAS int*)(F.lds + LDS_TAB); LAS int* rbs = cntl + 160;
    for (int layer = 0; layer < DEPTH; ++layer) {
        const int pb = layer * PH_PER_LAYER; const bool even = (layer & 1) == 0; const int jl = layer >> 1;
        const bool ovl = (F.G == 256);
        if (IN(pb + 0) && (layer == 0 || !ovl)) { SETPH(pb + 0); PF();
            prep_weights(P, args, layer, P.bid, P.G); prep_acts(P, args, layer, layer == 0);
            SEAM(); }
        if (IN(pb + 1)) { SETPH(pb + 1); PF();
            { const bf16_t* xin = (layer == 0) ? XB : XB2;
            if (even) { pg8::DenseSched S{(const char*)xin, (const char*)(W + W_IN / 2), DM, DM, T / 256, NE_PAD / 256, P.G, P.bid};
                EpiInEven E{H, (const float*)(ws + WS_ROPE_COS), (const float*)(ws + WS_ROPE_SIN)}; pg8::gemm_phase(P.lds, S, E, P.tid); }
            else { pg8::DenseSched S{(const char*)xin, (const char*)(W + W_IN / 2), DM, DM, T / 256, NO_PAD / 256, P.G, P.bid};
                EpiInOdd E{H, (float*)(ws + WS_LOGF), args.in[I_OD_BF] + jl * 16}; pg8::gemm_phase(P.lds, S, E, P.tid); } }
            SEAM(); }
        if ((DUP_K == 1 && (DUP_PAR == 2 || (layer & 1) == DUP_PAR))) { PF();
            { const bf16_t* xin = (layer == 0) ? XB : XB2;
            if (even) { pg8::DenseSched S{(const char*)xin, (const char*)(W + W_IN / 2), DM, DM, T / 256, NE_PAD / 256, P.G, P.bid};
                EpiInEven E{H, (const float*)(ws + WS_ROPE_COS), (const float*)(ws + WS_ROPE_SIN)}; pg8::gemm_phase(P.lds, S, E, P.tid); }
            else { pg8::DenseSched S{(const char*)xin, (const char*)(W + W_IN / 2), DM, DM, T / 256, NO_PAD / 256, P.G, P.bid};
                EpiInOdd E{H, (float*)(ws + WS_LOGF), args.in[I_OD_BF] + jl * 16}; pg8::gemm_phase(P.lds, S, E, P.tid); } }
            SEAM(); }
        if (even) {
        if (IN(pb + 2)) { SETPH(pb + 2); PF();
                for (int it = P.bid; it < 256; it += P.G) compress_item(P, args, layer, it);
                for (int u0 = 0; u0 < NB * 64; u0 += P.G) { const int u = u0 + (((u0 / P.G) & 1) ? (P.G - 1 - P.bid) : P.bid); if (u >= NB * 64) continue; const int qg = 63 - (u / NB), b = u % NB; dsa_unit(P, args, b, qg, H + EC_QA, NE_PAD); }
            SEAM(); }
        if ((DUP_K == 2 && (DUP_PAR == 2 || (layer & 1) == DUP_PAR))) { PF();
                for (int u0 = 0; u0 < NB * 64; u0 += P.G) { const int u = u0 + (((u0 / P.G) & 1) ? (P.G - 1 - P.bid) : P.bid); if (u >= NB * 64) continue; const int qg = 63 - (u / NB), b = u % NB; dsa_unit(P, args, b, qg, (bf16_t*)(ws + WS_R + 568 * MiB), 1024); }
            SEAM(); }
        if (IN(pb + 3)) { SETPH(pb + 3); PF();
                for (int u0 = 0; u0 < NB * 64; u0 += P.G) { const int u = u0 + (((u0 / P.G) & 1) ? (P.G - 1 - P.bid) : P.bid); if (u >= NB * 64) continue; const int qg = 63 - (u / NB), b = u % NB; nsa_unit(P, args, layer, b, qg, H + EC_QB, NE_PAD); }
            SEAM(); }
        if ((DUP_K == 3 && (DUP_PAR == 2 || (layer & 1) == DUP_PAR))) { PF();
                for (int u0 = 0; u0 < NB * 64; u0 += P.G) { const int u = u0 + (((u0 / P.G) & 1) ? (P.G - 1 - P.bid) : P.bid); if (u >= NB * 64) continue; const int qg = 63 - (u / NB), b = u % NB; nsa_unit(P, args, layer, b, qg, (bf16_t*)(ws + WS_R + 568 * MiB) + 512, 1024); }
            SEAM(); }
        } else {
        if (IN(pb + 2)) { SETPH(pb + 2); PF();
            scan_phase(P, args);
            SEAM(); }
        if (IN(pb + 3)) { SETPH(pb + 3); PF();
                fox_phase(P, args, H, NO_PAD);
            SEAM(); }
        if ((DUP_K == 3 && (DUP_PAR == 2 || (layer & 1) == DUP_PAR))) { PF();
#ifdef FOX_EXPT
                fox_phase<FOX_EXPT>(P, args, (bf16_t*)(ws + WS_R + 568 * MiB), 1024);
#else
                fox_phase(P, args, (bf16_t*)(ws + WS_R + 568 * MiB), 1024);
#endif
            SEAM(); }
        }
        if (IN(pb + 4)) { SETPH(pb + 4); PF();
            { pg8::DenseSched S{(const char*)H, (const char*)(W + W_O / 2), even ? NE_PAD : NO_PAD, DM, T / 256, DM / 256, P.G, P.bid};
              EpiOut E{(layer == 0) ? XB : XB2, (layer == 0) ? XB2 : XB}; pg8::gemm_phase(P.lds, S, E, P.tid); }
            SEAM(); }
        if ((DUP_K == 4 && (DUP_PAR == 2 || (layer & 1) == DUP_PAR))) { PF();
            { pg8::DenseSched S{(const char*)H, (const char*)(W + W_O / 2), even ? NE_PAD : NO_PAD, DM, T / 256, DM / 256, P.G, P.bid};
              EpiOut E{(layer == 0) ? XB : XB2, (bf16_t*)(ws + WS_R + 568 * MiB)}; pg8::gemm_phase(P.lds, S, E, P.tid); }
            SEAM(); }
        if (IN(pb + 5)) { SETPH(pb + 5); PF();
            route_phase(P, args, layer, (layer == 0) ? XB2 : XB, XD, false);
            SEAM(); }
        if ((DUP_K == 5 && (DUP_PAR == 2 || (layer & 1) == DUP_PAR))) { PF();
            route_phase(P, args, layer, (layer == 0) ? XB2 : XB, (bf16_t*)(ws + WS_R + 568 * MiB), true);
            SEAM(); }
        if (IN(pb + 6)) { SETPH(pb + 6); PF();
            const bool side = ovl && layer + 1 < DEPTH;
            if (side && (P.bid >> 3) >= 32 - SIDE_PX) prep_weights(P, args, layer + 1, (P.bid & 7) * SIDE_PX + (P.bid >> 3) - (32 - SIDE_PX), 8 * SIDE_PX);
            else { moe_tables(P, layer);
              MoeSched S{(const char*)XD, (const char*)(W + W_UP / 2), DM, DM, 2, (size_t)512 * DM * 2, rbs, cntl, 0, NV - 1, 0, rbs[NV] * 2, P.G, P.bid, (const int*)(ws + WS_SLOT_TK), true, side ? 32 - SIDE_PX : (P.G >> 3)};
              EpiUp E{(bf16_t*)(ws + WS_R + R_HMID)}; pg8::gemm_phase(P.lds, S, E, P.tid); }
            SEAM(); }
        if ((DUP_K == 6 && (DUP_PAR == 2 || (layer & 1) == DUP_PAR))) { PF();
            { moe_tables(P, layer);
              MoeSched S{(const char*)XD, (const char*)(W + W_UP / 2), DM, DM, 2, (size_t)512 * DM * 2, rbs, cntl, 0, NV - 1, 0, rbs[NV] * 2, P.G, P.bid, (const int*)(ws + WS_SLOT_TK), true, P.G >> 3};
              EpiUp E{(bf16_t*)(ws + WS_R + R_HMID)}; pg8::gemm_phase(P.lds, S, E, P.tid); }
            SEAM(); }
        if (IN(pb + 7)) { SETPH(pb + 7); PF();
                { LAS int* rcache = (LAS int*)(P.lds + LDS_TAB + 4096); if (P.tid < 2) rcache[P.tid] = 0;
                  moe_tables(P, layer);
                  MoeSched S{(const char*)(ws + WS_R + R_HMID), (const char*)(W + W_DN / 2), DFF, DFF, 4, (size_t)DM * DFF * 2, rbs, cntl, 0, NV - 1, 0, rbs[NV] * 4, P.G, P.bid, (const int*)(ws + WS_SLOT_TK), false, P.G >> 3};
                  EpiDown E{(bf16_t*)(ws + WS_R + R_YTOK), (const int*)(ws + WS_SLOT_TK), (const float*)(ws + WS_SLOT_G), cntl, false, rcache}; pg8::gemm_phase(P.lds, S, E, P.tid); }
            SEAM(); }
        if (IN(pb + 8)) { SETPH(pb + 8); PF();
#pragma unroll 1
            for (int hf = 0; hf < 2; ++hf) { int h2 = hf; asm volatile("" : "+s"(h2)); combine_phase(P, args, layer, h2, XD, XB, false); } }
        if (IN(pb + 10)) { PF();
            { pg8::DenseSched S{(const char*)(ws + WS_PB), (const char*)(W + W_P / 2), 256, 256, T / 256, DM / 256, P.G, P.bid};
              EpiPleE E{(bf16_t*)(ws + WS_R + R_E), (float*)(ws + WS_SSQ)}; pg8::gemm_phase(P.lds, S, E, P.tid); }
            SEAM(); }
        if ((DUP_K == 11 && (DUP_PAR == 2 || (layer & 1) == DUP_PAR))) { PF();
            { pg8::DenseSched S{(const char*)(ws + WS_PB), (const char*)(W + W_P / 2), 256, 256, T / 256, DM / 256, P.G, P.bid};
              EpiPleE E{(bf16_t*)(ws + WS_R + R_E), (float*)(ws + WS_SSQ)}; pg8::gemm_phase(P.lds, S, E, P.tid); }
            SEAM(); }
        if (IN(pb + 12)) { SETPH(pb + 12); PF();
            { pg8::DenseSched S{(const char*)XB, (const char*)(W + W_G / 2), DM, DM, T / 256, DM / 256, P.G, P.bid};
              EpiPleG E{XB, (const bf16_t*)(ws + WS_R + R_E), (const float*)(ws + WS_SSQ), args.in[I_PNG] + layer * DM, (layer + 1 < DEPTH) ? XB2 : (bf16_t*)nullptr, (layer + 1 < DEPTH) ? (float*)nullptr : args.out};
              pg8::gemm_phase(P.lds, S, E, P.tid); }
            if (ovl && layer + 1 < DEPTH) prep_acts(P, args, layer + 1, false);
            SEAM(); }
        if ((DUP_K == 12 && (DUP_PAR == 2 || (layer & 1) == DUP_PAR))) { PF();
            { pg8::DenseSched S{(const char*)XB, (const char*)(W + W_G / 2), DM, DM, T / 256, DM / 256, P.G, P.bid};
              EpiPleG E{XB, (const bf16_t*)(ws + WS_R + R_E), (const float*)(ws + WS_SSQ), args.in[I_PNG] + layer * DM, (bf16_t*)(ws + WS_R + 568 * MiB), (float*)nullptr}; pg8::gemm_phase(P.lds, S, E, P.tid); }
            SEAM(); }
    }
#ifdef EXTRA_BAR
    for (int i_ = 0; i_ < EXTRA_BAR; ++i_) { SEAM(); }
#endif
#if TIMING
    {
        VM_WAIT(); __syncthreads(); if (multi) xcd_barrier(bar);
        float ta = 0.f, tb = 0.f;
        for (int l = 0; l < DEPTH; ++l) for (int k = 0; k < 13; ++k) { const float d = (float)((unsigned long long*)(args.ws + WS_CTL + 512 * 1024))[l * 16 + k] * 0.01f;
            if (((TA_MASK >> k) & 1) && (TA_PAR == 2 || (l & 1) == TA_PAR)) ta += d; if (((TB_MASK >> k) & 1) && (TB_PAR == 2 || (l & 1) == TB_PAR)) tb += d; }
        for (size_t i = (size_t)blockIdx.x * 512 + F.tid; i < (size_t)T * DM; i += (size_t)gridDim.x * 512) args.out[i] = ta;
        VM_WAIT(); __syncthreads(); if (multi) xcd_barrier(bar);
        if (blockIdx.x == 0 && F.tid == 0) args.out[0] = tb * 100.f;
    }
#endif
#undef IN
#undef SEAM
}

extern "C" void kernel_launch(void* const* d_in, const int* in_sizes, int n_in, void* d_out, int out_size, void* d_ws, size_t ws_size, hipStream_t stream) {
    static int grid = 0;
    if (grid == 0) {
        if (n_in != 29 || in_sizes[0] != T * DM || out_size != T * DM || ws_size < WS_END) { fprintf(stderr, "kernel_launch: unexpected shapes / workspace (n_in %d, ws %zu, need %zu)\n", n_in, ws_size, (size_t)WS_END); grid = -1; return; }
        int dev = 0, cus = 0, per_cu = 0;
        if (hipGetDevice(&dev) != hipSuccess || hipDeviceGetAttribute(&cus, hipDeviceAttributeMultiprocessorCount, dev) != hipSuccess) { grid = -1; return; }
        if (hipFuncSetAttribute((const void*)fwd, hipFuncAttributeMaxDynamicSharedMemorySize, LDS_BYTES) != hipSuccess) { fprintf(stderr, "kernel_launch: hipFuncSetAttribute failed\n"); grid = -1; return; }
        if (hipOccupancyMaxActiveBlocksPerMultiprocessor(&per_cu, (const void*)fwd, 512, LDS_BYTES) != hipSuccess || per_cu < 1) { fprintf(stderr, "kernel_launch: occupancy query says %d\n", per_cu); }
        (void)hipGetLastError();
        grid = cus;
    }
    if (grid < 0) return;
    if (hipMemsetAsync((char*)d_ws + WS_CTL, 0, CTL_BYTES, stream) != hipSuccess) return;
    Args a{};
    for (int i = 0; i < 29; ++i) a.in[i] = (const float*)d_in[i];
    a.out = (float*)d_out; a.ws = (unsigned char*)d_ws;
#if MK_ONE_LAUNCH
    a.ph_lo = 0; a.ph_hi = N_PHASES;
    hipLaunchKernelGGL(fwd, dim3(grid), dim3(512), LDS_BYTES, stream, a.in[0], a.in[1], a.in[2], a.in[3], a.in[4], a.in[5], a.in[6], a.in[7], a.in[8], a.in[9], a.in[10], a.in[11], a.in[12], a.in[13], a.in[14], a.in[15], a.in[16], a.in[17], a.in[18], a.in[19], a.in[20], a.in[21], a.in[22], a.in[23], a.in[24], a.in[25], a.in[26], a.in[27], a.in[28], a.out, a.ws, a.ph_lo, a.ph_hi);
#else
    for (int ph = 0; ph < N_PHASES; ++ph) {
        if ((ph % PH_PER_LAYER) > 12) continue;
        a.ph_lo = ph; a.ph_hi = ph + 1;
        hipLaunchKernelGGL(fwd, dim3(grid), dim3(512), LDS_BYTES, stream, a.in[0], a.in[1], a.in[2], a.in[3], a.in[4], a.in[5], a.in[6], a.in[7], a.in[8], a.in[9], a.in[10], a.in[11], a.in[12], a.in[13], a.in[14], a.in[15], a.in[16], a.in[17], a.in[18], a.in[19], a.in[20], a.in[21], a.in[22], a.in[23], a.in[24], a.in[25], a.in[26], a.in[27], a.in[28], a.out, a.ws, a.ph_lo, a.ph_hi);
    }
#endif
}
```

```cpp
#include <hip/hip_runtime.h>
#include <cstdio>
#include <cstdint>

#define LAS __attribute__((address_space(3)))
#define GAS __attribute__((address_space(1)))
typedef unsigned short bf16_t;
typedef short bf16x8 __attribute__((ext_vector_type(8)));
typedef short s16x4 __attribute__((ext_vector_type(4)));
typedef float f32x2 __attribute__((ext_vector_type(2)));
typedef float f32x4 __attribute__((ext_vector_type(4)));
typedef float f32x16 __attribute__((ext_vector_type(16)));
typedef unsigned u32x2 __attribute__((ext_vector_type(2)));
typedef unsigned u32x4 __attribute__((ext_vector_type(4)));
typedef GAS unsigned gu32;

#ifndef SIDE_PX
#define SIDE_PX 3
#endif
#ifndef Y_FP8
#define Y_FP8 1
#endif
#ifndef MK_ONE_LAUNCH
#define MK_ONE_LAUNCH 1
#endif

constexpr int DM = 1024, NB = 32, SEQ = 2048, DEPTH = 4, T = NB * SEQ;
constexpr int EVEN_COLS = 2144, ODD_COLS = 3088, NE_PAD = 2304, NO_PAD = 3328;
constexpr int NEXP = 64, NV = 130  , HALF_T = T / 2, DFF = 256;
constexpr float LN_EPS = 1e-5f, RMS_EPS = 1e-6f;
constexpr float ALPHA = 1.6817928305074290f;
constexpr float LOG2E = 1.4426950408889634f;
constexpr float QK_C = 0.125f * LOG2E;
constexpr float NEGBIG = -1e30f;

constexpr int EC_QA = 0, EC_QB = 512, EC_QI = 1024, EC_KA = 1536, EC_KI = 1600, EC_KS = 1664, EC_KW = 1728;
constexpr int EC_VA = 1792, EC_KC = 1856, EC_VC = 1920, EC_VS = 1984, EC_VW = 2048, EC_WI = 2112, EC_GB = 2120;

constexpr size_t MiB = 1u << 20;
constexpr size_t WS_CTL = 0, CTL_BYTES = 1 * MiB;
constexpr size_t WS_ROPE_COS = 1 * MiB, WS_ROPE_SIN = WS_ROPE_COS + 256 * 1024;
constexpr size_t WS_SLOT_TK = 2 * MiB;
constexpr size_t WS_SLOT_G = WS_SLOT_TK + (size_t)NV * HALF_T * 4;
constexpr size_t WS_DCUM = 38 * MiB;
constexpr size_t WS_LOGF = 42 * MiB;
constexpr size_t WS_KC = 46 * MiB, WS_VC = WS_KC + 512 * 1024;
constexpr size_t WS_SSQ = 47 * MiB;
constexpr size_t WS_PB = 51 * MiB;
constexpr size_t WS_MISC = 83 * MiB;
constexpr size_t WS_XB = 84 * MiB;
constexpr size_t WS_W = 212 * MiB, W_BUF = 128 * MiB;
constexpr size_t W_IN = 0, W_O = 7 * MiB, W_G = 9 * MiB, W_P = 11 * MiB, W_RH = 11 * MiB + 512 * 1024, W_RL = W_RH + 128 * 1024  , W_C1K = 12 * MiB, W_C1V = W_C1K + 256 * 1024, W_C2K = W_C1V + 256 * 1024, W_C2V = W_C2K + 8192;
constexpr size_t W_UP = 16 * MiB  , W_DN = 82 * MiB  ;
constexpr size_t WS_R = 468 * MiB;
constexpr size_t R_H = 0, R_HMID = 0, R_E = 0, R_YTOK = 320 * MiB, R_XB2 = 440 * MiB;
constexpr size_t WS_END = WS_R + 896 * MiB;
static_assert(Y_FP8 == 1 && R_YTOK + (size_t)T * 9 * 1024 <= 896 * MiB, "ytok");
static_assert(W_DN + 65ull * 1024 * 256 * 2 <= 128 * MiB, "w");
constexpr int CW_BAR = 4096;
constexpr int CW_CNT = 16384;
constexpr int XBW = 3456;

constexpr int RING_BYTES = 131072;
constexpr int LDS_TAB = RING_BYTES;
constexpr int LDS_MISC = RING_BYTES + 20480;
constexpr int LDS_BYTES = RING_BYTES + 20480 + 256;

#define LDS_WAIT() asm volatile("s_waitcnt lgkmcnt(0)" ::: "memory")
#define VM_WAIT() asm volatile("s_waitcnt vmcnt(0)" ::: "memory")
#define RLX_AGENT __ATOMIC_RELAXED, __HIP_MEMORY_SCOPE_AGENT
__device__ __forceinline__ unsigned f2bf(float f) { unsigned u = __builtin_bit_cast(unsigned, f); return (u + 0x7fffu + ((u >> 16) & 1u)) >> 16; }
__device__ __forceinline__ unsigned pk2(float lo, float hi) { return f2bf(lo) | (f2bf(hi) << 16); }
__device__ __forceinline__ float bf2f(unsigned short h) { return __builtin_bit_cast(float, (unsigned)h << 16); }
__device__ __forceinline__ float bflo(unsigned w) { return __builtin_bit_cast(float, w << 16); }
__device__ __forceinline__ float bfhi(unsigned w) { return __builtin_bit_cast(float, w & 0xffff0000u); }
template <int CTRL> __device__ __forceinline__ float dpp_mov(float x) { return __builtin_bit_cast(float, __builtin_amdgcn_update_dpp(0, __builtin_bit_cast(int, x), CTRL, 0xf, 0xf, true)); }
template <int CTRL> __device__ __forceinline__ unsigned dpp_movu(unsigned x) { return (unsigned)__builtin_amdgcn_update_dpp(0, (int)x, CTRL, 0xf, 0xf, true); }
#define DPP_X1 0xB1
#define DPP_X2 0x4E
#define DPP_HM 0x141
#define DPP_RM 0x140
__device__ __forceinline__ float bperm_xor(float x, int lane, int mask) { return __builtin_bit_cast(float, __builtin_amdgcn_ds_bpermute((lane ^ mask) << 2, __builtin_bit_cast(int, x))); }
__device__ __forceinline__ float sum_x32(float x, int lane) { return x + bperm_xor(x, lane, 32); }
__device__ __forceinline__ float max_x32(float x, int lane) { return fmaxf(x, bperm_xor(x, lane, 32)); }
__device__ __forceinline__ float sum_x16(float x, int lane) { return x + bperm_xor(x, lane, 16); }
__device__ __forceinline__ float wave_sum(float v) {
    v += dpp_mov<DPP_X1>(v); v += dpp_mov<DPP_X2>(v); v += dpp_mov<DPP_HM>(v); v += dpp_mov<DPP_RM>(v);
    const float r0 = __builtin_bit_cast(float, __builtin_amdgcn_readlane(__builtin_bit_cast(int, v), 0)), r1 = __builtin_bit_cast(float, __builtin_amdgcn_readlane(__builtin_bit_cast(int, v), 16)),
                r2 = __builtin_bit_cast(float, __builtin_amdgcn_readlane(__builtin_bit_cast(int, v), 32)), r3 = __builtin_bit_cast(float, __builtin_amdgcn_readlane(__builtin_bit_cast(int, v), 48));
    return (r0 + r1) + (r2 + r3);
}
__device__ __forceinline__ int wave_sum_i(int v) {
    v += __builtin_amdgcn_update_dpp(0, v, DPP_X1, 0xf, 0xf, true); v += __builtin_amdgcn_update_dpp(0, v, DPP_X2, 0xf, 0xf, true);
    v += __builtin_amdgcn_update_dpp(0, v, DPP_HM, 0xf, 0xf, true); v += __builtin_amdgcn_update_dpp(0, v, DPP_RM, 0xf, 0xf, true);
    return (__builtin_amdgcn_readlane(v, 0) + __builtin_amdgcn_readlane(v, 16)) + (__builtin_amdgcn_readlane(v, 32) + __builtin_amdgcn_readlane(v, 48));
}
__device__ __forceinline__ float fast_exp2(float x) { return __builtin_amdgcn_exp2f(x); }
__device__ __forceinline__ float sigmoidf_(float x) { return __builtin_amdgcn_rcpf(1.0f + __expf(-x)); }

#define XB_TMO      128
#define XB_XCNT(j)  (256  + 64 * (j))
#define XB_XSUB(j)  (1280 + 64 * (j))
#define XB_XGEN(j)  (2304 + 64 * (j))
#define XB_TOP      3328
#define XB_TOPGEN   3392
#define XCD_BAR_WORDS 3456
#define XB_SPIN_CAP (1u << 22)
__device__ __forceinline__ unsigned xb_ld(unsigned* p)              { return __hip_atomic_load(p, __ATOMIC_RELAXED, __HIP_MEMORY_SCOPE_AGENT); }
__device__ __forceinline__ unsigned xb_add(unsigned* p, unsigned v) { return __hip_atomic_fetch_add(p, v, __ATOMIC_RELAXED, __HIP_MEMORY_SCOPE_AGENT); }
__device__ __forceinline__ unsigned xb_xcc_id() { return (unsigned)__builtin_amdgcn_s_getreg((3 << 11) | 20) & 0xFu; }
#define XB_SPIN(cond, bar) do { unsigned _sp = 0; while (cond) { __builtin_amdgcn_s_sleep(1); \
    if ((++_sp & 255u) == 0u) { if (xb_ld(&(bar)[XB_TMO])) break; if (_sp > XB_SPIN_CAP) { atomicAdd(&(bar)[XB_TMO], 1u); break; } } } } while (0)
struct XcdBarrier { unsigned* bar; unsigned x; volatile LAS unsigned* st; };
__device__ __forceinline__ XcdBarrier xcd_barrier_post(unsigned* bar, volatile LAS unsigned* st) {
    XcdBarrier b; b.bar = bar; b.x = xb_xcc_id(); b.st = st;
    if (threadIdx.x == 0) (void)xb_add(&bar[XB_XCNT(b.x)], 1u);
    return b;
}
__device__ __forceinline__ void xcd_barrier_complete(unsigned* bar, unsigned x, unsigned& nloc, unsigned& nx) {
    const unsigned G = gridDim.x * gridDim.y * gridDim.z;
    unsigned sum, cnt, mine, sp = 0u;
    for (;;) {
        sum = 0u; cnt = 0u; mine = 0u;
#pragma unroll
        for (unsigned j = 0; j < 16; ++j) { const unsigned c = xb_ld(&bar[XB_XCNT(j)]); sum += c; cnt += (c > 0u) ? 1u : 0u; mine = (j == x) ? c : mine; }
        if (sum == G) break;
        __builtin_amdgcn_s_sleep(1);
        if ((++sp & 255u) == 0u) { if (xb_ld(&bar[XB_TMO])) break; if (sp > XB_SPIN_CAP) { atomicAdd(&bar[XB_TMO], 1u); break; } }
    }
    nloc = mine > 0u ? mine : 1u; nx = cnt > 0u ? cnt : 1u;
}
__device__ __forceinline__ void xcd_barrier(const XcdBarrier& b) {
    asm volatile("s_waitcnt vmcnt(0)" ::: "memory");
    __syncthreads();
    if (threadIdx.x == 0) {
        unsigned* bar = b.bar; unsigned bx = b.x; asm volatile("" : "+s"(bx)); asm volatile("" : "+s"(bar));
        __builtin_amdgcn_s_waitcnt(0);
        unsigned nloc = b.st[0], nx = b.st[1];
        if (nloc == 0u) { xcd_barrier_complete(bar, bx, nloc, nx); b.st[0] = nloc; b.st[1] = nx; }
        const unsigned old = xb_add(&bar[XB_XSUB(bx)], 1u);
        const unsigned gen = old / nloc;
        if (old + 1u == (gen + 1u) * nloc) {
            __builtin_amdgcn_fence(__ATOMIC_RELEASE, "agent");
            asm volatile("s_waitcnt vmcnt(0)" ::: "memory");
            const unsigned og = xb_add(&bar[XB_TOP], 1u);
            const unsigned tg = og / nx;
            if (og + 1u == (tg + 1u) * nx) xb_add(&bar[XB_TOPGEN], 1u);
            else XB_SPIN(xb_ld(&bar[XB_TOPGEN]) == tg, bar);
            __builtin_amdgcn_fence(__ATOMIC_ACQUIRE, "agent");
            xb_add(&bar[XB_XGEN(bx)], 1u);
            asm volatile("s_waitcnt vmcnt(0)" ::: "memory");
        } else {
            XB_SPIN(xb_ld(&bar[XB_XGEN(bx)]) == gen, bar);
            __builtin_amdgcn_fence(__ATOMIC_ACQUIRE, "agent");
            asm volatile("s_waitcnt vmcnt(0)" ::: "memory");
        }
    }
    __syncthreads();
}

namespace pg8 {
constexpr int BM = 256, BK = 64, HALF = 128, HTB = HALF * BK * 2, STAGE_BYTES = 8 * HTB, NXCD = 8, WGM = 8;
__host__ __device__ __forceinline__ int lds_byte(int r, int c) { const int st = (r >> 4) * 2 + (c >> 5), rr = r & 15, cc = c & 31, ob = rr * 64 + cc * 2; return st * 1024 + (ob ^ (((ob >> 9) & 1) << 5)); }
__host__ __device__ __forceinline__ void stage_rc(int b, int& R, int& C) { const int st = b / 1024, sb = b % 1024, swz = sb ^ (((sb >> 9) & 1) << 5); R = (st >> 1) * 16 + swz / 64; C = (st & 1) * 32 + (swz % 64) / 2; }
__host__ __device__ __forceinline__ int perm32(int rho) { const int n = rho >> 4, i = rho & 15; return 8 * (i >> 2) + 4 * n + (i & 3); }

struct Unit { int pm, pn, v, rb; };

__device__ __forceinline__ bool static_next(int nM, int nN, int G, int c, int i, Unit& u) {
    const int nwg = nM * nN; const long L = (long)i * G + c; if (L >= nwg) return false;
    int wgid = (int)L; { const int q = nwg / NXCD, r = nwg % NXCD, xcd = wgid % NXCD, off = wgid / NXCD; wgid = (xcd < r ? xcd * (q + 1) : r * (q + 1) + (xcd - r) * q) + off; }
    const int nig = WGM * nN, gid = wgid / nig, fm = gid * WGM, gsz = (nM - fm) < WGM ? (nM - fm) : WGM;
    u.pm = fm + ((wgid % nig) % gsz); u.pn = (wgid % nig) / gsz; u.v = 0; u.rb = 0; return true;
}
struct DenseSched {
    const char* A; const char* Bt; int lda, K, nM, nN, G, c;
    __device__ __forceinline__ bool next(int i, Unit& u) const { return static_next(nM, nN, G, c, i, u); }
    __device__ __forceinline__ bool next_after(int i, const Unit&, Unit& u) const { return next(i, u); }
    __device__ __forceinline__ bool same_rows(const Unit&, const Unit&) const { return false; }
    __device__ __forceinline__ const char* a_base(const Unit& u) const { return A + (size_t)u.pm * 256 * lda * 2; }
    __device__ __forceinline__ const char* b_base(const Unit& u) const { return Bt + (size_t)u.pn * 256 * K * 2; }
    __device__ __forceinline__ void a_off(const Unit&, const int (&R)[2], const int (&C)[2], unsigned (&o)[2][2]) const {
#pragma unroll
        for (int h = 0; h < 2; ++h)
#pragma unroll
            for (int i = 0; i < 2; ++i) o[h][i] = (unsigned)((h * 128 + R[i]) * lda + C[i]) * 2u;
    }
};

__device__ __forceinline__ unsigned cvt_pk_bf16(float lo, float hi) { unsigned r; asm volatile("v_cvt_pk_bf16_f32 %0, %1, %2" : "=v"(r) : "v"(lo), "v"(hi)); return r; }

template <class Epi, class Sched>
__device__ __forceinline__ void gemm_phase(LAS unsigned char* lds, const Sched& S, const Epi& E, int tid) {
    const int wid = __builtin_amdgcn_readfirstlane(tid >> 6), lane = tid & 63, wr = wid >> 2, wc = wid & 3, fr = lane & 15, fq = lane >> 4;
    const int K = S.K, nt = K / BK;
    int RR[2], CC[2]; unsigned voffB[2];
#pragma unroll
    for (int i = 0; i < 2; ++i) { int R, C; stage_rc(tid * 16 + i * 8192, R, C); const int Rb = Epi::PERM ? ((R & ~31) + perm32(R & 31)) : R;
        RR[i] = R; CC[i] = C; voffB[i] = (unsigned)(Rb * K + C) * 2u; }
    const size_t kstep = (size_t)(BK * 2);
    const size_t hstep = (size_t)HALF * K * 2;
    const unsigned ldsw = (unsigned)wid * 1024u;
    const int aoff = lds_byte(wr * 64 + fr, fq * 8), boff = lds_byte(wc * 32 + fr, fq * 8);
#define PG8_SA(b, h) (((b) * 2 + (h)) * HTB)
#define PG8_SB(b, h) ((4 + (b) * 2 + (h)) * HTB)
#define PG8_STAGE(bufoff, gbase, voff) do { _Pragma("unroll") for (int _i = 0; _i < 2; ++_i) \
        __builtin_amdgcn_global_load_lds((const unsigned*)((const char*)(gbase) + (voff)[_i]), (LAS unsigned*)(lds + (bufoff) + ldsw + _i * 8192), 16, 0, 0); } while (0)
#define PG8_LDA(dst, b, h) do { _Pragma("unroll") for (int m = 0; m < 4; ++m) _Pragma("unroll") for (int k = 0; k < 2; ++k) dst[m][k] = *(const LAS bf16x8*)(lds + PG8_SA(b, h) + aoff + m * 2048 + k * 1024); } while (0)
#define PG8_LDB(dst, b, h) do { _Pragma("unroll") for (int n = 0; n < 2; ++n) _Pragma("unroll") for (int k = 0; k < 2; ++k) dst[n][k] = *(const LAS bf16x8*)(lds + PG8_SB(b, h) + boff + n * 2048 + k * 1024); } while (0)
#define PG8_MMA(ai, bj, At, Bt) do { __builtin_amdgcn_s_setprio(1); _Pragma("unroll") for (int m = 0; m < 4; ++m) _Pragma("unroll") for (int n = 0; n < 2; ++n) _Pragma("unroll") for (int k = 0; k < 2; ++k) \
        acc[ai][bj][m][n] = __builtin_amdgcn_mfma_f32_16x16x32_bf16(Bt[n][k], At[m][k], acc[ai][bj][m][n], 0, 0, 0); __builtin_amdgcn_s_setprio(0); } while (0)
#define PG8_WAIT_V(n) asm volatile("s_waitcnt vmcnt(" #n ")" ::: "memory")
#define PG8_WAIT_L(n) asm volatile("s_waitcnt lgkmcnt(" #n ")" ::: "memory")
#define PG8_BAR __builtin_amdgcn_s_barrier()
#define PG8_SCHED __builtin_amdgcn_sched_barrier(0)
    Unit cur, nxt; int ui = 0;
    if (!S.next(0, cur)) return;
    f32x4 acc[2][2][4][2];
    float zz = 0.f; asm volatile("" : "+v"(zz));
#pragma unroll
    for (int a = 0; a < 2; ++a)
#pragma unroll
        for (int b = 0; b < 2; ++b)
#pragma unroll
            for (int m = 0; m < 4; ++m)
#pragma unroll
                for (int n = 0; n < 2; ++n) acc[a][b][m][n] = (f32x4){zz, zz, zz, zz};
    bf16x8 At[4][2], B0[2][2], B1[2][2];
    unsigned oa[2][2], on[2][2];
    S.a_off(cur, RR, CC, oa);
    const char* cA = S.a_base(cur); const char* cB = S.b_base(cur);
    PG8_STAGE(PG8_SB(0, 0), cB, voffB); PG8_STAGE(PG8_SB(0, 1), cB + hstep, voffB); PG8_STAGE(PG8_SA(0, 0), cA, oa[0]); PG8_STAGE(PG8_SA(0, 1), cA, oa[1]);
    if (wr == 1) PG8_BAR;
    PG8_WAIT_V(2); PG8_BAR;
    PG8_STAGE(PG8_SB(1, 0), cB + kstep, voffB); PG8_STAGE(PG8_SA(1, 0), cA + kstep, oa[0]); PG8_STAGE(PG8_SB(1, 1), cB + hstep + kstep, voffB);
    PG8_WAIT_V(6); PG8_BAR;
    for (;;) {
        const bool has_next = S.next_after(ui + 1, cur, nxt);
        const char* nA = has_next ? S.a_base(nxt) : cA; const char* nB = has_next ? S.b_base(nxt) : cB;
        if (has_next && !S.same_rows(cur, nxt)) S.a_off(nxt, RR, CC, on);
        else {
#pragma unroll
            for (int h = 0; h < 2; ++h)
#pragma unroll
                for (int i = 0; i < 2; ++i) on[h][i] = oa[h][i];
        }
        for (int t = 0; t < nt; t += 2) {
            const bool last = (t == nt - 2);
            const char* a1 = cA + (size_t)(t + 1) * kstep;
            const char* a2 = last ? nA : cA + (size_t)(t + 2) * kstep; const char* b2 = last ? nB : cB + (size_t)(t + 2) * kstep;
            const char* a3 = a2 + kstep; const char* b3 = b2 + kstep;
            unsigned x0[2], x1[2];
#pragma unroll
            for (int i = 0; i < 2; ++i) { x0[i] = last ? on[0][i] : oa[0][i]; x1[i] = last ? on[1][i] : oa[1][i]; }
            PG8_LDB(B0, 0, 0); PG8_LDB(B1, 0, 1); PG8_SCHED; PG8_LDA(At, 0, 0); PG8_STAGE(PG8_SA(1, 1), a1, oa[1]);
            PG8_WAIT_V(8); PG8_WAIT_L(0); PG8_BAR; PG8_MMA(0, 0, At, B0); PG8_MMA(0, 1, At, B1); PG8_BAR; PG8_SCHED;
            PG8_LDA(At, 0, 1); PG8_STAGE(PG8_SB(0, 0), b2, voffB); PG8_STAGE(PG8_SB(0, 1), b2 + hstep, voffB); PG8_STAGE(PG8_SA(0, 0), a2, x0);
            PG8_WAIT_V(8); PG8_WAIT_L(0); PG8_BAR; PG8_MMA(1, 0, At, B0); PG8_MMA(1, 1, At, B1); PG8_BAR; PG8_SCHED;
            PG8_LDB(B0, 1, 0); PG8_LDB(B1, 1, 1); PG8_SCHED; PG8_LDA(At, 1, 0); PG8_STAGE(PG8_SA(0, 1), a2, x1);
            PG8_WAIT_V(8); PG8_WAIT_L(0); PG8_BAR; PG8_MMA(0, 0, At, B0); PG8_MMA(0, 1, At, B1); PG8_BAR; PG8_SCHED;
            PG8_LDA(At, 1, 1); PG8_STAGE(PG8_SB(1, 0), b3, voffB); PG8_STAGE(PG8_SB(1, 1), b3 + hstep, voffB); PG8_STAGE(PG8_SA(1, 0), a3, x0);
            PG8_WAIT_V(8); PG8_WAIT_L(0); PG8_BAR; PG8_MMA(1, 0, At, B0); PG8_MMA(1, 1, At, B1); PG8_BAR; PG8_SCHED;
        }
        if (wr == 0) PG8_BAR;
        E(acc, cur, wr, wc, fr, fq);
        if (!has_next) break;
#pragma unroll
        for (int a = 0; a < 2; ++a)
#pragma unroll
            for (int b = 0; b < 2; ++b)
#pragma unroll
                for (int m = 0; m < 4; ++m)
#pragma unroll
                    for (int n = 0; n < 2; ++n) acc[a][b][m][n] = (f32x4){zz, zz, zz, zz};
        cur = nxt; cA = nA; cB = nB; ++ui;
#pragma unroll
        for (int h = 0; h < 2; ++h)
#pragma unroll
            for (int i = 0; i < 2; ++i) oa[h][i] = on[h][i];
        if (wr == 1) PG8_BAR;
    }
    PG8_WAIT_V(0);
    PG8_BAR;
#undef PG8_SA
#undef PG8_SB
#undef PG8_STAGE
#undef PG8_LDA
#undef PG8_LDB
#undef PG8_MMA
#undef PG8_WAIT_V
#undef PG8_WAIT_L
#undef PG8_BAR
#undef PG8_SCHED
}
}

using pg8::Unit;
__device__ __forceinline__ u32x4 pack8(f32x4 a, f32x4 b) { u32x4 w; w.x = pg8::cvt_pk_bf16(a[0], a[1]); w.y = pg8::cvt_pk_bf16(a[2], a[3]); w.z = pg8::cvt_pk_bf16(b[0], b[1]); w.w = pg8::cvt_pk_bf16(b[2], b[3]); return w; }

struct EpiInEven {
    static constexpr bool PERM = true;
    bf16_t* H; const float* cosT; const float* sinT;
    __device__ __forceinline__ void operator()(const f32x4 (&acc)[2][2][4][2], const Unit& u, int wr, int wc, int fr, int fq) const {
        const int row0 = u.pm * 256 + wr * 64 + fr, col0 = u.pn * 256 + wc * 32 + 8 * fq;
        const bool rope = u.pn < 7; const int j0 = (wc & 1) * 16 + 4 * fq;
#pragma unroll
        for (int ai = 0; ai < 2; ++ai) {
            f32x4 cs[4], sn[4];
#pragma unroll
            for (int m = 0; m < 4; ++m) { const int pos = (row0 + ai * 128 + m * 16) & (SEQ - 1);
                cs[m] = (f32x4){1.f, 1.f, 1.f, 1.f}; sn[m] = (f32x4){0.f, 0.f, 0.f, 0.f};
                if (rope) { cs[m] = *(const f32x4*)(cosT + pos * 32 + j0); sn[m] = *(const f32x4*)(sinT + pos * 32 + j0); } }
#pragma unroll
            for (int m = 0; m < 4; ++m) {
                const int row = row0 + ai * 128 + m * 16; const f32x4 c = cs[m], z = sn[m];
                bf16_t* rowp = H + (size_t)row * NE_PAD + col0;
#pragma unroll
                for (int bj = 0; bj < 2; ++bj) {
                    const f32x4 v0 = acc[ai][bj][m][0], v1 = acc[ai][bj][m][1];
                    f32x4 o0, o1;
                    o0[0] = v0[0] * c[0] - v0[1] * z[0]; o0[1] = v0[1] * c[0] + v0[0] * z[0];
                    o0[2] = v0[2] * c[1] - v0[3] * z[1]; o0[3] = v0[3] * c[1] + v0[2] * z[1];
                    o1[0] = v1[0] * c[2] - v1[1] * z[2]; o1[1] = v1[1] * c[2] + v1[0] * z[2];
                    o1[2] = v1[2] * c[3] - v1[3] * z[3]; o1[3] = v1[3] * c[3] + v1[2] * z[3];
                    *(u32x4*)(rowp + bj * 128) = pack8(o0, o1);
                }
            }
        }
    }
};
struct EpiInOdd {
    static constexpr bool PERM = true;
    bf16_t* H; float* logf; const float* bf;
    __device__ __forceinline__ void operator()(const f32x4 (&acc)[2][2][4][2], const Unit& u, int wr, int wc, int fr, int fq) const {
        const int row0 = u.pm * 256 + wr * 64 + fr, col0 = u.pn * 256 + wc * 32 + 8 * fq;
        float zz = 0.f; asm volatile("" : "+v"(zz));
#pragma unroll
        for (int ai = 0; ai < 2; ++ai)
#pragma unroll
            for (int m = 0; m < 4; ++m) {
                const int row = row0 + ai * 128 + m * 16;
                bf16_t* rowp = H + (size_t)row * NO_PAD + col0;
#pragma unroll
                for (int bj = 0; bj < 2; ++bj) *(u32x4*)(rowp + bj * 128) = pack8(acc[ai][bj][m][0] + zz, acc[ai][bj][m][1] + zz);
                if (u.pn == 12 && wc == 0 && fq < 2) {
                    f32x4 r0, r1;
#pragma unroll
                    for (int j = 0; j < 4; ++j) {
                        const float x0 = acc[ai][0][m][0][j] + bf[8 * fq + j], x1 = acc[ai][0][m][1][j] + bf[8 * fq + 4 + j];
                        r0[j] = fminf(x0, 0.f) - log1pf(__expf(-fabsf(x0))); r1[j] = fminf(x1, 0.f) - log1pf(__expf(-fabsf(x1)));
                    }
                    *(f32x4*)(logf + (size_t)row * 16 + 8 * fq) = r0; *(f32x4*)(logf + (size_t)row * 16 + 8 * fq + 4) = r1;
                }
                asm volatile("" ::: "memory");
            }
    }
};
struct EpiOut {
    static constexpr bool PERM = true;
    const bf16_t* X; bf16_t* Y;
    __device__ __forceinline__ void operator()(const f32x4 (&acc)[2][2][4][2], const Unit& u, int wr, int wc, int fr, int fq) const {
        const int row0 = u.pm * 256 + wr * 64 + fr, col0 = u.pn * 256 + wc * 32 + 8 * fq;
#pragma unroll
        for (int ai = 0; ai < 2; ++ai) {
            u32x4 x[4][2];
#pragma unroll
            for (int m = 0; m < 4; ++m) { const size_t off = (size_t)(row0 + ai * 128 + m * 16) * DM + col0;
#pragma unroll
                for (int bj = 0; bj < 2; ++bj) x[m][bj] = *(const u32x4*)(X + off + bj * 128); }
#pragma unroll
            for (int m = 0; m < 4; ++m) { const size_t off = (size_t)(row0 + ai * 128 + m * 16) * DM + col0;
#pragma unroll
                for (int bj = 0; bj < 2; ++bj) { const u32x4 w = x[m][bj]; const f32x4 a0 = acc[ai][bj][m][0], a1 = acc[ai][bj][m][1];
                    const f32x4 o0 = {bflo(w.x) * ALPHA + a0[0], bfhi(w.x) * ALPHA + a0[1], bflo(w.y) * ALPHA + a0[2], bfhi(w.y) * ALPHA + a0[3]};
                    const f32x4 o1 = {bflo(w.z) * ALPHA + a1[0], bfhi(w.z) * ALPHA + a1[1], bflo(w.w) * ALPHA + a1[2], bfhi(w.w) * ALPHA + a1[3]};
                    *(u32x4*)(Y + off + bj * 128) = pack8(o0, o1); } }
        }
    }
};
struct EpiUp {
    static constexpr bool PERM = false;
    bf16_t* Hm;
    __device__ __forceinline__ void operator()(const f32x4 (&acc)[2][2][4][2], const Unit& u, int wr, int wc, int fr, int fq) const {
        const int row0 = u.pm * 256 + wr * 64 + fr, col0 = u.pn * 128 + wc * 16 + 4 * fq;
#pragma unroll
        for (int ai = 0; ai < 2; ++ai)
#pragma unroll
            for (int m = 0; m < 4; ++m) {
                bf16_t* rowp = Hm + (size_t)(row0 + ai * 128 + m * 16) * DFF + col0;
#pragma unroll
                for (int bj = 0; bj < 2; ++bj) {
                    const f32x4 a = acc[ai][bj][m][0], b = acc[ai][bj][m][1]; f32x4 h;
#pragma unroll
                    for (int j = 0; j < 4; ++j) h[j] = a[j] * b[j] * __builtin_amdgcn_rcpf(1.0f + fast_exp2(-a[j] * LOG2E));
                    u32x2 w; w.x = pg8::cvt_pk_bf16(h[0], h[1]); w.y = pg8::cvt_pk_bf16(h[2], h[3]);
                    *(u32x2*)(rowp + bj * 64) = w;
                }
            }
    }
};
struct EpiDown {
    static constexpr bool PERM = true;
    bf16_t* Y; const int* slot_tk; const float* slot_g; const LAS int* cnt; bool dense; LAS int* rc;
    __device__ __forceinline__ void operator()(const f32x4 (&acc)[2][2][4][2], const Unit& u, int wr, int wc, int fr, int fq) const {
        const int e = u.v % 65, half = u.v / 65, n = cnt[u.v];
        const int col0 = u.pn * 256 + wc * 32 + 8 * fq;
        int drow[8]; float gg[8];
        const int tagv = u.v * 4096 + u.rb + 1;
        const bool hit = !dense && (rc[wr] == tagv);
        if (hit) {
#pragma unroll
            for (int i = 0; i < 8; ++i) { const int rl = (i >> 2) * 128 + wr * 64 + (i & 3) * 16 + fr; drow[i] = rc[16 + 2 * rl]; gg[i] = __builtin_bit_cast(float, rc[16 + 2 * rl + 1]); }
        } else {
#pragma unroll
            for (int i = 0; i < 8; ++i) {
                const int pos = u.rb * 256 + (i >> 2) * 128 + wr * 64 + (i & 3) * 16 + fr;
                drow[i] = -1; gg[i] = 1.f;
                if (dense) { drow[i] = (u.pm & 63) * 256 + (i >> 2) * 128 + wr * 64 + (i & 3) * 16 + fr; }
                else if (pos < n) {
                    if (e == 64) drow[i] = (half * HALF_T + pos) * 9 + 8;
                    else { const int tk = slot_tk[(size_t)u.v * HALF_T + pos]; gg[i] = slot_g[(size_t)u.v * HALF_T + pos]; drow[i] = (tk >> 3) * 9 + (tk & 7); }
                }
            }
            if (!dense && wc == 0) {
                if (fq == 0) {
#pragma unroll
                    for (int i = 0; i < 8; ++i) { const int rl = (i >> 2) * 128 + wr * 64 + (i & 3) * 16 + fr; rc[16 + 2 * rl] = drow[i]; rc[16 + 2 * rl + 1] = __builtin_bit_cast(int, gg[i]); } }
                asm volatile("s_waitcnt lgkmcnt(0)" ::: "memory");
                if (fq == 0 && fr == 0) rc[wr] = tagv;
            }
        }
#pragma unroll
        for (int ai = 0; ai < 2; ++ai)
#pragma unroll
            for (int m = 0; m < 4; ++m) {
                const int i = ai * 4 + m;
                if (drow[i] >= 0) {
#if Y_FP8
                    const float g = gg[i] * 32.0f; unsigned char* rowp = (unsigned char*)Y + (size_t)drow[i] * DM + col0;
#pragma unroll
                    for (int bj = 0; bj < 2; ++bj) { f32x4 v0 = acc[ai][bj][m][0] * g, v1 = acc[ai][bj][m][1] * g; u32x2 w;
#pragma unroll
                        for (int q = 0; q < 4; ++q) { v0[q] = __builtin_amdgcn_fmed3f(v0[q], -416.0f, 416.0f); v1[q] = __builtin_amdgcn_fmed3f(v1[q], -416.0f, 416.0f); }
                        w.x = __builtin_amdgcn_cvt_pk_fp8_f32(v0[0], v0[1], 0u, false); w.x = __builtin_amdgcn_cvt_pk_fp8_f32(v0[2], v0[3], w.x, true);
                        w.y = __builtin_amdgcn_cvt_pk_fp8_f32(v1[0], v1[1], 0u, false); w.y = __builtin_amdgcn_cvt_pk_fp8_f32(v1[2], v1[3], w.y, true);
                        *(u32x2*)(rowp + bj * 128) = w; }
#else
                    const float g = gg[i]; bf16_t* rowp = Y + (size_t)drow[i] * DM + col0;
#pragma unroll
                    for (int bj = 0; bj < 2; ++bj) *(u32x4*)(rowp + bj * 128) = pack8(acc[ai][bj][m][0] * g, acc[ai][bj][m][1] * g);
#endif
                }
            }
    }
};
struct EpiPleE {
    static constexpr bool PERM = true;
    bf16_t* E; float* ssq;
    __device__ __forceinline__ void operator()(const f32x4 (&acc)[2][2][4][2], const Unit& u, int wr, int wc, int fr, int fq) const {
        const int row0 = u.pm * 256 + wr * 64 + fr, col0 = u.pn * 256 + wc * 32 + 8 * fq;
        float zz = 0.f; asm volatile("" : "+v"(zz));
#pragma unroll
        for (int ai = 0; ai < 2; ++ai)
#pragma unroll
            for (int m = 0; m < 4; ++m) {
                const int row = row0 + ai * 128 + m * 16;
                bf16_t* rowp = E + (size_t)row * DM + col0; float s = 0.f;
#pragma unroll
                for (int bj = 0; bj < 2; ++bj) {
                    const f32x4 a = acc[ai][bj][m][0] + zz, b = acc[ai][bj][m][1] + zz;
                    s += (a[0] * a[0] + a[1] * a[1]) + (a[2] * a[2] + a[3] * a[3]) + (b[0] * b[0] + b[1] * b[1]) + (b[2] * b[2] + b[3] * b[3]);
                    *(u32x4*)(rowp + bj * 128) = pack8(a, b);
                }
                s = sum_x16(s, fr + 16 * fq); s = sum_x32(s, fr + 16 * fq);
                if (fq == 0) ssq[(size_t)row * 16 + u.pn * 4 + wc] = s;
                asm volatile("" ::: "memory");
            }
    }
};
struct EpiPleG {
    static constexpr bool PERM = true;
    const bf16_t* X; const bf16_t* E; const float* ssq; const float* g; bf16_t* XO; float* OUTF;
    __device__ __forceinline__ void operator()(const f32x4 (&acc)[2][2][4][2], const Unit& u, int wr, int wc, int fr, int fq) const {
        const int row0 = u.pm * 256 + wr * 64 + fr, col0 = u.pn * 256 + wc * 32 + 8 * fq, lane = fr + 16 * fq;
#pragma unroll
        for (int ai = 0; ai < 2; ++ai)
#pragma unroll
            for (int mp = 0; mp < 2; ++mp) {
                u32x4 x[2][2], ew[2][2]; f32x4 sq[2];
#pragma unroll
                for (int mm = 0; mm < 2; ++mm) { const int row = row0 + ai * 128 + (2 * mp + mm) * 16; const size_t off = (size_t)row * DM + col0;
                    sq[mm] = *(const f32x4*)(ssq + (size_t)row * 16 + 4 * fq);
#pragma unroll
                    for (int bj = 0; bj < 2; ++bj) { x[mm][bj] = *(const u32x4*)(X + off + bj * 128); ew[mm][bj] = *(const u32x4*)(E + off + bj * 128); } }
#pragma unroll
                for (int mm = 0; mm < 2; ++mm) { const int m = 2 * mp + mm; const size_t off = (size_t)(row0 + ai * 128 + m * 16) * DM + col0;
                    float t = (sq[mm][0] + sq[mm][1]) + (sq[mm][2] + sq[mm][3]); t = sum_x16(t, lane); t = sum_x32(t, lane); const float r = 1.0f / sqrtf(t * (1.0f / DM) + RMS_EPS);
#pragma unroll
                    for (int bj = 0; bj < 2; ++bj) { const u32x4 xw = x[mm][bj], e = ew[mm][bj]; const f32x4 a0 = acc[ai][bj][m][0], a1 = acc[ai][bj][m][1];
                        const f32x4 g0 = *(const f32x4*)(g + col0 + bj * 128), g1 = *(const f32x4*)(g + col0 + bj * 128 + 4);
                        f32x4 o0, o1;
                        o0[0] = bflo(xw.x) + sigmoidf_(a0[0]) * (bflo(e.x) * r) * g0[0]; o0[1] = bfhi(xw.x) + sigmoidf_(a0[1]) * (bfhi(e.x) * r) * g0[1];
                        o0[2] = bflo(xw.y) + sigmoidf_(a0[2]) * (bflo(e.y) * r) * g0[2]; o0[3] = bfhi(xw.y) + sigmoidf_(a0[3]) * (bfhi(e.y) * r) * g0[3];
                        o1[0] = bflo(xw.z) + sigmoidf_(a1[0]) * (bflo(e.z) * r) * g1[0]; o1[1] = bfhi(xw.z) + sigmoidf_(a1[1]) * (bfhi(e.z) * r) * g1[1];
                        o1[2] = bflo(xw.w) + sigmoidf_(a1[2]) * (bflo(e.w) * r) * g1[2]; o1[3] = bfhi(xw.w) + sigmoidf_(a1[3]) * (bfhi(e.w) * r) * g1[3];
                        if (XO) *(u32x4*)(XO + off + bj * 128) = pack8(o0, o1);
                        if (OUTF) { *(f32x4*)(OUTF + off + bj * 128) = o0; *(f32x4*)(OUTF + off + bj * 128 + 4) = o1; } } }
            }
    }
};

struct MoeSched {
    const char* A; const char* W; int lda, K, npn; size_t wstride;
    const LAS int* rbs; const LAS int* cnt; int vlo, vhi, rb0, nunits, G, c; const int* slot_tk; bool gather; int gxl;
    __device__ __forceinline__ bool next(int i, Unit& u) const {
        const int nrb = nunits / npn;
        if ((G & 7) != 0) { const int r2 = (i / npn) * G + c; if (r2 >= nrb) return false; u.pn = i % npn; return finish(rb0 + r2, u); }
        const int chunk = (nrb + 7) >> 3, gx = gxl, x = c & 7, j = c >> 3;
        if (j >= gx) return false;
        int clen = nrb - x * chunk; clen = clen < 0 ? 0 : (clen > chunk ? chunk : clen);
        const int fr = clen / gx, ifull = fr * npn;
        int li, pn;
        if (i < ifull) { li = j + (i / npn) * gx; pn = i % npn; }
        else { const int q = (i - ifull) * gx + j; if (q >= (clen - fr * gx) * npn) return false;
               li = fr * gx + q / npn; pn = q % npn; }
        u.pn = pn; return finish(rb0 + x * chunk + li, u);
    }
    __device__ __forceinline__ bool next_after(int i, const Unit& prev, Unit& u) const {
        if ((G & 7) != 0 || (npn & (npn - 1)) != 0) return next(i, u);
        if (prev.pn + 1 < npn && (i & (npn - 1)) == prev.pn + 1) {
            if (i < nfull()) { u = prev; u.pn = prev.pn + 1; return true; }
        }
        return next(i, u);
    }
    __device__ __forceinline__ int nfull() const {
        const int nrb = nunits / npn, chunk = (nrb + 7) >> 3, x = c & 7;
        int clen = nrb - x * chunk; clen = clen < 0 ? 0 : (clen > chunk ? chunk : clen);
        return (clen / gxl) * npn;
    }
    __device__ __forceinline__ bool finish(int rbg, Unit& u) const {
        int lo = vlo, hi = vhi;
        while (lo < hi) { const int mid = (lo + hi + 1) >> 1; if (rbs[mid] <= rbg) lo = mid; else hi = mid - 1; }
        u.v = lo; u.rb = rbg - rbs[lo]; u.pm = rbg; return true;
    }
    __device__ __forceinline__ bool same_rows(const Unit& u, const Unit& w) const { return gather && u.v == w.v && u.rb == w.rb; }
    __device__ __forceinline__ const char* a_base(const Unit& u) const { return gather ? A : A + (size_t)u.pm * 256 * lda * 2; }
    __device__ __forceinline__ const char* b_base(const Unit& u) const { return W + (size_t)(u.v % 65) * wstride + (size_t)u.pn * 256 * K * 2; }
    __device__ __forceinline__ void a_off(const Unit& u, const int (&R)[2], const int (&C)[2], unsigned (&o)[2][2]) const {
        if (gather) {
            const int e = u.v % 65, half = u.v / 65, n = cnt[u.v];
#pragma unroll
            for (int h = 0; h < 2; ++h)
#pragma unroll
                for (int i = 0; i < 2; ++i) {
                    const int pos = u.rb * 256 + h * 128 + R[i]; int tok;
                    if (e == 64) tok = half * HALF_T + pos;
                    else tok = pos < n ? (slot_tk[(size_t)u.v * HALF_T + pos] >> 3) : 0;
                    o[h][i] = (unsigned)(tok * lda + C[i]) * 2u;
                    asm volatile("" : "+v"(o[h][i]));
                }
        } else {
#pragma unroll
            for (int h = 0; h < 2; ++h)
#pragma unroll
                for (int i = 0; i < 2; ++i) o[h][i] = (unsigned)((h * 128 + R[i]) * lda + C[i]) * 2u;
        }
    }
};

struct Args {
    const float* in[29]; float* out; unsigned char* ws; int ph_lo, ph_hi;
};
enum InIdx { I_X = 0, I_P, I_EV_WIN, I_EV_BGATE, I_CPK, I_CW1K, I_CW2K, I_CPV, I_CW1V, I_CW2V, I_EV_WO, I_OD_WIN, I_OD_BF, I_OD_WO,
             I_LN1G, I_LN1B, I_LN2G, I_LN2B, I_RW, I_RB, I_EW1, I_EW3, I_EW2, I_SW1, I_SW3, I_SW2, I_PWG, I_PWP, I_PNG };
__device__ __forceinline__ size_t wbuf_off(int layer) { int p = __builtin_amdgcn_readfirstlane(layer & 1); asm volatile("" : "+s"(p)); return (size_t)p * W_BUF; }
struct Frame {
    LAS unsigned char* lds; int tid, lane, wave, G, bid;
    unsigned char* ws; gu32* ctl;
};

__device__ __forceinline__ int rope_perm(int d) { return 2 * (d & 31) + (d >> 5); }
__device__ __forceinline__ int map_even(int c) {
    if (c < 512) return EC_QA + (c & ~63) + rope_perm(c & 63);
    if (c < 576) return EC_KA + rope_perm(c - 512);
    if (c < 640) return EC_VA + (c - 576);
    if (c < 1152) { const int r = c - 640; return EC_QI + (r & ~63) + rope_perm(r & 63); }
    if (c < 1216) return EC_KI + rope_perm(c - 1152);
    if (c < 1224) return EC_WI + (c - 1216);
    if (c < 1736) { const int r = c - 1224; return EC_QB + (r & ~63) + rope_perm(r & 63); }
    if (c < 2120) { const int r = c - 1736, j = r >> 6, d = r & 63;
        switch (j) { case 0: return EC_KC + d; case 1: return EC_VC + d; case 2: return EC_KS + rope_perm(d); case 3: return EC_VS + d; case 4: return EC_KW + rope_perm(d); default: return EC_VW + d; } }
    return EC_GB + (c - 2120);
}
enum MapId { MAP_ID = 0, MAP_EVEN, MAP_W1, MAP_W3, MAP_ROPE };
__device__ __forceinline__ int map_col(int id, int c) {
    switch (id) { case MAP_EVEN: return map_even(c); case MAP_W1: return 32 * (c >> 4) + (c & 15); case MAP_W3: return 32 * (c >> 4) + 16 + (c & 15); case MAP_ROPE: return rope_perm(c); default: return c; }
}
__device__ __forceinline__ void tr_load(f32x4 (&v)[16], const float* src, int ldn, int ncols, int k0, int n0, int lane) {
    const int cq = 4 * (lane & 15), rq = lane >> 4;
    const bool full = (n0 + 64 <= ncols);
#pragma unroll
    for (int i = 0; i < 16; ++i) {
        const float* p = src + (size_t)(k0 + 4 * i + rq) * ldn + n0 + cq;
        if (full) v[i] = *(const f32x4*)p;
        else { v[i][0] = (n0 + cq + 0 < ncols) ? p[0] : 0.f; v[i][1] = (n0 + cq + 1 < ncols) ? p[1] : 0.f; v[i][2] = (n0 + cq + 2 < ncols) ? p[2] : 0.f; v[i][3] = (n0 + cq + 3 < ncols) ? p[3] : 0.f; }
    }
}
__device__ __forceinline__ void tr_finish(const f32x4 (&v)[16], int ncols, bf16_t* dst, int dpitch, int k0, int n0, int mapid, LAS unsigned short* scr, int lane, const float* rscale, bool lo) {
    const int cq = 4 * (lane & 15), rq = lane >> 4;
    if (rscale == nullptr && !lo) {
#pragma unroll
        for (int i = 0; i < 16; ++i) {
#pragma unroll
            for (int j = 0; j < 4; ++j) scr[(cq + j) * 72 + 4 * i + rq] = (unsigned short)f2bf(v[i][j]); }
    } else {
#pragma unroll
        for (int i = 0; i < 16; ++i) {
            const int k = 4 * i + rq; const float rs = rscale ? rscale[k0 + k] : 1.f;
#pragma unroll
            for (int j = 0; j < 4; ++j) { float x = v[i][j] * rs; if (lo) x -= bf2f((unsigned short)f2bf(x));
                scr[(cq + j) * 72 + k] = (unsigned short)f2bf(x); }
        }
    }
    LDS_WAIT(); asm volatile("" ::: "memory");
    const int c = lane & 7;
#pragma unroll
    for (int j = 0; j < 8; ++j) { const int nl = (lane >> 3) + 8 * j, n = n0 + nl;
        const u32x4 o = *(const LAS u32x4*)(scr + nl * 72 + 8 * c);
        if (n < ncols) *(u32x4*)(dst + (size_t)map_col(mapid, n) * dpitch + k0 + 8 * c) = o; }
    LDS_WAIT(); asm volatile("" ::: "memory");
}
__device__ __forceinline__ void tr_item(const float* src, int ldn, int ncols, bf16_t* dst, int dpitch, int k0, int n0, int mapid, LAS unsigned short* scr, int lane, const float* rscale = nullptr, bool lo = false) {
    f32x4 v[16]; tr_load(v, src, ldn, ncols, k0, n0, lane); tr_finish(v, ncols, dst, dpitch, k0, n0, mapid, scr, lane, rscale, lo);
}
__device__ __forceinline__ void sincos_d(double a, float& s, float& c) {
    const double TWO_PI = 6.283185307179586476925286766559, INV = 0.15915494309189533576888376337251;
    const double k = rint(a * INV); double r = a - k * TWO_PI;
    const double r2 = r * r; double ts = 1.0, tc = 1.0;
#pragma unroll
    for (int i = 14; i >= 1; --i) { ts = 1.0 - ts * r2 / (double)((2 * i) * (2 * i + 1)); tc = 1.0 - tc * r2 / (double)((2 * i - 1) * (2 * i)); }
    s = (float)(r * ts); c = (float)tc;
}

struct TrJob { const float* src; bf16_t* dst; int K, N, ldn, dpitch, mapid; const float* rscale; int lo; };
__device__ __forceinline__ TrJob get_job(const Args& a, unsigned char* wsp, int layer, int jid) {
    const int j = layer >> 1; const bool even = (layer & 1) == 0;
    bf16_t* W = (bf16_t*)(wsp + WS_W + wbuf_off(layer));
    TrJob t; t.mapid = MAP_ID; t.rscale = nullptr; t.lo = 0;
    if (jid == 0) { if (even) { t.src = a.in[I_EV_WIN] + (size_t)j * DM * EVEN_COLS; t.N = EVEN_COLS; t.mapid = MAP_EVEN; } else { t.src = a.in[I_OD_WIN] + (size_t)j * DM * ODD_COLS; t.N = ODD_COLS; }
        t.K = DM; t.ldn = t.N; t.dst = W + W_IN / 2; t.dpitch = DM; return t; }
    if (jid == 1) { t.src = (even ? a.in[I_EV_WO] : a.in[I_OD_WO]) + (size_t)j * DM * DM; t.K = DM; t.N = DM; t.ldn = DM; t.dst = W + W_O / 2; t.dpitch = DM; return t; }
    if (jid == 2) { t.src = a.in[I_PWG] + (size_t)layer * DM * DM; t.K = DM; t.N = DM; t.ldn = DM; t.dst = W + W_G / 2; t.dpitch = DM; return t; }
    if (jid == 3) { t.src = a.in[I_PWP] + (size_t)layer * 256 * DM; t.K = 256; t.N = DM; t.ldn = DM; t.dst = W + W_P / 2; t.dpitch = 256; return t; }
    if (jid < 8) {
        const int q = jid - 4;
        if (q == 0) { t.src = a.in[I_CW1K] + (size_t)j * 2048 * 64; t.K = 2048; t.dst = W + W_C1K / 2; t.dpitch = 2048; }
        else if (q == 1) { t.src = a.in[I_CW1V] + (size_t)j * 2048 * 64; t.K = 2048; t.dst = W + W_C1V / 2; t.dpitch = 2048; }
        else if (q == 2) { t.src = a.in[I_CW2K] + (size_t)j * 64 * 64; t.K = 64; t.dst = W + W_C2K / 2; t.dpitch = 64; t.mapid = MAP_ROPE; }
        else { t.src = a.in[I_CW2V] + (size_t)j * 64 * 64; t.K = 64; t.dst = W + W_C2V / 2; t.dpitch = 64; }
        t.N = 64; t.ldn = 64; return t; }
    if (jid < 10) {
        t.src = a.in[I_RW] + (size_t)layer * DM * NEXP; t.K = DM; t.N = NEXP; t.ldn = NEXP; t.dpitch = DM; t.rscale = a.in[I_LN1G] + layer * DM; t.lo = jid - 8; t.dst = W + (t.lo ? W_RL : W_RH) / 2; return t; }
    const int r = jid - 10, e = r / 3, w = r % 3;
    if (w < 2) { const float* s = (e == 64) ? a.in[w == 0 ? I_SW1 : I_SW3] + (size_t)layer * DM * DFF : a.in[w == 0 ? I_EW1 : I_EW3] + ((size_t)layer * NEXP + e) * DM * DFF;
        t.src = s; t.K = DM; t.N = DFF; t.ldn = DFF; t.dst = W + W_UP / 2 + (size_t)e * 512 * DM; t.dpitch = DM; t.mapid = (w == 0) ? MAP_W1 : MAP_W3; return t; }
    t.src = (e == 64) ? a.in[I_SW2] + (size_t)layer * DFF * DM : a.in[I_EW2] + ((size_t)layer * NEXP + e) * DFF * DM;
    t.K = DFF; t.N = DM; t.ldn = DM; t.dst = W + W_DN / 2 + (size_t)e * DM * DFF; t.dpitch = DFF; return t;
}
constexpr int NJOBS = 10 + 65 * 3;

__device__ __forceinline__ void prep_weights(const Frame& F, const Args& a, int layer, int wid, int nw) {
    const int gw = wid * 8 + F.wave, NGW = nw * 8, gt = wid * 512 + F.tid, NGT = nw * 512;
    LAS unsigned short* scr = (LAS unsigned short*)(F.lds + F.wave * 16384);
    int base = 0;
    for (int jid = 0; jid < 10; ++jid) {
        const TrJob jb = get_job(a, F.ws, layer, jid);
        const int nblk = (jb.N + 63) / 64, nit = (jb.K / 64) * nblk;
        int first = (gw - (base % NGW) + NGW) % NGW;
        for (int it = first; it < nit; it += 2 * NGW) {
            const int it2 = it + NGW; const bool two = it2 < nit;
            f32x4 va[16], vb[16];
            tr_load(va, jb.src, jb.ldn, jb.N, 64 * (it / nblk), 64 * (it % nblk), F.lane);
            if (two) tr_load(vb, jb.src, jb.ldn, jb.N, 64 * (it2 / nblk), 64 * (it2 % nblk), F.lane);
            tr_finish(va, jb.N, jb.dst, jb.dpitch, 64 * (it / nblk), 64 * (it % nblk), jb.mapid, scr, F.lane, jb.rscale, jb.lo != 0);
            if (two) tr_finish(vb, jb.N, jb.dst, jb.dpitch, 64 * (it2 / nblk), 64 * (it2 % nblk), jb.mapid, scr, F.lane, jb.rscale, jb.lo != 0);
        }
        base += nit;
    }
    {
        constexpr int NI = 65 * 3 * 64;
        int g = (gw - (base % NGW) + NGW) % NGW;
        f32x4 va[16], vb[16]; TrJob ja, jn;
#define EXP_LOAD(V, J, G) do { J = get_job(a, F.ws, layer, 10 + ((G) >> 6)); const int it_ = (G) & 63, sh_ = (J.N == 256) ? 2 : 4; tr_load(V, J.src, J.ldn, J.N, 64 * (it_ >> sh_), 64 * (it_ & ((1 << sh_) - 1)), F.lane); } while (0)
#define EXP_FIN(V, J, G) do { const int it_ = (G) & 63, sh_ = (J.N == 256) ? 2 : 4; tr_finish(V, J.N, J.dst, J.dpitch, 64 * (it_ >> sh_), 64 * (it_ & ((1 << sh_) - 1)), J.mapid, scr, F.lane, nullptr, false); } while (0)
        if (g < NI) EXP_LOAD(va, ja, g);
        while (g < NI) {
            const int g1 = g + NGW, g2 = g + 2 * NGW;
            if (g1 < NI) EXP_LOAD(vb, jn, g1);
            EXP_FIN(va, ja, g);
            if (g1 >= NI) break;
            if (g2 < NI) EXP_LOAD(va, ja, g2);
            EXP_FIN(vb, jn, g1);
            g = g2;
        }
#undef EXP_LOAD
#undef EXP_FIN
    }
    { const int r0 = (layer & 1) ? ODD_COLS : EVEN_COLS, r1 = (layer & 1) ? NO_PAD : NE_PAD; u32x4* z = (u32x4*)(F.ws + WS_W + wbuf_off(layer) + W_IN + (size_t)r0 * DM * 2);
      const int n16 = (r1 - r0) * DM * 2 / 16; unsigned zq = 0u; asm volatile("" : "+v"(zq)); for (int i = gt; i < n16; i += NGT) z[i] = (u32x4){zq, zq, zq, zq}; }
    if ((layer & 1) == 0 && wid < 2) {
        const int j = layer >> 1; const float* pe = a.in[wid == 0 ? I_CPK : I_CPV] + (size_t)j * 2048; const float* w1 = a.in[wid == 0 ? I_CW1K : I_CW1V] + (size_t)j * 2048 * 64;
        LAS float* red = (LAS float*)(F.lds + 8 * 16384);
        __syncthreads();
        const int n = F.tid & 63, part = F.tid >> 6; float s = 0.f;
        for (int k0 = part * 256; k0 < part * 256 + 256; k0 += 32) {
            float wv[32], pv[32];
#pragma unroll
            for (int q = 0; q < 32; ++q) { wv[q] = w1[(size_t)(k0 + q) * 64 + n]; pv[q] = pe[k0 + q]; }
#pragma unroll
            for (int q = 0; q < 32; ++q) s += pv[q] * wv[q]; }
        red[part * 64 + n] = s; __syncthreads();
        if (F.tid < 64) { float tot = 0.f; for (int q = 0; q < 8; ++q) tot += red[q * 64 + F.tid]; ((float*)(F.ws + WS_MISC))[wid * 64 + F.tid] = tot; }
        __syncthreads();
    }
}
__device__ __forceinline__ void prep_acts(const Frame& F, const Args& a, int layer, bool first) {
    const int gt = F.bid * 512 + F.tid, NGT = F.G * 512;
    { const f32x4* p = (const f32x4*)(a.in[I_P] + (size_t)layer * T * 256); u32x2* o = (u32x2*)(F.ws + WS_PB);
      for (int i = gt; i < T * 256 / 4; i += NGT) { const f32x4 v = p[i]; u32x2 w; w.x = pk2(v[0], v[1]); w.y = pk2(v[2], v[3]); o[i] = w; } }
    if (first) {
        const f32x4* x = (const f32x4*)a.in[I_X]; u32x2* o = (u32x2*)(F.ws + WS_XB);
        for (int i = gt; i < T * DM / 4; i += NGT) { const f32x4 v = x[i]; u32x2 w; w.x = pk2(v[0], v[1]); w.y = pk2(v[2], v[3]); o[i] = w; }
        float* ct = (float*)(F.ws + WS_ROPE_COS); float* st = (float*)(F.ws + WS_ROPE_SIN);
        for (int i = gt; i < SEQ * 32; i += NGT) { const int pos = i >> 5, j = i & 31; double inv = 1.0;
            for (int q = 0; q < j; ++q) inv *= 0.74989420933245582730;
            const float ang = (float)pos * (float)inv; float s, c; sincos_d((double)ang, s, c); ct[i] = c; st[i] = s; }
    }
    if (F.bid == F.G - 1) {
        const float* RW = a.in[I_RW] + (size_t)layer * DM * NEXP; const float* g1 = a.in[I_LN1G] + layer * DM; const float* b1 = a.in[I_LN1B] + layer * DM;
        LAS float* red = (LAS float*)(F.lds + 8 * 16384);
        __syncthreads();
        const int n = F.tid & 63, part = F.tid >> 6; float sc = 0.f, sb = 0.f;
        for (int k0 = part * 128; k0 < part * 128 + 128; k0 += 32) {
            float wv[32];
#pragma unroll
            for (int q = 0; q < 32; ++q) wv[q] = RW[(size_t)(k0 + q) * NEXP + n];
#pragma unroll
            for (int q = 0; q < 32; ++q) { sc += g1[k0 + q] * wv[q]; sb += b1[k0 + q] * wv[q]; } }
        red[part * 64 + n] = sc; red[512 + part * 64 + n] = sb; __syncthreads();
        if (F.tid < 128) { const int o = F.tid & 63, w = F.tid >> 6; float tot = 0.f; for (int q = 0; q < 8; ++q) tot += red[w * 512 + q * 64 + o]; ((float*)(F.ws + WS_MISC))[256 + F.tid] = tot; }
        __syncthreads();
    }
}

__device__ __forceinline__ void scan_phase(const Frame& F, const Args& a) {
    const float* lf = (const float*)(F.ws + WS_LOGF); float* dc = (float*)(F.ws + WS_DCUM);
    LAS float* wsum = (LAS float*)F.lds;
    for (int s = F.bid; s < NB * 16; s += F.G) {
        const int b = s >> 4, h = s & 15; const size_t base = ((size_t)b * SEQ) * 16 + h;
        float v[4]; float run = 0.f;
#pragma unroll
        for (int i = 0; i < 4; ++i) { run += lf[base + (size_t)(F.tid * 4 + i) * 16]; v[i] = run; }
        float inc = run;
        inc += dpp_mov<0x111>(inc); inc += dpp_mov<0x112>(inc); inc += dpp_mov<0x114>(inc); inc += dpp_mov<0x118>(inc);
        { const float r0 = __builtin_bit_cast(float, __builtin_amdgcn_readlane(__builtin_bit_cast(int, inc), 15)), r1 = __builtin_bit_cast(float, __builtin_amdgcn_readlane(__builtin_bit_cast(int, inc), 31)),
                      r2 = __builtin_bit_cast(float, __builtin_amdgcn_readlane(__builtin_bit_cast(int, inc), 47));
          const int rw = F.lane >> 4; inc += (rw == 1) ? r0 : (rw == 2) ? (r0 + r1) : (rw == 3) ? ((r0 + r1) + r2) : 0.f; }
        if (F.lane == 63) wsum[F.wave] = inc;
        __syncthreads();
        float off = inc - run;
        for (int w = 0; w < F.wave; ++w) off += wsum[w];
#pragma unroll
        for (int i = 0; i < 4; ++i) dc[base + (size_t)(F.tid * 4 + i) * 16] = (v[i] + off) * LOG2E;
        __syncthreads();
    }
}

__device__ __forceinline__ void ln_row16(float (&v)[16], const float* g, const float* b, int lane) {
    float s = 0.f;
#pragma unroll
    for (int i = 0; i < 16; ++i) s += v[i];
    const float mean = wave_sum(s) * (1.f / DM); float s2 = 0.f;
#pragma unroll
    for (int i = 0; i < 16; ++i) { v[i] -= mean; s2 += v[i] * v[i]; }
    const float rstd = 1.0f / sqrtf(wave_sum(s2) * (1.f / DM) + LN_EPS);
#pragma unroll
    for (int q = 0; q < 4; ++q) { const f32x4 gg = *(const f32x4*)(g + lane * 16 + 4 * q), bb = *(const f32x4*)(b + lane * 16 + 4 * q);
#pragma unroll
        for (int i = 0; i < 4; ++i) v[4 * q + i] = v[4 * q + i] * rstd * gg[i] + bb[i]; }
}
__device__ __forceinline__ void ln_stats16(const float (&v)[16], float& mean, float& rstd) {
    float s = 0.f;
#pragma unroll
    for (int i = 0; i < 16; ++i) s += v[i];
    mean = wave_sum(s) * (1.f / DM); float s2 = 0.f;
#pragma unroll
    for (int i = 0; i < 16; ++i) { const float d = v[i] - mean; s2 += d * d; }
    rstd = 1.0f / sqrtf(wave_sum(s2) * (1.f / DM) + LN_EPS);
}
__device__ __forceinline__ void ln_apply16(float (&v)[16], float mean, float rstd, const float* g, const float* b, int lane) {
#pragma unroll
    for (int q = 0; q < 4; ++q) { const f32x4 gg = *(const f32x4*)(g + lane * 16 + 4 * q), bb = *(const f32x4*)(b + lane * 16 + 4 * q);
#pragma unroll
        for (int i = 0; i < 4; ++i) v[4 * q + i] = (v[4 * q + i] - mean) * rstd * gg[i] + bb[i]; }
}
__device__ __forceinline__ void store_row16_bf(const float (&v)[16], bf16_t* xb, int lane) {
    u32x4 w0, w1; w0.x = pk2(v[0], v[1]); w0.y = pk2(v[2], v[3]); w0.z = pk2(v[4], v[5]); w0.w = pk2(v[6], v[7]);
    w1.x = pk2(v[8], v[9]); w1.y = pk2(v[10], v[11]); w1.z = pk2(v[12], v[13]); w1.w = pk2(v[14], v[15]);
    *(u32x4*)(xb + lane * 16) = w0; *(u32x4*)(xb + lane * 16 + 8) = w1;
}
__device__ __forceinline__ void store_row16(const float (&v)[16], float* xf, bf16_t* xb, int lane) {
#pragma unroll
    for (int q = 0; q < 4; ++q) *(f32x4*)(xf + lane * 16 + 4 * q) = (f32x4){v[4 * q], v[4 * q + 1], v[4 * q + 2], v[4 * q + 3]};
    u32x4 w0, w1; w0.x = pk2(v[0], v[1]); w0.y = pk2(v[2], v[3]); w0.z = pk2(v[4], v[5]); w0.w = pk2(v[6], v[7]);
    w1.x = pk2(v[8], v[9]); w1.y = pk2(v[10], v[11]); w1.z = pk2(v[12], v[13]); w1.w = pk2(v[14], v[15]);
    *(u32x4*)(xb + lane * 16) = w0; *(u32x4*)(xb + lane * 16 + 8) = w1;
}

#ifndef ROUTE_EXPT
#define ROUTE_EXPT 0
#endif
__device__ __forceinline__ void unpack16(const u32x4 w0, const u32x4 w1, float (&v)[16]) {
    v[0] = bflo(w0.x); v[1] = bfhi(w0.x); v[2] = bflo(w0.y); v[3] = bfhi(w0.y); v[4] = bflo(w0.z); v[5] = bfhi(w0.z); v[6] = bflo(w0.w); v[7] = bfhi(w0.w);
    v[8] = bflo(w1.x); v[9] = bfhi(w1.x); v[10] = bflo(w1.y); v[11] = bfhi(w1.y); v[12] = bflo(w1.z); v[13] = bfhi(w1.z); v[14] = bflo(w1.w); v[15] = bfhi(w1.w);
}
__device__ __forceinline__ void route_phase(const Frame& F, const Args& a, int layer, const bf16_t* X, bf16_t* XB, bool dummy) {
    const float* g = a.in[I_LN1G] + layer * DM; const float* bta = a.in[I_LN1B] + layer * DM;
    const float* RW = a.in[I_RW] + (size_t)layer * DM * NEXP; const float* RBs = a.in[I_RB] + layer * NEXP;
    int* slot_tk = (int*)(F.ws + WS_SLOT_TK); float* slot_g = (float*)(F.ws + WS_SLOT_G);
    gu32* cntg = F.ctl + CW_CNT + layer * 256;
    LAS float* lg = (LAS float*)(F.lds + F.wave * 8192);
    LAS unsigned* rec_e = (LAS unsigned*)(F.lds + 65536);
    LAS float* rec_g = (LAS float*)(F.lds + 65536 + 8192);
    LAS unsigned* lcnt = (LAS unsigned*)(F.lds + 65536 + 16384);
    LAS unsigned* gbase = lcnt + 64;
    const int lane = F.lane;
    for (int ub = F.bid; ub < T / 256; ub += F.G) {
        if (F.tid < 64) lcnt[F.tid] = 0u;
        __syncthreads();
        const int r0 = ub * 256 + F.wave * 32;
        LAS float* stl = (LAS float*)(F.lds + 65536 + 16384 + 512) + F.wave * 64;
        for (int r4 = 0; r4 < 32; r4 += 8) {
            u32x4 v4[8][2];
#pragma unroll
            for (int j = 0; j < 8; ++j) { const bf16_t* xr = X + (size_t)(r0 + r4 + j) * DM + lane * 16; v4[j][0] = *(const u32x4*)xr; v4[j][1] = *(const u32x4*)(xr + 8); }
#pragma unroll
            for (int j = 0; j < 8; ++j) { float v[16]; unpack16(v4[j][0], v4[j][1], v);
                float mean, rstd; ln_stats16(v, mean, rstd);
                if (lane == 0) { stl[2 * (r4 + j)] = mean; stl[2 * (r4 + j) + 1] = rstd; }
                ln_apply16(v, mean, rstd, g, bta, lane); store_row16_bf(v, XB + (size_t)(r0 + r4 + j) * DM, lane); }
        }
        LDS_WAIT(); asm volatile("" ::: "memory");
        f32x16 c0 = {}, c1 = {};
        { const bf16_t* ar = X + (size_t)(r0 + (lane & 31)) * DM + (lane >> 5) * 8;
          const bf16_t* Wh = (const bf16_t*)(F.ws + WS_W + wbuf_off(layer) + W_RH); const bf16_t* Wl = (const bf16_t*)(F.ws + WS_W + wbuf_off(layer) + W_RL);
          const int se = F.tid >> 3, sg8 = (F.tid & 7) * 16;
          u32x4 bh[2], bl[2];
          bh[0] = *(const u32x4*)(Wh + (size_t)se * DM + sg8); bh[1] = *(const u32x4*)(Wh + (size_t)se * DM + sg8 + 8); bl[0] = *(const u32x4*)(Wl + (size_t)se * DM + sg8); bl[1] = *(const u32x4*)(Wl + (size_t)se * DM + sg8 + 8);
          for (int c = 0; c < ((ROUTE_EXPT == 1 && dummy) ? 0 : 8); ++c) {
              LAS unsigned char* Bs = F.lds + (c & 1) * 34816;
              *(LAS u32x4*)(Bs + se * 272 + sg8 * 2) = bh[0]; *(LAS u32x4*)(Bs + se * 272 + sg8 * 2 + 16) = bh[1];
              *(LAS u32x4*)(Bs + 17408 + se * 272 + sg8 * 2) = bl[0]; *(LAS u32x4*)(Bs + 17408 + se * 272 + sg8 * 2 + 16) = bl[1];
              bf16x8 af[8];
#pragma unroll
              for (int st = 0; st < 8; ++st) af[st] = *(const bf16x8*)(ar + c * 128 + st * 16);
              __syncthreads();
              if (c + 1 < 8) { const size_t o = (size_t)se * DM + (c + 1) * 128 + sg8;
                  bh[0] = *(const u32x4*)(Wh + o); bh[1] = *(const u32x4*)(Wh + o + 8); bl[0] = *(const u32x4*)(Wl + o); bl[1] = *(const u32x4*)(Wl + o + 8); }
              const LAS unsigned char* bp = Bs + (lane & 31) * 272 + (lane >> 5) * 16;
#pragma unroll
              for (int st = 0; st < 8; ++st) {
                  const bf16x8 h0 = *(const LAS bf16x8*)(bp + st * 32), h1 = *(const LAS bf16x8*)(bp + 32 * 272 + st * 32);
                  const bf16x8 l0 = *(const LAS bf16x8*)(bp + 17408 + st * 32), l1 = *(const LAS bf16x8*)(bp + 17408 + 32 * 272 + st * 32);
                  c0 = __builtin_amdgcn_mfma_f32_32x32x16_bf16(af[st], h0, c0, 0, 0, 0); c1 = __builtin_amdgcn_mfma_f32_32x32x16_bf16(af[st], h1, c1, 0, 0, 0);
                  c0 = __builtin_amdgcn_mfma_f32_32x32x16_bf16(af[st], l0, c0, 0, 0, 0); c1 = __builtin_amdgcn_mfma_f32_32x32x16_bf16(af[st], l1, c1, 0, 0, 0);
              }
          }
        }
        __syncthreads();
#pragma unroll
        for (int rr = 0; rr < 16; ++rr) { const int row = (rr & 3) + 8 * (rr >> 2) + 4 * (lane >> 5); lg[row * 64 + (lane & 31)] = c0[rr]; lg[row * 64 + 32 + (lane & 31)] = c1[rr]; }
        LDS_WAIT(); asm volatile("" ::: "memory");
        const float rcs = ((const float*)(F.ws + WS_MISC))[256 + lane], rb1 = ((const float*)(F.ws + WS_MISC))[256 + 64 + lane];
        const float rbias = RBs[lane];
        for (int r = 0; r < ((ROUTE_EXPT == 2 && dummy) ? 0 : 32); ++r) {
            const float sg = sigmoidf_(stl[2 * r + 1] * (lg[r * 64 + lane] - stl[2 * r] * rcs) + rb1); const float sb = sg + rbias;
            float m1 = sb;
            m1 = fmaxf(m1, dpp_mov<DPP_X1>(m1)); m1 = fmaxf(m1, dpp_mov<DPP_X2>(m1)); m1 = fmaxf(m1, dpp_mov<DPP_HM>(m1));
            const unsigned long long eqm = __ballot(sb == m1); const int gsh = lane & ~7;
            const unsigned gm = (unsigned)(eqm >> gsh) & 0xffu; const int first = __builtin_ctz(gm);
            float m2 = ((lane & 7) == first) ? NEGBIG : sb;
            m2 = fmaxf(m2, dpp_mov<DPP_X1>(m2)); m2 = fmaxf(m2, dpp_mov<DPP_X2>(m2)); m2 = fmaxf(m2, dpp_mov<DPP_HM>(m2));
            const float gs = m1 + m2;
            int grank = 0;
#pragma unroll
            for (int q = 0; q < 8; ++q) { const float o = __builtin_bit_cast(float, __builtin_amdgcn_readlane(__builtin_bit_cast(int, gs), q * 8)); grank += (o > gs || (o == gs && q < (lane >> 3))) ? 1 : 0; }
            const float sm = (grank < 4) ? sb : NEGBIG;
            int rank = 0;
#pragma unroll
            for (int q = 0; q < 64; ++q) { const float o = __builtin_bit_cast(float, __builtin_amdgcn_readlane(__builtin_bit_cast(int, sm), q)); rank += (o > sm) ? 1 : 0; }
            bool tie = false;
#pragma unroll
            for (int k = 0; k < 8; ++k) tie |= (__popcll(__ballot(rank == k)) != 1);
            if (tie) { rank = 0;
#pragma unroll 1
                for (int q = 0; q < 64; ++q) { const float o = __builtin_bit_cast(float, __builtin_amdgcn_readlane(__builtin_bit_cast(int, sm), q)); rank += (o > sm || (o == sm && q < lane)) ? 1 : 0; } }
            const bool sel = rank < 8;
            const float ssum = wave_sum(sel ? sg : 0.f);
            if (sel) { const unsigned lp = __hip_atomic_fetch_add(&lcnt[lane], 1u, __ATOMIC_RELAXED, __HIP_MEMORY_SCOPE_WORKGROUP); const int row = F.wave * 32 + r; rec_e[row * 8 + rank] = (unsigned)lane | (lp << 8); rec_g[row * 8 + rank] = sg / ssum * 2.5f; }
        }
        __syncthreads();
        const int half = (ub * 256) / HALF_T;
        if (F.tid < 64) gbase[F.tid] = dummy ? 0u : __hip_atomic_fetch_add(cntg + half * 65 + F.tid, lcnt[F.tid], RLX_AGENT);
        __syncthreads();
        for (int i = F.tid; i < 2048; i += 512) { const unsigned re = rec_e[i]; const int e = re & 255, lp = re >> 8, v = half * 65 + e; const int pos = gbase[e] + lp;
            const int t = ub * 256 + (i >> 3);
            if (!dummy) { slot_tk[(size_t)v * HALF_T + pos] = t * 8 + (i & 7); slot_g[(size_t)v * HALF_T + pos] = rec_g[i]; } }
        __syncthreads();
    }
}

__device__ __forceinline__ void combine_phase(const Frame& F, const Args& a, int layer, int half, const bf16_t* X1, bf16_t* X2, bool dummy) {
    const bf16_t* Y = (const bf16_t*)(F.ws + WS_R + R_YTOK);
    const float* g = a.in[I_LN2G] + layer * DM; const float* bta = a.in[I_LN2B] + layer * DM;
    const int lane = F.lane;
    for (int tl = F.bid * 8 + F.wave; tl < HALF_T; tl += F.G * 8) {
        const int t = half * HALF_T + tl; float v[16];
        { const bf16_t* xr = X1 + (size_t)t * DM + lane * 16; unpack16(*(const u32x4*)xr, *(const u32x4*)(xr + 8), v); }
#pragma unroll
        for (int i = 0; i < 16; ++i) v[i] *= ALPHA;
        float m[16];
#pragma unroll
        for (int i = 0; i < 16; ++i) m[i] = 0.f;
#pragma unroll
#if Y_FP8
        for (int k = 0; k < 9; ++k) { const u32x4 w = *(const u32x4*)((const unsigned char*)Y + ((size_t)t * 9 + k) * DM + lane * 16);
            m[0] += __builtin_amdgcn_cvt_f32_fp8(w.x, 0); m[1] += __builtin_amdgcn_cvt_f32_fp8(w.x, 1); m[2] += __builtin_amdgcn_cvt_f32_fp8(w.x, 2); m[3] += __builtin_amdgcn_cvt_f32_fp8(w.x, 3);
            m[4] += __builtin_amdgcn_cvt_f32_fp8(w.y, 0); m[5] += __builtin_amdgcn_cvt_f32_fp8(w.y, 1); m[6] += __builtin_amdgcn_cvt_f32_fp8(w.y, 2); m[7] += __builtin_amdgcn_cvt_f32_fp8(w.y, 3);
            m[8] += __builtin_amdgcn_cvt_f32_fp8(w.z, 0); m[9] += __builtin_amdgcn_cvt_f32_fp8(w.z, 1); m[10] += __builtin_amdgcn_cvt_f32_fp8(w.z, 2); m[11] += __builtin_amdgcn_cvt_f32_fp8(w.z, 3);
            m[12] += __builtin_amdgcn_cvt_f32_fp8(w.w, 0); m[13] += __builtin_amdgcn_cvt_f32_fp8(w.w, 1); m[14] += __builtin_amdgcn_cvt_f32_fp8(w.w, 2); m[15] += __builtin_amdgcn_cvt_f32_fp8(w.w, 3); }
#pragma unroll
        for (int i = 0; i < 16; ++i) m[i] *= (1.0f / 32.0f);
#else
        for (int k = 0; k < 9; ++k) { const bf16_t* yr = Y + ((size_t)tl * 9 + k) * DM + lane * 16; float yv[16]; unpack16(*(const u32x4*)yr, *(const u32x4*)(yr + 8), yv);
#pragma unroll
            for (int i = 0; i < 16; ++i) m[i] += yv[i]; }
#endif
#pragma unroll
        for (int i = 0; i < 16; ++i) v[i] += m[i];
        ln_row16(v, g, bta, lane);
        if (!dummy) store_row16_bf(v, X2 + (size_t)t * DM, lane);
    }
}

constexpr int KP = 144, VP = 192;
constexpr int KT_BYTES = 64 * KP, VT_BYTES = 64 * VP, KV_BUF = KT_BYTES + VT_BYTES;
__device__ __forceinline__ int crow(int r, int hi) { return (r & 3) + 8 * (r >> 2) + 4 * hi; }
__device__ __forceinline__ s16x4 vtr(const LAS unsigned char* p) { return __builtin_bit_cast(s16x4, __builtin_amdgcn_ds_read_tr16_b64_v4i16((LAS s16x4*)p)); }

struct KVRegs { u32x4 k, v; };
__device__ __forceinline__ void kv_load(KVRegs& r, const bf16_t* Kp, const bf16_t* Vp, size_t pitch, int row0, int tid) {
    const size_t off = (size_t)(row0 + (tid >> 3)) * pitch + (tid & 7) * 8;
    r.k = *(const u32x4*)(Kp + off); r.v = *(const u32x4*)(Vp + off);
}
__device__ __forceinline__ void kv_store(const KVRegs& r, LAS unsigned char* buf, int tid) {
    *(LAS u32x4*)(buf + (tid >> 3) * KP + (tid & 7) * 16) = r.k;
    *(LAS u32x4*)(buf + KT_BYTES + (tid >> 3) * VP + (tid & 7) * 16) = r.v;
}
__device__ __forceinline__ void qk_tile(f32x16& p0, f32x16& p1, const LAS unsigned char* kt, const bf16x8 (&qf)[4], int lane) {
    const LAS unsigned char* kb = kt + (lane & 31) * KP + (lane >> 5) * 16;
    p0 = (f32x16){}; p1 = (f32x16){};
#pragma unroll
    for (int ks = 0; ks < 4; ++ks) {
        const bf16x8 k0 = *(const LAS bf16x8*)(kb + ks * 32), k1 = *(const LAS bf16x8*)(kb + 32 * KP + ks * 32);
        p0 = __builtin_amdgcn_mfma_f32_32x32x16_bf16(k0, qf[ks], p0, 0, 0, 0);
        p1 = __builtin_amdgcn_mfma_f32_32x32x16_bf16(k1, qf[ks], p1, 0, 0, 0);
    }
}
__device__ __forceinline__ bf16x8 pfrag(const f32x16& p, int s) {
    u32x4 w; w.x = pg8::cvt_pk_bf16(p[8 * s], p[8 * s + 1]); w.y = pg8::cvt_pk_bf16(p[8 * s + 2], p[8 * s + 3]); w.z = pg8::cvt_pk_bf16(p[8 * s + 4], p[8 * s + 5]); w.w = pg8::cvt_pk_bf16(p[8 * s + 6], p[8 * s + 7]);
    return __builtin_bit_cast(bf16x8, w);
}
__device__ __forceinline__ void pv_sub(f32x16& o0, f32x16& o1, const LAS unsigned char* vt, int sub, const f32x16& p, int lane) {
    const LAS unsigned char* vb = vt + (sub * 32 + (lane >> 5) * 4 + ((lane & 15) >> 2)) * VP + (16 * ((lane >> 4) & 1) + 4 * (lane & 3)) * 2;
#pragma unroll
    for (int s = 0; s < 2; ++s) {
        const bf16x8 pb = pfrag(p, s);
        const s16x4 a0 = vtr(vb + (16 * s) * VP), a1 = vtr(vb + (16 * s + 8) * VP), b0 = vtr(vb + (16 * s) * VP + 64), b1 = vtr(vb + (16 * s + 8) * VP + 64);
        const bf16x8 va = {a0[0], a0[1], a0[2], a0[3], a1[0], a1[1], a1[2], a1[3]}, vbb = {b0[0], b0[1], b0[2], b0[3], b1[0], b1[1], b1[2], b1[3]};
        o0 = __builtin_amdgcn_mfma_f32_32x32x16_bf16(va, pb, o0, 0, 0, 0);
        o1 = __builtin_amdgcn_mfma_f32_32x32x16_bf16(vbb, pb, o1, 0, 0, 0);
    }
}
__device__ __forceinline__ float max3f(float a, float b, float c) { float r; asm("v_max3_f32 %0, %1, %2, %3" : "=v"(r) : "v"(a), "v"(b), "v"(c)); return r; }
template <bool SCALED, int EXPT = 0>
__device__ __forceinline__ void softmax_pv(f32x16& p0, f32x16& p1, f32x16& o0, f32x16& o1, float& m, float& l, const LAS unsigned char* vt, int lane, bool v0 = true, bool v1 = true) {
    if (EXPT == 1) { l += p0[0]; pv_sub(o0, o1, vt, 0, p0, lane); pv_sub(o0, o1, vt, 1, p1, lane); return; }
    asm volatile("s_nop 15" : "+v"(p0), "+v"(p1));
    float mx;
    { float a = max3f(p0[0], p0[1], p0[2]), b = max3f(p1[0], p1[1], p1[2]);
      a = max3f(a, p0[3], p0[4]); b = max3f(b, p1[3], p1[4]); a = max3f(a, p0[5], p0[6]); b = max3f(b, p1[5], p1[6]);
      a = max3f(a, p0[7], p0[8]); b = max3f(b, p1[7], p1[8]); a = max3f(a, p0[9], p0[10]); b = max3f(b, p1[9], p1[10]);
      a = max3f(a, p0[11], p0[12]); b = max3f(b, p1[11], p1[12]); a = max3f(a, p0[13], p0[14]); b = max3f(b, p1[13], p1[14]);
      a = fmaxf(a, p0[15]); b = fmaxf(b, p1[15]); mx = fmaxf(v0 ? a : NEGBIG, v1 ? b : NEGBIG); }
    mx = max_x32(mx, lane);
    if (!SCALED) mx *= QK_C;
    const float mn = (mx - m > 8.0f) ? mx : m, alpha = fast_exp2(m - mn);
    const float mn0 = v0 ? mn : 1e30f, mn1 = v1 ? mn : 1e30f;
    f32x2 ls2 = {0.f, 0.f};
#pragma unroll
    for (int r = 0; r < 16; r += 2) {
        f32x2 a = {p0[r], p0[r + 1]}, b = {p1[r], p1[r + 1]};
        if (SCALED) { a = a - mn0; b = b - mn1; } else { a = a * QK_C - mn0; b = b * QK_C - mn1; }
        a[0] = fast_exp2(a[0]); a[1] = fast_exp2(a[1]); b[0] = fast_exp2(b[0]); b[1] = fast_exp2(b[1]);
        p0[r] = a[0]; p0[r + 1] = a[1]; p1[r] = b[0]; p1[r + 1] = b[1];
        ls2 += a; ls2 += b; }
    float ls = ls2[0] + ls2[1];
    ls = sum_x32(ls, lane);
    l = l * alpha + ls; m = mn;
    if (!__all(alpha == 1.0f)) { o0 *= alpha; o1 *= alpha; }
    pv_sub(o0, o1, vt, 0, p0, lane); pv_sub(o0, o1, vt, 1, p1, lane);
}
__device__ __forceinline__ void load_qf(bf16x8 (&qf)[4], const bf16_t* qrow, int lane) {
#pragma unroll
    for (int ks = 0; ks < 4; ++ks) qf[ks] = *(const bf16x8*)(qrow + 16 * ks + 8 * (lane >> 5));
}
__device__ __forceinline__ void store_ot(const f32x16& o0, const f32x16& o1, float sc, bf16_t* orow, int lane) {
    const int hi = lane >> 5;
#pragma unroll
    for (int g = 0; g < 4; ++g) {
        u32x2 w; w.x = pg8::cvt_pk_bf16(o0[4 * g] * sc, o0[4 * g + 1] * sc); w.y = pg8::cvt_pk_bf16(o0[4 * g + 2] * sc, o0[4 * g + 3] * sc); *(u32x2*)(orow + 8 * g + 4 * hi) = w;
        u32x2 x; x.x = pg8::cvt_pk_bf16(o1[4 * g] * sc, o1[4 * g + 1] * sc); x.y = pg8::cvt_pk_bf16(o1[4 * g + 2] * sc, o1[4 * g + 3] * sc); *(u32x2*)(orow + 32 + 8 * g + 4 * hi) = x;
    }
}

template <int EXPT = 0>
__device__ __forceinline__ void fox_phase(const Frame& F, const Args& a, bf16_t* O, int opitch) {
    bf16_t* H = (bf16_t*)(F.ws + WS_R + R_H); const float* DC = (const float*)(F.ws + WS_DCUM);
    const int lane = F.lane, tid = F.tid, hi = lane >> 5;
    LAS unsigned char* kvb = F.lds; LAS float* dkb = (LAS float*)(F.lds + 4 * KV_BUF);
    const int NU = NB * 16 * 8;
    KVRegs krA, krB; float dkA = 0.f, dkB = 0.f; bf16x8 qf[4];
    if (F.bid < NU) { const int ui = F.bid, qb = 7 - (ui / (NB * 16)), bh = ui % (NB * 16), b = bh >> 4, h = bh & 15; const size_t rb0 = (size_t)b * SEQ;
        const bf16_t* Kp = H + rb0 * NO_PAD + 1024 + h * 64; const bf16_t* Vp = H + rb0 * NO_PAD + 2048 + h * 64;
        load_qf(qf, H + (rb0 + qb * 256 + F.wave * 32 + (lane & 31)) * NO_PAD + h * 64, lane);
        kv_load(krA, Kp, Vp, NO_PAD, 0, tid); if (tid < 64) dkA = DC[(rb0 + tid) * 16 + h];
        kv_load(krB, Kp, Vp, NO_PAD, 64, tid); if (tid < 64) dkB = DC[(rb0 + 64 + tid) * 16 + h]; }
    for (int ui = F.bid; ui < NU; ui += F.G) {
        const int qb = 7 - (ui / (NB * 16)), bh = ui % (NB * 16), b = bh >> 4, h = bh & 15;
        const size_t rb0 = (size_t)b * SEQ;
        const bf16_t* Kp = H + rb0 * NO_PAD + 1024 + h * 64; const bf16_t* Vp = H + rb0 * NO_PAD + 2048 + h * 64;
        const int q0 = qb * 256 + F.wave * 32, tq = q0 + (lane & 31);
        f32x16 o0 = {}, o1 = {}; float m = -1e20f, l = 0.f;
        const int ntile = qb * 4 + 4; const int wlast = (q0 + 31) >> 6;
        const int un = ui + F.G; const bool hn = un < NU;
        const int qbn = 7 - (un / (NB * 16)), bhn = un % (NB * 16), bn = bhn >> 4, hnx = bhn & 15; const size_t rbn = (size_t)bn * SEQ;
        const bf16_t* Kn = H + rbn * NO_PAD + 1024 + hnx * 64; const bf16_t* Vn = H + rbn * NO_PAD + 2048 + hnx * 64;
#define FOX_FILL(KR, DKR, T) do { const int t = (T); kv_store(KR, kvb + (t & 3) * KV_BUF, tid); if (tid < 64) dkb[(t & 3) * 64 + tid] = -DKR; } while (0)
#define FOX_NEXT(KR, DKR, T) do { const int t = (T); if (t + 2 < ntile) { kv_load(KR, Kp, Vp, NO_PAD, (t + 2) * 64, tid); if (tid < 64) DKR = DC[(rb0 + (t + 2) * 64 + tid) * 16 + h]; } \
            else if (hn) { kv_load(KR, Kn, Vn, NO_PAD, (t + 2 - ntile) * 64, tid); if (tid < 64) DKR = DC[(rbn + (t + 2 - ntile) * 64 + tid) * 16 + hnx]; } } while (0)
#define FOX_COMP(T) do { const int t = (T); LAS unsigned char* buf = kvb + (t & 3) * KV_BUF; \
            if (EXPT == 2) { l += ((const LAS float*)buf)[lane]; } else if (t <= wlast) { \
                f32x16 p0, p1; qk_tile(p0, p1, buf, qf, lane); \
                const LAS float* dk = dkb + (t & 3) * 64; \
                if (64 * t + 63 <= q0) { \
                    _Pragma("unroll") for (int r = 0; r < 16; ++r) { const int kk = crow(r, hi); p0[r] = __builtin_fmaf(p0[r], QK_C, dk[kk]); p1[r] = __builtin_fmaf(p1[r], QK_C, dk[kk + 32]); } \
                } else { \
                    _Pragma("unroll") for (int r = 0; r < 16; ++r) { const int kk = crow(r, hi), key = t * 64 + kk; \
                        const float s0 = __builtin_fmaf(p0[r], QK_C, dk[kk]), s1 = __builtin_fmaf(p1[r], QK_C, dk[kk + 32]); \
                        p0[r] = (key <= tq) ? s0 : NEGBIG; p1[r] = (key + 32 <= tq) ? s1 : NEGBIG; } \
                } \
                softmax_pv<true, EXPT>(p0, p1, o0, o1, m, l, buf + KT_BYTES, lane); \
            } } while (0)
        for (int t2 = 0; t2 < ntile; t2 += 2) {
            FOX_FILL(krA, dkA, t2); FOX_FILL(krB, dkB, t2 + 1);
            __syncthreads();
            FOX_NEXT(krA, dkA, t2); FOX_NEXT(krB, dkB, t2 + 1);
            FOX_COMP(t2); FOX_COMP(t2 + 1);
        }
#undef FOX_FILL
#undef FOX_NEXT
#undef FOX_COMP
        if (hn) load_qf(qf, H + (rbn + qbn * 256 + F.wave * 32 + (lane & 31)) * NO_PAD + hnx * 64, lane);
        store_ot(o0, o1, 1.0f / l, O + (rb0 + tq) * opitch + h * 64, lane);
        __syncthreads();
    }
}

template <class MaskFn>
__device__ __forceinline__ void attn_tiles(const Frame& F, unsigned tm, const bf16_t* Kp, const bf16_t* Vp, size_t pitch, const bf16x8 (&qf)[4],
                                            f32x16& o0, f32x16& o1, float& m, float& l, LAS unsigned char* kvb, MaskFn&& mask) {
    const int tid = F.tid, lane = F.lane;
    KVRegs krA, krB;
    int tA = -1, tB = -1;
    if (tm) { tA = __builtin_ctz(tm); tm &= tm - 1; kv_load(krA, Kp, Vp, pitch, tA * 64, tid); }
    if (tm) { tB = __builtin_ctz(tm); tm &= tm - 1; kv_load(krB, Kp, Vp, pitch, tB * 64, tid); }
#define ATT_TILE(KR, TV, PAR) do { const int t = TV; LAS unsigned char* buf = kvb + (PAR) * KV_BUF; \
        kv_store(KR, buf, tid); \
        __syncthreads(); \
        if (tm) { TV = __builtin_ctz(tm); tm &= tm - 1; kv_load(KR, Kp, Vp, pitch, TV * 64, tid); } else TV = -1; \
        f32x16 p0, p1; qk_tile(p0, p1, buf, qf, lane); \
        bool v0 = true, v1 = true; mask(p0, p1, t, v0, v1); \
        softmax_pv<false>(p0, p1, o0, o1, m, l, buf + KT_BYTES, lane, v0, v1); } while (0)
    while (tA >= 0) { ATT_TILE(krA, tA, 0); if (tB < 0) break; ATT_TILE(krB, tB, 1); }
#undef ATT_TILE
    __syncthreads();
}
__device__ __forceinline__ unsigned pkh(float a, float b) { const _Float16 x = (_Float16)a, y = (_Float16)b; return (unsigned)__builtin_bit_cast(unsigned short, x) | ((unsigned)__builtin_bit_cast(unsigned short, y) << 16); }
__device__ __forceinline__ float h2f(unsigned short h) { return (float)__builtin_bit_cast(_Float16, h); }
__device__ __forceinline__ float dpp_f(float x, int ctrl_sel) {
    const int v = __builtin_bit_cast(int, x); int r;
    if (ctrl_sel == 0) r = __builtin_amdgcn_update_dpp(0, v, 0xB1, 0xf, 0xf, true);
    else if (ctrl_sel == 1) r = __builtin_amdgcn_update_dpp(0, v, 0x4E, 0xf, 0xf, true);
    else r = __builtin_amdgcn_update_dpp(0, v, 0x141, 0xf, 0xf, true);
    return __builtin_bit_cast(float, r);
}

__device__ __forceinline__ void dsa_unit(const Frame& F, const Args& a, int b, int qg, bf16_t* O, int opitch) {
    bf16_t* H = (bf16_t*)(F.ws + WS_R + R_H);
    const int lane = F.lane, hi = lane >> 5, t0 = qg * 32; const size_t rb0 = (size_t)b * SEQ;
    LAS float* sc = (LAS float*)F.lds;
    LAS unsigned* bm = (LAS unsigned*)(F.lds + LDS_TAB);
    for (int hf = 0; hf < 2; ++hf) {
        const int tq0 = t0 + 16 * hf, nkt = ((tq0 + 15) >> 5) + 1;
        {
            bf16x8 qi[4][4], wf[4][2];
#pragma unroll
            for (int ct = 0; ct < 4; ++ct) { const int q = tq0 + 4 * ct + ((lane & 31) >> 3), head = lane & 7; const bf16_t* rp = H + (rb0 + q) * NE_PAD;
#pragma unroll
                for (int ks = 0; ks < 4; ++ks) qi[ct][ks] = *(const bf16x8*)(rp + EC_QI + head * 64 + 16 * ks + 8 * hi);
                const int qp = lane & 31; u32x2 w4 = {0u, 0u};
                if (qp < 4) w4 = *(const u32x2*)(H + (rb0 + tq0 + 4 * ct + qp) * NE_PAD + EC_WI + 4 * hi);
                const u32x4 s0 = {(qp == 0) ? w4.x : 0u, (qp == 0) ? w4.y : 0u, (qp == 1) ? w4.x : 0u, (qp == 1) ? w4.y : 0u};
                const u32x4 s1 = {(qp == 2) ? w4.x : 0u, (qp == 2) ? w4.y : 0u, (qp == 3) ? w4.x : 0u, (qp == 3) ? w4.y : 0u};
                wf[ct][0] = __builtin_bit_cast(bf16x8, s0); wf[ct][1] = __builtin_bit_cast(bf16x8, s1); }
            for (int kt = F.wave; kt < nkt; kt += 8) {
                bf16x8 kf[4]; { const bf16_t* kp = H + (rb0 + kt * 32 + (lane & 31)) * NE_PAD + EC_KI + 8 * hi;
#pragma unroll
                    for (int ks = 0; ks < 4; ++ks) kf[ks] = *(const bf16x8*)(kp + 16 * ks); }
#pragma unroll
                for (int ct = 0; ct < 4; ++ct) {
                    f32x16 acc = {};
#pragma unroll
                    for (int ks = 0; ks < 4; ++ks) acc = __builtin_amdgcn_mfma_f32_32x32x16_bf16(qi[ct][ks], kf[ks], acc, 0, 0, 0);
#pragma unroll
                    for (int r = 0; r < 16; ++r) acc[r] = fmaxf(acc[r], 0.f);
                    f32x16 y = {};
                    y = __builtin_amdgcn_mfma_f32_32x32x16_bf16(wf[ct][0], pfrag(acc, 0), y, 0, 0, 0);
                    y = __builtin_amdgcn_mfma_f32_32x32x16_bf16(wf[ct][1], pfrag(acc, 1), y, 0, 0, 0);
                    if (lane < 32) { LAS float* dst = sc + (4 * ct) * 2048 + kt * 32 + lane;
                        dst[0] = y[0]; dst[2048] = y[1]; dst[4096] = y[2]; dst[6144] = y[3]; }
                }
            }
        }
        __syncthreads();
        for (int q2 = 0; q2 < 2; ++q2) {
            const int ql = 2 * F.wave + q2, tq = tq0 + ql, n = tq + 1;
            unsigned u[32];
#pragma unroll
            for (int j = 0; j < 32; ++j) { const int idx = 64 * j + lane; unsigned bits = 0u;
                if (idx < n) { bits = __builtin_bit_cast(unsigned, sc[ql * 2048 + idx]); if ((bits << 1) == 0u) bits = 0u; bits ^= (bits & 0x80000000u) ? 0xffffffffu : 0x80000000u; }
                u[j] = bits; }
            unsigned thr = 0u; int need = 0; bool exact = false;
            if (n > 256) {
                const int ng = (n + 511) >> 9;
                for (int bit = 31; bit >= 0; --bit) { const unsigned cand = thr | (1u << bit); int c = 0;
#pragma unroll
                    for (int g = 0; g < 4; ++g) if (g < ng) {
#pragma unroll
                        for (int j = 8 * g; j < 8 * g + 8; ++j) c += (u[j] >= cand) ? 1 : 0; }
                    c = wave_sum_i(c);
                    if (c >= 256) { thr = cand; if (c == 256) { exact = true; break; } } }
                if (!exact) { int cgt = 0;
#pragma unroll
                    for (int j = 0; j < 32; ++j) cgt += (u[j] > thr) ? 1 : 0;
                    cgt = wave_sum_i(cgt);
                    need = 256 - cgt; }
            }
            const unsigned long long lt = (1ull << lane) - 1ull; int er = 0;
            if (exact) {
#pragma unroll
                for (int j = 0; j < 32; ++j) { const unsigned long long sm = __ballot(u[j] >= thr);
                    if (lane == 0) { bm[(16 * hf + ql) * 64 + 2 * j] = (unsigned)sm; bm[(16 * hf + ql) * 64 + 2 * j + 1] = (unsigned)(sm >> 32); } } }
            else
#pragma unroll
            for (int j = 0; j < 32; ++j) { const int idx = 64 * j + lane; bool sel;
                if (n > 256) {
                  const unsigned long long eqm = __ballot(u[j] == thr && idx < n); sel = (u[j] > thr) || (u[j] == thr && idx < n && (er + __popcll(eqm & lt)) < need); er += __popcll(eqm); }
                else sel = idx < n;
                const unsigned long long sm = __ballot(sel);
                if (lane == 0) { bm[(16 * hf + ql) * 64 + 2 * j] = (unsigned)sm; bm[(16 * hf + ql) * 64 + 2 * j + 1] = (unsigned)(sm >> 32); } }
        }
        __syncthreads();
    }
    const int tq = t0 + (lane & 31);
    bf16x8 qf[4]; load_qf(qf, H + (rb0 + tq) * NE_PAD + EC_QA + F.wave * 64, lane);
    f32x16 o0 = {}, o1 = {}; float m = -1e20f, l = 0.f;
    const int ntile = ((t0 + 31) >> 6) + 1; const unsigned tm = (ntile >= 32) ? 0xffffffffu : ((1u << ntile) - 1u);
    const LAS unsigned* bq = bm + (lane & 31) * 64;
    attn_tiles(F, tm, H + rb0 * NE_PAD + EC_KA, H + rb0 * NE_PAD + EC_VA, NE_PAD, qf, o0, o1, m, l, F.lds,
        [&](f32x16& p0, f32x16& p1, int t, bool&, bool&) { const unsigned w0 = bq[2 * t] >> (4 * hi), w1 = bq[2 * t + 1] >> (4 * hi);
#pragma unroll
            for (int r = 0; r < 16; ++r) { const int sh = (r & 3) + 8 * (r >> 2);
                p0[r] = ((w0 >> sh) & 1u) ? p0[r] : NEGBIG; p1[r] = ((w1 >> sh) & 1u) ? p1[r] : NEGBIG; } });
    store_ot(o0, o1, 1.0f / l, O + (rb0 + tq) * opitch + F.wave * 64, lane);
}

__device__ __forceinline__ void compress_item(const Frame& F, const Args& a, int layer, int item) {
    const bf16_t* H = (const bf16_t*)(F.ws + WS_R + R_H); const bf16_t* W = (const bf16_t*)(F.ws + WS_W + wbuf_off(layer));
    const int kv = item & 1, ct = (item >> 1) & 3, b = item >> 3, lane = F.lane, hi = lane >> 5;
    const bf16_t* w1t = W + (kv ? W_C1V : W_C1K) / 2; const bf16_t* w2t = W + (kv ? W_C2V : W_C2K) / 2;
    const float* bias1 = (const float*)(F.ws + WS_MISC) + kv * 64;
    bf16_t* outp = (bf16_t*)(F.ws + (kv ? WS_VC : WS_KC)) + (size_t)b * 128 * 64;
    const int col = kv ? EC_VC : EC_KC;
    LAS float* part = (LAS float*)F.lds; LAS unsigned short* hs = (LAS unsigned short*)(F.lds + 65536);
    int c = ct * 32 + (lane & 31); if (c > 126) c = 126;
    f32x16 a0 = {}, a1 = {};
#pragma unroll 8
    for (int ks = F.wave * 16; ks < F.wave * 16 + 16; ++ks) {
        const bf16x8 af = *(const bf16x8*)(H + ((size_t)b * SEQ + 16 * c + (ks >> 2)) * NE_PAD + col + 16 * (ks & 3) + 8 * hi);
        const bf16x8 b0 = *(const bf16x8*)(w1t + (size_t)(lane & 31) * 2048 + 16 * ks + 8 * hi), b1 = *(const bf16x8*)(w1t + (size_t)(32 + (lane & 31)) * 2048 + 16 * ks + 8 * hi);
        a0 = __builtin_amdgcn_mfma_f32_32x32x16_bf16(af, b0, a0, 0, 0, 0); a1 = __builtin_amdgcn_mfma_f32_32x32x16_bf16(af, b1, a1, 0, 0, 0);
    }
#pragma unroll
    for (int r = 0; r < 16; ++r) { part[F.wave * 2048 + crow(r, hi) * 64 + (lane & 31)] = a0[r]; part[F.wave * 2048 + crow(r, hi) * 64 + 32 + (lane & 31)] = a1[r]; }
    __syncthreads();
#pragma unroll
    for (int i = 0; i < 4; ++i) { const int idx = F.tid + 512 * i; float s = bias1[idx & 63];
#pragma unroll
        for (int w = 0; w < 8; ++w) s += part[w * 2048 + idx];
        const float h = s / (1.0f + __expf(-s)); hs[(idx >> 6) * 72 + (idx & 63)] = (unsigned short)f2bf(h); }
    __syncthreads();
    if (F.wave < 2) {
        const int nt = F.wave; f32x16 acc = {};
#pragma unroll
        for (int ks = 0; ks < 4; ++ks) { const bf16x8 af = *(const LAS bf16x8*)((const LAS unsigned char*)hs + (lane & 31) * 144 + (16 * ks + 8 * hi) * 2);
            const bf16x8 bf = *(const bf16x8*)(w2t + (size_t)(nt * 32 + (lane & 31)) * 64 + 16 * ks + 8 * hi);
            acc = __builtin_amdgcn_mfma_f32_32x32x16_bf16(af, bf, acc, 0, 0, 0); }
        const int n = nt * 32 + (lane & 31);
        const float* cosT = (const float*)(F.ws + WS_ROPE_COS); const float* sinT = (const float*)(F.ws + WS_ROPE_SIN);
#pragma unroll
        for (int r = 0; r < 16; ++r) { const int cg = ct * 32 + crow(r, hi); float v = acc[r];
            if (kv == 0) { const float o = dpp_mov<DPP_X1>(v); int pos = 16 * cg + 31; if (pos > SEQ - 1) pos = SEQ - 1; const float cs = cosT[pos * 32 + (n >> 1)], sn = sinT[pos * 32 + (n >> 1)];
                v = (n & 1) ? (v * cs + o * sn) : (v * cs - o * sn); }
            outp[(size_t)cg * 64 + n] = (unsigned short)((cg <= 126) ? f2bf(v) : 0u); }
    }
    __syncthreads();
}

__device__ __forceinline__ void nsa_unit(const Frame& F, const Args& a, int layer, int b, int qg, bf16_t* O, int opitch) {
    bf16_t* H = (bf16_t*)(F.ws + WS_R + R_H);
    const int lane = F.lane, hi = lane >> 5, tid = F.tid, t0 = qg * 32, cur = qg; const size_t rb0 = (size_t)b * SEQ;
    const int tq = t0 + (lane & 31);
    LAS unsigned char* kvb = F.lds;
    LAS unsigned short* slab = (LAS unsigned short*)(F.lds + 2 * KV_BUF);
    LAS float* pcs = (LAS float*)(F.lds + 2 * KV_BUF + 65536);
    LAS unsigned* selm = (LAS unsigned*)(pcs + 4096);
    const bf16_t* rowp = H + (rb0 + tq) * NE_PAD;
    bf16x8 qf[4]; load_qf(qf, rowp + EC_QB + F.wave * 64, lane);
    const float* bg = a.in[I_EV_BGATE] + (layer >> 1) * 24 + F.wave * 3;
    const float g0 = sigmoidf_(bf2f(rowp[EC_GB + F.wave * 3 + 0]) + bg[0]), g1 = sigmoidf_(bf2f(rowp[EC_GB + F.wave * 3 + 1]) + bg[1]), g2 = sigmoidf_(bf2f(rowp[EC_GB + F.wave * 3 + 2]) + bg[2]);
    { const bf16_t* kc = (const bf16_t*)(F.ws + WS_KC) + (size_t)b * 128 * 64; const bf16_t* vc = (const bf16_t*)(F.ws + WS_VC) + (size_t)b * 128 * 64;
      KVRegs r0, r1; kv_load(r0, kc, vc, 64, 0, tid); kv_load(r1, kc, vc, 64, 64, tid); kv_store(r0, kvb, tid); kv_store(r1, kvb + KV_BUF, tid); }
    __syncthreads();
    f32x16 pc[4]; f32x16 oa0 = {}, oa1 = {};
    {
        const int cmax = (tq >= 31) ? min(126, (tq - 31) >> 4) : -1;
        qk_tile(pc[0], pc[1], kvb, qf, lane); asm volatile("" ::: "memory"); qk_tile(pc[2], pc[3], kvb + KV_BUF, qf, lane); asm volatile("" ::: "memory");
        float mx = NEGBIG;
#pragma unroll
        for (int s = 0; s < 4; ++s)
#pragma unroll
            for (int r = 0; r < 16; ++r) { const int c = 32 * s + crow(r, hi); pc[s][r] = (c <= cmax) ? pc[s][r] * QK_C : NEGBIG; mx = fmaxf(mx, pc[s][r]); }
        mx = max_x32(mx, lane);
        float ls = 0.f;
#pragma unroll
        for (int s = 0; s < 4; ++s)
#pragma unroll
            for (int r = 0; r < 16; ++r) { pc[s][r] = (pc[s][r] > -1e29f) ? fast_exp2(pc[s][r] - mx) : 0.f; ls += pc[s][r]; }
        ls = sum_x32(ls, lane);
        const float inv = (ls > 0.f) ? 1.0f / ls : 0.f;
#pragma unroll
        for (int s = 0; s < 4; ++s) pc[s] *= inv;
        f32x16 c0 = {}, c1 = {};
        asm volatile("" ::: "memory");
        pv_sub(c0, c1, kvb + KT_BYTES, 0, pc[0], lane); asm volatile("" ::: "memory"); pv_sub(c0, c1, kvb + KT_BYTES, 1, pc[1], lane); asm volatile("" ::: "memory");
        pv_sub(c0, c1, kvb + KV_BUF + KT_BYTES, 0, pc[2], lane); asm volatile("" ::: "memory"); pv_sub(c0, c1, kvb + KV_BUF + KT_BYTES, 1, pc[3], lane); asm volatile("" ::: "memory");
        oa0 = c0 * g0; oa1 = c1 * g0;
    }
    { LAS unsigned short* sl = slab + F.wave * 4096 + (lane & 31) * 128 + 4 * hi;
#pragma unroll
      for (int s = 0; s < 4; ++s)
#pragma unroll
          for (int g = 0; g < 4; ++g) { u32x2 w; w.x = pkh(pc[s][4 * g], pc[s][4 * g + 1]); w.y = pkh(pc[s][4 * g + 2], pc[s][4 * g + 3]); *(LAS u32x2*)(sl + 32 * s + 8 * g) = w; } }
    __syncthreads();
#pragma unroll
    for (int i = 0; i < 8; ++i) { const int idx = tid + 512 * i; float s8 = 0.f;
#pragma unroll
        for (int w = 0; w < 8; ++w) s8 += h2f(slab[w * 4096 + idx]);
        pcs[idx] = s8; }
    __syncthreads();
#pragma unroll
    for (int qq = 0; qq < 4; ++qq) { const int q = 4 * F.wave + qq; const LAS float* pr = pcs + q * 128;
        float v = pr[2 * lane] + 0.5f * ((lane > 0 ? pr[2 * lane - 1] : 0.f) + pr[2 * lane + 1]);
        if (lane == 0 || lane == cur || lane == cur - 1) v = 1e30f - (float)lane * 1e27f; else if (lane > cur) v = NEGBIG;
        int rank = 0;
#pragma unroll
        for (int j = 0; j < 64; ++j) { const float o = __builtin_bit_cast(float, __builtin_amdgcn_readlane(__builtin_bit_cast(int, v), j)); rank += (o > v) ? 1 : 0; }
        bool tie = false;
#pragma unroll
        for (int k = 0; k < 8; ++k) tie |= (__popcll(__ballot(rank == k)) != 1);
        if (tie) { rank = 0;
#pragma unroll 1
            for (int j = 0; j < 64; ++j) { const float o = __builtin_bit_cast(float, __builtin_amdgcn_readlane(__builtin_bit_cast(int, v), j)); rank += (o > v || (o == v && j < lane)) ? 1 : 0; } }
        const unsigned long long sm = __ballot(rank < 8);
        if (lane == 0) { selm[2 * q] = (unsigned)sm; selm[2 * q + 1] = (unsigned)(sm >> 32); } }
    __syncthreads();
    LAS float* stash = (LAS float*)(F.lds + 2 * KV_BUF) + F.wave * 2048 + lane;
#pragma unroll
    for (int r = 0; r < 16; ++r) { stash[r * 64] = oa0[r]; stash[(16 + r) * 64] = oa1[r]; }
    {
        unsigned long long un = 0ull;
        { const unsigned lo = selm[2 * (lane & 31)], hh = selm[2 * (lane & 31) + 1]; unsigned ul = lo, uh = hh;
          ul |= dpp_movu<DPP_X1>(ul); ul |= dpp_movu<DPP_X2>(ul); ul |= dpp_movu<DPP_HM>(ul); ul |= dpp_movu<DPP_RM>(ul);
          uh |= dpp_movu<DPP_X1>(uh); uh |= dpp_movu<DPP_X2>(uh); uh |= dpp_movu<DPP_HM>(uh); uh |= dpp_movu<DPP_RM>(uh);
          un = ((unsigned long long)((unsigned)__builtin_amdgcn_readlane((int)uh, 0) | (unsigned)__builtin_amdgcn_readlane((int)uh, 16)) << 32) | ((unsigned)__builtin_amdgcn_readlane((int)ul, 0) | (unsigned)__builtin_amdgcn_readlane((int)ul, 16)); }
        if (cur < 63) un &= (1ull << (cur + 1)) - 1ull;
        unsigned tm = 0u;
        for (int t = 0; t <= (cur >> 1); ++t) if ((un >> (2 * t)) & 3ull) tm |= 1u << t;
        const unsigned long long mysel = ((unsigned long long)selm[2 * (lane & 31) + 1] << 32) | selm[2 * (lane & 31)];
        f32x16 s0 = {}, s1 = {}; float m = -1e20f, l = 0.f;
        attn_tiles(F, tm, H + rb0 * NE_PAD + EC_KS, H + rb0 * NE_PAD + EC_VS, NE_PAD, qf, s0, s1, m, l, kvb,
            [&](f32x16& p0, f32x16& p1, int t, bool& v0, bool& v1) { const bool b0 = (mysel >> (2 * t)) & 1ull, b1 = (mysel >> (2 * t + 1)) & 1ull;
                if (64 * t + 63 <= t0) { v0 = b0; v1 = b1; }
                else {
#pragma unroll
                    for (int r = 0; r < 16; ++r) { const int key = 64 * t + crow(r, hi);
                        p0[r] = (b0 && key <= tq) ? p0[r] : NEGBIG; p1[r] = (b1 && key + 32 <= tq) ? p1[r] : NEGBIG; } } });
        const float sc = g1 / l;
#pragma unroll
        for (int r = 0; r < 16; ++r) { stash[r * 64] += s0[r] * sc; stash[(16 + r) * 64] += s1[r] * sc; }
    }
    {
        const int tlo = (t0 >= 511) ? ((t0 - 511) >> 6) : 0, thi = (t0 + 31) >> 6;
        unsigned tm = 0u; for (int t = tlo; t <= thi; ++t) tm |= 1u << t;
        f32x16 s0 = {}, s1 = {}; float m = -1e20f, l = 0.f;
        attn_tiles(F, tm, H + rb0 * NE_PAD + EC_KW, H + rb0 * NE_PAD + EC_VW, NE_PAD, qf, s0, s1, m, l, kvb,
            [&](f32x16& p0, f32x16& p1, int t, bool&, bool&) {
                const bool interior = (64 * t + 63 <= t0) && (64 * t + 512 > t0 + 31);
                if (!interior) {
#pragma unroll
                    for (int r = 0; r < 16; ++r) { const int key = 64 * t + crow(r, hi);
                        p0[r] = (key <= tq && key + 512 > tq) ? p0[r] : NEGBIG; p1[r] = (key + 32 <= tq && key + 32 + 512 > tq) ? p1[r] : NEGBIG; } } });
        const float sc = g2 / l;
#pragma unroll
        for (int r = 0; r < 16; ++r) { oa0[r] = stash[r * 64] + s0[r] * sc; oa1[r] = stash[(16 + r) * 64] + s1[r] * sc; }
    }
    store_ot(oa0, oa1, 1.0f, O + (rb0 + tq) * opitch + F.wave * 64, lane);
    __syncthreads();
}

__device__ __forceinline__ void moe_tables(const Frame& F, int layer) {
    LAS int* cntl = (LAS int*)(F.lds + LDS_TAB); LAS int* rbs = cntl + 160;
    __syncthreads();
    if (F.tid < NV) cntl[F.tid] = ((F.tid % 65) == 64) ? HALF_T : (int)__hip_atomic_load(F.ctl + CW_CNT + layer * 256 + F.tid, RLX_AGENT);
    __syncthreads();
    if (F.tid <= NV) { int run = 0; for (int u = 0; u < F.tid; ++u) run += (cntl[u] + 255) >> 8; rbs[F.tid] = run; }
    __syncthreads();
}

constexpr int PH_PER_LAYER = 16, N_PHASES = DEPTH * PH_PER_LAYER;
__global__ void __launch_bounds__(512, 2) fwd(const float* i0, const float* i1, const float* i2, const float* i3, const float* i4, const float* i5, const float* i6, const float* i7, const float* i8, const float* i9, const float* i10, const float* i11, const float* i12, const float* i13, const float* i14, const float* i15, const float* i16, const float* i17, const float* i18, const float* i19, const float* i20, const float* i21, const float* i22, const float* i23, const float* i24, const float* i25, const float* i26, const float* i27, const float* i28, float* out_, unsigned char* ws_, int ph_lo_, int ph_hi_) {
    Args args; args.in[0] = i0; args.in[1] = i1; args.in[2] = i2; args.in[3] = i3; args.in[4] = i4; args.in[5] = i5; args.in[6] = i6; args.in[7] = i7; args.in[8] = i8; args.in[9] = i9; args.in[10] = i10; args.in[11] = i11; args.in[12] = i12; args.in[13] = i13; args.in[14] = i14; args.in[15] = i15; args.in[16] = i16; args.in[17] = i17; args.in[18] = i18; args.in[19] = i19; args.in[20] = i20; args.in[21] = i21; args.in[22] = i22; args.in[23] = i23; args.in[24] = i24; args.in[25] = i25; args.in[26] = i26; args.in[27] = i27; args.in[28] = i28; args.out = out_; args.ws = ws_; args.ph_lo = ph_lo_; args.ph_hi = ph_hi_;
    extern __shared__ __attribute__((aligned(16))) unsigned char lds_raw[];
    Frame F; F.lds = (LAS unsigned char*)lds_raw; F.tid = threadIdx.x; F.lane = F.tid & 63; F.wave = __builtin_amdgcn_readfirstlane(F.tid >> 6);
    F.G = gridDim.x; F.bid = blockIdx.x; F.ws = args.ws; F.ctl = (gu32*)(args.ws + WS_CTL);
    volatile LAS unsigned* MISC = (volatile LAS unsigned*)(F.lds + LDS_MISC);
    if (threadIdx.x < 64) MISC[threadIdx.x] = 0u;
    __syncthreads();
#if MK_ONE_LAUNCH
    constexpr int lo = 0, hi = N_PHASES; constexpr bool multi = true;
#else
    const int lo = args.ph_lo, hi = args.ph_hi; const bool multi = (hi - lo) > 1;
#endif
    XcdBarrier bar; bar.bar = (unsigned*)(F.ctl + CW_BAR); bar.x = 0; bar.st = MISC;
    if (multi) bar = xcd_barrier_post((unsigned*)(F.ctl + CW_BAR), MISC);
#ifndef PHMASK
#define PHMASK 0xffff
#endif
#define IN(k) (((PHMASK >> ((k) & 15)) & 1) && lo <= (k) && (k) < hi)
#ifndef TIMING
#define TIMING 0
#endif
#if TIMING
    if (F.tid == 0) { const unsigned long long t0_ = wall_clock64(); MISC[16] = (unsigned)t0_; MISC[17] = (unsigned)(t0_ >> 32); }
#define SEAM() do { if (multi) xcd_barrier(bar); if (blockIdx.x == 0 && F.tid == 0) { const unsigned long long tn = wall_clock64(); const unsigned long long tp = ((unsigned long long)MISC[17] << 32) | MISC[16]; \
    ((unsigned long long*)(args.ws + WS_CTL + 512 * 1024))[MISC[18]] = tn - tp; MISC[16] = (unsigned)tn; MISC[17] = (unsigned)(tn >> 32); } } while (0)
#define SETPH(k) do { if (F.tid == 0) MISC[18] = (unsigned)(k); } while (0)
#else
#define SEAM() do { if (multi) xcd_barrier(bar); } while (0)
#define SETPH(k)
#endif
#ifndef DUP_K
#define DUP_K -1
#define DUP_PAR 2
#endif
#define NREP(k) ((DUP_K == (k) && (DUP_PAR == 2 || (layer & 1) == DUP_PAR)) ? 2 : 1)
#define PF() Frame P = F; { int t_; asm volatile("v_mbcnt_lo_u32_b32 %0, -1, 0\n\tv_mbcnt_hi_u32_b32 %0, -1, %0" : "=v"(t_)); t_ += F.wave * 64; P.tid = t_; P.lane = t_ & 63; int w_ = F.wave; asm volatile("" : "+s"(w_)); P.wave = w_; GAS unsigned char* p_ = (GAS unsigned char*)args.ws; asm volatile("" : "+s"(p_)); P.ws = (unsigned char*)p_; P.ctl = (gu32*)(p_ + WS_CTL); } \
    unsigned char* ws = P.ws; bf16_t* XB = (bf16_t*)(ws + WS_XB); bf16_t* XB2 = (bf16_t*)(ws + WS_R + R_XB2); bf16_t* XD = (bf16_t*)args.out; (void)XD; bf16_t* H = (bf16_t*)(ws + WS_R + R_H); bf16_t* W = (bf16_t*)(ws + WS_W + wbuf_off(layer)); (void)XB; (void)XB2; (void)H; (void)W;
    LAS int* cntl = (LAS int*)(F.lds + LDS_TAB); LAS int* rbs = cntl + 160;
    for (int layer = 0; layer < DEPTH; ++layer) {
        const int pb = layer * PH_PER_LAYER; const bool even = (layer & 1) == 0; const int jl = layer >> 1;
        const bool ovl = (F.G == 256);
        if (IN(pb + 0) && (layer == 0 || !ovl)) { SETPH(pb + 0); PF();
            prep_weights(P, args, layer, P.bid, P.G); prep_acts(P, args, layer, layer == 0);
            SEAM(); }
        if (IN(pb + 1)) { SETPH(pb + 1); PF();
            { const bf16_t* xin = (layer == 0) ? XB : XB2;
            if (even) { pg8::DenseSched S{(const char*)xin, (const char*)(W + W_IN / 2), DM, DM, T / 256, NE_PAD / 256, P.G, P.bid};
                EpiInEven E{H, (const float*)(ws + WS_ROPE_COS), (const float*)(ws + WS_ROPE_SIN)}; pg8::gemm_phase(P.lds, S, E, P.tid); }
            else { pg8::DenseSched S{(const char*)xin, (const char*)(W + W_IN / 2), DM, DM, T / 256, NO_PAD / 256, P.G, P.bid};
                EpiInOdd E{H, (float*)(ws + WS_LOGF), args.in[I_OD_BF] + jl * 16}; pg8::gemm_phase(P.lds, S, E, P.tid); } }
            SEAM(); }
        if ((DUP_K == 1 && (DUP_PAR == 2 || (layer & 1) == DUP_PAR))) { PF();
            { const bf16_t* xin = (layer == 0) ? XB : XB2;
            if (even) { pg8::DenseSched S{(const char*)xin, (const char*)(W + W_IN / 2), DM, DM, T / 256, NE_PAD / 256, P.G, P.bid};
                EpiInEven E{H, (const float*)(ws + WS_ROPE_COS), (const float*)(ws + WS_ROPE_SIN)}; pg8::gemm_phase(P.lds, S, E, P.tid); }
            else { pg8::DenseSched S{(const char*)xin, (const char*)(W + W_IN / 2), DM, DM, T / 256, NO_PAD / 256, P.G, P.bid};
                EpiInOdd E{H, (float*)(ws + WS_LOGF), args.in[I_OD_BF] + jl * 16}; pg8::gemm_phase(P.lds, S, E, P.tid); } }
            SEAM(); }
        if (even) {
        if (IN(pb + 2)) { SETPH(pb + 2); PF();
                for (int it = P.bid; it < 256; it += P.G) compress_item(P, args, layer, it);
                for (int u0 = 0; u0 < NB * 64; u0 += P.G) { const int u = u0 + (((u0 / P.G) & 1) ? (P.G - 1 - P.bid) : P.bid); if (u >= NB * 64) continue; const int qg = 63 - (u / NB), b = u % NB; dsa_unit(P, args, b, qg, H + EC_QA, NE_PAD); }
            SEAM(); }
        if ((DUP_K == 2 && (DUP_PAR == 2 || (layer & 1) == DUP_PAR))) { PF();
                for (int u0 = 0; u0 < NB * 64; u0 += P.G) { const int u = u0 + (((u0 / P.G) & 1) ? (P.G - 1 - P.bid) : P.bid); if (u >= NB * 64) continue; const int qg = 63 - (u / NB), b = u % NB; dsa_unit(P, args, b, qg, (bf16_t*)(ws + WS_R + 568 * MiB), 1024); }
            SEAM(); }
        if (IN(pb + 3)) { SETPH(pb + 3); PF();
                for (int u0 = 0; u0 < NB * 64; u0 += P.G) { const int u = u0 + (((u0 / P.G) & 1) ? (P.G - 1 - P.bid) : P.bid); if (u >= NB * 64) continue; const int qg = 63 - (u / NB), b = u % NB; nsa_unit(P, args, layer, b, qg, H + EC_QB, NE_PAD); }
            SEAM(); }
        if ((DUP_K == 3 && (DUP_PAR == 2 || (layer & 1) == DUP_PAR))) { PF();
                for (int u0 = 0; u0 < NB * 64; u0 += P.G) { const int u = u0 + (((u0 / P.G) & 1) ? (P.G - 1 - P.bid) : P.bid); if (u >= NB * 64) continue; const int qg = 63 - (u / NB), b = u % NB; nsa_unit(P, args, layer, b, qg, (bf16_t*)(ws + WS_R + 568 * MiB) + 512, 1024); }
            SEAM(); }
        } else {
        if (IN(pb + 2)) { SETPH(pb + 2); PF();
            scan_phase(P, args);
            SEAM(); }
        if (IN(pb + 3)) { SETPH(pb + 3); PF();
                fox_phase(P, args, H, NO_PAD);
            SEAM(); }
        if ((DUP_K == 3 && (DUP_PAR == 2 || (layer & 1) == DUP_PAR))) { PF();
#ifdef FOX_EXPT
                fox_phase<FOX_EXPT>(P, args, (bf16_t*)(ws + WS_R + 568 * MiB), 1024);
#else
                fox_phase(P, args, (bf16_t*)(ws + WS_R + 568 * MiB), 1024);
#endif
            SEAM(); }
        }
        if (IN(pb + 4)) { SETPH(pb + 4); PF();
            { pg8::DenseSched S{(const char*)H, (const char*)(W + W_O / 2), even ? NE_PAD : NO_PAD, DM, T / 256, DM / 256, P.G, P.bid};
              EpiOut E{(layer == 0) ? XB : XB2, (layer == 0) ? XB2 : XB}; pg8::gemm_phase(P.lds, S, E, P.tid); }
            SEAM(); }
        if ((DUP_K == 4 && (DUP_PAR == 2 || (layer & 1) == DUP_PAR))) { PF();
            { pg8::DenseSched S{(const char*)H, (const char*)(W + W_O / 2), even ? NE_PAD : NO_PAD, DM, T / 256, DM / 256, P.G, P.bid};
              EpiOut E{(layer == 0) ? XB : XB2, (bf16_t*)(ws + WS_R + 568 * MiB)}; pg8::gemm_phase(P.lds, S, E, P.tid); }
            SEAM(); }
        if (IN(pb + 5)) { SETPH(pb + 5); PF();
            route_phase(P, args, layer, (layer == 0) ? XB2 : XB, XD, false);
            SEAM(); }
        if ((DUP_K == 5 && (DUP_PAR == 2 || (layer & 1) == DUP_PAR))) { PF();
            route_phase(P, args, layer, (layer == 0) ? XB2 : XB, (bf16_t*)(ws + WS_R + 568 * MiB), true);
            SEAM(); }
        if (IN(pb + 6)) { SETPH(pb + 6); PF();
            const bool side = ovl && layer + 1 < DEPTH;
            if (side && (P.bid >> 3) >= 32 - SIDE_PX) prep_weights(P, args, layer + 1, (P.bid & 7) * SIDE_PX + (P.bid >> 3) - (32 - SIDE_PX), 8 * SIDE_PX);
            else { moe_tables(P, layer);
              MoeSched S{(const char*)XD, (const char*)(W + W_UP / 2), DM, DM, 2, (size_t)512 * DM * 2, rbs, cntl, 0, NV - 1, 0, rbs[NV] * 2, P.G, P.bid, (const int*)(ws + WS_SLOT_TK), true, side ? 32 - SIDE_PX : (P.G >> 3)};
              EpiUp E{(bf16_t*)(ws + WS_R + R_HMID)}; pg8::gemm_phase(P.lds, S, E, P.tid); }
            SEAM(); }
        if ((DUP_K == 6 && (DUP_PAR == 2 || (layer & 1) == DUP_PAR))) { PF();
            { moe_tables(P, layer);
              MoeSched S{(const char*)XD, (const char*)(W + W_UP / 2), DM, DM, 2, (size_t)512 * DM * 2, rbs, cntl, 0, NV - 1, 0, rbs[NV] * 2, P.G, P.bid, (const int*)(ws + WS_SLOT_TK), true, P.G >> 3};
              EpiUp E{(bf16_t*)(ws + WS_R + R_HMID)}; pg8::gemm_phase(P.lds, S, E, P.tid); }
            SEAM(); }
        if (IN(pb + 7)) { SETPH(pb + 7); PF();
                { LAS int* rcache = (LAS int*)(P.lds + LDS_TAB + 4096); if (P.tid < 2) rcache[P.tid] = 0;
                  moe_tables(P, layer);
                  MoeSched S{(const char*)(ws + WS_R + R_HMID), (const char*)(W + W_DN / 2), DFF, DFF, 4, (size_t)DM * DFF * 2, rbs, cntl, 0, NV - 1, 0, rbs[NV] * 4, P.G, P.bid, (const int*)(ws + WS_SLOT_TK), false, P.G >> 3};
                  EpiDown E{(bf16_t*)(ws + WS_R + R_YTOK), (const int*)(ws + WS_SLOT_TK), (const float*)(ws + WS_SLOT_G), cntl, false, rcache}; pg8::gemm_phase(P.lds, S, E, P.tid); }
            SEAM(); }
        if (IN(pb + 8)) { SETPH(pb + 8); PF();
#pragma unroll 1
            for (int hf = 0; hf < 2; ++hf) { int h2 = hf; asm volatile("" : "+s"(h2)); combine_phase(P, args, layer, h2, XD, XB, false); } }
        if (IN(pb + 10)) { PF();
            { pg8::DenseSched S{(const char*)(ws + WS_PB), (const char*)(W + W_P / 2), 256, 256, T / 256, DM / 256, P.G, P.bid};
              EpiPleE E{(bf16_t*)(ws + WS_R + R_E), (float*)(ws + WS_SSQ)}; pg8::gemm_phase(P.lds, S, E, P.tid); }
            SEAM(); }
        if ((DUP_K == 11 && (DUP_PAR == 2 || (layer & 1) == DUP_PAR))) { PF();
            { pg8::DenseSched S{(const char*)(ws + WS_PB), (const char*)(W + W_P / 2), 256, 256, T / 256, DM / 256, P.G, P.bid};
              EpiPleE E{(bf16_t*)(ws + WS_R + R_E), (float*)(ws + WS_SSQ)}; pg8::gemm_phase(P.lds, S, E, P.tid); }
            SEAM(); }
        if (IN(pb + 12)) { SETPH(pb + 12); PF();
            { pg8::DenseSched S{(const char*)XB, (const char*)(W + W_G / 2), DM, DM, T / 256, DM / 256, P.G, P.bid};
              EpiPleG E{XB, (const bf16_t*)(ws + WS_R + R_E), (const float*)(ws + WS_SSQ), args.in[I_PNG] + layer * DM, (layer + 1 < DEPTH) ? XB2 : (bf16_t*)nullptr, (layer + 1 < DEPTH) ? (float*)nullptr : args.out};
              pg8::gemm_phase(P.lds, S, E, P.tid); }
            if (ovl && layer + 1 < DEPTH) prep_acts(P, args, layer + 1, false);
            SEAM(); }
        if ((DUP_K == 12 && (DUP_PAR == 2 || (layer & 1) == DUP_PAR))) { PF();
            { pg8::DenseSched S{(const char*)XB, (const char*)(W + W_G / 2), DM, DM, T / 256, DM / 256, P.G, P.bid};
              EpiPleG E{XB, (const bf16_t*)(ws + WS_R + R_E), (const float*)(ws + WS_SSQ), args.in[I_PNG] + layer * DM, (bf16_t*)(ws + WS_R + 568 * MiB), (float*)nullptr}; pg8::gemm_phase(P.lds, S, E, P.tid); }
            SEAM(); }
    }
#ifdef EXTRA_BAR
    for (int i_ = 0; i_ < EXTRA_BAR; ++i_) { SEAM(); }
#endif
#if TIMING
    {
        VM_WAIT(); __syncthreads(); if (multi) xcd_barrier(bar);
        float ta = 0.f, tb = 0.f;
        for (int l = 0; l < DEPTH; ++l) for (int k = 0; k < 13; ++k) { const float d = (float)((unsigned long long*)(args.ws + WS_CTL + 512 * 1024))[l * 16 + k] * 0.01f;
            if (((TA_MASK >> k) & 1) && (TA_PAR == 2 || (l & 1) == TA_PAR)) ta += d; if (((TB_MASK >> k) & 1) && (TB_PAR == 2 || (l & 1) == TB_PAR)) tb += d; }
        for (size_t i = (size_t)blockIdx.x * 512 + F.tid; i < (size_t)T * DM; i += (size_t)gridDim.x * 512) args.out[i] = ta;
        VM_WAIT(); __syncthreads(); if (multi) xcd_barrier(bar);
        if (blockIdx.x == 0 && F.tid == 0) args.out[0] = tb * 100.f;
    }
#endif
#undef IN
#undef SEAM
}

extern "C" void kernel_launch(void* const* d_in, const int* in_sizes, int n_in, void* d_out, int out_size, void* d_ws, size_t ws_size, hipStream_t stream) {
    static int grid = 0;
    if (grid == 0) {
        if (n_in != 29 || in_sizes[0] != T * DM || out_size != T * DM || ws_size < WS_END) { fprintf(stderr, "kernel_launch: unexpected shapes / workspace (n_in %d, ws %zu, need %zu)\n", n_in, ws_size, (size_t)WS_END); grid = -1; return; }
        int dev = 0, cus = 0, per_cu = 0;
        if (hipGetDevice(&dev) != hipSuccess || hipDeviceGetAttribute(&cus, hipDeviceAttributeMultiprocessorCount, dev) != hipSuccess) { grid = -1; return; }
        if (hipFuncSetAttribute((const void*)fwd, hipFuncAttributeMaxDynamicSharedMemorySize, LDS_BYTES) != hipSuccess) { fprintf(stderr, "kernel_launch: hipFuncSetAttribute failed\n"); grid = -1; return; }
        if (hipOccupancyMaxActiveBlocksPerMultiprocessor(&per_cu, (const void*)fwd, 512, LDS_BYTES) != hipSuccess || per_cu < 1) { fprintf(stderr, "kernel_launch: occupancy query says %d\n", per_cu); }
        (void)hipGetLastError();
        grid = cus;
    }
    if (grid < 0) return;
    if (hipMemsetAsync((char*)d_ws + WS_CTL, 0, CTL_BYTES, stream) != hipSuccess) return;
    Args a{};
    for (int i = 0; i < 29; ++i) a.in[i] = (const float*)d_in[i];
    a.out = (float*)d_out; a.ws = (unsigned char*)d_ws;
#if MK_ONE_LAUNCH
    a.ph_lo = 0; a.ph_hi = N_PHASES;
    hipLaunchKernelGGL(fwd, dim3(grid), dim3(512), LDS_BYTES, stream, a.in[0], a.in[1], a.in[2], a.in[3], a.in[4], a.in[5], a.in[6], a.in[7], a.in[8], a.in[9], a.in[10], a.in[11], a.in[12], a.in[13], a.in[14], a.in[15], a.in[16], a.in[17], a.in[18], a.in[19], a.in[20], a.in[21], a.in[22], a.in[23], a.in[24], a.in[25], a.in[26], a.in[27], a.in[28], a.out, a.ws, a.ph_lo, a.ph_hi);
#else
    for (int ph = 0; ph < N_PHASES; ++ph) {
        if ((ph % PH_PER_LAYER) > 12) continue;
        a.ph_lo = ph; a.ph_hi = ph + 1;
        hipLaunchKernelGGL(fwd, dim3(grid), dim3(512), LDS_BYTES, stream, a.in[0], a.in[1], a.in[2], a.in[3], a.in[4], a.in[5], a.in[6], a.in[7], a.in[8], a.in[9], a.in[10], a.in[11], a.in[12], a.in[13], a.in[14], a.in[15], a.in[16], a.in[17], a.in[18], a.in[19], a.in[20], a.in[21], a.in[22], a.in[23], a.in[24], a.in[25], a.in[26], a.in[27], a.in[28], a.out, a.ws, a.ph_lo, a.ph_hi);
    }
#endif
}
```
